# Optimizing an MI355X kernel written in HIP

```python
import math
import jax
import jax.numpy as jnp
from jax import lax
import numpy as np

D_MODEL = 1024
BATCH = 16
SEQ = 2048
DEPTH = 2

GRID_W = 64
CTX_LEN = 256
EPS = 1e-6

D_MIX = D_MODEL
HY_WIDTH = D_MIX // 2
GLA_WIDTH = D_MIX - HY_WIDTH

HY_ORDER = 2
HY_CONV = 3
HY_EMB = 33
HY_HIDDEN = 64
HY_FREQ = 1.0
HY_TARGET = 1e-2
HY_FAST_PCT = 0.3
HY_SLOW_PCT = 1.5
HY_MIN_DECAY = math.log(1.0 / HY_TARGET) / HY_SLOW_PCT
HY_MAX_DECAY = math.log(1.0 / HY_TARGET) / HY_FAST_PCT
HY_FILTER_STD = 0.01
HY_COLS = (HY_ORDER + 1) * HY_WIDTH

GLA_HEADS = 4
GLA_QK = GLA_WIDTH // 2
GLA_DK = GLA_QK // GLA_HEADS
GLA_DV = GLA_WIDTH // GLA_HEADS
GLA_RANK = 16
GLA_TAU = 16.0
GLA_CHUNK = 64
GLA_COLS = 2 * GLA_QK + 2 * GLA_WIDTH + 2 * GLA_RANK

IN_COLS = HY_COLS + GLA_COLS

N_EXPERTS = 256
TOP_K = 8
N_GROUPS = 8
TOPK_GROUPS = 4
D_EXPERT = 256
ROUTED_SCALE = 2.5
MOE_BLOCK = 128

kernel_name = 'hybrid_hyena_gla_moe_dit_block'


def rmsnorm(x, g):
    x32 = x.astype(jnp.float32)
    y = x32 * lax.rsqrt(jnp.mean(x32 * x32, axis=-1, keepdims=True) + EPS) * g.astype(jnp.float32)
    return y.astype(x.dtype)


def modulate(x, shift, scale):
    return x * (1.0 + scale) + shift


def rev(t):
    return jnp.flip(t, axis=1)


def grid_pos_emb(rows):
    r, col = jnp.meshgrid(jnp.arange(rows, dtype=jnp.float32), jnp.arange(GRID_W, dtype=jnp.float32), indexing='ij')
    quarter = D_MODEL // 4
    omega = 1.0 / (10000.0 ** (jnp.arange(quarter, dtype=jnp.float32) / quarter))
    def emb(p):
        a = p.reshape(-1)[:, None] * omega[None, :]
        return jnp.concatenate([jnp.sin(a), jnp.cos(a)], axis=-1)
    return jnp.concatenate([emb(r), emb(col)], axis=-1)


def hyena_pos_features(L):
    t = jnp.linspace(0.0, 1.0, L, dtype=jnp.float32)[:, None]
    bands = (HY_EMB - 1) // 2
    w = 2.0 * math.pi * jnp.arange(L, dtype=jnp.float32)[:, None] / L
    f = jnp.linspace(1e-4, bands - 1, bands, dtype=jnp.float32)[None, :]
    return jnp.concatenate([t, jnp.cos(f * w), -jnp.sin(f * w)], axis=-1)


def hyena_filters(L, w1, b1, w2, b2, w3):
    pos = hyena_pos_features(L).astype(w1.dtype)
    hid = jnp.sin(HY_FREQ * (pos @ w1 + b1))
    hid = jnp.sin(HY_FREQ * (hid @ w2 + b2))
    h = (hid @ w3).astype(jnp.float32).reshape(L, HY_ORDER, 2, HY_WIDTH)
    t = jnp.linspace(0.0, 1.0, L, dtype=jnp.float32)[:, None]
    deltas = jnp.linspace(HY_MIN_DECAY, HY_MAX_DECAY, HY_WIDTH, dtype=jnp.float32)[None, :]
    return h * jnp.exp(-t * deltas)[:, None, None, :]


def short_conv3(u, w, b):
    up = jnp.pad(u, ((0, 0), (1, 1), (0, 0)))
    return up[:, :-2] * w[0] + up[:, 1:-1] * w[1] + up[:, 2:] * w[2] + b


def long_conv(u, h_fwd, h_bwd, d_skip):
    L = u.shape[1]
    n = 2 * L
    u32 = u.astype(jnp.float32)
    H = jnp.fft.rfft(h_fwd, n=n, axis=0) + jnp.conj(jnp.fft.rfft(h_bwd, n=n, axis=0))
    y = jnp.fft.irfft(jnp.fft.rfft(u32, n=n, axis=1) * H[None], n=n, axis=1)[:, :L]
    return y + u32 * d_skip.astype(jnp.float32)


def hyena_mixer(zh, conv_w, conv_b, filt, skip):
    u = short_conv3(zh, conv_w, conv_b)
    v, x1, x2 = jnp.split(u, 3, axis=-1)
    y = x1.astype(jnp.float32) * long_conv(v, filt[:, 0, 0], filt[:, 0, 1], skip[0])
    y = x2.astype(jnp.float32) * long_conv(y, filt[:, 1, 0], filt[:, 1, 1], skip[1])
    return y.astype(zh.dtype)


def gla_inputs(zg, wa2, ba2):
    B, L, _ = zg.shape
    q, k, v, r, a = jnp.split(zg, [GLA_QK, 2 * GLA_QK, 2 * GLA_QK + GLA_WIDTH, 2 * GLA_QK + 2 * GLA_WIDTH], axis=-1)
    q = q.reshape(B, L, GLA_HEADS, GLA_DK) * (GLA_DK ** -0.5)
    k = k.reshape(B, L, GLA_HEADS, GLA_DK)
    v = v.reshape(B, L, GLA_HEADS, GLA_DV)
    a_f, a_b = jnp.split(a, 2, axis=-1)
    def log_gate(a_dir, w, bias):
        g = jax.nn.log_sigmoid((a_dir @ w + bias).astype(jnp.float32)) / GLA_TAU
        return g.reshape(B, L, GLA_HEADS, GLA_DK)
    return q, k, v, r, log_gate(a_f, wa2[0], ba2[0]), log_gate(a_b, wa2[1], ba2[1])


def gla_chunked(q, k, v, log_a, s0):
    B, L, H, DK = q.shape
    DV = v.shape[-1]
    n = L // GLA_CHUNK
    def chunks(t):
        return t.astype(jnp.float32).reshape(B, n, GLA_CHUNK, H, t.shape[-1]).transpose(1, 0, 3, 2, 4)
    qc, kc, vc, ac = chunks(q), chunks(k), chunks(v), chunks(log_a)
    b = jnp.cumsum(ac, axis=3)
    b_last = b[:, :, :, -1:, :]
    q_e = qc * jnp.exp(b)
    k_e = kc * jnp.exp(-b)
    k_s = kc * jnp.exp(b_last - b)
    mask = jnp.tril(jnp.ones((GLA_CHUNK, GLA_CHUNK), dtype=bool))
    att = jnp.where(mask, jnp.einsum('nbhtd,nbhsd->nbhts', q_e, k_e), 0.0)
    o_intra = jnp.einsum('nbhts,nbhsv->nbhtv', att, vc)
    decay = jnp.exp(b_last[:, :, :, 0, :])
    def step(S, inp):
        qe, ks, vv, dcy = inp
        o = jnp.einsum('bhtd,bhdv->bhtv', qe, S)
        S = dcy[..., None] * S + jnp.einsum('bhsd,bhsv->bhdv', ks, vv)
        return S, o
    s_fin, o_inter = lax.scan(step, s0, (q_e, k_s, vc, decay))
    o = (o_intra + o_inter).transpose(1, 0, 3, 2, 4).reshape(B, L, H, DV)
    return o, s_fin


def gla_final_state(k, v, log_a):
    b = jnp.cumsum(log_a, axis=1)
    ks = k.astype(jnp.float32) * jnp.exp(b[:, -1:] - b)
    return jnp.einsum('blhd,blhv->bhdv', ks, v.astype(jnp.float32))


def gla_output(o, r, g):
    B, L = o.shape[:2]
    o = o * lax.rsqrt(jnp.mean(o * o, axis=-1, keepdims=True) + EPS) * g.astype(jnp.float32)
    o = o.reshape(B, L, GLA_WIDTH) * jax.nn.silu(r.astype(jnp.float32))
    return o.astype(r.dtype)


def moe_ffn(u, w_r, b_r, w1, w3, w2, ws1, ws3, ws2):
    N, D = u.shape
    s = jax.nn.sigmoid((u @ w_r).astype(jnp.float32))
    sel = (s + b_r.astype(jnp.float32)).reshape(N, N_GROUPS, N_EXPERTS // N_GROUPS)
    group_score = lax.top_k(sel, 2)[0].sum(-1)
    _, gidx = lax.top_k(group_score, TOPK_GROUPS)
    gmask = jnp.sum(jax.nn.one_hot(gidx, N_GROUPS), axis=1) > 0
    sel = jnp.where(gmask[:, :, None], sel, -jnp.inf).reshape(N, N_EXPERTS)
    _, idx = lax.top_k(sel, TOP_K)
    gate = jnp.take_along_axis(s, idx, axis=1)
    gate = gate / jnp.sum(gate, axis=-1, keepdims=True) * ROUTED_SCALE

    NK = N * TOP_K
    flat_e = idx.reshape(NK).astype(jnp.int32)
    flat_tok = jnp.arange(NK, dtype=jnp.int32) // TOP_K
    flat_g = gate.reshape(NK)
    order = jnp.argsort(flat_e)
    se = flat_e[order]
    counts = jnp.bincount(flat_e, length=N_EXPERTS).astype(jnp.int32)
    start = jnp.cumsum(counts) - counts
    padded = (counts + MOE_BLOCK - 1) // MOE_BLOCK * MOE_BLOCK
    pad_end = jnp.cumsum(padded)
    pad_start = pad_end - padded
    dest = pad_start[se] + jnp.arange(NK, dtype=jnp.int32) - start[se]
    n_blocks = -(-(NK + N_EXPERTS * (MOE_BLOCK - 1)) // MOE_BLOCK)
    n_slots = n_blocks * MOE_BLOCK
    slot_tok = jnp.full((n_slots,), N, dtype=jnp.int32).at[dest].set(flat_tok[order])
    slot_gate = jnp.zeros((n_slots,), jnp.float32).at[dest].set(flat_g[order])
    block_start = jnp.arange(n_blocks, dtype=jnp.int32) * MOE_BLOCK
    block_e = jnp.minimum(jnp.searchsorted(pad_end, block_start, side='right'), N_EXPERTS - 1)
    u_pad = jnp.concatenate([u, jnp.zeros((1, D), u.dtype)], axis=0)

    def expert_block(acc, blk):
        tok, g, e = blk
        xb = u_pad[tok]
        hb = jax.nn.silu(xb @ w1[e]) * (xb @ w3[e])
        yb = (hb @ w2[e]).astype(jnp.float32) * g[:, None]
        return acc.at[tok].add(yb), None

    acc, _ = lax.scan(expert_block, jnp.zeros((N + 1, D), jnp.float32),
                      (slot_tok.reshape(n_blocks, MOE_BLOCK), slot_gate.reshape(n_blocks, MOE_BLOCK), block_e))
    shared = (jax.nn.silu(u @ ws1) * (u @ ws3)) @ ws2
    return (acc[:N] + shared.astype(jnp.float32)).astype(u.dtype)


def setup_inputs(seed: int = 0) -> dict:
    key = jax.random.key(seed)
    k = jax.random.split(key, 30)
    D, E, F = D_MODEL, N_EXPERTS, D_EXPERT
    def nrm(kk, shape, scale):
        return jax.random.normal(kk, shape, jnp.float32) * scale
    return {
        'x': nrm(k[0], (BATCH, SEQ, D), 1.0),
        'c': nrm(k[1], (BATCH, D), 1.0),
        'ctx': nrm(k[2], (BATCH, CTX_LEN, D), 1.0),
        'c_ctx': nrm(k[3], (D,), 1.0),
        'ada_w': nrm(k[4], (DEPTH, D, 6 * D), 0.5 * D ** -0.5),
        'ada_b': nrm(k[5], (DEPTH, 6 * D), 0.02),
        'norm1_g': 1.0 + nrm(k[6], (DEPTH, D), 0.02),
        'norm2_g': 1.0 + nrm(k[7], (DEPTH, D), 0.02),
        'w_in': nrm(k[8], (DEPTH, D, IN_COLS), D ** -0.5),
        'w_out': nrm(k[9], (DEPTH, D_MIX, D), D_MIX ** -0.5),
        'hy_conv_w': nrm(k[10], (DEPTH, HY_CONV, HY_COLS), HY_CONV ** -0.5),
        'hy_conv_b': nrm(k[11], (DEPTH, HY_COLS), 0.02),
        'hy_f_w1': nrm(k[12], (DEPTH, HY_EMB, HY_HIDDEN), HY_EMB ** -0.5),
        'hy_f_b1': nrm(k[13], (DEPTH, HY_HIDDEN), 0.1),
        'hy_f_w2': nrm(k[14], (DEPTH, HY_HIDDEN, HY_HIDDEN), HY_HIDDEN ** -0.5),
        'hy_f_b2': nrm(k[15], (DEPTH, HY_HIDDEN), 0.1),
        'hy_f_w3': nrm(k[16], (DEPTH, HY_HIDDEN, HY_ORDER * 2 * HY_WIDTH), HY_FILTER_STD),
        'hy_skip': nrm(k[17], (DEPTH, HY_ORDER, HY_WIDTH), 0.5),
        'gla_wa2': nrm(k[18], (DEPTH, 2, GLA_RANK, GLA_QK), GLA_RANK ** -0.5),
        'gla_ba2': nrm(k[19], (DEPTH, 2, GLA_QK), 0.5),
        'gla_norm_g': 1.0 + nrm(k[20], (DEPTH, GLA_DV), 0.02),
        'router_w': nrm(k[21], (DEPTH, D, E), D ** -0.5),
        'router_b': nrm(k[22], (DEPTH, E), 0.01),
        'exp_w1': nrm(k[23], (DEPTH, E, D, F), D ** -0.5),
        'exp_w3': nrm(k[24], (DEPTH, E, D, F), D ** -0.5),
        'exp_w2': nrm(k[25], (DEPTH, E, F, D), F ** -0.5),
        'sh_w1': nrm(k[26], (DEPTH, D, F), D ** -0.5),
        'sh_w3': nrm(k[27], (DEPTH, D, F), D ** -0.5),
        'sh_w2': nrm(k[28], (DEPTH, F, D), F ** -0.5),
        'final_g': 1.0 + nrm(k[29], (D,), 0.02),
    }


def reference(x, c, ctx, c_ctx, ada_w, ada_b, norm1_g, norm2_g, w_in, w_out, hy_conv_w, hy_conv_b,
              hy_f_w1, hy_f_b1, hy_f_w2, hy_f_b2, hy_f_w3, hy_skip, gla_wa2, gla_ba2, gla_norm_g,
              router_w, router_b, exp_w1, exp_w3, exp_w2, sh_w1, sh_w3, sh_w2, final_g):
    B, L, D = x.shape
    Lc = ctx.shape[1]
    rows = L // GRID_W
    xs = x + grid_pos_emb(rows).astype(x.dtype)
    xc = ctx
    cond = jax.nn.silu(c)
    cond_ctx = jax.nn.silu(c_ctx)
    zero_state = jnp.zeros((B, GLA_HEADS, GLA_DK, GLA_DV), jnp.float32)
    for l in range(DEPTH):
        last = l == DEPTH - 1
        mod = (cond @ ada_w[l] + ada_b[l])[:, None, :]
        mod_c = (cond_ctx @ ada_w[l] + ada_b[l])[None, None, :]
        sh1, sc1, g1, sh2, sc2, g2 = jnp.split(mod, 6, axis=-1)
        csh1, csc1, cg1, csh2, csc2, cg2 = jnp.split(mod_c, 6, axis=-1)
        hy_w = (hy_f_w1[l], hy_f_b1[l], hy_f_w2[l], hy_f_b2[l], hy_f_w3[l])

        z = modulate(rmsnorm(xs, norm1_g[l]), sh1, sc1) @ w_in[l]
        hcn = modulate(rmsnorm(xc, norm1_g[l]), csh1, csc1)
        q, k, v, r, la_f, la_b = gla_inputs(z[..., HY_COLS:], gla_wa2[l], gla_ba2[l])
        if last:
            _, kc, vc, _, lac_f, lac_b = gla_inputs(hcn @ w_in[l][:, HY_COLS:], gla_wa2[l], gla_ba2[l])
            s_f = gla_final_state(kc, vc, lac_f)
            s_b = gla_final_state(rev(kc), rev(vc), rev(lac_b))
        else:
            zc = hcn @ w_in[l]
            qc, kc, vc, rc, lac_f, lac_b = gla_inputs(zc[..., HY_COLS:], gla_wa2[l], gla_ba2[l])
            oc_f, s_f = gla_chunked(qc, kc, vc, lac_f, zero_state)
            oc_b, s_b = gla_chunked(rev(qc), rev(kc), rev(vc), rev(lac_b), zero_state)
            yc_gla = gla_output(oc_f + rev(oc_b), rc, gla_norm_g[l])
            yc_hy = hyena_mixer(zc[..., :HY_COLS], hy_conv_w[l], hy_conv_b[l],
                                hyena_filters(Lc, *hy_w), hy_skip[l])
            xc = xc + cg1 * (jnp.concatenate([yc_hy, yc_gla], axis=-1) @ w_out[l])
        y_hy = hyena_mixer(z[..., :HY_COLS], hy_conv_w[l], hy_conv_b[l], hyena_filters(L, *hy_w), hy_skip[l])
        o_f, _ = gla_chunked(q, k, v, la_f, s_f)
        o_b, _ = gla_chunked(rev(q), rev(k), rev(v), rev(la_b), s_b)
        y_gla = gla_output(o_f + rev(o_b), r, gla_norm_g[l])
        xs = xs + g1 * (jnp.concatenate([y_hy, y_gla], axis=-1) @ w_out[l])

        moe_w = (router_w[l], router_b[l], exp_w1[l], exp_w3[l], exp_w2[l], sh_w1[l], sh_w3[l], sh_w2[l])
        u = modulate(rmsnorm(xs, norm2_g[l]), sh2, sc2).reshape(B * L, D)
        if last:
            xs = xs + g2 * moe_ffn(u, *moe_w).reshape(B, L, D)
        else:
            uc = modulate(rmsnorm(xc, norm2_g[l]), csh2, csc2).reshape(B * Lc, D)
            out = moe_ffn(jnp.concatenate([u, uc], axis=0), *moe_w)
            xs = xs + g2 * out[:B * L].reshape(B, L, D)
            xc = xc + cg2 * out[B * L:].reshape(B, Lc, D)
    return rmsnorm(xs, final_g)
```

```cpp
#include <hip/hip_runtime.h>
#include <hip/hip_bf16.h>
#include <stdint.h>
#include <string.h>

typedef __hip_bfloat16 bf16;

constexpr int D = 1024, NB = 16, SEQ = 2048, LC = 256, DEPTH = 2;
constexpr int NL = NB * SEQ, NC = NB * LC, NT = NL + NC;
constexpr int HYW = 512, HYCOLS = 1536, GLACOLS = 1568, INCOLS = 3104;
constexpr int NE = 256, TOPK = 8, DE = 256;
constexpr int NSLOT = NT * TOPK + NE * 256;
constexpr float EPS = 1e-6f;
constexpr float HY_MIN_DECAY = 3.0701134573253945f;
constexpr float HY_MAX_DECAY = 15.350567286626973f;
constexpr int GSTR_L = 4096, GSTR_C = 512;
constexpr int WIN_ROWS = HYCOLS;
constexpr int GW_ROWS = 7 * 256;

__device__ __forceinline__ float bf2f(bf16 v) { return __bfloat162float(v); }
__device__ __forceinline__ bf16 f2bf(float v) { return __float2bfloat16(v); }
__device__ __forceinline__ float silu_f(float x) { return x / (1.f + __expf(-x)); }
__device__ __forceinline__ float sigmoid_f(float x) { return 1.f / (1.f + __expf(-x)); }
__device__ __forceinline__ float logsigmoid_f(float x) { return fminf(x, 0.f) - __logf(1.f + __expf(-fabsf(x))); }

__device__ __forceinline__ float shx_f(float v, int mask, int lane) { return __int_as_float(__builtin_amdgcn_ds_bpermute((lane ^ mask) << 2, __float_as_int(v))); }
__device__ __forceinline__ int shx_i(int v, int mask, int lane) { return __builtin_amdgcn_ds_bpermute((lane ^ mask) << 2, v); }
__device__ __forceinline__ float shl_f(float v, int src) { return __int_as_float(__builtin_amdgcn_ds_bpermute(src << 2, __float_as_int(v))); }
__device__ __forceinline__ int shl_i(int v, int src) { return __builtin_amdgcn_ds_bpermute(src << 2, v); }
__device__ __forceinline__ float wave_sum(float v, int lane) {
#pragma unroll
  for (int o = 32; o > 0; o >>= 1) v += shx_f(v, o, lane);
  return v;
}

struct Inputs {
  const float *x, *c, *ctx, *c_ctx, *ada_w, *ada_b, *norm1_g, *norm2_g, *w_in, *w_out, *hy_conv_w, *hy_conv_b,
      *hy_f_w1, *hy_f_b1, *hy_f_w2, *hy_f_b2, *hy_f_w3, *hy_skip, *gla_wa2, *gla_ba2, *gla_norm_g, *router_w,
      *router_b, *exp_w1, *exp_w3, *exp_w2, *sh_w1, *sh_w3, *sh_w2, *final_g;
};

__device__ __forceinline__ int opq(int v) { asm volatile("" : "+s"(v)); return v; }
__device__ __forceinline__ int tid_opaque() { int t = threadIdx.x; asm volatile("" : "+v"(t)); return t; }
__device__ __forceinline__ int row_batch(int row) { return row < NL ? (row >> 11) : 16; }

#define XB_TMO      128
#define XB_XCNT(j)  (256  + 64 * (j))
#define XB_XSUB(j)  (1280 + 64 * (j))
#define XB_XGEN(j)  (2304 + 64 * (j))
#define XB_TOP      3328
#define XB_TOPGEN   3392
#define XCD_BAR_WORDS 3456
#define XB_SPIN_CAP (1u << 18)
#define LAS __attribute__((address_space(3)))

__device__ __forceinline__ unsigned xb_ld(unsigned* p)              { return __hip_atomic_load(p, __ATOMIC_RELAXED, __HIP_MEMORY_SCOPE_AGENT); }
__device__ __forceinline__ unsigned xb_add(unsigned* p, unsigned v) { return __hip_atomic_fetch_add(p, v, __ATOMIC_RELAXED, __HIP_MEMORY_SCOPE_AGENT); }
__device__ __forceinline__ unsigned xb_xcc_id() { return (unsigned)__builtin_amdgcn_s_getreg((3 << 11) | 20) & 0xFu; }
#define XB_SPIN(cond, bar) do { unsigned _sp = 0; while (cond) { __builtin_amdgcn_s_sleep(1); \
    if ((++_sp & 255u) == 0u) { if (xb_ld(&(bar)[XB_TMO])) break; if (_sp > XB_SPIN_CAP) { atomicAdd(&(bar)[XB_TMO], 1u); break; } } } } while (0)

struct XcdBarrier {
    unsigned* bar; unsigned x;
    volatile LAS unsigned* st;
};

__device__ __forceinline__ XcdBarrier xcd_barrier_post(unsigned* bar, volatile LAS unsigned* st) {
    XcdBarrier b; b.bar = bar; b.x = xb_xcc_id(); b.st = st;
    if (threadIdx.x == 0) (void)xb_add(&bar[XB_XCNT(b.x)], 1u);
    return b;
}
__device__ __forceinline__ void xcd_barrier_complete(unsigned* bar, unsigned x, unsigned& nloc, unsigned& nx) {
    const unsigned G = gridDim.x * gridDim.y * gridDim.z;
    unsigned sum, cnt, mine, sp = 0u;
    for (;;) {
        sum = 0u; cnt = 0u; mine = 0u;
#pragma unroll
        for (unsigned j = 0; j < 16; ++j) { const unsigned c = xb_ld(&bar[XB_XCNT(j)]); sum += c; cnt += (c > 0u) ? 1u : 0u; mine = (j == x) ? c : mine; }
        if (sum == G) break;
        __builtin_amdgcn_s_sleep(1);
        if ((++sp & 255u) == 0u) { if (xb_ld(&bar[XB_TMO])) break; if (sp > XB_SPIN_CAP) { atomicAdd(&bar[XB_TMO], 1u); break; } }
    }
    nloc = mine > 0u ? mine : 1u; nx = cnt > 0u ? cnt : 1u;
}
__device__ __forceinline__ void xcd_barrier(const XcdBarrier& b) {
    asm volatile("s_waitcnt vmcnt(0)" ::: "memory");
    __syncthreads();
    if (threadIdx.x == 0) {
        unsigned* bar = b.bar;
        __builtin_amdgcn_s_waitcnt(0);
        unsigned nloc = b.st[0], nx = b.st[1];
        if (nloc == 0u) { xcd_barrier_complete(bar, b.x, nloc, nx); b.st[0] = nloc; b.st[1] = nx; }
        const unsigned old = xb_add(&bar[XB_XSUB(b.x)], 1u);
        const unsigned gen = old / nloc;
        if (old + 1u == (gen + 1u) * nloc) {
            __builtin_amdgcn_fence(__ATOMIC_RELEASE, "agent");
            asm volatile("s_waitcnt vmcnt(0)" ::: "memory");
            const unsigned og = xb_add(&bar[XB_TOP], 1u);
            const unsigned tg = og / nx;
            if (og + 1u == (tg + 1u) * nx) xb_add(&bar[XB_TOPGEN], 1u);
            else XB_SPIN(xb_ld(&bar[XB_TOPGEN]) == tg, bar);
            __builtin_amdgcn_fence(__ATOMIC_ACQUIRE, "agent");
            xb_add(&bar[XB_XGEN(b.x)], 1u);
            asm volatile("s_waitcnt vmcnt(0)" ::: "memory");
        } else {
            XB_SPIN(xb_ld(&bar[XB_XGEN(b.x)]) == gen, bar);
            __builtin_amdgcn_fence(__ATOMIC_ACQUIRE, "agent");
            asm volatile("s_waitcnt vmcnt(0)" ::: "memory");
        }
    }
    __syncthreads();
}

__device__ __forceinline__ void grid_sync(unsigned* bar0, char* stw) {
  unsigned* q = bar0;
  asm volatile("" : "+s"(q));
  XcdBarrier b; b.bar = q; b.x = xb_xcc_id(); b.st = (volatile LAS unsigned*)stw;
  xcd_barrier(b);
}

typedef __attribute__((ext_vector_type(8))) __bf16 bf16x8;
typedef __attribute__((ext_vector_type(16))) float f32x16;
typedef __attribute__((ext_vector_type(4))) float f32x4;
typedef __attribute__((ext_vector_type(2))) float f32x2v;
typedef __attribute__((ext_vector_type(2))) __bf16 bf16x2v;
typedef __attribute__((ext_vector_type(4))) unsigned int u32x4;
typedef __attribute__((ext_vector_type(2))) unsigned int u32x2;

__device__ __forceinline__ unsigned pack_bf16(float a, float b) {
  f32x2v v = {a, b};
  return __builtin_bit_cast(unsigned, __builtin_convertvector(v, bf16x2v));
}
__device__ __forceinline__ int swz(int row, int chunk) { return row * 128 + ((chunk ^ ((row >> 1) & 7)) << 4); }
__device__ __forceinline__ int rowmap(int reg, int lh) { return (reg & 3) + 8 * (reg >> 2) + 4 * lh; }

__device__ __forceinline__ int find_group(const int* __restrict__ pad_start, int m0) {
  int lo = 0, hi = NE - 1;
  while (lo < hi) {
    int mid = (lo + hi + 1) >> 1;
    if (pad_start[mid] <= m0) lo = mid; else hi = mid - 1;
  }
  return lo;
}

__device__ __forceinline__ void cvt_wave_tile(const float* __restrict__ src, bf16* __restrict__ dst, int K, int N, int kt, int ntile, int lane) {
  const int k0 = kt * 64 + (lane & 7) * 8, n0 = ntile * 32 + (lane >> 3) * 4;
  const float* s = src + (size_t)k0 * N + n0;
  const f32x4 v0 = __builtin_nontemporal_load((const f32x4*)(s)), v1 = __builtin_nontemporal_load((const f32x4*)(s + (size_t)N));
  const f32x4 v2 = __builtin_nontemporal_load((const f32x4*)(s + (size_t)2 * N)), v3 = __builtin_nontemporal_load((const f32x4*)(s + (size_t)3 * N));
  const f32x4 v4 = __builtin_nontemporal_load((const f32x4*)(s + (size_t)4 * N)), v5 = __builtin_nontemporal_load((const f32x4*)(s + (size_t)5 * N));
  const f32x4 v6 = __builtin_nontemporal_load((const f32x4*)(s + (size_t)6 * N)), v7 = __builtin_nontemporal_load((const f32x4*)(s + (size_t)7 * N));
  bf16* d = dst + (size_t)n0 * K + k0;
  *(u32x4*)(d) = (u32x4){pack_bf16(v0.x, v1.x), pack_bf16(v2.x, v3.x), pack_bf16(v4.x, v5.x), pack_bf16(v6.x, v7.x)};
  *(u32x4*)(d + (size_t)K) = (u32x4){pack_bf16(v0.y, v1.y), pack_bf16(v2.y, v3.y), pack_bf16(v4.y, v5.y), pack_bf16(v6.y, v7.y)};
  *(u32x4*)(d + (size_t)2 * K) = (u32x4){pack_bf16(v0.z, v1.z), pack_bf16(v2.z, v3.z), pack_bf16(v4.z, v5.z), pack_bf16(v6.z, v7.z)};
  *(u32x4*)(d + (size_t)3 * K) = (u32x4){pack_bf16(v0.w, v1.w), pack_bf16(v2.w, v3.w), pack_bf16(v4.w, v5.w), pack_bf16(v6.w, v7.w)};
}
typedef __attribute__((ext_vector_type(8))) int i32x8;
typedef __attribute__((ext_vector_type(4))) int i32x4;
__device__ __forceinline__ float clamp_fp8(float x) { return __builtin_amdgcn_fmed3f(x, -448.0f, 448.0f); }
__device__ __forceinline__ unsigned pk4_fp8(float a, float b, float c, float d) {
  a = clamp_fp8(a); b = clamp_fp8(b); c = clamp_fp8(c); d = clamp_fp8(d);
  int w = 0;
  w = __builtin_amdgcn_cvt_pk_fp8_f32(a, b, w, false);
  w = __builtin_amdgcn_cvt_pk_fp8_f32(c, d, w, true);
  return (unsigned)w;
}
__device__ __forceinline__ void cvt8_wave_tile(const float* __restrict__ src, unsigned char* __restrict__ dst, int K, int N, int kt, int ntile, int lane) {
  const int k0 = kt * 64 + (lane & 7) * 8, n0 = ntile * 32 + (lane >> 3) * 4;
  const float* s = src + (size_t)k0 * N + n0;
  const float sc = 16.0f;
  const f32x4 v0 = __builtin_nontemporal_load((const f32x4*)(s)) * sc, v1 = __builtin_nontemporal_load((const f32x4*)(s + (size_t)N)) * sc;
  const f32x4 v2 = __builtin_nontemporal_load((const f32x4*)(s + (size_t)2 * N)) * sc, v3 = __builtin_nontemporal_load((const f32x4*)(s + (size_t)3 * N)) * sc;
  const f32x4 v4 = __builtin_nontemporal_load((const f32x4*)(s + (size_t)4 * N)) * sc, v5 = __builtin_nontemporal_load((const f32x4*)(s + (size_t)5 * N)) * sc;
  const f32x4 v6 = __builtin_nontemporal_load((const f32x4*)(s + (size_t)6 * N)) * sc, v7 = __builtin_nontemporal_load((const f32x4*)(s + (size_t)7 * N)) * sc;
  unsigned char* d = dst + (size_t)n0 * K + k0;
  *(u32x2*)(d) = (u32x2){pk4_fp8(v0.x, v1.x, v2.x, v3.x), pk4_fp8(v4.x, v5.x, v6.x, v7.x)};
  *(u32x2*)(d + (size_t)K) = (u32x2){pk4_fp8(v0.y, v1.y, v2.y, v3.y), pk4_fp8(v4.y, v5.y, v6.y, v7.y)};
  *(u32x2*)(d + (size_t)2 * K) = (u32x2){pk4_fp8(v0.z, v1.z, v2.z, v3.z), pk4_fp8(v4.z, v5.z, v6.z, v7.z)};
  *(u32x2*)(d + (size_t)3 * K) = (u32x2){pk4_fp8(v0.w, v1.w, v2.w, v3.w), pk4_fp8(v4.w, v5.w, v6.w, v7.w)};
}
__device__ __forceinline__ void cvt8_job(const float* __restrict__ src, unsigned char* __restrict__ dst, int K, int N, int nmat, int bid, int nblk, int W = 0) {
  const int tid = tid_opaque(), lane = tid & 63, wave = tid >> 6;
  if (W == 0) W = N;
  const int tk = K >> 6, tn = W >> 5, per = tk * tn;
  const int total = per * nmat;
  for (int u = bid * 8 + wave; u < total; u += nblk * 8) {
    const int mat = u / per, r = u - mat * per;
    const int ntile = r / tk, kt = r - ntile * tk;
    cvt8_wave_tile(src + (size_t)mat * K * N, dst + (size_t)mat * K * W, K, N, kt, ntile, lane);
  }
}

__device__ __forceinline__ void cvt_job(const float* __restrict__ src, bf16* __restrict__ dst, int K, int N, int nmat, int bid, int nblk, int W = 0) {
  const int tid = tid_opaque(), lane = tid & 63, wave = tid >> 6;
  if (W == 0) W = N;
  const int tk = K >> 6, tn = W >> 5, per = tk * tn;
  const int total = per * nmat;
  for (int u = bid * 8 + wave; u < total; u += nblk * 8) {
    const int mat = u / per, r = u - mat * per;
    const int ntile = r / tk, kt = r - ntile * tk;
    cvt_wave_tile(src + (size_t)mat * K * N, dst + (size_t)mat * K * W, K, N, kt, ntile, lane);
  }
}

constexpr int G8_HT = 128 * 64;
constexpr int G8_LDS = 8 * G8_HT * 2;

__device__ __forceinline__ int g8_lds_byte(int r, int c) {
  int st = (r >> 4) * 2 + (c >> 5), rr = r & 15, cc = c & 31, ob = rr * 64 + cc * 2;
  return st * 1024 + (ob ^ (((ob >> 9) & 1) << 5));
}
__device__ __forceinline__ void g8_stage_rc(int b, int& R, int& C) {
  int st = b / 1024, sb = b % 1024, sw = sb ^ (((sb >> 9) & 1) << 5);
  R = (st >> 1) * 16 + sw / 64; C = (st & 1) * 32 + (sw % 64) / 2;
}

typedef f32x4 g8acc_t[2][2][4][2];

template <class P>
__device__ __forceinline__ void gemm8_run(const P& p, char* smem, int bid, int nblk) {
  const int ntl = __builtin_amdgcn_readfirstlane(p.ntiles());
  if (bid >= ntl) return;
  bf16* shm = (bf16*)smem;
#define SA(b, h) (shm + ((b) * 2 + (h)) * G8_HT)
#define SB(b, h) (shm + (4 + (b) * 2 + (h)) * G8_HT)
#define GLDS(SRC, DST) __builtin_amdgcn_global_load_lds((const unsigned*)(SRC), (unsigned*)(DST), 16, 0, 0)
#define STAGE_A(PP, BASE, KT) do { GLDS((BASE) + (oa + (KT) * 64), (char*)(PP) + ldsd); GLDS((BASE) + 64 * P::A_PITCH + (oa + (KT) * 64), (char*)(PP) + ldsd + 8192); } while (0)
#define STAGE_B(PP, BASE, OB, KT) do { \
    if constexpr (P::B_GATHER) { GLDS((BASE) + ((((OB) & 0xffffu) * (unsigned)P::B_PITCH + cc) + (KT) * 64), (char*)(PP) + ldsd); \
                                 GLDS((BASE) + ((((OB) >> 16) * (unsigned)P::B_PITCH + cc) + (KT) * 64), (char*)(PP) + ldsd + 8192); } \
    else { GLDS((BASE) + ((OB) + (KT) * 64), (char*)(PP) + ldsd); GLDS((BASE) + 64 * P::B_PITCH + ((OB) + (KT) * 64), (char*)(PP) + ldsd + 8192); } } while (0)
#define LDA(dst, b, h) for (int m = 0; m < 4; ++m) \
    dst[m] = __builtin_shufflevector(*reinterpret_cast<const i32x4*>((char*)SA(b, h) + aoff + m * 2048), \
                                     *reinterpret_cast<const i32x4*>((char*)SA(b, h) + aoff + m * 2048 + 1024), 0, 1, 2, 3, 4, 5, 6, 7)
#define LDB(dst, b, h) for (int n = 0; n < 2; ++n) \
    dst[n] = __builtin_shufflevector(*reinterpret_cast<const i32x4*>((char*)SB(b, h) + boff + n * 2048), \
                                     *reinterpret_cast<const i32x4*>((char*)SB(b, h) + boff + n * 2048 + 1024), 0, 1, 2, 3, 4, 5, 6, 7)
#define FRAG_LO(x) __builtin_bit_cast(bf16x8, __builtin_shufflevector(x, x, 0, 1, 2, 3))
#define FRAG_HI(x) __builtin_bit_cast(bf16x8, __builtin_shufflevector(x, x, 4, 5, 6, 7))
#define MMA(ai, bj, At_, Bt_) do { __builtin_amdgcn_s_setprio(1); \
    if constexpr (P::FP8) { \
      for (int m = 0; m < 4; ++m) for (int n = 0; n < 2; ++n) \
        asm volatile("v_mfma_scale_f32_16x16x128_f8f6f4 %0, %1, %2, %0, %3, %3 op_sel_hi:[0,0,0]" \
                     : "+v"(acc[ai][bj][m][n]) : "v"(At_[m]), "v"(Bt_[n]), "v"(mxs)); \
    } else { \
      for (int m = 0; m < 4; ++m) for (int n = 0; n < 2; ++n) { \
        acc[ai][bj][m][n] = __builtin_amdgcn_mfma_f32_16x16x32_bf16(FRAG_LO(At_[m]), FRAG_LO(Bt_[n]), acc[ai][bj][m][n], 0, 0, 0); \
        acc[ai][bj][m][n] = __builtin_amdgcn_mfma_f32_16x16x32_bf16(FRAG_HI(At_[m]), FRAG_HI(Bt_[n]), acc[ai][bj][m][n], 0, 0, 0); } \
    } \
    __builtin_amdgcn_s_setprio(0); } while (0)
#define WAIT_V(n) asm volatile("s_waitcnt vmcnt(" #n ")" ::: "memory")
#define WAIT_L(n) asm volatile("s_waitcnt lgkmcnt(" #n ")" ::: "memory")
#define BAR __builtin_amdgcn_s_barrier()
#define SCHED __builtin_amdgcn_sched_barrier(0)

  typename P::Ctx cur, nxt;
  p.tile(bid, cur);
  int aoff, boff, ldsd;
  unsigned oa, cc, ob0, ob1;
  bool wr1;
  {
    const int tid = tid_opaque();
    const int wid = tid >> 6, lane = tid & 63, wr = wid >> 2, wc = wid & 3, fr = lane & 15, fq = lane >> 4;
    aoff = g8_lds_byte(wr * 64 + fr, fq * 8); boff = g8_lds_byte(wc * 32 + fr, fq * 8);
    ldsd = tid * 16; wr1 = (wr == 1);
    int R0, C0;
    g8_stage_rc(tid * 16, R0, C0);
    cc = C0;
    oa = (((R0 >> 2) & 3) * 16 + (R0 >> 4) * 4 + (R0 & 3)) * P::A_PITCH + C0;
    if constexpr (P::B_GATHER) {
      ob0 = p.b_row(cur, 0, R0) | (p.b_row(cur, 0, R0 + 64) << 16);
      ob1 = p.b_row(cur, 1, R0) | (p.b_row(cur, 1, R0 + 64) << 16);
    } else { ob0 = R0 * P::B_PITCH + C0; ob1 = ob0; }
  }
  const bf16* ca0 = p.a_base(cur, 0);
  const bf16* ca1 = p.a_base(cur, 1);
  const bf16* cb0 = p.b_base(cur, 0);
  const bf16* cb1 = p.b_base(cur, 1);

  g8acc_t acc;
#pragma unroll
  for (int a0 = 0; a0 < 2; ++a0)
#pragma unroll
    for (int b0 = 0; b0 < 2; ++b0)
#pragma unroll
      for (int m = 0; m < 4; ++m)
#pragma unroll
        for (int n = 0; n < 2; ++n) acc[a0][b0][m][n] = (f32x4){0.f, 0.f, 0.f, 0.f};
  i32x8 At[4], B0[2], B1[2];
  const int mxs = 0x7F7F7F7F;
  const int nt = opq(P::NKT);
  STAGE_B(SB(0, 0), cb0, ob0, 0); STAGE_A(SA(0, 0), ca0, 0);
  STAGE_B(SB(0, 1), cb1, ob1, 0); STAGE_A(SA(0, 1), ca1, 0);
  if (wr1) BAR;
  WAIT_V(4); BAR;
  STAGE_B(SB(1, 0), cb0, ob0, 1); STAGE_A(SA(1, 0), ca0, 1); STAGE_B(SB(1, 1), cb1, ob1, 1);
  WAIT_V(6); BAR;
#pragma unroll 1
  for (int idx = bid;;) {
    const int nidx = idx + nblk;
    const bool has_next = nidx < ntl;
    if (has_next) p.tile(nidx, nxt); else nxt = cur;
    const bf16* na0 = p.a_base(nxt, 0);
    const bf16* na1 = p.a_base(nxt, 1);
    const bf16* nb0 = p.b_base(nxt, 0);
    const bf16* nb1 = p.b_base(nxt, 1);
    unsigned nob0 = ob0, nob1 = ob1;
    if constexpr (P::B_GATHER) {
      const int t2 = tid_opaque();
      int R0, C0;
      g8_stage_rc(t2 * 16, R0, C0);
      nob0 = p.b_row(nxt, 0, R0) | (p.b_row(nxt, 0, R0 + 64) << 16);
      nob1 = p.b_row(nxt, 1, R0) | (p.b_row(nxt, 1, R0 + 64) << 16);
    }
#pragma unroll 1
    for (int t = 0; t < nt; t += 2) {
      const bool last = (t == nt - 2);
      const bf16* a2h0 = last ? na0 : ca0; const bf16* a2h1 = last ? na1 : ca1;
      const bf16* b2h0 = last ? nb0 : cb0; const bf16* b2h1 = last ? nb1 : cb1;
      const int k2 = last ? 0 : t + 2;
      const unsigned q0 = last ? nob0 : ob0, q1 = last ? nob1 : ob1;
      LDB(B0, 0, 0); SCHED; LDA(At, 0, 0); STAGE_A(SA(1, 1), ca1, t + 1);
      WAIT_L(8); BAR; WAIT_L(0); MMA(0, 0, At, B0); BAR; SCHED;
      LDB(B1, 0, 1); STAGE_B(SB(0, 0), b2h0, q0, k2);
      BAR; WAIT_L(0); MMA(0, 1, At, B1); BAR;
      LDA(At, 0, 1); STAGE_A(SA(0, 0), a2h0, k2);
      BAR; WAIT_L(0); MMA(1, 0, At, B0); BAR; SCHED;
      STAGE_B(SB(0, 1), b2h1, q1, k2);
      WAIT_V(6); BAR; MMA(1, 1, At, B1); BAR;
      LDB(B0, 1, 0); SCHED; LDA(At, 1, 0); STAGE_A(SA(0, 1), a2h1, k2);
      WAIT_L(8); BAR; WAIT_L(0); MMA(0, 0, At, B0); BAR; SCHED;
      LDB(B1, 1, 1); STAGE_B(SB(1, 0), b2h0, q0, k2 + 1);
      BAR; WAIT_L(0); MMA(0, 1, At, B1); BAR;
      LDA(At, 1, 1); STAGE_A(SA(1, 0), a2h0, k2 + 1);
      BAR; WAIT_L(0); MMA(1, 0, At, B0); BAR; SCHED;
      STAGE_B(SB(1, 1), b2h1, q1, k2 + 1);
      WAIT_V(6); BAR; MMA(1, 1, At, B1); BAR;
    }
    if constexpr (P::FP8) asm volatile("s_nop 15\n\ts_nop 15" ::: "memory");
    {
      const int t3 = tid_opaque();
      const int wid = t3 >> 6, lane = t3 & 63;
      p.epi(cur, acc, wid >> 2, wid & 3, lane & 15, lane >> 4);
    }
    if (!has_next) break;
#pragma unroll
    for (int a0 = 0; a0 < 2; ++a0)
#pragma unroll
      for (int b0 = 0; b0 < 2; ++b0)
#pragma unroll
        for (int m = 0; m < 4; ++m)
#pragma unroll
          for (int n = 0; n < 2; ++n) acc[a0][b0][m][n] = (f32x4){0.f, 0.f, 0.f, 0.f};
    cur = nxt; ca0 = na0; ca1 = na1; cb0 = nb0; cb1 = nb1;
    ob0 = nob0; ob1 = nob1;
    idx = nidx;
  }
  WAIT_V(0);
  if (!wr1) BAR;
  BAR;
#undef SA
#undef SB
#undef GLDS
#undef STAGE_A
#undef STAGE_B
#undef LDA
#undef LDB
#undef MMA
#undef FRAG_LO
#undef FRAG_HI
#undef WAIT_V
#undef WAIT_L
#undef BAR
#undef SCHED
}

#define G8_FOR_BLK(AI, BJ, M, N) \
  _Pragma("unroll") for (int AI = 0; AI < 2; ++AI) _Pragma("unroll") for (int BJ = 0; BJ < 2; ++BJ) \
  _Pragma("unroll") for (int M = 0; M < 4; ++M) _Pragma("unroll") for (int N = 0; N < 2; ++N)
#define G8_AIDX(AI, M) ((AI) * 128 + wr * 64 + fq * 16 + (M) * 4)
#define G8_BIDX(BJ, N) ((BJ) * 128 + wc * 32 + (N) * 16 + fr)
__device__ __forceinline__ u32x2 pack4_bf16(const f32x4 v) { return (u32x2){pack_bf16(v.x, v.y), pack_bf16(v.z, v.w)}; }
__device__ __forceinline__ unsigned pack4_fp8(const f32x4 v) { return pk4_fp8(v.x, v.y, v.z, v.w); }
__device__ __forceinline__ u32x4 pack8_bf16(const f32x4 a, const f32x4 b) { return (u32x4){pack_bf16(a.x, a.y), pack_bf16(a.z, a.w), pack_bf16(b.x, b.y), pack_bf16(b.z, b.w)}; }
#define G8_FOR_BLK2(AI, BJ, M2, N) \
  _Pragma("unroll") for (int AI = 0; AI < 2; ++AI) _Pragma("unroll") for (int BJ = 0; BJ < 2; ++BJ) \
  _Pragma("unroll") for (int M2 = 0; M2 < 4; M2 += 2) _Pragma("unroll") for (int N = 0; N < 2; ++N)

struct G8InZT {
  static constexpr int NKT = 16; static constexpr bool B_GATHER = false; static constexpr bool FP8 = false; static constexpr int B_PITCH = D; static constexpr int A_PITCH = D;
  template <class C_> __device__ unsigned b_row(const C_&, int, int) const { return 0u; }
  struct Ctx { int t0, z0; };
  const bf16* wt; const bf16* A; bf16* zt; int ntok;
  __device__ int ntiles() const { return 6 * (ntok / 256); }
  __device__ void tile(int idx, Ctx& c) const { int tt = idx / 6; c.z0 = (idx - tt * 6) * 256; c.t0 = tt * 256; }
  __device__ const bf16* a_base(const Ctx& c, int h) const { return A + (size_t)(c.t0 + h * 128) * D; }
  __device__ unsigned a_off(const Ctx&, int, int r) const { return r * D; }
  __device__ const bf16* b_base(const Ctx& c, int h) const { return wt + (size_t)(c.z0 + h * 128) * D; }
  __device__ unsigned b_off(const Ctx&, int, int r) const { return r * D; }
  __device__ void epi(const Ctx& c, g8acc_t& acc, int wr, int wc, int fr, int fq) const {
    G8_FOR_BLK2(ai, bj, m, n) {
      const int tok = c.t0 + G8_AIDX(ai, m), z = c.z0 + G8_BIDX(bj, n);
      *(u32x4*)(zt + (size_t)z * NT + tok) = pack8_bf16(acc[ai][bj][m][n], acc[ai][bj][m + 1][n]);
    }
  }
};
struct G8InG {
  static constexpr int NKT = 8; static constexpr bool B_GATHER = false; static constexpr bool FP8 = true; static constexpr int B_PITCH = D / 2; static constexpr int A_PITCH = D / 2;
  template <class C_> __device__ unsigned b_row(const C_&, int, int) const { return 0u; }
  struct Ctx { int c0, t0; };
  const unsigned char* wt; const unsigned char* A; bf16* zg;
  __device__ int ntiles() const { return 7 * (NT / 256); }
  __device__ void tile(int idx, Ctx& c) const { int tt = idx / 7; c.t0 = tt * 256; c.c0 = (idx - tt * 7) * 256; }
  __device__ const bf16* a_base(const Ctx& c, int h) const { return (const bf16*)(wt + (size_t)(c.c0 + h * 128) * D); }
  __device__ unsigned a_off(const Ctx&, int, int r) const { return r * (D / 2); }
  __device__ const bf16* b_base(const Ctx& c, int h) const { return (const bf16*)(A + (size_t)(c.t0 + h * 128) * D); }
  __device__ unsigned b_off(const Ctx&, int, int r) const { return r * (D / 2); }
  __device__ void epi(const Ctx& c, g8acc_t& acc, int wr, int wc, int fr, int fq) const {
    const float isc = 1.0f / 16.0f;
    G8_FOR_BLK2(ai, bj, m, n) {
      const int col = c.c0 + G8_AIDX(ai, m), tok = c.t0 + G8_BIDX(bj, n);
      if (col < GLACOLS) *(u32x4*)(zg + (size_t)tok * GLACOLS + col) = pack8_bf16(acc[ai][bj][m][n] * isc, acc[ai][bj][m + 1][n] * isc);
    }
  }
};
struct G8Out {
  static constexpr int NKT = 16; static constexpr bool B_GATHER = false; static constexpr bool FP8 = false; static constexpr int B_PITCH = D; static constexpr int A_PITCH = D;
  template <class C_> __device__ unsigned b_row(const C_&, int, int) const { return 0u; }
  struct Ctx { int c0, t0; };
  int mrows; const bf16* ymix; const bf16* wt; const float* modl; float* xs;
  __device__ int ntiles() const { return (mrows / 256) * 4; }
  __device__ void tile(int idx, Ctx& c) const { c.t0 = (idx >> 2) * 256; c.c0 = (idx & 3) * 256; }
  __device__ const bf16* a_base(const Ctx& c, int h) const { return wt + (size_t)(c.c0 + h * 128) * D; }
  __device__ unsigned a_off(const Ctx&, int, int r) const { return r * D; }
  __device__ const bf16* b_base(const Ctx& c, int h) const { return ymix + (size_t)(c.t0 + h * 128) * D; }
  __device__ unsigned b_off(const Ctx&, int, int r) const { return r * D; }
  __device__ void epi(const Ctx& c, g8acc_t& acc, int wr, int wc, int fr, int fq) const {
    const float* g1 = modl + (size_t)row_batch(c.t0) * 6 * D + 2 * D;
    G8_FOR_BLK(ai, bj, m, n) {
      const int col = c.c0 + G8_AIDX(ai, m), tok = c.t0 + G8_BIDX(bj, n);
      float* xp = xs + (size_t)tok * D + col;
      *(f32x4*)xp = *(const f32x4*)xp + *(const f32x4*)(g1 + col) * acc[ai][bj][m][n];
    }
  }
};
struct G8Router {
  static constexpr int NKT = 16; static constexpr bool B_GATHER = false; static constexpr bool FP8 = false; static constexpr int B_PITCH = D; static constexpr int A_PITCH = D;
  template <class C_> __device__ unsigned b_row(const C_&, int, int) const { return 0u; }
  struct Ctx { int t0; };
  int mrows; const bf16* A; const bf16* rwt; float* logits;
  __device__ int ntiles() const { return mrows / 256; }
  __device__ void tile(int idx, Ctx& c) const { c.t0 = idx * 256; }
  __device__ const bf16* a_base(const Ctx&, int h) const { return rwt + (size_t)(h * 128) * D; }
  __device__ unsigned a_off(const Ctx&, int, int r) const { return r * D; }
  __device__ const bf16* b_base(const Ctx& c, int h) const { return A + (size_t)(c.t0 + h * 128) * D; }
  __device__ unsigned b_off(const Ctx&, int, int r) const { return r * D; }
  __device__ void epi(const Ctx& c, g8acc_t& acc, int wr, int wc, int fr, int fq) const {
    G8_FOR_BLK(ai, bj, m, n) {
      const int e = G8_AIDX(ai, m), tok = c.t0 + G8_BIDX(bj, n);
      *(f32x4*)(logits + (size_t)tok * NE + e) = acc[ai][bj][m][n];
    }
  }
};
struct G8ShUp {
  static constexpr int NKT = 8; static constexpr bool B_GATHER = false; static constexpr bool FP8 = true; static constexpr int B_PITCH = D / 2; static constexpr int A_PITCH = D / 2;
  template <class C_> __device__ unsigned b_row(const C_&, int, int) const { return 0u; }
  struct Ctx { int t0, hb; };
  int mrows; const unsigned char* A8; const unsigned char* s1t; const unsigned char* s3t; unsigned char* hs;
  __device__ int ntiles() const { return (mrows / 256) * 2; }
  __device__ void tile(int idx, Ctx& c) const { c.t0 = (idx >> 1) * 256; c.hb = (idx & 1) * 128; }
  __device__ const bf16* a_base(const Ctx& c, int h) const { return (const bf16*)((h ? s3t : s1t) + (size_t)c.hb * D); }
  __device__ unsigned a_off(const Ctx&, int, int r) const { return r * (D / 2); }
  __device__ const bf16* b_base(const Ctx& c, int h) const { return (const bf16*)(A8 + (size_t)(c.t0 + h * 128) * D); }
  __device__ unsigned b_off(const Ctx&, int, int r) const { return r * (D / 2); }
  __device__ void epi(const Ctx& c, g8acc_t& acc, int wr, int wc, int fr, int fq) const {
    const float isc = 1.0f / 16.0f;
#pragma unroll
    for (int bj = 0; bj < 2; ++bj)
#pragma unroll
      for (int n = 0; n < 2; ++n) {
        const int hcol = c.hb + wr * 64 + fq * 16, tok = c.t0 + G8_BIDX(bj, n);
        u32x4 o;
#pragma unroll
        for (int m = 0; m < 4; ++m) {
          const f32x4 u = acc[0][bj][m][n] * isc, v = acc[1][bj][m][n] * isc;
          const unsigned w = pk4_fp8(silu_f(u.x) * v.x, silu_f(u.y) * v.y, silu_f(u.z) * v.z, silu_f(u.w) * v.w);
          if (m == 0) o.x = w; else if (m == 1) o.y = w; else if (m == 2) o.z = w; else o.w = w;
        }
        *(u32x4*)(hs + (size_t)tok * DE + hcol) = o;
      }
  }
};
struct G8Up {
  static constexpr int NKT = 8; static constexpr bool B_GATHER = true; static constexpr bool FP8 = true; static constexpr int B_PITCH = D / 2; static constexpr int A_PITCH = D / 2;
  struct Ctx { int s0, hb, grp; };
  const unsigned char* A8; const int* slot_tok; const int* pad_start; const unsigned char* w1t; const unsigned char* w3t; unsigned char* H; const unsigned short* tile_e;
  __device__ int ntiles() const { return (pad_start[NE] >> 8) * 2; }
  __device__ void tile(int idx, Ctx& c) const { c.s0 = (idx >> 1) * 256; c.hb = (idx & 1) * 128; c.grp = __builtin_amdgcn_readfirstlane((int)tile_e[idx >> 1]); }
  __device__ const bf16* a_base(const Ctx& c, int h) const { return (const bf16*)((h ? w3t : w1t) + ((size_t)c.grp * DE + c.hb) * D); }
  __device__ unsigned a_off(const Ctx&, int, int r) const { return r * (D / 2); }
  __device__ const bf16* b_base(const Ctx&, int) const { return (const bf16*)A8; }
  __device__ unsigned b_off(const Ctx&, int, int) const { return 0u; }
  __device__ unsigned b_row(const Ctx& c, int h, int r) const { int t = slot_tok[c.s0 + h * 128 + r]; t = (t < 0 || t >= NT) ? 0 : t; return (unsigned)t; }
  __device__ void epi(const Ctx& c, g8acc_t& acc, int wr, int wc, int fr, int fq) const {
    const float isc = 1.0f / 16.0f;
#pragma unroll
    for (int bj = 0; bj < 2; ++bj)
#pragma unroll
      for (int n = 0; n < 2; ++n) {
        const int hcol = c.hb + wr * 64 + fq * 16, slot = c.s0 + G8_BIDX(bj, n);
        u32x4 o;
#pragma unroll
        for (int m = 0; m < 4; ++m) {
          const f32x4 u = acc[0][bj][m][n] * isc, v = acc[1][bj][m][n] * isc;
          const unsigned w = pk4_fp8(silu_f(u.x) * v.x, silu_f(u.y) * v.y, silu_f(u.z) * v.z, silu_f(u.w) * v.w);
          if (m == 0) o.x = w; else if (m == 1) o.y = w; else if (m == 2) o.z = w; else o.w = w;
        }
        *(u32x4*)(H + (size_t)slot * DE + hcol) = o;
      }
  }
};
struct G8ShDown {
  static constexpr int NKT = 2; static constexpr bool B_GATHER = false; static constexpr bool FP8 = true; static constexpr int B_PITCH = DE / 2; static constexpr int A_PITCH = DE / 2;
  template <class C_> __device__ unsigned b_row(const C_&, int, int) const { return 0u; }
  struct Ctx { int c0, t0; };
  int mrows; const unsigned char* hs; const unsigned char* wt; const float* modl; float* xs;
  __device__ int ntiles() const { return (mrows / 256) * 4; }
  __device__ void tile(int idx, Ctx& c) const { c.t0 = (idx >> 2) * 256; c.c0 = (idx & 3) * 256; }
  __device__ const bf16* a_base(const Ctx& c, int h) const { return (const bf16*)(wt + (size_t)(c.c0 + h * 128) * DE); }
  __device__ unsigned a_off(const Ctx&, int, int r) const { return r * (DE / 2); }
  __device__ const bf16* b_base(const Ctx& c, int h) const { return (const bf16*)(hs + (size_t)(c.t0 + h * 128) * DE); }
  __device__ unsigned b_off(const Ctx&, int, int r) const { return r * (DE / 2); }
  __device__ void epi(const Ctx& c, g8acc_t& acc, int wr, int wc, int fr, int fq) const {
    const float* g2 = modl + (size_t)row_batch(c.t0) * 6 * D + 5 * D;
    const float isc = 1.0f / 16.0f;
    G8_FOR_BLK(ai, bj, m, n) {
      const int col = c.c0 + G8_AIDX(ai, m), tok = c.t0 + G8_BIDX(bj, n);
      float* xp = xs + (size_t)tok * D + col;
      *(f32x4*)xp = *(const f32x4*)xp + *(const f32x4*)(g2 + col) * (acc[ai][bj][m][n] * isc);
    }
  }
};
struct G8Down {
  static constexpr int NKT = 2; static constexpr bool B_GATHER = false; static constexpr bool FP8 = true; static constexpr int B_PITCH = DE / 2; static constexpr int A_PITCH = DE / 2;
  struct Ctx { int c0, s0, grp; };
  const unsigned char* H; const int* pad_start; const unsigned char* w2t; unsigned char* Y; const unsigned short* tile_e;
  template <class C_> __device__ unsigned b_row(const C_&, int, int) const { return 0u; }
  __device__ int ntiles() const { return (pad_start[NE] >> 8) * 4; }
  __device__ void tile(int idx, Ctx& c) const { c.s0 = (idx >> 2) * 256; c.c0 = (idx & 3) * 256; c.grp = __builtin_amdgcn_readfirstlane((int)tile_e[idx >> 2]); }
  __device__ const bf16* a_base(const Ctx& c, int h) const { return (const bf16*)(w2t + ((size_t)c.grp * D + c.c0 + h * 128) * DE); }
  __device__ unsigned a_off(const Ctx&, int, int r) const { return r * (DE / 2); }
  __device__ const bf16* b_base(const Ctx& c, int h) const { return (const bf16*)(H + (size_t)(c.s0 + h * 128) * DE); }
  __device__ unsigned b_off(const Ctx&, int, int r) const { return r * (DE / 2); }
  __device__ void epi(const Ctx& c, g8acc_t& acc, int wr, int wc, int fr, int fq) const {
    const float isc = 1.0f / 16.0f;
#pragma unroll
    for (int ai = 0; ai < 2; ++ai)
#pragma unroll
      for (int bj = 0; bj < 2; ++bj)
#pragma unroll
        for (int n = 0; n < 2; ++n) {
          const int col = c.c0 + G8_AIDX(ai, 0), slot = c.s0 + G8_BIDX(bj, n);
          u32x4 o;
          o.x = pack4_fp8(acc[ai][bj][0][n] * isc); o.y = pack4_fp8(acc[ai][bj][1][n] * isc);
          o.z = pack4_fp8(acc[ai][bj][2][n] * isc); o.w = pack4_fp8(acc[ai][bj][3][n] * isc);
          *(u32x4*)(Y + (size_t)slot * D + col) = o;
        }
  }
};

constexpr int UST = 2056;
constexpr int HY_U_BYTES = 16 * UST * 2;
constexpr int TCOPY = 2064;
constexpr int HY_T_BYTES = 4 * TCOPY * 4;
constexpr int HY_LDS = HY_U_BYTES + HY_T_BYTES;
constexpr int USTC = 264;
constexpr int TCOPYC = 264;

__device__ __forceinline__ f32x4 mfma16(bf16x8 a, bf16x8 b, f32x4 c) {
  return __builtin_amdgcn_mfma_f32_16x16x32_bf16(a, b, c, 0, 0, 0);
}
__device__ __forceinline__ float bflo(unsigned v) { return __uint_as_float(v << 16); }
__device__ __forceinline__ float bfhi(unsigned v) { return __uint_as_float(v & 0xffff0000u); }
__device__ __forceinline__ float ldbf(const bf16* p) { return bf2f(*p); }

template <int GSTR, int TCP>
__device__ __forceinline__ void hy_load_tables(const bf16* __restrict__ G, int c, unsigned* T) {
  constexpr int NCH = GSTR / 8;
  for (int q = tid_opaque(); q < 2 * NCH; q += 512) {
    int o = q / NCH, ch = q - o * NCH;
    const unsigned* s32 = (const unsigned*)(G + ((size_t)(o * 512 + c)) * GSTR);
    u32x4 a = *(const u32x4*)(s32 + 4 * ch);
    unsigned nx = (ch + 1 < NCH) ? s32[4 * ch + 4] : 0u;
    unsigned* d0 = T + o * 2 * TCP;
    unsigned* d1 = d0 + TCP;
    *(u32x4*)(d0 + 4 * ch) = a;
    u32x4 b;
    b.x = (a.x >> 16) | (a.y << 16); b.y = (a.y >> 16) | (a.z << 16); b.z = (a.z >> 16) | (a.w << 16); b.w = (a.w >> 16) | (nx << 16);
    *(u32x4*)(d1 + 4 * ch) = b;
  }
}

template <int L, int USTR>
__device__ __forceinline__ void hy_load_u(const bf16* __restrict__ z, float w0, float w1, float w2, float bb, bf16* U) {
  constexpr int CPB = L / 8;
  for (int q = tid_opaque(); q < 16 * CPB; q += 512) {
    int b = q / CPB, t8 = (q - b * CPB) * 8;
    const bf16* zr = z + (size_t)b * L + t8;
    u32x4 v = *(const u32x4*)zr;
    float zm = t8 > 0 ? ldbf(zr - 1) : 0.f;
    float zp = t8 + 8 < L ? ldbf(zr + 8) : 0.f;
    float e0 = bflo(v.x), e1 = bfhi(v.x), e2 = bflo(v.y), e3 = bfhi(v.y), e4 = bflo(v.z), e5 = bfhi(v.z), e6 = bflo(v.w), e7 = bfhi(v.w);
    u32x4 o;
    o.x = pack_bf16(w0 * zm + w1 * e0 + w2 * e1 + bb, w0 * e0 + w1 * e1 + w2 * e2 + bb);
    o.y = pack_bf16(w0 * e1 + w1 * e2 + w2 * e3 + bb, w0 * e2 + w1 * e3 + w2 * e4 + bb);
    o.z = pack_bf16(w0 * e3 + w1 * e4 + w2 * e5 + bb, w0 * e4 + w1 * e5 + w2 * e6 + bb);
    o.w = pack_bf16(w0 * e5 + w1 * e6 + w2 * e7 + bb, w0 * e6 + w1 * e7 + w2 * zp + bb);
    *(u32x4*)(U + b * USTR + t8) = o;
  }
}

template <int L>
__device__ __forceinline__ void hy_gate4(const bf16* __restrict__ zr, int t0, float w0, float w1, float w2, float bb, float (&x)[4]) {
  u32x2 v = *(const u32x2*)(zr + t0);
  float zm = t0 > 0 ? ldbf(zr + t0 - 1) : 0.f;
  float zp = t0 + 4 < L ? ldbf(zr + t0 + 4) : 0.f;
  float e0 = bflo(v.x), e1 = bfhi(v.x), e2 = bflo(v.y), e3 = bfhi(v.y);
  x[0] = w0 * zm + w1 * e0 + w2 * e1 + bb;
  x[1] = w0 * e0 + w1 * e1 + w2 * e2 + bb;
  x[2] = w0 * e1 + w1 * e2 + w2 * e3 + bb;
  x[3] = w0 * e2 + w1 * e3 + w2 * zp + bb;
}

__device__ __forceinline__ void hy_load_gate(const bf16* __restrict__ z, float w0, float w1, float w2, float bb, unsigned long long* __restrict__ gs) {
  constexpr int CPB = SEQ / 8;
  for (int q = tid_opaque(); q < 16 * CPB; q += 512) {
    int b = q / CPB, t8 = (q - b * CPB) * 8;
    const bf16* zr = z + (size_t)b * SEQ + t8;
    u32x4 v = *(const u32x4*)zr;
    float zm = t8 > 0 ? ldbf(zr - 1) : 0.f;
    float zp = t8 + 8 < SEQ ? ldbf(zr + 8) : 0.f;
    float e0 = bflo(v.x), e1 = bfhi(v.x), e2 = bflo(v.y), e3 = bfhi(v.y), e4 = bflo(v.z), e5 = bfhi(v.z), e6 = bflo(v.w), e7 = bfhi(v.w);
    const unsigned a0 = pack_bf16(w0 * zm + w1 * e0 + w2 * e1 + bb, w0 * e0 + w1 * e1 + w2 * e2 + bb);
    const unsigned a1 = pack_bf16(w0 * e1 + w1 * e2 + w2 * e3 + bb, w0 * e2 + w1 * e3 + w2 * e4 + bb);
    const unsigned a2 = pack_bf16(w0 * e3 + w1 * e4 + w2 * e5 + bb, w0 * e4 + w1 * e5 + w2 * e6 + bb);
    const unsigned a3 = pack_bf16(w0 * e5 + w1 * e6 + w2 * e7 + bb, w0 * e6 + w1 * e7 + w2 * zp + bb);
    const int slot = ((t8 >> 8) * 16 + ((t8 >> 4) & 15)) * 64 + ((t8 >> 2) & 3) * 16 + b;
    gs[slot] = ((unsigned long long)a1 << 32) | a0;
    gs[slot + 16] = ((unsigned long long)a3 << 32) | a2;
  }
}

__device__ __forceinline__ bf16x8 hy_frag(const unsigned* p) {
  u32x4 v; v.x = p[0]; v.y = p[1]; v.z = p[2]; v.w = p[3];
  return __builtin_bit_cast(bf16x8, v);
}

__device__ __forceinline__ void hyena_latent(int c, const bf16* __restrict__ zt, const float* __restrict__ cw,
                                             const float* __restrict__ cb, const bf16* __restrict__ G,
                                             bf16* __restrict__ yt, char* smem, unsigned long long* __restrict__ gsc) {
  const int tid = tid_opaque(), lane = tid & 63, wave = tid >> 6;
  bf16* U = (bf16*)smem;
  unsigned* T = (unsigned*)(smem + HY_U_BYTES);
  __syncthreads();
  hy_load_tables<GSTR_L, TCOPY>(G, c, T);
  hy_load_u<SEQ, UST>(zt + (size_t)c * NT, cw[c], cw[HYCOLS + c], cw[2 * HYCOLS + c], cb[c], U);
  hy_load_gate(zt + (size_t)(512 + c) * NT, cw[512 + c], cw[HYCOLS + 512 + c], cw[2 * HYCOLS + 512 + c], cb[512 + c], gsc);
  hy_load_gate(zt + (size_t)(1024 + c) * NT, cw[1024 + c], cw[HYCOLS + 1024 + c], cw[2 * HYCOLS + 1024 + c], cb[1024 + c], gsc + 8192);
  asm volatile("s_waitcnt vmcnt(0)" ::: "memory");
  __syncthreads();
  const int r = lane & 15, kg = lane >> 4;
  const int par = (r + 1) & 1;
  const int base_dw = 1023 - (r >> 1) + 4 * kg - 128 * wave;
  const char* ub = smem + (r * UST + 8 * kg) * 2;
  const int tw = wave * 256;
#pragma unroll 1
  for (int order = 0; order < 2; ++order) {
    const unsigned* tb = T + order * 2 * TCOPY + par * TCOPY + base_dw;
    f32x4 acc[16];
#pragma unroll
    for (int i = 0; i < 16; ++i) acc[i] = (f32x4){0.f, 0.f, 0.f, 0.f};
    bf16x8 W[16];
#pragma unroll
    for (int f = -15; f <= 0; ++f) W[f & 15] = hy_frag(tb + 8 * f);
#pragma unroll 1
    for (int J = 0; J < 8; ++J) {
      const unsigned* tj = tb + 128 * J;
      const char* uj = ub + 512 * J;
#pragma unroll
      for (int jj = 0; jj < 8; ++jj) {
        bf16x8 uf = *(const bf16x8*)(uj + 64 * jj);
        acc[15] = mfma16(W[(2 * jj - 15) & 15], uf, acc[15]);
        acc[14] = mfma16(W[(2 * jj - 14) & 15], uf, acc[14]);
        if (J * 8 + jj < 63) {
          W[(2 * jj + 1) & 15] = hy_frag(tj + 8 * (2 * jj + 1));
          W[(2 * jj + 2) & 15] = hy_frag(tj + 8 * (2 * jj + 2));
        }
#pragma unroll
        for (int i = 13; i >= 0; --i) acc[i] = mfma16(W[(2 * jj - i) & 15], uf, acc[i]);
      }
    }
    __syncthreads();
    {
      const int col = (order + 1) * 512 + c;
      const float w0 = cw[col], w1 = cw[HYCOLS + col], w2 = cw[2 * HYCOLS + col], bb = cb[col];
      const bf16* zr = zt + (size_t)col * NT + (size_t)r * SEQ;
      const unsigned long long* gq = gsc + order * 8192 + (wave * 16) * 64 + lane;
      unsigned long long gv[16];
#pragma unroll
      for (int i = 0; i < 16; ++i) gv[i] = __hip_atomic_load(gq + i * 64, __ATOMIC_RELAXED, __HIP_MEMORY_SCOPE_AGENT);
#pragma unroll
      for (int i = 0; i < 16; ++i) {
        const int t0 = tw + 16 * i + 4 * kg;
        const unsigned lo = (unsigned)gv[i], hi = (unsigned)(gv[i] >> 32);
        u32x2 o;
        o.x = pack_bf16(bflo(lo) * acc[i][0], bfhi(lo) * acc[i][1]);
        o.y = pack_bf16(bflo(hi) * acc[i][2], bfhi(hi) * acc[i][3]);
        *(u32x2*)(U + r * UST + t0) = o;
      }
    }
    __syncthreads();
  }
  for (int q = tid; q < 16 * 256; q += 512) {
    int b = q >> 8, t8 = (q & 255) * 8;
    *(u32x4*)(yt + (size_t)c * NT + (size_t)b * SEQ + t8) = *(const u32x4*)(U + b * UST + t8);
  }
}

__device__ __forceinline__ void hyena_ctx(int c, const bf16* __restrict__ zt, const float* __restrict__ cw,
                                          const float* __restrict__ cb, const bf16* __restrict__ G,
                                          bf16* __restrict__ yt, char* smem) {
  const int tid = tid_opaque(), lane = tid & 63, wave = tid >> 6;
  bf16* U = (bf16*)smem;
  unsigned* T = (unsigned*)(smem + HY_U_BYTES);
  __syncthreads();
  hy_load_tables<GSTR_C, TCOPYC>(G, c, T);
  hy_load_u<LC, USTC>(zt + (size_t)c * NT, cw[c], cw[HYCOLS + c], cw[2 * HYCOLS + c], cb[c], U);
  __syncthreads();
  const int r = lane & 15, kg = lane >> 4;
  const int par = (r + 1) & 1;
  const int base_dw = (8 * kg - r + 255 - par) >> 1;
  const char* ub = smem + (r * USTC + 8 * kg) * 2;
#pragma unroll 1
  for (int order = 0; order < 2; ++order) {
    const unsigned* tb = T + order * 2 * TCOPYC + par * TCOPYC + base_dw;
    f32x4 acc[2];
    acc[0] = (f32x4){0.f, 0.f, 0.f, 0.f};
    acc[1] = acc[0];
#pragma unroll
    for (int j = 0; j < 8; ++j) {
      bf16x8 uf = *(const bf16x8*)(ub + 64 * j);
#pragma unroll
      for (int ii = 0; ii < 2; ++ii) {
        const int i = wave * 2 + ii;
        acc[ii] = mfma16(hy_frag(tb + 16 * j - 8 * i), uf, acc[ii]);
      }
    }
    __syncthreads();
    {
      const int col = (order + 1) * 512 + c;
      const float w0 = cw[col], w1 = cw[HYCOLS + col], w2 = cw[2 * HYCOLS + col], bb = cb[col];
      const bf16* zr = zt + (size_t)col * NT + (size_t)r * LC;
#pragma unroll
      for (int ii = 0; ii < 2; ++ii) {
        const int t0 = (wave * 2 + ii) * 16 + 4 * kg;
        float x[4];
        hy_gate4<LC>(zr, t0, w0, w1, w2, bb, x);
        u32x2 o;
        o.x = pack_bf16(x[0] * acc[ii][0], x[1] * acc[ii][1]);
        o.y = pack_bf16(x[2] * acc[ii][2], x[3] * acc[ii][3]);
        *(u32x2*)(U + r * USTC + t0) = o;
      }
    }
    __syncthreads();
  }
  {
    int b = tid >> 5, t8 = (tid & 31) * 8;
    *(u32x4*)(yt + (size_t)c * NT + (size_t)b * LC + t8) = *(const u32x4*)(U + b * USTC + t8);
  }
}

struct HyArgs {
  const bf16* zt; const float* cw; const float* cb; const bf16* gl; const bf16* gc; bf16* yt; int do_ctx; int pad_;
};

__global__ void __launch_bounds__(512, 2) k_hyena(HyArgs a) {
  extern __shared__ __attribute__((aligned(16))) char smem[];
  for (int c = blockIdx.x; c < HYW; c += gridDim.x) {
    hyena_latent(c, a.zt, a.cw, a.cb, a.gl, a.yt, smem, nullptr);
    if (a.do_ctx) hyena_ctx(c, a.zt + NL, a.cw, a.cb, a.gc, a.yt + NL, smem);
  }
}

constexpr int GL_QE = 0, GL_KE = 8192, GL_KST = 16384, GL_ATT = 24576, GL_ST = 32768, GL_VT = 49152  ;
constexpr int GL_RAW = 81920  , GL_RAWSZ = 18432, GL_SEG = 118784, GL_DEC = 120832;
constexpr int GLA_LDS = 121088;

__device__ __forceinline__ f32x16 mfma32(bf16x8 a, bf16x8 b, f32x16 c) {
  return __builtin_amdgcn_mfma_f32_32x32x16_bf16(a, b, c, 0, 0, 0);
}
__device__ __forceinline__ unsigned short bf16bits(float v) { bf16 h = f2bf(v); return *(unsigned short*)&h; }

struct GlaArgs {
  const bf16* zg; const float* wa2; const float* ba2; float* of; float* ob; int emit_ctx; int pad_;
};

__device__ __forceinline__ void gla_unit(int unit, const GlaArgs& a, char* smem) {
  const int tid = tid_opaque(), lane = tid & 63, wave = tid >> 6;
  const int dir = unit & 1, h = (unit >> 1) & 3, b = unit >> 3;
  const int lr = lane & 31, lh = lane >> 5;
  const int swl = (lr >> 1) & 7;
  float* outp = dir ? a.ob : a.of;
  __syncthreads();
  const int d = tid & 63, sg = tid >> 6;
  float wa[16];
#pragma unroll
  for (int r = 0; r < 16; ++r) wa[r] = a.wa2[(dir * 16 + r) * 256 + h * 64 + d];
  const float ba = a.ba2[dir * 256 + h * 64 + d];
  { unsigned zz = 0u; asm volatile("" : "+v"(zz));
    for (int q = tid; q < 16384 / 16; q += 512) *(u32x4*)(smem + GL_ST + q * 16) = (u32x4){zz, zz, zz, zz}; }
  f32x16 S;
#pragma unroll
  for (int r = 0; r < 16; ++r) S[r] = 0.f;

  const int qi = tid >> 3, qc = tid & 7;
  const int ai = (tid >> 1) & 63, ac = tid & 1;
  const int vsg = (tid >> 5) & 7, vdq = tid & 31;
  u32x4 pq, pk, pa;
  u32x2 pw0, pw1, pw2, pw3, pw4, pw5, pw6, pw7;

#define GLA_ROW(N_, I_, ROW_)                                                        \
  {                                                                                  \
    const int n_ = (N_);                                                             \
    const int Ls_ = n_ < 4 ? LC : SEQ;                                               \
    const int cn_ = n_ < 4 ? n_ : n_ - 4;                                            \
    const int rb_ = n_ < 4 ? (NL + b * LC) : (b * SEQ);                              \
    const int pos_ = cn_ * 64 + (I_);                                                \
    ROW_ = rb_ + (dir ? (Ls_ - 1 - pos_) : pos_);                                    \
  }
#define GLA_LOAD_RAW(N_)                                                             \
  {                                                                                  \
    int row_;                                                                        \
    GLA_ROW(N_, qi, row_);                                                           \
    const bf16* zr_ = a.zg + (size_t)row_ * GLACOLS;                                 \
    pq = *(const u32x4*)(zr_ + h * 64 + qc * 8);                                     \
    pk = *(const u32x4*)(zr_ + 256 + h * 64 + qc * 8);                               \
    int ra_;                                                                         \
    GLA_ROW(N_, ai, ra_);                                                            \
    pa = *(const u32x4*)(a.zg + (size_t)ra_ * GLACOLS + 1536 + dir * 16 + ac * 8);   \
  }
#define GLA_LOAD_V(N_)                                                               \
  {                                                                                  \
    int rv_;                                                                         \
    GLA_ROW(N_, vsg * 8 + 0, rv_); pw0 = *(const u32x2*)(a.zg + (size_t)rv_ * GLACOLS + 512 + h * 128 + vdq * 4); \
    GLA_ROW(N_, vsg * 8 + 1, rv_); pw1 = *(const u32x2*)(a.zg + (size_t)rv_ * GLACOLS + 512 + h * 128 + vdq * 4); \
    GLA_ROW(N_, vsg * 8 + 2, rv_); pw2 = *(const u32x2*)(a.zg + (size_t)rv_ * GLACOLS + 512 + h * 128 + vdq * 4); \
    GLA_ROW(N_, vsg * 8 + 3, rv_); pw3 = *(const u32x2*)(a.zg + (size_t)rv_ * GLACOLS + 512 + h * 128 + vdq * 4); \
    GLA_ROW(N_, vsg * 8 + 4, rv_); pw4 = *(const u32x2*)(a.zg + (size_t)rv_ * GLACOLS + 512 + h * 128 + vdq * 4); \
    GLA_ROW(N_, vsg * 8 + 5, rv_); pw5 = *(const u32x2*)(a.zg + (size_t)rv_ * GLACOLS + 512 + h * 128 + vdq * 4); \
    GLA_ROW(N_, vsg * 8 + 6, rv_); pw6 = *(const u32x2*)(a.zg + (size_t)rv_ * GLACOLS + 512 + h * 128 + vdq * 4); \
    GLA_ROW(N_, vsg * 8 + 7, rv_); pw7 = *(const u32x2*)(a.zg + (size_t)rv_ * GLACOLS + 512 + h * 128 + vdq * 4); \
  }
#define GLA_STORE_RAW(RB_)                                                           \
  {                                                                                  \
    char* rw_ = smem + GL_RAW + (RB_) * GL_RAWSZ;                                    \
    *(u32x4*)(rw_ + qi * 128 + qc * 16) = pq;                                        \
    *(u32x4*)(rw_ + 8192 + qi * 128 + qc * 16) = pk;                                 \
    if (tid < 128) *(u32x4*)(rw_ + 16384 + ai * 32 + ac * 16) = pa;                  \
  }
#define GLA_STORE_V(VB_)                                                             \
  if (tid < 256) {                                                                   \
    char* vt_ = smem + GL_VT + (VB_) * 16384;                                        \
    u32x4 o;                                                                         \
    o.x = (pw0.x & 0xffffu) | (pw1.x << 16); o.y = (pw2.x & 0xffffu) | (pw3.x << 16); o.z = (pw4.x & 0xffffu) | (pw5.x << 16); o.w = (pw6.x & 0xffffu) | (pw7.x << 16); \
    *(u32x4*)(vt_ + swz(vdq * 4 + 0, vsg)) = o;                                      \
    o.x = (pw0.x >> 16) | (pw1.x & 0xffff0000u); o.y = (pw2.x >> 16) | (pw3.x & 0xffff0000u); o.z = (pw4.x >> 16) | (pw5.x & 0xffff0000u); o.w = (pw6.x >> 16) | (pw7.x & 0xffff0000u); \
    *(u32x4*)(vt_ + swz(vdq * 4 + 1, vsg)) = o;                                      \
    o.x = (pw0.y & 0xffffu) | (pw1.y << 16); o.y = (pw2.y & 0xffffu) | (pw3.y << 16); o.z = (pw4.y & 0xffffu) | (pw5.y << 16); o.w = (pw6.y & 0xffffu) | (pw7.y << 16); \
    *(u32x4*)(vt_ + swz(vdq * 4 + 2, vsg)) = o;                                      \
    o.x = (pw0.y >> 16) | (pw1.y & 0xffff0000u); o.y = (pw2.y >> 16) | (pw3.y & 0xffff0000u); o.z = (pw4.y >> 16) | (pw5.y & 0xffff0000u); o.w = (pw6.y >> 16) | (pw7.y & 0xffff0000u); \
    *(u32x4*)(vt_ + swz(vdq * 4 + 3, vsg)) = o;                                      \
  }
#define GLA_STEP3(RB_)                                                               \
  {                                                                                  \
    const char* ra_ = smem + GL_RAW + (RB_) * GL_RAWSZ + 16384;                      \
    float run = 0.f;                                                                 \
    _Pragma("unroll") for (int ii = 0; ii < 8; ++ii) {                               \
      const int i = sg * 8 + ii;                                                     \
      const u32x4 a0 = *(const u32x4*)(ra_ + i * 32);                                \
      const u32x4 a1 = *(const u32x4*)(ra_ + i * 32 + 16);                           \
      float g = ba;                                                                  \
      g += bflo(a0.x) * wa[0] + bfhi(a0.x) * wa[1] + bflo(a0.y) * wa[2] + bfhi(a0.y) * wa[3]; \
      g += bflo(a0.z) * wa[4] + bfhi(a0.z) * wa[5] + bflo(a0.w) * wa[6] + bfhi(a0.w) * wa[7]; \
      g += bflo(a1.x) * wa[8] + bfhi(a1.x) * wa[9] + bflo(a1.y) * wa[10] + bfhi(a1.y) * wa[11]; \
      g += bflo(a1.z) * wa[12] + bfhi(a1.z) * wa[13] + bflo(a1.w) * wa[14] + bfhi(a1.w) * wa[15]; \
      run += logsigmoid_f(g) * (1.0f / 16.0f);                                       \
      bl[ii] = run;                                                                  \
    }                                                                                \
    *(float*)(smem + GL_SEG + (sg * 64 + d) * 4) = run;                              \
  }
#define GLA_STEP5(RB_)                                                               \
  {                                                                                  \
    const char* rq_ = smem + GL_RAW + (RB_) * GL_RAWSZ;                              \
    float off = 0.f, tot = 0.f;                                                      \
    _Pragma("unroll") for (int s = 0; s < 8; ++s) {                                  \
      float v = *(const float*)(smem + GL_SEG + (s * 64 + d) * 4);                  \
      off += (s < sg) ? v : 0.f;                                                     \
      tot += v;                                                                      \
    }                                                                                \
    float ks[8];                                                                     \
    _Pragma("unroll") for (int ii = 0; ii < 8; ++ii) {                               \
      const int i = sg * 8 + ii;                                                     \
      const float bb = off + bl[ii];                                                 \
      const float qv = bf2f(*(const bf16*)(rq_ + i * 128 + d * 2));                 \
      const float kv = bf2f(*(const bf16*)(rq_ + 8192 + i * 128 + d * 2));          \
      const int eo = swz(i, d >> 3) + (d & 7) * 2;                                   \
      *(unsigned short*)(smem + GL_QE + eo) = bf16bits(qv * 0.125f * __expf(bb));    \
      *(unsigned short*)(smem + GL_KE + eo) = bf16bits(kv * __expf(-bb));            \
      ks[ii] = kv * __expf(tot - bb);                                                \
    }                                                                                \
    u32x4 o;                                                                         \
    o.x = pack_bf16(ks[0], ks[1]); o.y = pack_bf16(ks[2], ks[3]); o.z = pack_bf16(ks[4], ks[5]); o.w = pack_bf16(ks[6], ks[7]); \
    *(u32x4*)(smem + GL_KST + swz(d, sg)) = o;                                       \
    if (sg == 0) *(float*)(smem + GL_DEC + d * 4) = __expf(tot);                     \
  }

  const int tm = wave >> 2, tn = wave & 3;
  float bl[8];
  f32x16 oprev;
#pragma unroll
  for (int r = 0; r < 16; ++r) oprev[r] = 0.f;

  GLA_LOAD_RAW(0); GLA_LOAD_V(0);
  GLA_STORE_RAW(0); GLA_STORE_V(0);
  GLA_LOAD_RAW(1);
  GLA_STORE_RAW(1);
  __syncthreads();
  GLA_STEP3(0);
  __syncthreads();
  GLA_STEP5(0);
  GLA_LOAD_RAW(2); GLA_LOAD_V(1);
  __syncthreads();
#pragma unroll 1
  for (int n = 0; n < 36; ++n) {
    const int vb = n & 1;
    const bool has1 = n + 1 < 36;
    f32x16 oacc;
#pragma unroll
    for (int r = 0; r < 16; ++r) oacc[r] = 0.f;
#pragma unroll
    for (int r = 0; r < 16; ++r) S[r] *= *(const float*)(smem + GL_DEC + (tm * 32 + rowmap(r, lh)) * 4);
#pragma unroll
    for (int ks4 = 0; ks4 < 4; ++ks4) {
      const int c = ((2 * ks4 + lh) ^ swl) << 4;
      const bf16x8 fq = *(const bf16x8*)(smem + GL_QE + (tm * 32 + lr) * 128 + c);
      const bf16x8 fs = *(const bf16x8*)(smem + GL_ST + (tn * 32 + lr) * 128 + c);
      oacc = mfma32(fq, fs, oacc);
      const bf16x8 fk = *(const bf16x8*)(smem + GL_KST + (tm * 32 + lr) * 128 + c);
      const bf16x8 fv = *(const bf16x8*)(smem + GL_VT + vb * 16384 + (tn * 32 + lr) * 128 + c);
      S = mfma32(fk, fv, S);
    }
    if (wave < 4) {
      const int am = wave >> 1, an = wave & 1;
      f32x16 att;
#pragma unroll
      for (int r = 0; r < 16; ++r) att[r] = 0.f;
#pragma unroll
      for (int ks4 = 0; ks4 < 4; ++ks4) {
        const int c = ((2 * ks4 + lh) ^ swl) << 4;
        const bf16x8 fq = *(const bf16x8*)(smem + GL_QE + (am * 32 + lr) * 128 + c);
        const bf16x8 fk = *(const bf16x8*)(smem + GL_KE + (an * 32 + lr) * 128 + c);
        att = mfma32(fq, fk, att);
      }
      const int s = an * 32 + lr;
#pragma unroll
      for (int r = 0; r < 16; ++r) {
        const int t = am * 32 + rowmap(r, lh);
        const float v = (s <= t) ? att[r] : 0.f;
        *(unsigned short*)(smem + GL_ATT + swz(t, s >> 3) + (s & 7) * 2) = bf16bits(v);
      }
    }
    if (has1) GLA_STEP3((n + 1) & 1);
    __syncthreads();
#pragma unroll
    for (int ks4 = 0; ks4 < 4; ++ks4) {
      const int c = ((2 * ks4 + lh) ^ swl) << 4;
      const bf16x8 fa = *(const bf16x8*)(smem + GL_ATT + (tm * 32 + lr) * 128 + c);
      const bf16x8 fv = *(const bf16x8*)(smem + GL_VT + vb * 16384 + (tn * 32 + lr) * 128 + c);
      oacc = mfma32(fa, fv, oacc);
    }
#pragma unroll
    for (int g = 0; g < 4; ++g) {
      u32x2 o;
      o.x = pack_bf16(S[4 * g + 0], S[4 * g + 1]);
      o.y = pack_bf16(S[4 * g + 2], S[4 * g + 3]);
      *(u32x2*)(smem + GL_ST + swz(tn * 32 + lr, tm * 4 + g) + 8 * lh) = o;
    }
    if (has1) {
      GLA_STEP5((n + 1) & 1);
      GLA_STORE_V((n + 1) & 1);
      if (n + 2 < 36) GLA_STORE_RAW(n & 1);
    }
    if (n > 0 && (n - 1 >= 4 || a.emit_ctx)) {
#pragma unroll
      for (int r = 0; r < 16; ++r) {
        int row;
        GLA_ROW(n - 1, tm * 32 + rowmap(r, lh), row);
        outp[(size_t)row * 512 + h * 128 + tn * 32 + lr] = oprev[r];
      }
    }
    { const int nr = n + 3 < 36 ? n + 3 : 35; GLA_LOAD_RAW(nr); const int nv = n + 2 < 36 ? n + 2 : 35; GLA_LOAD_V(nv); }
    oprev = oacc;
    __syncthreads();
  }
  {
#pragma unroll
    for (int r = 0; r < 16; ++r) {
      int row;
      GLA_ROW(35, tm * 32 + rowmap(r, lh), row);
      outp[(size_t)row * 512 + h * 128 + tn * 32 + lr] = oprev[r];
    }
  }
#undef GLA_ROW
#undef GLA_LOAD_RAW
#undef GLA_LOAD_V
#undef GLA_STORE_RAW
#undef GLA_STORE_V
#undef GLA_STEP3
#undef GLA_STEP5
}

__global__ void __launch_bounds__(512, 2) k_gla(GlaArgs a) {
  extern __shared__ __attribute__((aligned(16))) char smem[];
  for (int u = blockIdx.x; u < 128; u += gridDim.x) gla_unit(u, a, smem);
}

constexpr int CTRL_Q = 0;
constexpr int CTRL_CNT = 128;
constexpr int CTRL_CUR = 640;
constexpr int CTRL_XR = 1152;
constexpr int CTRL_WORDS = 1152 + 256;
constexpr size_t al256(size_t v) { return (v + 255) / 256 * 256; }
namespace wso {
constexpr size_t bar = 0;
constexpr size_t ctrl = al256(bar + (size_t)XCD_BAR_WORDS * 4);
constexpr size_t zero_end = al256(ctrl + (size_t)CTRL_WORDS * 4);
constexpr size_t xs = al256(ctrl + (size_t)CTRL_WORDS * 4);
constexpr size_t mod = al256(xs + (size_t)NT * D * 4);
constexpr size_t abuf = al256(mod + (size_t)DEPTH * 17 * 6 * D * 4);
constexpr size_t zt = al256(abuf + (size_t)NT * D * 2);
constexpr size_t zg = al256(zt + (size_t)HYCOLS * NT * 2);
constexpr size_t yt = al256(zg + (size_t)NT * GLACOLS * 2);
constexpr size_t of = al256(yt + (size_t)HYW * NT * 2);
constexpr size_t ob = al256(of + (size_t)NT * 512 * 4);
constexpr size_t ymix = al256(ob + (size_t)NT * 512 * 4);
constexpr size_t region_end_raw = al256(ymix + (size_t)NT * D * 2);
constexpr size_t region_end = (region_end_raw > zt + al256((size_t)NSLOT * D * 2)) ? region_end_raw : zt + al256((size_t)NSLOT * D * 2);
constexpr size_t hid = region_end;
constexpr size_t gl = al256(hid + (size_t)DEPTH * 2 * SEQ * 64 * 4);
constexpr size_t gc = al256(gl + (size_t)DEPTH * 2 * HYW * GSTR_L * 2);
constexpr size_t logits = al256(gc + (size_t)2 * HYW * GSTR_C * 2);
constexpr size_t tok_e = al256(logits + (size_t)NT * NE * 4);
constexpr size_t tok_gate = al256(tok_e + (size_t)NT * TOPK * 4);
constexpr size_t tok_slot = al256(tok_gate + (size_t)NT * TOPK * 4);
constexpr size_t pad_start = al256(tok_slot + (size_t)NT * TOPK * 4);
constexpr size_t slot_tok = al256(pad_start + (size_t)(NE + 2) * 4);
constexpr size_t blkcnt = al256(slot_tok + (size_t)NSLOT * 4);
constexpr size_t hbuf = al256(blkcnt + (size_t)512 * NE * 4);
constexpr size_t hs = al256(hbuf + (size_t)NSLOT * DE);
constexpr size_t w_in_t = al256(hs + (size_t)NT * DE);
constexpr size_t w_out_t = al256(w_in_t + (size_t)DEPTH * WIN_ROWS * D * 2);
constexpr size_t router_t = al256(w_out_t + (size_t)DEPTH * D * D * 2);
constexpr size_t sh1_t = al256(router_t + (size_t)DEPTH * NE * D * 2);
constexpr size_t sh3_t = al256(sh1_t + (size_t)DEPTH * DE * D);
constexpr size_t sh2_t = al256(sh3_t + (size_t)DEPTH * DE * D);
constexpr size_t e1_t = al256(sh2_t + (size_t)DEPTH * D * DE);
constexpr size_t e3_t = al256(e1_t + (size_t)NE * DE * D);
constexpr size_t e2_t = al256(e3_t + (size_t)NE * DE * D);
constexpr size_t abuf8 = al256(e2_t + (size_t)NE * D * DE);
constexpr size_t w_g8 = al256(abuf8 + (size_t)NT * D);
constexpr size_t hy_scr = al256(w_g8 + (size_t)DEPTH * GW_ROWS * D);
constexpr size_t total = al256(hy_scr + (size_t)512 * 2 * 8192 * 8);
constexpr size_t ybuf = zt;
}
struct WS {
  char* b;
  __device__ __forceinline__ unsigned* bar() const { char* q = b; asm volatile("" : "+s"(q)); return (unsigned*)(q + wso::bar); }
  __device__ __forceinline__ int* ctrl() const { char* q = b; asm volatile("" : "+s"(q)); return (int*)(q + wso::ctrl); }
  __device__ __forceinline__ float* xs() const { char* q = b; asm volatile("" : "+s"(q)); return (float*)(q + wso::xs); }
  __device__ __forceinline__ float* mod() const { char* q = b; asm volatile("" : "+s"(q)); return (float*)(q + wso::mod); }
  __device__ __forceinline__ bf16* abuf() const { char* q = b; asm volatile("" : "+s"(q)); return (bf16*)(q + wso::abuf); }
  __device__ __forceinline__ bf16* zt() const { char* q = b; asm volatile("" : "+s"(q)); return (bf16*)(q + wso::zt); }
  __device__ __forceinline__ bf16* zg() const { char* q = b; asm volatile("" : "+s"(q)); return (bf16*)(q + wso::zg); }
  __device__ __forceinline__ bf16* yt() const { char* q = b; asm volatile("" : "+s"(q)); return (bf16*)(q + wso::yt); }
  __device__ __forceinline__ float* of() const { char* q = b; asm volatile("" : "+s"(q)); return (float*)(q + wso::of); }
  __device__ __forceinline__ float* ob() const { char* q = b; asm volatile("" : "+s"(q)); return (float*)(q + wso::ob); }
  __device__ __forceinline__ bf16* ymix() const { char* q = b; asm volatile("" : "+s"(q)); return (bf16*)(q + wso::ymix); }
  __device__ __forceinline__ float* hid() const { char* q = b; asm volatile("" : "+s"(q)); return (float*)(q + wso::hid); }
  __device__ __forceinline__ bf16* gl() const { char* q = b; asm volatile("" : "+s"(q)); return (bf16*)(q + wso::gl); }
  __device__ __forceinline__ bf16* gc() const { char* q = b; asm volatile("" : "+s"(q)); return (bf16*)(q + wso::gc); }
  __device__ __forceinline__ float* logits() const { char* q = b; asm volatile("" : "+s"(q)); return (float*)(q + wso::logits); }
  __device__ __forceinline__ int* tok_e() const { char* q = b; asm volatile("" : "+s"(q)); return (int*)(q + wso::tok_e); }
  __device__ __forceinline__ float* tok_gate() const { char* q = b; asm volatile("" : "+s"(q)); return (float*)(q + wso::tok_gate); }
  __device__ __forceinline__ int* tok_slot() const { char* q = b; asm volatile("" : "+s"(q)); return (int*)(q + wso::tok_slot); }
  __device__ __forceinline__ int* pad_start() const { char* q = b; asm volatile("" : "+s"(q)); return (int*)(q + wso::pad_start); }
  __device__ __forceinline__ int* slot_tok() const { char* q = b; asm volatile("" : "+s"(q)); return (int*)(q + wso::slot_tok); }
  __device__ __forceinline__ int* blkcnt() const { char* q = b; asm volatile("" : "+s"(q)); return (int*)(q + wso::blkcnt); }
  __device__ __forceinline__ unsigned char* hbuf() const { char* q = b; asm volatile("" : "+s"(q)); return (unsigned char*)(q + wso::hbuf); }
  __device__ __forceinline__ unsigned char* hs() const { char* q = b; asm volatile("" : "+s"(q)); return (unsigned char*)(q + wso::hs); }
  __device__ __forceinline__ bf16* w_in_t() const { char* q = b; asm volatile("" : "+s"(q)); return (bf16*)(q + wso::w_in_t); }
  __device__ __forceinline__ bf16* w_out_t() const { char* q = b; asm volatile("" : "+s"(q)); return (bf16*)(q + wso::w_out_t); }
  __device__ __forceinline__ bf16* router_t() const { char* q = b; asm volatile("" : "+s"(q)); return (bf16*)(q + wso::router_t); }
  __device__ __forceinline__ unsigned char* sh1_t() const { char* q = b; asm volatile("" : "+s"(q)); return (unsigned char*)(q + wso::sh1_t); }
  __device__ __forceinline__ unsigned char* sh3_t() const { char* q = b; asm volatile("" : "+s"(q)); return (unsigned char*)(q + wso::sh3_t); }
  __device__ __forceinline__ unsigned char* sh2_t() const { char* q = b; asm volatile("" : "+s"(q)); return (unsigned char*)(q + wso::sh2_t); }
  __device__ __forceinline__ unsigned char* e1_t() const { char* q = b; asm volatile("" : "+s"(q)); return (unsigned char*)(q + wso::e1_t); }
  __device__ __forceinline__ unsigned char* e3_t() const { char* q = b; asm volatile("" : "+s"(q)); return (unsigned char*)(q + wso::e3_t); }
  __device__ __forceinline__ unsigned char* e2_t() const { char* q = b; asm volatile("" : "+s"(q)); return (unsigned char*)(q + wso::e2_t); }
  __device__ __forceinline__ unsigned char* ybuf() const { char* q = b; asm volatile("" : "+s"(q)); return (unsigned char*)(q + wso::ybuf); }
  __device__ __forceinline__ unsigned char* abuf8() const { char* q = b; asm volatile("" : "+s"(q)); return (unsigned char*)(q + wso::abuf8); }
  __device__ __forceinline__ unsigned char* w_g8() const { char* q = b; asm volatile("" : "+s"(q)); return (unsigned char*)(q + wso::w_g8); }
  __device__ __forceinline__ unsigned long long* hy_scr() const { char* q = b; asm volatile("" : "+s"(q)); return (unsigned long long*)(q + wso::hy_scr); }
};

constexpr int MEGA_LDS_MAIN = G8_LDS;
constexpr int LDS_TILE_E = MEGA_LDS_MAIN + 16;
constexpr int MEGA_LDS = MEGA_LDS_MAIN + 16 + 4096;

struct MP { Inputs in; WS w; float* out; };

__device__ __forceinline__ void row_load(const float* __restrict__ p, int lane, f32x4 (&v)[4]) {
#pragma unroll
  for (int j = 0; j < 4; ++j) v[j] = *(const f32x4*)(p + j * 256 + lane * 4);
}
__device__ __forceinline__ float row_rinv(const f32x4 (&v)[4], int lane) {
  float ss = 0.f;
#pragma unroll
  for (int j = 0; j < 4; ++j) ss += v[j].x * v[j].x + v[j].y * v[j].y + v[j].z * v[j].z + v[j].w * v[j].w;
  ss = wave_sum(ss, lane);
  return rsqrtf(ss * (1.0f / D) + EPS);
}
__device__ __forceinline__ void row_norm_mod_store(const f32x4 (&v)[4], float rinv, const float* __restrict__ g,
                                                   const float* __restrict__ sh, const float* __restrict__ sc, int lane,
                                                   bf16* __restrict__ dst, unsigned char* __restrict__ dst8 = nullptr) {
#pragma unroll
  for (int j = 0; j < 4; ++j) {
    const int d = j * 256 + lane * 4;
    const f32x4 gv = *(const f32x4*)(g + d), shv = *(const f32x4*)(sh + d), scv = *(const f32x4*)(sc + d);
    const float y0 = v[j].x * rinv * gv.x * (1.f + scv.x) + shv.x, y1 = v[j].y * rinv * gv.y * (1.f + scv.y) + shv.y;
    const float y2 = v[j].z * rinv * gv.z * (1.f + scv.z) + shv.z, y3 = v[j].w * rinv * gv.w * (1.f + scv.w) + shv.w;
    u32x2 o;
    o.x = pack_bf16(y0, y1);
    o.y = pack_bf16(y2, y3);
    *(u32x2*)(dst + d) = o;
    if (dst8) *(unsigned*)(dst8 + d) = pk4_fp8(y0, y1, y2, y3);
  }
}

__device__ __forceinline__ void ph_mod_hid(const MP& p, char* smem, int bid, int nblk) {
  const int tid = tid_opaque(), lane = tid & 63, wave = tid >> 6;
  float* sc = (float*)smem;
  for (int u = bid; u < 192; u += nblk) {
    const int l = u / 96, col0 = (u - l * 96) * 64;
    __syncthreads();
    for (int i = tid; i < 17 * 1024; i += 512) {
      const int r = i >> 10, k = i & 1023;
      const float v = (r < 16) ? p.in.c[r * D + k] : p.in.c_ctx[k];
      sc[i] = silu_f(v);
    }
    __syncthreads();
    const int col = tid & 63, ks = tid >> 6;
    float acc[17];
#pragma unroll
    for (int r = 0; r < 17; ++r) acc[r] = 0.f;
    const float* wp = p.in.ada_w + ((size_t)l * D + ks * 128) * (6 * D) + col0 + col;
#pragma unroll 16
    for (int kk = 0; kk < 128; ++kk) {
      const float wv = wp[(size_t)kk * (6 * D)];
#pragma unroll
      for (int r = 0; r < 17; ++r) acc[r] += sc[r * 1024 + ks * 128 + kk] * wv;
    }
    __syncthreads();
#pragma unroll
    for (int r = 0; r < 17; ++r) sc[(ks * 17 + r) * 64 + col] = acc[r];
    __syncthreads();
    for (int i = tid; i < 17 * 64; i += 512) {
      const int r = i >> 6, cc = i & 63;
      float s = 0.f;
#pragma unroll
      for (int k8 = 0; k8 < 8; ++k8) s += sc[(k8 * 17 + r) * 64 + cc];
      p.w.mod()[((size_t)l * 17 + r) * (6 * D) + col0 + cc] = s + p.in.ada_b[l * 6 * D + col0 + cc];
    }
  }
  for (int it = bid; it * 8 < 4352; it += nblk) {
    const int rid = it * 8 + wave;
    int l, ty, t;
    if (rid < 2048) { l = 0; ty = 0; t = rid; }
    else if (rid < 2304) { l = 0; ty = 1; t = rid - 2048; }
    else { l = 1; ty = 0; t = rid - 2304; }
    const int L = ty ? LC : SEQ;
    const float* w1 = p.in.hy_f_w1 + l * 33 * 64; const float* b1 = p.in.hy_f_b1 + l * 64;
    const float* w2 = p.in.hy_f_w2 + l * 64 * 64; const float* b2 = p.in.hy_f_b2 + l * 64;
    float pv = 0.f;
    if (lane == 0) pv = (float)t / (float)(L - 1);
    else if (lane < 33) {
      const int bi = (lane - 1) & 15;
      const float wph = 2.0f * 3.14159265358979323846f * (float)t / (float)L;
      const float f = 1e-4f + (float)bi * ((15.0f - 1e-4f) / 15.0f);
      pv = (lane <= 16) ? cosf(f * wph) : -sinf(f * wph);
    }
    float a1 = b1[lane];
#pragma unroll
    for (int i = 0; i < 33; ++i) a1 += shl_f(pv, i) * w1[i * 64 + lane];
    const float h1 = sinf(a1);
    float a2 = b2[lane];
#pragma unroll 16
    for (int i = 0; i < 64; ++i) a2 += shl_f(h1, i) * w2[i * 64 + lane];
    p.w.hid()[((size_t)(l * 2 + ty) * SEQ + t) * 64 + lane] = sinf(a2);
  }
}

__device__ __forceinline__ void ph_gtab(const MP& p, char* smem, int bid, int nblk) {
  const int tid = tid_opaque();
  float* wl = (float*)smem;
  for (int u = bid; u < 544; u += nblk) {
    int l, ty, ib, cg;
    if (u < 512) { l = u >> 8; ty = 0; ib = (u >> 5) & 7; cg = u & 31; }
    else { l = 0; ty = 1; ib = 0; cg = u - 512; }
    const int L = ty ? LC : SEQ, gstr = ty ? GSTR_C : GSTR_L;
    const float* hid = p.w.hid() + (size_t)(l * 2 + ty) * SEQ * 64;
    const float* w3 = p.in.hy_f_w3 + (size_t)l * 64 * 2048;
    const float* skip = p.in.hy_skip + l * 2 * 512;
    bf16* G = ty ? p.w.gc() : (p.w.gl() + (size_t)l * 2 * HYW * GSTR_L);
    __syncthreads();
    for (int i = tid; i < 2 * 32 * 64; i += 512) {
      const int dir = i >> 11, cc = (i >> 6) & 31, j = i & 63;
      const int oc = cg * 32 + cc, o = oc >> 9, c = oc & 511;
      wl[i] = w3[(size_t)j * 2048 + o * 1024 + dir * 512 + c];
    }
    __syncthreads();
    const int i = ib * 512 + tid;
    const int dd = i - (L - 1);
    const int t = dd < 0 ? -dd : dd;
    const bool inr = i < 2 * L - 1;
    const int dir = dd > 0 ? 1 : 0;
    float hr[64];
    {
      const float* hp = hid + (size_t)(inr ? t : 0) * 64;
#pragma unroll
      for (int j = 0; j < 16; ++j) { const f32x4 v = *(const f32x4*)(hp + 4 * j); hr[4 * j] = v.x; hr[4 * j + 1] = v.y; hr[4 * j + 2] = v.z; hr[4 * j + 3] = v.w; }
    }
    const float tn = (float)t / (float)(L - 1);
#pragma unroll 1
    for (int cc = 0; cc < 32; ++cc) {
      const int oc = cg * 32 + cc, o = oc >> 9, c = oc & 511;
      const float* wc = wl + (dir * 32 + cc) * 64;
      float s = 0.f;
#pragma unroll
      for (int j = 0; j < 16; ++j) { const f32x4 wv = *(const f32x4*)(wc + 4 * j); s += hr[4 * j] * wv.x + hr[4 * j + 1] * wv.y + hr[4 * j + 2] * wv.z + hr[4 * j + 3] * wv.w; }
      if (dd == 0) {
        const float* wc1 = wl + (32 + cc) * 64;
        float s1 = 0.f;
#pragma unroll
        for (int j = 0; j < 16; ++j) { const f32x4 wv = *(const f32x4*)(wc1 + 4 * j); s1 += hr[4 * j] * wv.x + hr[4 * j + 1] * wv.y + hr[4 * j + 2] * wv.z + hr[4 * j + 3] * wv.w; }
        s += s1;
      }
      const float delta = HY_MIN_DECAY + (float)c * ((HY_MAX_DECAY - HY_MIN_DECAY) / 511.0f);
      float val = s * __expf(-tn * delta);
      if (dd == 0) val += skip[o * 512 + c];
      if (!inr) val = 0.f;
      G[(size_t)oc * gstr + i] = f2bf(val);
    }
  }
}

__device__ __forceinline__ void ph_init_norm1(const MP& p, int bid, int nblk) {
  const int lane = tid_opaque() & 63, wave = tid_opaque() >> 6;
  const float* g = p.in.norm1_g;
  for (int it = bid; it * 8 < SEQ; it += nblk) {
    const int t = it * 8 + wave;
    const float rr = (float)(t >> 6), colp = (float)(t & 63);
    f32x4 e[4];
#pragma unroll
    for (int j = 0; j < 4; ++j) {
      float ev[4];
#pragma unroll
      for (int q = 0; q < 4; ++q) {
        const int i = lane * 4 + q;
        const float omega = 1.0f / powf(10000.0f, (float)i / 256.0f);
        const float a = ((j < 2) ? rr : colp) * omega;
        ev[q] = (j & 1) ? cosf(a) : sinf(a);
      }
      e[j] = (f32x4){ev[0], ev[1], ev[2], ev[3]};
    }
    for (int b = 0; b < NB; ++b) {
      const int row = b * SEQ + t;
      f32x4 v[4];
      row_load(p.in.x + (size_t)row * D, lane, v);
#pragma unroll
      for (int j = 0; j < 4; ++j) { v[j] += e[j]; *(f32x4*)(p.w.xs() + (size_t)row * D + j * 256 + lane * 4) = v[j]; }
      const float rinv = row_rinv(v, lane);
      const float* mb = p.w.mod() + (size_t)b * 6 * D;
      row_norm_mod_store(v, rinv, g, mb, mb + D, lane, p.w.abuf() + (size_t)row * D, p.w.abuf8() + (size_t)row * D);
    }
  }
  for (int it = bid; it * 8 < NC; it += nblk) {
    const int rc = it * 8 + wave, row = NL + rc;
    f32x4 v[4];
    row_load(p.in.ctx + (size_t)rc * D, lane, v);
#pragma unroll
    for (int j = 0; j < 4; ++j) *(f32x4*)(p.w.xs() + (size_t)row * D + j * 256 + lane * 4) = v[j];
    const float rinv = row_rinv(v, lane);
    const float* mb = p.w.mod() + (size_t)16 * 6 * D;
    row_norm_mod_store(v, rinv, g, mb, mb + D, lane, p.w.abuf() + (size_t)row * D, p.w.abuf8() + (size_t)row * D);
  }
}

__device__ __forceinline__ void ph_mixer(const MP& p, char* smem, int l, bool last) {
  int* qctr = p.w.ctrl() + CTRL_Q + 64 * l;
  int* slot = (int*)(smem + MEGA_LDS_MAIN + 8);
  GlaArgs ga;
  ga.zg = p.w.zg(); ga.wa2 = p.in.gla_wa2 + (size_t)l * 2 * 16 * 256; ga.ba2 = p.in.gla_ba2 + (size_t)l * 2 * 256;
  ga.of = p.w.of(); ga.ob = p.w.ob(); ga.emit_ctx = last ? 0 : 1; ga.pad_ = 0;
  const float* cw = p.in.hy_conv_w + (size_t)l * 3 * HYCOLS;
  const float* cb = p.in.hy_conv_b + (size_t)l * HYCOLS;
  const bf16* gl = p.w.gl() + (size_t)l * 2 * HYW * GSTR_L;
  for (;;) {
    __syncthreads();
    if (tid_opaque() == 0) *slot = atomicAdd(qctr, 1);
    __syncthreads();
    const int u = *slot;
    const int nunits = last ? 640 : 1152;
    if (u >= nunits) break;
    if (u < 128) gla_unit(u, ga, smem);
    else if (u < 640) hyena_latent(u - 128, p.w.zt(), cw, cb, gl, p.w.yt(), smem, p.w.hy_scr() + (size_t)blockIdx.x * 16384);
    else hyena_ctx(u - 640, p.w.zt() + NL, cw, cb, p.w.gc(), p.w.yt() + NL, smem);
  }
}

__device__ __forceinline__ void ph_gla_out(const MP& p, char* smem, int l, int mrows, int bid, int nblk) {
  const int tid = tid_opaque();
  const int lane = tid & 63, wave = tid >> 6;
  {
    const float* gn = p.in.gla_norm_g + l * 128 + (lane & 15) * 8;
    const f32x4 ga = *(const f32x4*)gn, gb = *(const f32x4*)(gn + 4);
    const float* of = p.w.of(); const float* ob = p.w.ob(); const bf16* zg = p.w.zg(); bf16* ymix = p.w.ymix();
#pragma unroll 2
    for (int it = bid; it * 8 < mrows; it += nblk) {
      const int row = it * 8 + wave;
      const size_t base = (size_t)row * 512 + lane * 8;
      const f32x4 a0 = *(const f32x4*)(of + base), a1 = *(const f32x4*)(of + base + 4);
      const f32x4 b0 = *(const f32x4*)(ob + base), b1 = *(const f32x4*)(ob + base + 4);
      const u32x4 rv = *(const u32x4*)(zg + (size_t)row * GLACOLS + 1024 + lane * 8);
      const f32x4 o0 = a0 + b0, o1 = a1 + b1;
      float ss = o0.x * o0.x + o0.y * o0.y + o0.z * o0.z + o0.w * o0.w + o1.x * o1.x + o1.y * o1.y + o1.z * o1.z + o1.w * o1.w;
      ss += shx_f(ss, 1, lane); ss += shx_f(ss, 2, lane); ss += shx_f(ss, 4, lane); ss += shx_f(ss, 8, lane);
      const float rinv = rsqrtf(ss * (1.0f / 128.0f) + EPS);
      u32x4 o;
      o.x = pack_bf16(o0.x * rinv * ga.x * silu_f(bflo(rv.x)), o0.y * rinv * ga.y * silu_f(bfhi(rv.x)));
      o.y = pack_bf16(o0.z * rinv * ga.z * silu_f(bflo(rv.y)), o0.w * rinv * ga.w * silu_f(bfhi(rv.y)));
      o.z = pack_bf16(o1.x * rinv * gb.x * silu_f(bflo(rv.z)), o1.y * rinv * gb.y * silu_f(bfhi(rv.z)));
      o.w = pack_bf16(o1.z * rinv * gb.z * silu_f(bflo(rv.w)), o1.w * rinv * gb.w * silu_f(bfhi(rv.w)));
      *(u32x4*)(ymix + (size_t)row * D + 512 + lane * 8) = o;
    }
  }
  {
    const bf16* yt = p.w.yt(); bf16* ymix = p.w.ymix();
    for (int tt = bid; tt * 64 < mrows; tt += nblk) {
      const int tok0 = tt * 64;
      __syncthreads();
#pragma unroll
      for (int i = 0; i < 8; ++i) {
        const int q = tid + i * 512, c = q >> 3, ch = q & 7;
        const u32x4 v = *(const u32x4*)(yt + (size_t)c * NT + tok0 + ch * 8);
        unsigned* d = (unsigned*)(smem + c * 132 + ch * 16);
        d[0] = v.x; d[1] = v.y; d[2] = v.z; d[3] = v.w;
      }
      __syncthreads();
#pragma unroll
      for (int i = 0; i < 8; ++i) {
        const int c8 = wave * 8 + (lane & 7), t = i * 8 + (lane >> 3);
        const unsigned short* s = (const unsigned short*)(smem + (c8 * 8) * 132 + t * 2);
        const unsigned e0 = s[0], e1 = s[66], e2 = s[132], e3 = s[198], e4 = s[264], e5 = s[330], e6 = s[396], e7 = s[462];
        *(u32x4*)(ymix + (size_t)(tok0 + t) * D + c8 * 8) = (u32x4){e0 | (e1 << 16), e2 | (e3 << 16), e4 | (e5 << 16), e6 | (e7 << 16)};
      }
    }
  }
}

__device__ __forceinline__ void ph_norm2(const MP& p, int l, int mrows, int bid, int nblk) {
  const int lane = tid_opaque() & 63, wave = tid_opaque() >> 6;
  const float* g = p.in.norm2_g + l * D;
  const float* modl = p.w.mod() + (size_t)l * 17 * 6 * D;
  for (int it = bid; it * 8 < mrows; it += nblk) {
    const int row = it * 8 + wave;
    f32x4 v[4];
    row_load(p.w.xs() + (size_t)row * D, lane, v);
    const float rinv = row_rinv(v, lane);
    const float* mb = modl + (size_t)row_batch(row) * 6 * D;
    row_norm_mod_store(v, rinv, g, mb + 3 * D, mb + 4 * D, lane, p.w.abuf() + (size_t)row * D, p.w.abuf8() + (size_t)row * D);
  }
}

__device__ __forceinline__ void ph_route(const MP& p, char* smem, int l, int ntok, int bid, int nblk) {
  const int tid = tid_opaque();
  const int lane = tid & 63, wave = tid >> 6;
  const float* rb = p.in.router_b + l * NE;
  int* lcnt = (int*)smem;
  __syncthreads();
  if (tid < NE) lcnt[tid] = 0;
  __syncthreads();
  const f32x4 bb = *(const f32x4*)(rb + lane * 4);
  const int tpb = (ntok + nblk - 1) / nblk;
  for (int it = wave; it < tpb; it += 8) {
    const int tok = bid * tpb + it;
    if (tok >= ntok) break;
    const f32x4 lg = *(const f32x4*)(p.w.logits() + (size_t)tok * NE + lane * 4);
    const float s0 = sigmoid_f(lg.x), s1 = sigmoid_f(lg.y), s2 = sigmoid_f(lg.z), s3 = sigmoid_f(lg.w);
    const float v0 = s0 + bb.x, v1 = s1 + bb.y, v2 = s2 + bb.z, v3 = s3 + bb.w;
    float m1 = fmaxf(v0, v1), m2 = fminf(v0, v1);
    { float n1 = fmaxf(m1, v2); float n2 = fmaxf(fminf(m1, v2), m2); m1 = n1; m2 = n2; }
    { float n1 = fmaxf(m1, v3); float n2 = fmaxf(fminf(m1, v3), m2); m1 = n1; m2 = n2; }
#pragma unroll
    for (int o = 1; o <= 4; o <<= 1) {
      float a1 = shx_f(m1, o, lane), a2 = shx_f(m2, o, lane);
      float n1 = fmaxf(m1, a1);
      float n2 = fmaxf(fminf(m1, a1), fmaxf(m2, a2));
      m1 = n1; m2 = n2;
    }
    const float gs = m1 + m2;
    const int g = lane >> 3;
    int rank = 0;
#pragma unroll
    for (int gg = 0; gg < 8; ++gg) {
      const float og = __int_as_float(__builtin_amdgcn_readlane(__float_as_int(gs), gg * 8));
      rank += (og > gs || (og == gs && gg < g)) ? 1 : 0;
    }
    unsigned k0, k1, k2, k3;
    {
      const bool sel = rank < 4;
      unsigned u;
      u = __float_as_uint(v0); u = (u & 0x80000000u) ? ~u : (u | 0x80000000u); k0 = sel ? ((u & 0xffffff00u) | (unsigned)(255 - (lane * 4 + 0))) : 0u;
      u = __float_as_uint(v1); u = (u & 0x80000000u) ? ~u : (u | 0x80000000u); k1 = sel ? ((u & 0xffffff00u) | (unsigned)(255 - (lane * 4 + 1))) : 0u;
      u = __float_as_uint(v2); u = (u & 0x80000000u) ? ~u : (u | 0x80000000u); k2 = sel ? ((u & 0xffffff00u) | (unsigned)(255 - (lane * 4 + 2))) : 0u;
      u = __float_as_uint(v3); u = (u & 0x80000000u) ? ~u : (u | 0x80000000u); k3 = sel ? ((u & 0xffffff00u) | (unsigned)(255 - (lane * 4 + 3))) : 0u;
    }
    float gsum = 0.f, myg = 0.f; int mye = 0;
#pragma unroll
    for (int k = 0; k < TOPK; ++k) {
      unsigned m = max(max(k0, k1), max(k2, k3));
      m = max(m, (unsigned)__builtin_amdgcn_update_dpp(0, (int)m, 0x111, 0xf, 0xf, false));
      m = max(m, (unsigned)__builtin_amdgcn_update_dpp(0, (int)m, 0x112, 0xf, 0xf, false));
      m = max(m, (unsigned)__builtin_amdgcn_update_dpp(0, (int)m, 0x114, 0xf, 0xf, false));
      m = max(m, (unsigned)__builtin_amdgcn_update_dpp(0, (int)m, 0x118, 0xf, 0xf, false));
      m = max(m, (unsigned)__builtin_amdgcn_update_dpp(0, (int)m, 0x142, 0xa, 0xf, false));
      m = max(m, (unsigned)__builtin_amdgcn_update_dpp(0, (int)m, 0x143, 0xc, 0xf, false));
      const unsigned wk = (unsigned)__builtin_amdgcn_readlane((int)m, 63);
      const int we = 255 - (int)(wk & 255u);
      const int wl = we >> 2, wi = we & 3;
      const float sv = __int_as_float(__builtin_amdgcn_readlane(__float_as_int(wi == 0 ? s0 : wi == 1 ? s1 : wi == 2 ? s2 : s3), wl));
      if (lane == wl) { if (wi == 0) k0 = 0u; else if (wi == 1) k1 = 0u; else if (wi == 2) k2 = 0u; else k3 = 0u; }
      gsum += sv;
      if (lane == k) { myg = sv; mye = we; }
    }
    if (lane < TOPK) {
      p.w.tok_e()[tok * TOPK + lane] = mye;
      p.w.tok_gate()[tok * TOPK + lane] = myg / gsum * 2.5f;
      atomicAdd(&lcnt[mye], 1);
    }
  }
  __syncthreads();
  if (tid < NE) p.w.blkcnt()[bid * NE + tid] = lcnt[tid];
}

__device__ __forceinline__ void ph_assign(const MP& p, char* smem, int l, int ntok, int bid, int nblk) {
  const int tid = tid_opaque();
  int* ps = (int*)smem;
  int* cur = (int*)smem + 512;
  __syncthreads();
  int* part = (int*)smem + 1024;
  {
    const int eg = tid & 63, bg = tid >> 6;
    const int per = (nblk + 7) >> 3;
    int t0 = 0, t1 = 0, t2 = 0, t3 = 0, b0 = 0, b1 = 0, b2 = 0, b3 = 0;
    const int* src = p.w.blkcnt() + eg * 4;
#pragma unroll 8
    for (int i = 0; i < per; ++i) {
      const int b = bg * per + i;
      if (b < nblk) {
        const u32x4 v = *(const u32x4*)(src + (size_t)b * NE);
        t0 += (int)v.x; t1 += (int)v.y; t2 += (int)v.z; t3 += (int)v.w;
        if (b < bid) { b0 += (int)v.x; b1 += (int)v.y; b2 += (int)v.z; b3 += (int)v.w; }
      }
    }
    int* pt = part + bg * 512 + eg * 4;
    pt[0] = t0; pt[1] = t1; pt[2] = t2; pt[3] = t3;
    pt[256] = b0; pt[257] = b1; pt[258] = b2; pt[259] = b3;
  }
  __syncthreads();
  int before = 0;
  if (tid < NE) {
    int tot = 0;
#pragma unroll
    for (int g = 0; g < 8; ++g) { tot += part[g * 512 + tid]; before += part[g * 512 + 256 + tid]; }
    const int pc = (tot + 255) & ~255;
    const int lane = tid & 63;
    int inc = pc;
#pragma unroll
    for (int o = 1; o < 64; o <<= 1) { const int n = shl_i(inc, lane - o); if (lane >= o) inc += n; }
    ps[tid + 1] = inc;
    if (lane == 63) cur[tid >> 6] = inc;
  }
  __syncthreads();
  if (tid < NE) {
    const int w = tid >> 6;
    int offs = 0;
#pragma unroll
    for (int k = 0; k < 3; ++k) offs += (k < w) ? cur[k] : 0;
    ps[tid + 1] += offs;
    if (tid == 0) ps[0] = 0;
  }
  __syncthreads();
  if (tid < NE) {
    unsigned short* te = (unsigned short*)(smem + LDS_TILE_E);
    for (int t = ps[tid] >> 8; t < (ps[tid + 1] >> 8); ++t) te[t] = (unsigned short)tid;
  }
  if (tid < NE) cur[tid] = ps[tid] + before;
  if (bid == 0 && tid <= NE) p.w.pad_start()[tid] = ps[tid];
  __syncthreads();
  const int tpb = (ntok + nblk - 1) / nblk;
  for (int i = tid; i < tpb * TOPK; i += 512) {
    const int gi = bid * tpb * TOPK + i;
    if (gi >= ntok * TOPK) break;
    const int e = p.w.tok_e()[gi];
    const int slot = atomicAdd(&cur[e], 1);
    p.w.slot_tok()[slot] = gi >> 3;
    p.w.tok_slot()[gi] = slot;
  }
}

__device__ __forceinline__ void ph_combine(const MP& p, int l, int mrows, bool last, int bid, int nblk) {
  const int lane = tid_opaque() & 63, wave = tid_opaque() >> 6;
  const float* modl = p.w.mod() + (size_t)l * 17 * 6 * D;
  for (int it = bid; it * 8 < mrows; it += nblk) {
    const int row = it * 8 + wave;
    const int b = row_batch(row);
    f32x4 v[4], acc[4];
    row_load(p.w.xs() + (size_t)row * D, lane, v);
#pragma unroll
    for (int j = 0; j < 4; ++j) acc[j] = (f32x4){0.f, 0.f, 0.f, 0.f};
    int sl = 0; float gt = 0.f;
    if (lane < TOPK) { sl = p.w.tok_slot()[row * TOPK + lane]; gt = p.w.tok_gate()[row * TOPK + lane]; }
#pragma unroll
    for (int k = 0; k < TOPK; ++k) {
      const int s = shl_i(sl, k);
      const float gk = shl_f(gt, k);
      const unsigned char* yr = p.w.ybuf() + (size_t)s * D + lane * 4;
#pragma unroll
      for (int j = 0; j < 4; ++j) {
        const int y = *(const int*)(yr + j * 256);
        const f32x2v lo = __builtin_amdgcn_cvt_pk_f32_fp8(y, false), hi = __builtin_amdgcn_cvt_pk_f32_fp8(y, true);
        acc[j].x += gk * lo.x; acc[j].y += gk * lo.y; acc[j].z += gk * hi.x; acc[j].w += gk * hi.y;
      }
    }
    const float* g2 = modl + (size_t)b * 6 * D + 5 * D;
#pragma unroll
    for (int j = 0; j < 4; ++j) {
      const f32x4 gv = *(const f32x4*)(g2 + j * 256 + lane * 4);
      v[j] += gv * acc[j];
    }
    const float rinv = row_rinv(v, lane);
    if (last) {
#pragma unroll
      for (int j = 0; j < 4; ++j) {
        const f32x4 fg = *(const f32x4*)(p.in.final_g + j * 256 + lane * 4);
        *(f32x4*)(p.out + (size_t)row * D + j * 256 + lane * 4) = v[j] * rinv * fg;
      }
    } else {
#pragma unroll
      for (int j = 0; j < 4; ++j) *(f32x4*)(p.w.xs() + (size_t)row * D + j * 256 + lane * 4) = v[j];
      const float* mb = p.w.mod() + ((size_t)(l + 1) * 17 + b) * 6 * D;
      row_norm_mod_store(v, rinv, p.in.norm1_g + (l + 1) * D, mb, mb + D, lane, p.w.abuf() + (size_t)row * D, p.w.abuf8() + (size_t)row * D);
    }
  }
}

__global__ void __launch_bounds__(512, 2) k_mega(MP p) {
  extern __shared__ __attribute__((aligned(16))) char smem[];
  const int bid = blockIdx.x, nblk = gridDim.x;
  if (tid_opaque() == 0) *(u32x4*)(smem + MEGA_LDS_MAIN) = (u32x4){0u, 0u, 0u, 0u};
  __syncthreads();
  (void)xcd_barrier_post(p.w.bar(), (volatile LAS unsigned*)(smem + MEGA_LDS_MAIN));

  if (threadIdx.x == 0) {
    const unsigned xcc = xb_xcc_id();
    const int rank = atomicAdd(&p.w.ctrl()[CTRL_XR + 16 * xcc], 1);
    *(int*)(smem + MEGA_LDS_MAIN + 12) = rank;
  }
  ph_mod_hid(p, smem, bid, nblk);
  cvt_job(p.in.w_in, p.w.w_in_t(), D, INCOLS, 1, bid, nblk, HYCOLS);
  cvt_job(p.in.w_in + (size_t)D * INCOLS, p.w.w_in_t() + (size_t)WIN_ROWS * D, D, INCOLS, 1, bid, nblk, HYCOLS);
  cvt8_job(p.in.w_in + HYCOLS, p.w.w_g8(), D, INCOLS, 1, bid, nblk, GLACOLS);
  cvt8_job(p.in.w_in + (size_t)D * INCOLS + HYCOLS, p.w.w_g8() + (size_t)GW_ROWS * D, D, INCOLS, 1, bid, nblk, GLACOLS);
  cvt_job(p.in.w_out, p.w.w_out_t(), D, D, DEPTH, bid, nblk);
  cvt_job(p.in.router_w, p.w.router_t(), D, NE, DEPTH, bid, nblk);
  cvt8_job(p.in.sh_w1, p.w.sh1_t(), D, DE, DEPTH, bid, nblk);
  cvt8_job(p.in.sh_w3, p.w.sh3_t(), D, DE, DEPTH, bid, nblk);
  cvt8_job(p.in.sh_w2, p.w.sh2_t(), DE, D, DEPTH, bid, nblk);
  cvt8_job(p.in.exp_w1, p.w.e1_t(), D, DE, NE, bid, nblk);
  cvt8_job(p.in.exp_w3, p.w.e3_t(), D, DE, NE, bid, nblk);
  cvt8_job(p.in.exp_w2, p.w.e2_t(), DE, D, NE, bid, nblk);
  grid_sync(p.w.bar(), smem + MEGA_LDS_MAIN);
  int vb = bid;
  {
    const int rank = *(const int*)(smem + MEGA_LDS_MAIN + 12);
    const unsigned xcc = xb_xcc_id();
    int npop = 0, xidx = 0, cnt0 = -1; bool equal = true;
    for (int j = 0; j < 16; ++j) {
      const int c = p.w.ctrl()[CTRL_XR + 16 * j];
      if (c > 0) {
        if (cnt0 < 0) cnt0 = c; else if (c != cnt0) equal = false;
        if (j < (int)xcc) ++xidx;
        ++npop;
      }
    }
    if (equal && cnt0 > 0 && npop * cnt0 == nblk && rank < cnt0) vb = xidx * cnt0 + rank;
  }
  ph_gtab(p, smem, bid, nblk);
  ph_init_norm1(p, bid, nblk);
  grid_sync(p.w.bar(), smem + MEGA_LDS_MAIN);

  const int vbu = __builtin_amdgcn_readfirstlane(vb);
#pragma unroll 1
  for (int l0 = 0; l0 < DEPTH; ++l0) {
#define LL opq(l0)
    const bool last = (l0 == DEPTH - 1);
    const int mrows = last ? NL : NT;
#define MODL (p.w.mod() + (size_t)LL * 17 * 6 * D)
    if (l0 > 0) {
      cvt8_job(p.in.exp_w1 + (size_t)LL * NE * D * DE, p.w.e1_t(), D, DE, NE, opq(bid), nblk);
      cvt8_job(p.in.exp_w3 + (size_t)LL * NE * D * DE, p.w.e3_t(), D, DE, NE, opq(bid), nblk);
      cvt8_job(p.in.exp_w2 + (size_t)LL * NE * DE * D, p.w.e2_t(), DE, D, NE, opq(bid), nblk);
    }
    {
      G8InZT g; g.wt = p.w.w_in_t() + (size_t)LL * WIN_ROWS * D; g.A = p.w.abuf(); g.zt = p.w.zt(); g.ntok = last ? NL : NT;
      gemm8_run(g, smem, opq(vbu), nblk);
    }
    {
      G8InG g; g.wt = p.w.w_g8() + (size_t)LL * GW_ROWS * D; g.A = p.w.abuf8(); g.zg = p.w.zg();
      gemm8_run(g, smem, opq(vbu), nblk);
    }
    grid_sync(p.w.bar(), smem + MEGA_LDS_MAIN);
    ph_mixer(p, smem, LL, last);
    grid_sync(p.w.bar(), smem + MEGA_LDS_MAIN);
    ph_gla_out(p, smem, LL, mrows, opq(bid), nblk);
    grid_sync(p.w.bar(), smem + MEGA_LDS_MAIN);
    {
      G8Out g; g.mrows = mrows; g.ymix = p.w.ymix(); g.wt = p.w.w_out_t() + (size_t)LL * D * D; g.modl = MODL; g.xs = p.w.xs();
      gemm8_run(g, smem, opq(vbu), nblk);
    }
    grid_sync(p.w.bar(), smem + MEGA_LDS_MAIN);
    ph_norm2(p, LL, mrows, opq(bid), nblk);
    grid_sync(p.w.bar(), smem + MEGA_LDS_MAIN);
    {
      G8Router g; g.mrows = mrows; g.A = p.w.abuf(); g.rwt = p.w.router_t() + (size_t)LL * NE * D; g.logits = p.w.logits();
      gemm8_run(g, smem, opq(vbu), nblk);
    }
    {
      G8ShUp g; g.mrows = mrows; g.A8 = p.w.abuf8(); g.s1t = p.w.sh1_t() + (size_t)LL * DE * D; g.s3t = p.w.sh3_t() + (size_t)LL * DE * D; g.hs = p.w.hs();
      gemm8_run(g, smem, opq(vbu), nblk);
    }
    grid_sync(p.w.bar(), smem + MEGA_LDS_MAIN);
    ph_route(p, smem, LL, mrows, opq(bid), nblk);
    grid_sync(p.w.bar(), smem + MEGA_LDS_MAIN);
    ph_assign(p, smem, LL, mrows, opq(bid), nblk);
    grid_sync(p.w.bar(), smem + MEGA_LDS_MAIN);
    {
      G8Up g; g.A8 = p.w.abuf8(); g.slot_tok = p.w.slot_tok(); g.pad_start = p.w.pad_start(); g.w1t = p.w.e1_t(); g.w3t = p.w.e3_t(); g.H = p.w.hbuf(); g.tile_e = (const unsigned short*)(smem + LDS_TILE_E);
      gemm8_run(g, smem, opq(vbu), nblk);
    }
    {
      G8ShDown g; g.mrows = mrows; g.hs = p.w.hs(); g.wt = p.w.sh2_t() + (size_t)LL * D * DE; g.modl = MODL; g.xs = p.w.xs();
      gemm8_run(g, smem, opq(vbu), nblk);
    }
    grid_sync(p.w.bar(), smem + MEGA_LDS_MAIN);
    {
      G8Down g; g.H = p.w.hbuf(); g.pad_start = p.w.pad_start(); g.w2t = p.w.e2_t(); g.Y = p.w.ybuf(); g.tile_e = (const unsigned short*)(smem + LDS_TILE_E);
      gemm8_run(g, smem, opq(vbu), nblk);
    }
    grid_sync(p.w.bar(), smem + MEGA_LDS_MAIN);
    ph_combine(p, LL, mrows, last, opq(bid), nblk);
    if (!last) grid_sync(p.w.bar(), smem + MEGA_LDS_MAIN);
  }
#undef LL
#undef MODL
}

static inline size_t align_up(size_t v, size_t a) { return (v + a - 1) / a * a; }

extern "C" void kernel_launch(void* const* d_in, const int* in_sizes, int n_in, void* d_out, int out_size, void* d_ws,
                              size_t ws_size, hipStream_t stream) {
  MP p;
  memset(&p, 0, sizeof(p));
  const float** ip = (const float**)&p.in;
  for (int i = 0; i < 30; ++i) ip[i] = (const float*)d_in[i];
  p.out = (float*)d_out;

  p.w.b = (char*)d_ws;
  const size_t zero_bytes = wso::zero_end;
  (void)ws_size; (void)n_in; (void)in_sizes; (void)out_size;

  static int grid = 0;
  if (!grid) {
    hipFuncSetAttribute((const void*)k_mega, hipFuncAttributeMaxDynamicSharedMemorySize, MEGA_LDS);
    int dev = 0, cus = 0, per_cu = 0;
    hipGetDevice(&dev);
    hipDeviceGetAttribute(&cus, hipDeviceAttributeMultiprocessorCount, dev);
    hipOccupancyMaxActiveBlocksPerMultiprocessor(&per_cu, k_mega, 512, MEGA_LDS);
    if (cus <= 0) cus = 256;
    grid = per_cu >= 1 ? cus : 0;
    if (grid <= 0) grid = 256;
  }
  hipMemsetAsync(d_ws, 0, zero_bytes, stream);
  hipLaunchKernelGGL(k_mega, dim3(grid), dim3(512), MEGA_LDS, stream, p);
}
```

```cpp
#include <hip/hip_runtime.h>
#include <hip/hip_bf16.h>
#include <stdint.h>
#include <string.h>

typedef __hip_bfloat16 bf16;

constexpr int D = 1024, NB = 16, SEQ = 2048, LC = 256, DEPTH = 2;
constexpr int NL = NB * SEQ, NC = NB * LC, NT = NL + NC;
constexpr int HYW = 512, HYCOLS = 1536, GLACOLS = 1568, INCOLS = 3104;
constexpr int NE = 256, TOPK = 8, DE = 256;
constexpr int NSLOT = NT * TOPK + NE * 256;
constexpr float EPS = 1e-6f;
constexpr float HY_MIN_DECAY = 3.0701134573253945f;
constexpr float HY_MAX_DECAY = 15.350567286626973f;
constexpr int GSTR_L = 4096, GSTR_C = 512;
constexpr int WIN_ROWS = HYCOLS;
constexpr int GW_ROWS = 7 * 256;

__device__ __forceinline__ float bf2f(bf16 v) { return __bfloat162float(v); }
__device__ __forceinline__ bf16 f2bf(float v) { return __float2bfloat16(v); }
__device__ __forceinline__ float silu_f(float x) { return x / (1.f + __expf(-x)); }
__device__ __forceinline__ float sigmoid_f(float x) { return 1.f / (1.f + __expf(-x)); }
__device__ __forceinline__ float logsigmoid_f(float x) { return fminf(x, 0.f) - __logf(1.f + __expf(-fabsf(x))); }

__device__ __forceinline__ float shx_f(float v, int mask, int lane) { return __int_as_float(__builtin_amdgcn_ds_bpermute((lane ^ mask) << 2, __float_as_int(v))); }
__device__ __forceinline__ int shx_i(int v, int mask, int lane) { return __builtin_amdgcn_ds_bpermute((lane ^ mask) << 2, v); }
__device__ __forceinline__ float shl_f(float v, int src) { return __int_as_float(__builtin_amdgcn_ds_bpermute(src << 2, __float_as_int(v))); }
__device__ __forceinline__ int shl_i(int v, int src) { return __builtin_amdgcn_ds_bpermute(src << 2, v); }
__device__ __forceinline__ float wave_sum(float v, int lane) {
#pragma unroll
  for (int o = 32; o > 0; o >>= 1) v += shx_f(v, o, lane);
  return v;
}

struct Inputs {
  const float *x, *c, *ctx, *c_ctx, *ada_w, *ada_b, *norm1_g, *norm2_g, *w_in, *w_out, *hy_conv_w, *hy_conv_b,
      *hy_f_w1, *hy_f_b1, *hy_f_w2, *hy_f_b2, *hy_f_w3, *hy_skip, *gla_wa2, *gla_ba2, *gla_norm_g, *router_w,
      *router_b, *exp_w1, *exp_w3, *exp_w2, *sh_w1, *sh_w3, *sh_w2, *final_g;
};

__device__ __forceinline__ int opq(int v) { asm volatile("" : "+s"(v)); return v; }
__device__ __forceinline__ int tid_opaque() { int t = threadIdx.x; asm volatile("" : "+v"(t)); return t; }
__device__ __forceinline__ int row_batch(int row) { return row < NL ? (row >> 11) : 16; }

#define XB_TMO      128
#define XB_XCNT(j)  (256  + 64 * (j))
#define XB_XSUB(j)  (1280 + 64 * (j))
#define XB_XGEN(j)  (2304 + 64 * (j))
#define XB_TOP      3328
#define XB_TOPGEN   3392
#define XCD_BAR_WORDS 3456
#define XB_SPIN_CAP (1u << 18)
#define LAS __attribute__((address_space(3)))

__device__ __forceinline__ unsigned xb_ld(unsigned* p)              { return __hip_atomic_load(p, __ATOMIC_RELAXED, __HIP_MEMORY_SCOPE_AGENT); }
__device__ __forceinline__ unsigned xb_add(unsigned* p, unsigned v) { return __hip_atomic_fetch_add(p, v, __ATOMIC_RELAXED, __HIP_MEMORY_SCOPE_AGENT); }
__device__ __forceinline__ unsigned xb_xcc_id() { return (unsigned)__builtin_amdgcn_s_getreg((3 << 11) | 20) & 0xFu; }
#define XB_SPIN(cond, bar) do { unsigned _sp = 0; while (cond) { __builtin_amdgcn_s_sleep(1); \
    if ((++_sp & 255u) == 0u) { if (xb_ld(&(bar)[XB_TMO])) break; if (_sp > XB_SPIN_CAP) { atomicAdd(&(bar)[XB_TMO], 1u); break; } } } } while (0)

struct XcdBarrier {
    unsigned* bar; unsigned x;
    volatile LAS unsigned* st;
};

__device__ __forceinline__ XcdBarrier xcd_barrier_post(unsigned* bar, volatile LAS unsigned* st) {
    XcdBarrier b; b.bar = bar; b.x = xb_xcc_id(); b.st = st;
    if (threadIdx.x == 0) (void)xb_add(&bar[XB_XCNT(b.x)], 1u);
    return b;
}
__device__ __forceinline__ void xcd_barrier_complete(unsigned* bar, unsigned x, unsigned& nloc, unsigned& nx) {
    const unsigned G = gridDim.x * gridDim.y * gridDim.z;
    unsigned sum, cnt, mine, sp = 0u;
    for (;;) {
        sum = 0u; cnt = 0u; mine = 0u;
#pragma unroll
        for (unsigned j = 0; j < 16; ++j) { const unsigned c = xb_ld(&bar[XB_XCNT(j)]); sum += c; cnt += (c > 0u) ? 1u : 0u; mine = (j == x) ? c : mine; }
        if (sum == G) break;
        __builtin_amdgcn_s_sleep(1);
        if ((++sp & 255u) == 0u) { if (xb_ld(&bar[XB_TMO])) break; if (sp > XB_SPIN_CAP) { atomicAdd(&bar[XB_TMO], 1u); break; } }
    }
    nloc = mine > 0u ? mine : 1u; nx = cnt > 0u ? cnt : 1u;
}
__device__ __forceinline__ void xcd_barrier(const XcdBarrier& b) {
    asm volatile("s_waitcnt vmcnt(0)" ::: "memory");
    __syncthreads();
    if (threadIdx.x == 0) {
        unsigned* bar = b.bar;
        __builtin_amdgcn_s_waitcnt(0);
        unsigned nloc = b.st[0], nx = b.st[1];
        if (nloc == 0u) { xcd_barrier_complete(bar, b.x, nloc, nx); b.st[0] = nloc; b.st[1] = nx; }
        const unsigned old = xb_add(&bar[XB_XSUB(b.x)], 1u);
        const unsigned gen = old / nloc;
        if (old + 1u == (gen + 1u) * nloc) {
            __builtin_amdgcn_fence(__ATOMIC_RELEASE, "agent");
            asm volatile("s_waitcnt vmcnt(0)" ::: "memory");
            const unsigned og = xb_add(&bar[XB_TOP], 1u);
            const unsigned tg = og / nx;
            if (og + 1u == (tg + 1u) * nx) xb_add(&bar[XB_TOPGEN], 1u);
            else XB_SPIN(xb_ld(&bar[XB_TOPGEN]) == tg, bar);
            __builtin_amdgcn_fence(__ATOMIC_ACQUIRE, "agent");
            xb_add(&bar[XB_XGEN(b.x)], 1u);
            asm volatile("s_waitcnt vmcnt(0)" ::: "memory");
        } else {
            XB_SPIN(xb_ld(&bar[XB_XGEN(b.x)]) == gen, bar);
            __builtin_amdgcn_fence(__ATOMIC_ACQUIRE, "agent");
            asm volatile("s_waitcnt vmcnt(0)" ::: "memory");
        }
    }
    __syncthreads();
}

__device__ __forceinline__ void grid_sync(unsigned* bar0, char* stw) {
  unsigned* q = bar0;
  asm volatile("" : "+s"(q));
  XcdBarrier b; b.bar = q; b.x = xb_xcc_id(); b.st = (volatile LAS unsigned*)stw;
  xcd_barrier(b);
}

typedef __attribute__((ext_vector_type(8))) __bf16 bf16x8;
typedef __attribute__((ext_vector_type(16))) float f32x16;
typedef __attribute__((ext_vector_type(4))) float f32x4;
typedef __attribute__((ext_vector_type(2))) float f32x2v;
typedef __attribute__((ext_vector_type(2))) __bf16 bf16x2v;
typedef __attribute__((ext_vector_type(4))) unsigned int u32x4;
typedef __attribute__((ext_vector_type(2))) unsigned int u32x2;

__device__ __forceinline__ unsigned pack_bf16(float a, float b) {
  f32x2v v = {a, b};
  return __builtin_bit_cast(unsigned, __builtin_convertvector(v, bf16x2v));
}
__device__ __forceinline__ int swz(int row, int chunk) { return row * 128 + ((chunk ^ ((row >> 1) & 7)) << 4); }
__device__ __forceinline__ int rowmap(int reg, int lh) { return (reg & 3) + 8 * (reg >> 2) + 4 * lh; }

__device__ __forceinline__ int find_group(const int* __restrict__ pad_start, int m0) {
  int lo = 0, hi = NE - 1;
  while (lo < hi) {
    int mid = (lo + hi + 1) >> 1;
    if (pad_start[mid] <= m0) lo = mid; else hi = mid - 1;
  }
  return lo;
}

__device__ __forceinline__ void cvt_wave_tile(const float* __restrict__ src, bf16* __restrict__ dst, int K, int N, int kt, int ntile, int lane) {
  const int k0 = kt * 64 + (lane & 7) * 8, n0 = ntile * 32 + (lane >> 3) * 4;
  const float* s = src + (size_t)k0 * N + n0;
  const f32x4 v0 = __builtin_nontemporal_load((const f32x4*)(s)), v1 = __builtin_nontemporal_load((const f32x4*)(s + (size_t)N));
  const f32x4 v2 = __builtin_nontemporal_load((const f32x4*)(s + (size_t)2 * N)), v3 = __builtin_nontemporal_load((const f32x4*)(s + (size_t)3 * N));
  const f32x4 v4 = __builtin_nontemporal_load((const f32x4*)(s + (size_t)4 * N)), v5 = __builtin_nontemporal_load((const f32x4*)(s + (size_t)5 * N));
  const f32x4 v6 = __builtin_nontemporal_load((const f32x4*)(s + (size_t)6 * N)), v7 = __builtin_nontemporal_load((const f32x4*)(s + (size_t)7 * N));
  bf16* d = dst + (size_t)n0 * K + k0;
  *(u32x4*)(d) = (u32x4){pack_bf16(v0.x, v1.x), pack_bf16(v2.x, v3.x), pack_bf16(v4.x, v5.x), pack_bf16(v6.x, v7.x)};
  *(u32x4*)(d + (size_t)K) = (u32x4){pack_bf16(v0.y, v1.y), pack_bf16(v2.y, v3.y), pack_bf16(v4.y, v5.y), pack_bf16(v6.y, v7.y)};
  *(u32x4*)(d + (size_t)2 * K) = (u32x4){pack_bf16(v0.z, v1.z), pack_bf16(v2.z, v3.z), pack_bf16(v4.z, v5.z), pack_bf16(v6.z, v7.z)};
  *(u32x4*)(d + (size_t)3 * K) = (u32x4){pack_bf16(v0.w, v1.w), pack_bf16(v2.w, v3.w), pack_bf16(v4.w, v5.w), pack_bf16(v6.w, v7.w)};
}
typedef __attribute__((ext_vector_type(8))) int i32x8;
typedef __attribute__((ext_vector_type(4))) int i32x4;
__device__ __forceinline__ float clamp_fp8(float x) { return __builtin_amdgcn_fmed3f(x, -448.0f, 448.0f); }
__device__ __forceinline__ unsigned pk4_fp8(float a, float b, float c, float d) {
  a = clamp_fp8(a); b = clamp_fp8(b); c = clamp_fp8(c); d = clamp_fp8(d);
  int w = 0;
  w = __builtin_amdgcn_cvt_pk_fp8_f32(a, b, w, false);
  w = __builtin_amdgcn_cvt_pk_fp8_f32(c, d, w, true);
  return (unsigned)w;
}
__device__ __forceinline__ void cvt8_wave_tile(const float* __restrict__ src, unsigned char* __restrict__ dst, int K, int N, int kt, int ntile, int lane) {
  const int k0 = kt * 64 + (lane & 7) * 8, n0 = ntile * 32 + (lane >> 3) * 4;
  const float* s = src + (size_t)k0 * N + n0;
  const float sc = 16.0f;
  const f32x4 v0 = __builtin_nontemporal_load((const f32x4*)(s)) * sc, v1 = __builtin_nontemporal_load((const f32x4*)(s + (size_t)N)) * sc;
  const f32x4 v2 = __builtin_nontemporal_load((const f32x4*)(s + (size_t)2 * N)) * sc, v3 = __builtin_nontemporal_load((const f32x4*)(s + (size_t)3 * N)) * sc;
  const f32x4 v4 = __builtin_nontemporal_load((const f32x4*)(s + (size_t)4 * N)) * sc, v5 = __builtin_nontemporal_load((const f32x4*)(s + (size_t)5 * N)) * sc;
  const f32x4 v6 = __builtin_nontemporal_load((const f32x4*)(s + (size_t)6 * N)) * sc, v7 = __builtin_nontemporal_load((const f32x4*)(s + (size_t)7 * N)) * sc;
  unsigned char* d = dst + (size_t)n0 * K + k0;
  *(u32x2*)(d) = (u32x2){pk4_fp8(v0.x, v1.x, v2.x, v3.x), pk4_fp8(v4.x, v5.x, v6.x, v7.x)};
  *(u32x2*)(d + (size_t)K) = (u32x2){pk4_fp8(v0.y, v1.y, v2.y, v3.y), pk4_fp8(v4.y, v5.y, v6.y, v7.y)};
  *(u32x2*)(d + (size_t)2 * K) = (u32x2){pk4_fp8(v0.z, v1.z, v2.z, v3.z), pk4_fp8(v4.z, v5.z, v6.z, v7.z)};
  *(u32x2*)(d + (size_t)3 * K) = (u32x2){pk4_fp8(v0.w, v1.w, v2.w, v3.w), pk4_fp8(v4.w, v5.w, v6.w, v7.w)};
}
__device__ __forceinline__ void cvt8_job(const float* __restrict__ src, unsigned char* __restrict__ dst, int K, int N, int nmat, int bid, int nblk, int W = 0) {
  const int tid = tid_opaque(), lane = tid & 63, wave = tid >> 6;
  if (W == 0) W = N;
  const int tk = K >> 6, tn = W >> 5, per = tk * tn;
  const int total = per * nmat;
  for (int u = bid * 8 + wave; u < total; u += nblk * 8) {
    const int mat = u / per, r = u - mat * per;
    const int ntile = r / tk, kt = r - ntile * tk;
    cvt8_wave_tile(src + (size_t)mat * K * N, dst + (size_t)mat * K * W, K, N, kt, ntile, lane);
  }
}

__device__ __forceinline__ void cvt_job(const float* __restrict__ src, bf16* __restrict__ dst, int K, int N, int nmat, int bid, int nblk, int W = 0) {
  const int tid = tid_opaque(), lane = tid & 63, wave = tid >> 6;
  if (W == 0) W = N;
  const int tk = K >> 6, tn = W >> 5, per = tk * tn;
  const int total = per * nmat;
  for (int u = bid * 8 + wave; u < total; u += nblk * 8) {
    const int mat = u / per, r = u - mat * per;
    const int ntile = r / tk, kt = r - ntile * tk;
    cvt_wave_tile(src + (size_t)mat * K * N, dst + (size_t)mat * K * W, K, N, kt, ntile, lane);
  }
}

constexpr int G8_HT = 128 * 64;
constexpr int G8_LDS = 8 * G8_HT * 2;

__device__ __forceinline__ int g8_lds_byte(int r, int c) {
  int st = (r >> 4) * 2 + (c >> 5), rr = r & 15, cc = c & 31, ob = rr * 64 + cc * 2;
  return st * 1024 + (ob ^ (((ob >> 9) & 1) << 5));
}
__device__ __forceinline__ void g8_stage_rc(int b, int& R, int& C) {
  int st = b / 1024, sb = b % 1024, sw = sb ^ (((sb >> 9) & 1) << 5);
  R = (st >> 1) * 16 + sw / 64; C = (st & 1) * 32 + (sw % 64) / 2;
}

typedef f32x4 g8acc_t[2][2][4][2];

template <class P>
__device__ __forceinline__ void gemm8_run(const P& p, char* smem, int bid, int nblk) {
  const int ntl = __builtin_amdgcn_readfirstlane(p.ntiles());
  if (bid >= ntl) return;
  bf16* shm = (bf16*)smem;
#define SA(b, h) (shm + ((b) * 2 + (h)) * G8_HT)
#define SB(b, h) (shm + (4 + (b) * 2 + (h)) * G8_HT)
#define GLDS(SRC, DST) __builtin_amdgcn_global_load_lds((const unsigned*)(SRC), (unsigned*)(DST), 16, 0, 0)
#define STAGE_A(PP, BASE, KT) do { GLDS((BASE) + (oa + (KT) * 64), (char*)(PP) + ldsd); GLDS((BASE) + 64 * P::A_PITCH + (oa + (KT) * 64), (char*)(PP) + ldsd + 8192); } while (0)
#define STAGE_B(PP, BASE, OB, KT) do { \
    if constexpr (P::B_GATHER) { GLDS((BASE) + ((((OB) & 0xffffu) * (unsigned)P::B_PITCH + cc) + (KT) * 64), (char*)(PP) + ldsd); \
                                 GLDS((BASE) + ((((OB) >> 16) * (unsigned)P::B_PITCH + cc) + (KT) * 64), (char*)(PP) + ldsd + 8192); } \
    else { GLDS((BASE) + ((OB) + (KT) * 64), (char*)(PP) + ldsd); GLDS((BASE) + 64 * P::B_PITCH + ((OB) + (KT) * 64), (char*)(PP) + ldsd + 8192); } } while (0)
#define LDA(dst, b, h) for (int m = 0; m < 4; ++m) \
    dst[m] = __builtin_shufflevector(*reinterpret_cast<const i32x4*>((char*)SA(b, h) + aoff + m * 2048), \
                                     *reinterpret_cast<const i32x4*>((char*)SA(b, h) + aoff + m * 2048 + 1024), 0, 1, 2, 3, 4, 5, 6, 7)
#define LDB(dst, b, h) for (int n = 0; n < 2; ++n) \
    dst[n] = __builtin_shufflevector(*reinterpret_cast<const i32x4*>((char*)SB(b, h) + boff + n * 2048), \
                                     *reinterpret_cast<const i32x4*>((char*)SB(b, h) + boff + n * 2048 + 1024), 0, 1, 2, 3, 4, 5, 6, 7)
#define FRAG_LO(x) __builtin_bit_cast(bf16x8, __builtin_shufflevector(x, x, 0, 1, 2, 3))
#define FRAG_HI(x) __builtin_bit_cast(bf16x8, __builtin_shufflevector(x, x, 4, 5, 6, 7))
#define MMA(ai, bj, At_, Bt_) do { __builtin_amdgcn_s_setprio(1); \
    if constexpr (P::FP8) { \
      for (int m = 0; m < 4; ++m) for (int n = 0; n < 2; ++n) \
        asm volatile("v_mfma_scale_f32_16x16x128_f8f6f4 %0, %1, %2, %0, %3, %3 op_sel_hi:[0,0,0]" \
                     : "+v"(acc[ai][bj][m][n]) : "v"(At_[m]), "v"(Bt_[n]), "v"(mxs)); \
    } else { \
      for (int m = 0; m < 4; ++m) for (int n = 0; n < 2; ++n) { \
        acc[ai][bj][m][n] = __builtin_amdgcn_mfma_f32_16x16x32_bf16(FRAG_LO(At_[m]), FRAG_LO(Bt_[n]), acc[ai][bj][m][n], 0, 0, 0); \
        acc[ai][bj][m][n] = __builtin_amdgcn_mfma_f32_16x16x32_bf16(FRAG_HI(At_[m]), FRAG_HI(Bt_[n]), acc[ai][bj][m][n], 0, 0, 0); } \
    } \
    __builtin_amdgcn_s_setprio(0); } while (0)
#define WAIT_V(n) asm volatile("s_waitcnt vmcnt(" #n ")" ::: "memory")
#define WAIT_L(n) asm volatile("s_waitcnt lgkmcnt(" #n ")" ::: "memory")
#define BAR __builtin_amdgcn_s_barrier()
#define SCHED __builtin_amdgcn_sched_barrier(0)

  typename P::Ctx cur, nxt;
  p.tile(bid, cur);
  int aoff, boff, ldsd;
  unsigned oa, cc, ob0, ob1;
  bool wr1;
  {
    const int tid = tid_opaque();
    const int wid = tid >> 6, lane = tid & 63, wr = wid >> 2, wc = wid & 3, fr = lane & 15, fq = lane >> 4;
    aoff = g8_lds_byte(wr * 64 + fr, fq * 8); boff = g8_lds_byte(wc * 32 + fr, fq * 8);
    ldsd = tid * 16; wr1 = (wr == 1);
    int R0, C0;
    g8_stage_rc(tid * 16, R0, C0);
    cc = C0;
    oa = (((R0 >> 2) & 3) * 16 + (R0 >> 4) * 4 + (R0 & 3)) * P::A_PITCH + C0;
    if constexpr (P::B_GATHER) {
      ob0 = p.b_row(cur, 0, R0) | (p.b_row(cur, 0, R0 + 64) << 16);
      ob1 = p.b_row(cur, 1, R0) | (p.b_row(cur, 1, R0 + 64) << 16);
    } else { ob0 = R0 * P::B_PITCH + C0; ob1 = ob0; }
  }
  const bf16* ca0 = p.a_base(cur, 0);
  const bf16* ca1 = p.a_base(cur, 1);
  const bf16* cb0 = p.b_base(cur, 0);
  const bf16* cb1 = p.b_base(cur, 1);

  g8acc_t acc;
#pragma unroll
  for (int a0 = 0; a0 < 2; ++a0)
#pragma unroll
    for (int b0 = 0; b0 < 2; ++b0)
#pragma unroll
      for (int m = 0; m < 4; ++m)
#pragma unroll
        for (int n = 0; n < 2; ++n) acc[a0][b0][m][n] = (f32x4){0.f, 0.f, 0.f, 0.f};
  i32x8 At[4], B0[2], B1[2];
  const int mxs = 0x7F7F7F7F;
  const int nt = opq(P::NKT);
  STAGE_B(SB(0, 0), cb0, ob0, 0); STAGE_A(SA(0, 0), ca0, 0);
  STAGE_B(SB(0, 1), cb1, ob1, 0); STAGE_A(SA(0, 1), ca1, 0);
  if (wr1) BAR;
  WAIT_V(4); BAR;
  STAGE_B(SB(1, 0), cb0, ob0, 1); STAGE_A(SA(1, 0), ca0, 1); STAGE_B(SB(1, 1), cb1, ob1, 1);
  WAIT_V(6); BAR;
#pragma unroll 1
  for (int idx = bid;;) {
    const int nidx = idx + nblk;
    const bool has_next = nidx < ntl;
    if (has_next) p.tile(nidx, nxt); else nxt = cur;
    const bf16* na0 = p.a_base(nxt, 0);
    const bf16* na1 = p.a_base(nxt, 1);
    const bf16* nb0 = p.b_base(nxt, 0);
    const bf16* nb1 = p.b_base(nxt, 1);
    unsigned nob0 = ob0, nob1 = ob1;
    if constexpr (P::B_GATHER) {
      const int t2 = tid_opaque();
      int R0, C0;
      g8_stage_rc(t2 * 16, R0, C0);
      nob0 = p.b_row(nxt, 0, R0) | (p.b_row(nxt, 0, R0 + 64) << 16);
      nob1 = p.b_row(nxt, 1, R0) | (p.b_row(nxt, 1, R0 + 64) << 16);
    }
#pragma unroll 1
    for (int t = 0; t < nt; t += 2) {
      const bool last = (t == nt - 2);
      const bf16* a2h0 = last ? na0 : ca0; const bf16* a2h1 = last ? na1 : ca1;
      const bf16* b2h0 = last ? nb0 : cb0; const bf16* b2h1 = last ? nb1 : cb1;
      const int k2 = last ? 0 : t + 2;
      const unsigned q0 = last ? nob0 : ob0, q1 = last ? nob1 : ob1;
      LDB(B0, 0, 0); SCHED; LDA(At, 0, 0); STAGE_A(SA(1, 1), ca1, t + 1);
      WAIT_L(8); BAR; WAIT_L(0); MMA(0, 0, At, B0); BAR; SCHED;
      LDB(B1, 0, 1); STAGE_B(SB(0, 0), b2h0, q0, k2);
      BAR; WAIT_L(0); MMA(0, 1, At, B1); BAR;
      LDA(At, 0, 1); STAGE_A(SA(0, 0), a2h0, k2);
      BAR; WAIT_L(0); MMA(1, 0, At, B0); BAR; SCHED;
      STAGE_B(SB(0, 1), b2h1, q1, k2);
      WAIT_V(6); BAR; MMA(1, 1, At, B1); BAR;
      LDB(B0, 1, 0); SCHED; LDA(At, 1, 0); STAGE_A(SA(0, 1), a2h1, k2);
      WAIT_L(8); BAR; WAIT_L(0); MMA(0, 0, At, B0); BAR; SCHED;
      LDB(B1, 1, 1); STAGE_B(SB(1, 0), b2h0, q0, k2 + 1);
      BAR; WAIT_L(0); MMA(0, 1, At, B1); BAR;
      LDA(At, 1, 1); STAGE_A(SA(1, 0), a2h0, k2 + 1);
      BAR; WAIT_L(0); MMA(1, 0, At, B0); BAR; SCHED;
      STAGE_B(SB(1, 1), b2h1, q1, k2 + 1);
      WAIT_V(6); BAR; MMA(1, 1, At, B1); BAR;
    }
    if constexpr (P::FP8) asm volatile("s_nop 15\n\ts_nop 15" ::: "memory");
    {
      const int t3 = tid_opaque();
      const int wid = t3 >> 6, lane = t3 & 63;
      p.epi(cur, acc, wid >> 2, wid & 3, lane & 15, lane >> 4);
    }
    if (!has_next) break;
#pragma unroll
    for (int a0 = 0; a0 < 2; ++a0)
#pragma unroll
      for (int b0 = 0; b0 < 2; ++b0)
#pragma unroll
        for (int m = 0; m < 4; ++m)
#pragma unroll
          for (int n = 0; n < 2; ++n) acc[a0][b0][m][n] = (f32x4){0.f, 0.f, 0.f, 0.f};
    cur = nxt; ca0 = na0; ca1 = na1; cb0 = nb0; cb1 = nb1;
    ob0 = nob0; ob1 = nob1;
    idx = nidx;
  }
  WAIT_V(0);
  if (!wr1) BAR;
  BAR;
#undef SA
#undef SB
#undef GLDS
#undef STAGE_A
#undef STAGE_B
#undef LDA
#undef LDB
#undef MMA
#undef FRAG_LO
#undef FRAG_HI
#undef WAIT_V
#undef WAIT_L
#undef BAR
#undef SCHED
}

#define G8_FOR_BLK(AI, BJ, M, N) \
  _Pragma("unroll") for (int AI = 0; AI < 2; ++AI) _Pragma("unroll") for (int BJ = 0; BJ < 2; ++BJ) \
  _Pragma("unroll") for (int M = 0; M < 4; ++M) _Pragma("unroll") for (int N = 0; N < 2; ++N)
#define G8_AIDX(AI, M) ((AI) * 128 + wr * 64 + fq * 16 + (M) * 4)
#define G8_BIDX(BJ, N) ((BJ) * 128 + wc * 32 + (N) * 16 + fr)
__device__ __forceinline__ u32x2 pack4_bf16(const f32x4 v) { return (u32x2){pack_bf16(v.x, v.y), pack_bf16(v.z, v.w)}; }
__device__ __forceinline__ unsigned pack4_fp8(const f32x4 v) { return pk4_fp8(v.x, v.y, v.z, v.w); }
__device__ __forceinline__ u32x4 pack8_bf16(const f32x4 a, const f32x4 b) { return (u32x4){pack_bf16(a.x, a.y), pack_bf16(a.z, a.w), pack_bf16(b.x, b.y), pack_bf16(b.z, b.w)}; }
#define G8_FOR_BLK2(AI, BJ, M2, N) \
  _Pragma("unroll") for (int AI = 0; AI < 2; ++AI) _Pragma("unroll") for (int BJ = 0; BJ < 2; ++BJ) \
  _Pragma("unroll") for (int M2 = 0; M2 < 4; M2 += 2) _Pragma("unroll") for (int N = 0; N < 2; ++N)

struct G8InZT {
  static constexpr int NKT = 16; static constexpr bool B_GATHER = false; static constexpr bool FP8 = false; static constexpr int B_PITCH = D; static constexpr int A_PITCH = D;
  template <class C_> __device__ unsigned b_row(const C_&, int, int) const { return 0u; }
  struct Ctx { int t0, z0; };
  const bf16* wt; const bf16* A; bf16* zt; int ntok;
  __device__ int ntiles() const { return 6 * (ntok / 256); }
  __device__ void tile(int idx, Ctx& c) const { int tt = idx / 6; c.z0 = (idx - tt * 6) * 256; c.t0 = tt * 256; }
  __device__ const bf16* a_base(const Ctx& c, int h) const { return A + (size_t)(c.t0 + h * 128) * D; }
  __device__ unsigned a_off(const Ctx&, int, int r) const { return r * D; }
  __device__ const bf16* b_base(const Ctx& c, int h) const { return wt + (size_t)(c.z0 + h * 128) * D; }
  __device__ unsigned b_off(const Ctx&, int, int r) const { return r * D; }
  __device__ void epi(const Ctx& c, g8acc_t& acc, int wr, int wc, int fr, int fq) const {
    G8_FOR_BLK2(ai, bj, m, n) {
      const int tok = c.t0 + G8_AIDX(ai, m), z = c.z0 + G8_BIDX(bj, n);
      *(u32x4*)(zt + (size_t)z * NT + tok) = pack8_bf16(acc[ai][bj][m][n], acc[ai][bj][m + 1][n]);
    }
  }
};
struct G8InG {
  static constexpr int NKT = 8; static constexpr bool B_GATHER = false; static constexpr bool FP8 = true; static constexpr int B_PITCH = D / 2; static constexpr int A_PITCH = D / 2;
  template <class C_> __device__ unsigned b_row(const C_&, int, int) const { return 0u; }
  struct Ctx { int c0, t0; };
  const unsigned char* wt; const unsigned char* A; bf16* zg;
  __device__ int ntiles() const { return 7 * (NT / 256); }
  __device__ void tile(int idx, Ctx& c) const { int tt = idx / 7; c.t0 = tt * 256; c.c0 = (idx - tt * 7) * 256; }
  __device__ const bf16* a_base(const Ctx& c, int h) const { return (const bf16*)(wt + (size_t)(c.c0 + h * 128) * D); }
  __device__ unsigned a_off(const Ctx&, int, int r) const { return r * (D / 2); }
  __device__ const bf16* b_base(const Ctx& c, int h) const { return (const bf16*)(A + (size_t)(c.t0 + h * 128) * D); }
  __device__ unsigned b_off(const Ctx&, int, int r) const { return r * (D / 2); }
  __device__ void epi(const Ctx& c, g8acc_t& acc, int wr, int wc, int fr, int fq) const {
    const float isc = 1.0f / 16.0f;
    G8_FOR_BLK2(ai, bj, m, n) {
      const int col = c.c0 + G8_AIDX(ai, m), tok = c.t0 + G8_BIDX(bj, n);
      if (col < GLACOLS) *(u32x4*)(zg + (size_t)tok * GLACOLS + col) = pack8_bf16(acc[ai][bj][m][n] * isc, acc[ai][bj][m + 1][n] * isc);
    }
  }
};
struct G8Out {
  static constexpr int NKT = 16; static constexpr bool B_GATHER = false; static constexpr bool FP8 = false; static constexpr int B_PITCH = D; static constexpr int A_PITCH = D;
  template <class C_> __device__ unsigned b_row(const C_&, int, int) const { return 0u; }
  struct Ctx { int c0, t0; };
  int mrows; const bf16* ymix; const bf16* wt; const float* modl; float* xs;
  __device__ int ntiles() const { return (mrows / 256) * 4; }
  __device__ void tile(int idx, Ctx& c) const { c.t0 = (idx >> 2) * 256; c.c0 = (idx & 3) * 256; }
  __device__ const bf16* a_base(const Ctx& c, int h) const { return wt + (size_t)(c.c0 + h * 128) * D; }
  __device__ unsigned a_off(const Ctx&, int, int r) const { return r * D; }
  __device__ const bf16* b_base(const Ctx& c, int h) const { return ymix + (size_t)(c.t0 + h * 128) * D; }
  __device__ unsigned b_off(const Ctx&, int, int r) const { return r * D; }
  __device__ void epi(const Ctx& c, g8acc_t& acc, int wr, int wc, int fr, int fq) const {
    const float* g1 = modl + (size_t)row_batch(c.t0) * 6 * D + 2 * D;
    G8_FOR_BLK(ai, bj, m, n) {
      const int col = c.c0 + G8_AIDX(ai, m), tok = c.t0 + G8_BIDX(bj, n);
      float* xp = xs + (size_t)tok * D + col;
      *(f32x4*)xp = *(const f32x4*)xp + *(const f32x4*)(g1 + col) * acc[ai][bj][m][n];
    }
  }
};
struct G8Router {
  static constexpr int NKT = 16; static constexpr bool B_GATHER = false; static constexpr bool FP8 = false; static constexpr int B_PITCH = D; static constexpr int A_PITCH = D;
  template <class C_> __device__ unsigned b_row(const C_&, int, int) const { return 0u; }
  struct Ctx { int t0; };
  int mrows; const bf16* A; const bf16* rwt; float* logits;
  __device__ int ntiles() const { return mrows / 256; }
  __device__ void tile(int idx, Ctx& c) const { c.t0 = idx * 256; }
  __device__ const bf16* a_base(const Ctx&, int h) const { return rwt + (size_t)(h * 128) * D; }
  __device__ unsigned a_off(const Ctx&, int, int r) const { return r * D; }
  __device__ const bf16* b_base(const Ctx& c, int h) const { return A + (size_t)(c.t0 + h * 128) * D; }
  __device__ unsigned b_off(const Ctx&, int, int r) const { return r * D; }
  __device__ void epi(const Ctx& c, g8acc_t& acc, int wr, int wc, int fr, int fq) const {
    G8_FOR_BLK(ai, bj, m, n) {
      const int e = G8_AIDX(ai, m), tok = c.t0 + G8_BIDX(bj, n);
      *(f32x4*)(logits + (size_t)tok * NE + e) = acc[ai][bj][m][n];
    }
  }
};
struct G8ShUp {
  static constexpr int NKT = 8; static constexpr bool B_GATHER = false; static constexpr bool FP8 = true; static constexpr int B_PITCH = D / 2; static constexpr int A_PITCH = D / 2;
  template <class C_> __device__ unsigned b_row(const C_&, int, int) const { return 0u; }
  struct Ctx { int t0, hb; };
  int mrows; const unsigned char* A8; const unsigned char* s1t; const unsigned char* s3t; unsigned char* hs;
  __device__ int ntiles() const { return (mrows / 256) * 2; }
  __device__ void tile(int idx, Ctx& c) const { c.t0 = (idx >> 1) * 256; c.hb = (idx & 1) * 128; }
  __device__ const bf16* a_base(const Ctx& c, int h) const { return (const bf16*)((h ? s3t : s1t) + (size_t)c.hb * D); }
  __device__ unsigned a_off(const Ctx&, int, int r) const { return r * (D / 2); }
  __device__ const bf16* b_base(const Ctx& c, int h) const { return (const bf16*)(A8 + (size_t)(c.t0 + h * 128) * D); }
  __device__ unsigned b_off(const Ctx&, int, int r) const { return r * (D / 2); }
  __device__ void epi(const Ctx& c, g8acc_t& acc, int wr, int wc, int fr, int fq) const {
    const float isc = 1.0f / 16.0f;
#pragma unroll
    for (int bj = 0; bj < 2; ++bj)
#pragma unroll
      for (int n = 0; n < 2; ++n) {
        const int hcol = c.hb + wr * 64 + fq * 16, tok = c.t0 + G8_BIDX(bj, n);
        u32x4 o;
#pragma unroll
        for (int m = 0; m < 4; ++m) {
          const f32x4 u = acc[0][bj][m][n] * isc, v = acc[1][bj][m][n] * isc;
          const unsigned w = pk4_fp8(silu_f(u.x) * v.x, silu_f(u.y) * v.y, silu_f(u.z) * v.z, silu_f(u.w) * v.w);
          if (m == 0) o.x = w; else if (m == 1) o.y = w; else if (m == 2) o.z = w; else o.w = w;
        }
        *(u32x4*)(hs + (size_t)tok * DE + hcol) = o;
      }
  }
};
struct G8Up {
  static constexpr int NKT = 8; static constexpr bool B_GATHER = true; static constexpr bool FP8 = true; static constexpr int B_PITCH = D / 2; static constexpr int A_PITCH = D / 2;
  struct Ctx { int s0, hb, grp; };
  const unsigned char* A8; const int* slot_tok; const int* pad_start; const unsigned char* w1t; const unsigned char* w3t; unsigned char* H; const unsigned short* tile_e;
  __device__ int ntiles() const { return (pad_start[NE] >> 8) * 2; }
  __device__ void tile(int idx, Ctx& c) const { c.s0 = (idx >> 1) * 256; c.hb = (idx & 1) * 128; c.grp = __builtin_amdgcn_readfirstlane((int)tile_e[idx >> 1]); }
  __device__ const bf16* a_base(const Ctx& c, int h) const { return (const bf16*)((h ? w3t : w1t) + ((size_t)c.grp * DE + c.hb) * D); }
  __device__ unsigned a_off(const Ctx&, int, int r) const { return r * (D / 2); }
  __device__ const bf16* b_base(const Ctx&, int) const { return (const bf16*)A8; }
  __device__ unsigned b_off(const Ctx&, int, int) const { return 0u; }
  __device__ unsigned b_row(const Ctx& c, int h, int r) const { int t = slot_tok[c.s0 + h * 128 + r]; t = (t < 0 || t >= NT) ? 0 : t; return (unsigned)t; }
  __device__ void epi(const Ctx& c, g8acc_t& acc, int wr, int wc, int fr, int fq) const {
    const float isc = 1.0f / 16.0f;
#pragma unroll
    for (int bj = 0; bj < 2; ++bj)
#pragma unroll
      for (int n = 0; n < 2; ++n) {
        const int hcol = c.hb + wr * 64 + fq * 16, slot = c.s0 + G8_BIDX(bj, n);
        u32x4 o;
#pragma unroll
        for (int m = 0; m < 4; ++m) {
          const f32x4 u = acc[0][bj][m][n] * isc, v = acc[1][bj][m][n] * isc;
          const unsigned w = pk4_fp8(silu_f(u.x) * v.x, silu_f(u.y) * v.y, silu_f(u.z) * v.z, silu_f(u.w) * v.w);
          if (m == 0) o.x = w; else if (m == 1) o.y = w; else if (m == 2) o.z = w; else o.w = w;
        }
        *(u32x4*)(H + (size_t)slot * DE + hcol) = o;
      }
  }
};
struct G8ShDown {
  static constexpr int NKT = 2; static constexpr bool B_GATHER = false; static constexpr bool FP8 = true; static constexpr int B_PITCH = DE / 2; static constexpr int A_PITCH = DE / 2;
  template <class C_> __device__ unsigned b_row(const C_&, int, int) const { return 0u; }
  struct Ctx { int c0, t0; };
  int mrows; const unsigned char* hs; const unsigned char* wt; const float* modl; float* xs;
  __device__ int ntiles() const { return (mrows / 256) * 4; }
  __device__ void tile(int idx, Ctx& c) const { c.t0 = (idx >> 2) * 256; c.c0 = (idx & 3) * 256; }
  __device__ const bf16* a_base(const Ctx& c, int h) const { return (const bf16*)(wt + (size_t)(c.c0 + h * 128) * DE); }
  __device__ unsigned a_off(const Ctx&, int, int r) const { return r * (DE / 2); }
  __device__ const bf16* b_base(const Ctx& c, int h) const { return (const bf16*)(hs + (size_t)(c.t0 + h * 128) * DE); }
  __device__ unsigned b_off(const Ctx&, int, int r) const { return r * (DE / 2); }
  __device__ void epi(const Ctx& c, g8acc_t& acc, int wr, int wc, int fr, int fq) const {
    const float* g2 = modl + (size_t)row_batch(c.t0) * 6 * D + 5 * D;
    const float isc = 1.0f / 16.0f;
    G8_FOR_BLK(ai, bj, m, n) {
      const int col = c.c0 + G8_AIDX(ai, m), tok = c.t0 + G8_BIDX(bj, n);
      float* xp = xs + (size_t)tok * D + col;
      *(f32x4*)xp = *(const f32x4*)xp + *(const f32x4*)(g2 + col) * (acc[ai][bj][m][n] * isc);
    }
  }
};
struct G8Down {
  static constexpr int NKT = 2; static constexpr bool B_GATHER = false; static constexpr bool FP8 = true; static constexpr int B_PITCH = DE / 2; static constexpr int A_PITCH = DE / 2;
  struct Ctx { int c0, s0, grp; };
  const unsigned char* H; const int* pad_start; const unsigned char* w2t; unsigned char* Y; const unsigned short* tile_e;
  template <class C_> __device__ unsigned b_row(const C_&, int, int) const { return 0u; }
  __device__ int ntiles() const { return (pad_start[NE] >> 8) * 4; }
  __device__ void tile(int idx, Ctx& c) const { c.s0 = (idx >> 2) * 256; c.c0 = (idx & 3) * 256; c.grp = __builtin_amdgcn_readfirstlane((int)tile_e[idx >> 2]); }
  __device__ const bf16* a_base(const Ctx& c, int h) const { return (const bf16*)(w2t + ((size_t)c.grp * D + c.c0 + h * 128) * DE); }
  __device__ unsigned a_off(const Ctx&, int, int r) const { return r * (DE / 2); }
  __device__ const bf16* b_base(const Ctx& c, int h) const { return (const bf16*)(H + (size_t)(c.s0 + h * 128) * DE); }
  __device__ unsigned b_off(const Ctx&, int, int r) const { return r * (DE / 2); }
  __device__ void epi(const Ctx& c, g8acc_t& acc, int wr, int wc, int fr, int fq) const {
    const float isc = 1.0f / 16.0f;
#pragma unroll
    for (int ai = 0; ai < 2; ++ai)
#pragma unroll
      for (int bj = 0; bj < 2; ++bj)
#pragma unroll
        for (int n = 0; n < 2; ++n) {
          const int col = c.c0 + G8_AIDX(ai, 0), slot = c.s0 + G8_BIDX(bj, n);
          u32x4 o;
          o.x = pack4_fp8(acc[ai][bj][0][n] * isc); o.y = pack4_fp8(acc[ai][bj][1][n] * isc);
          o.z = pack4_fp8(acc[ai][bj][2][n] * isc); o.w = pack4_fp8(acc[ai][bj][3][n] * isc);
          *(u32x4*)(Y + (size_t)slot * D + col) = o;
        }
  }
};

constexpr int CVT_TILES = 3 * NE * 128;
struct CvtCtx { const float* w1; const float* w3; const float* w2; unsigned char* d1; unsigned char* d3; unsigned char* d2; int gw, nw, k; };
struct CvtRegs { int pend; f32x4 r0, r1, r2, r3, r4, r5, r6, r7; };
__device__ __forceinline__ void cvt_locate(const CvtCtx& js, int u, int lane, const float*& s, unsigned char*& d, int& K, int& N) {
  const int job = u >> 15, r = u & 32767, mat = r >> 7, rr = r & 127;
  int kt, ntile;
  if (job < 2) { K = D; N = DE; ntile = rr >> 4; kt = rr & 15; } else { K = DE; N = D; ntile = rr >> 2; kt = rr & 3; }
  const float* s1 = js.w1; const float* s3 = js.w3; const float* s2 = js.w2;
  unsigned char* q1 = js.d1; unsigned char* q3 = js.d3; unsigned char* q2 = js.d2;
  const float* sb = job == 0 ? s1 : (job == 1 ? s3 : s2);
  unsigned char* db = job == 0 ? q1 : (job == 1 ? q3 : q2);
  const int k0 = kt * 64 + (lane & 7) * 8, n0 = ntile * 32 + (lane >> 3) * 4;
  s = sb + (size_t)mat * D * DE + (size_t)k0 * N + n0;
  d = db + (size_t)mat * D * DE + (size_t)n0 * K + k0;
}
__device__ __forceinline__ void cvt_init(CvtRegs& st) {
  st.pend = -1;
  st.r0 = st.r1 = st.r2 = st.r3 = st.r4 = st.r5 = st.r6 = st.r7 = (f32x4){0.f, 0.f, 0.f, 0.f};
}
__device__ __forceinline__ void cvt_finish(const CvtCtx& cx, CvtRegs& st, int lane) {
  if (st.pend < 0) return;
  const float* s; unsigned char* d; int K, N;
  cvt_locate(cx, st.pend, lane, s, d, K, N);
  const float sc = 16.0f;
  const f32x4 v0 = st.r0 * sc, v1 = st.r1 * sc, v2 = st.r2 * sc, v3 = st.r3 * sc, v4 = st.r4 * sc, v5 = st.r5 * sc, v6 = st.r6 * sc, v7 = st.r7 * sc;
  *(u32x2*)(d) = (u32x2){pk4_fp8(v0.x, v1.x, v2.x, v3.x), pk4_fp8(v4.x, v5.x, v6.x, v7.x)};
  *(u32x2*)(d + (size_t)K) = (u32x2){pk4_fp8(v0.y, v1.y, v2.y, v3.y), pk4_fp8(v4.y, v5.y, v6.y, v7.y)};
  *(u32x2*)(d + (size_t)2 * K) = (u32x2){pk4_fp8(v0.z, v1.z, v2.z, v3.z), pk4_fp8(v4.z, v5.z, v6.z, v7.z)};
  *(u32x2*)(d + (size_t)3 * K) = (u32x2){pk4_fp8(v0.w, v1.w, v2.w, v3.w), pk4_fp8(v4.w, v5.w, v6.w, v7.w)};
  st.pend = -1;
}
__device__ __forceinline__ void cvt_step(CvtCtx& cx, CvtRegs& st, int lane) {
  cvt_finish(cx, st, lane);
  const int u = cx.gw + cx.k * cx.nw;
  if (u < CVT_TILES) {
    const float* s; unsigned char* d; int K, N;
    cvt_locate(cx, u, lane, s, d, K, N);
    st.r0 = __builtin_nontemporal_load((const f32x4*)(s));
    st.r1 = __builtin_nontemporal_load((const f32x4*)(s + (size_t)N));
    st.r2 = __builtin_nontemporal_load((const f32x4*)(s + (size_t)2 * N));
    st.r3 = __builtin_nontemporal_load((const f32x4*)(s + (size_t)3 * N));
    st.r4 = __builtin_nontemporal_load((const f32x4*)(s + (size_t)4 * N));
    st.r5 = __builtin_nontemporal_load((const f32x4*)(s + (size_t)5 * N));
    st.r6 = __builtin_nontemporal_load((const f32x4*)(s + (size_t)6 * N));
    st.r7 = __builtin_nontemporal_load((const f32x4*)(s + (size_t)7 * N));
    st.pend = u;
    ++cx.k;
  }
}

constexpr int UST = 2056;
constexpr int HY_U_BYTES = 16 * UST * 2;
constexpr int TCOPY = 2064;
constexpr int HY_T_BYTES = 4 * TCOPY * 4;
constexpr int HY_LDS = HY_U_BYTES + HY_T_BYTES;
constexpr int USTC = 264;
constexpr int TCOPYC = 264;

__device__ __forceinline__ f32x4 mfma16(bf16x8 a, bf16x8 b, f32x4 c) {
  return __builtin_amdgcn_mfma_f32_16x16x32_bf16(a, b, c, 0, 0, 0);
}
__device__ __forceinline__ float bflo(unsigned v) { return __uint_as_float(v << 16); }
__device__ __forceinline__ float bfhi(unsigned v) { return __uint_as_float(v & 0xffff0000u); }
__device__ __forceinline__ float ldbf(const bf16* p) { return bf2f(*p); }

template <int GSTR, int TCP>
__device__ __forceinline__ void hy_load_tables(const bf16* __restrict__ G, int c, unsigned* T) {
  constexpr int NCH = GSTR / 8;
  for (int q = tid_opaque(); q < 2 * NCH; q += 512) {
    int o = q / NCH, ch = q - o * NCH;
    const unsigned* s32 = (const unsigned*)(G + ((size_t)(o * 512 + c)) * GSTR);
    u32x4 a = *(const u32x4*)(s32 + 4 * ch);
    unsigned nx = (ch + 1 < NCH) ? s32[4 * ch + 4] : 0u;
    unsigned* d0 = T + o * 2 * TCP;
    unsigned* d1 = d0 + TCP;
    *(u32x4*)(d0 + 4 * ch) = a;
    u32x4 b;
    b.x = (a.x >> 16) | (a.y << 16); b.y = (a.y >> 16) | (a.z << 16); b.z = (a.z >> 16) | (a.w << 16); b.w = (a.w >> 16) | (nx << 16);
    *(u32x4*)(d1 + 4 * ch) = b;
  }
}

template <int L, int USTR>
__device__ __forceinline__ void hy_load_u(const bf16* __restrict__ z, float w0, float w1, float w2, float bb, bf16* U) {
  constexpr int CPB = L / 8;
  for (int q = tid_opaque(); q < 16 * CPB; q += 512) {
    int b = q / CPB, t8 = (q - b * CPB) * 8;
    const bf16* zr = z + (size_t)b * L + t8;
    u32x4 v = *(const u32x4*)zr;
    float zm = t8 > 0 ? ldbf(zr - 1) : 0.f;
    float zp = t8 + 8 < L ? ldbf(zr + 8) : 0.f;
    float e0 = bflo(v.x), e1 = bfhi(v.x), e2 = bflo(v.y), e3 = bfhi(v.y), e4 = bflo(v.z), e5 = bfhi(v.z), e6 = bflo(v.w), e7 = bfhi(v.w);
    u32x4 o;
    o.x = pack_bf16(w0 * zm + w1 * e0 + w2 * e1 + bb, w0 * e0 + w1 * e1 + w2 * e2 + bb);
    o.y = pack_bf16(w0 * e1 + w1 * e2 + w2 * e3 + bb, w0 * e2 + w1 * e3 + w2 * e4 + bb);
    o.z = pack_bf16(w0 * e3 + w1 * e4 + w2 * e5 + bb, w0 * e4 + w1 * e5 + w2 * e6 + bb);
    o.w = pack_bf16(w0 * e5 + w1 * e6 + w2 * e7 + bb, w0 * e6 + w1 * e7 + w2 * zp + bb);
    *(u32x4*)(U + b * USTR + t8) = o;
  }
}

template <int L>
__device__ __forceinline__ void hy_gate4(const bf16* __restrict__ zr, int t0, float w0, float w1, float w2, float bb, float (&x)[4]) {
  u32x2 v = *(const u32x2*)(zr + t0);
  float zm = t0 > 0 ? ldbf(zr + t0 - 1) : 0.f;
  float zp = t0 + 4 < L ? ldbf(zr + t0 + 4) : 0.f;
  float e0 = bflo(v.x), e1 = bfhi(v.x), e2 = bflo(v.y), e3 = bfhi(v.y);
  x[0] = w0 * zm + w1 * e0 + w2 * e1 + bb;
  x[1] = w0 * e0 + w1 * e1 + w2 * e2 + bb;
  x[2] = w0 * e1 + w1 * e2 + w2 * e3 + bb;
  x[3] = w0 * e2 + w1 * e3 + w2 * zp + bb;
}

__device__ __forceinline__ bf16x8 hy_frag(const unsigned* p) {
  u32x4 v; v.x = p[0]; v.y = p[1]; v.z = p[2]; v.w = p[3];
  return __builtin_bit_cast(bf16x8, v);
}

__device__ __forceinline__ void hyena_latent(int c, const bf16* __restrict__ zt, const float* __restrict__ cw,
                                             const float* __restrict__ cb, const bf16* __restrict__ G,
                                             bf16* __restrict__ yt, char* smem, CvtCtx& cx) {
  const int tid = tid_opaque(), lane = tid & 63, wave = tid >> 6;
  bf16* U = (bf16*)smem;
  unsigned* T = (unsigned*)(smem + HY_U_BYTES);
  __syncthreads();
  hy_load_tables<GSTR_L, TCOPY>(G, c, T);
  hy_load_u<SEQ, UST>(zt + (size_t)c * NT, cw[c], cw[HYCOLS + c], cw[2 * HYCOLS + c], cb[c], U);
  __syncthreads();
  const int r = lane & 15, kg = lane >> 4;
  const int par = (r + 1) & 1;
  const int base_dw = 1023 - (r >> 1) + 4 * kg - 128 * wave;
  const char* ub = smem + (r * UST + 8 * kg) * 2;
  const int tw = wave * 256;
#pragma unroll 1
  for (int order = 0; order < 2; ++order) {
    const unsigned* tb = T + order * 2 * TCOPY + par * TCOPY + base_dw;
    f32x4 acc[16];
#pragma unroll
    for (int i = 0; i < 16; ++i) acc[i] = (f32x4){0.f, 0.f, 0.f, 0.f};
    bf16x8 W[16];
#pragma unroll
    for (int f = -15; f <= 0; ++f) W[f & 15] = hy_frag(tb + 8 * f);
    CvtRegs cr; cvt_init(cr);
#pragma unroll 1
    for (int J = 0; J < 8; ++J) {
      const unsigned* tj = tb + 128 * J;
      const char* uj = ub + 512 * J;
#pragma unroll
      for (int jj = 0; jj < 8; ++jj) {
        if (jj == 0 || jj == 4) cvt_step(cx, cr, lane);
        bf16x8 uf = *(const bf16x8*)(uj + 64 * jj);
        acc[15] = mfma16(W[(2 * jj - 15) & 15], uf, acc[15]);
        acc[14] = mfma16(W[(2 * jj - 14) & 15], uf, acc[14]);
        if (J * 8 + jj < 63) {
          W[(2 * jj + 1) & 15] = hy_frag(tj + 8 * (2 * jj + 1));
          W[(2 * jj + 2) & 15] = hy_frag(tj + 8 * (2 * jj + 2));
        }
#pragma unroll
        for (int i = 13; i >= 0; --i) acc[i] = mfma16(W[(2 * jj - i) & 15], uf, acc[i]);
      }
    }
    cvt_finish(cx, cr, lane);
    __syncthreads();
    {
      const int col = (order + 1) * 512 + c;
      const float w0 = cw[col], w1 = cw[HYCOLS + col], w2 = cw[2 * HYCOLS + col], bb = cb[col];
      const bf16* zr = zt + (size_t)col * NT + (size_t)r * SEQ;
      u32x2 gv[16]; unsigned gm[16], gp[16];
#pragma unroll
      for (int i = 0; i < 16; ++i) {
        const int t0 = tw + 16 * i + 4 * kg;
        gv[i] = *(const u32x2*)(zr + t0);
        gm[i] = t0 > 0 ? (unsigned)*(const unsigned short*)(zr + t0 - 1) : 0u;
        gp[i] = t0 + 4 < SEQ ? (unsigned)*(const unsigned short*)(zr + t0 + 4) : 0u;
      }
#pragma unroll
      for (int i = 0; i < 16; ++i) {
        const int t0 = tw + 16 * i + 4 * kg;
        const float zm = __uint_as_float(gm[i] << 16), zp = __uint_as_float(gp[i] << 16);
        const float e0 = bflo(gv[i].x), e1 = bfhi(gv[i].x), e2 = bflo(gv[i].y), e3 = bfhi(gv[i].y);
        const float x0 = w0 * zm + w1 * e0 + w2 * e1 + bb, x1 = w0 * e0 + w1 * e1 + w2 * e2 + bb;
        const float x2 = w0 * e1 + w1 * e2 + w2 * e3 + bb, x3 = w0 * e2 + w1 * e3 + w2 * zp + bb;
        u32x2 o;
        o.x = pack_bf16(x0 * acc[i][0], x1 * acc[i][1]);
        o.y = pack_bf16(x2 * acc[i][2], x3 * acc[i][3]);
        *(u32x2*)(U + r * UST + t0) = o;
      }
    }
    __syncthreads();
  }
  for (int q = tid; q < 16 * 256; q += 512) {
    int b = q >> 8, t8 = (q & 255) * 8;
    *(u32x4*)(yt + (size_t)c * NT + (size_t)b * SEQ + t8) = *(const u32x4*)(U + b * UST + t8);
  }
}

__device__ __forceinline__ void hyena_ctx(int c, const bf16* __restrict__ zt, const float* __restrict__ cw,
                                          const float* __restrict__ cb, const bf16* __restrict__ G,
                                          bf16* __restrict__ yt, char* smem) {
  const int tid = tid_opaque(), lane = tid & 63, wave = tid >> 6;
  bf16* U = (bf16*)smem;
  unsigned* T = (unsigned*)(smem + HY_U_BYTES);
  __syncthreads();
  hy_load_tables<GSTR_C, TCOPYC>(G, c, T);
  hy_load_u<LC, USTC>(zt + (size_t)c * NT, cw[c], cw[HYCOLS + c], cw[2 * HYCOLS + c], cb[c], U);
  __syncthreads();
  const int r = lane & 15, kg = lane >> 4;
  const int par = (r + 1) & 1;
  const int base_dw = (8 * kg - r + 255 - par) >> 1;
  const char* ub = smem + (r * USTC + 8 * kg) * 2;
#pragma unroll 1
  for (int order = 0; order < 2; ++order) {
    const unsigned* tb = T + order * 2 * TCOPYC + par * TCOPYC + base_dw;
    f32x4 acc[2];
    acc[0] = (f32x4){0.f, 0.f, 0.f, 0.f};
    acc[1] = acc[0];
#pragma unroll
    for (int j = 0; j < 8; ++j) {
      bf16x8 uf = *(const bf16x8*)(ub + 64 * j);
#pragma unroll
      for (int ii = 0; ii < 2; ++ii) {
        const int i = wave * 2 + ii;
        acc[ii] = mfma16(hy_frag(tb + 16 * j - 8 * i), uf, acc[ii]);
      }
    }
    __syncthreads();
    {
      const int col = (order + 1) * 512 + c;
      const float w0 = cw[col], w1 = cw[HYCOLS + col], w2 = cw[2 * HYCOLS + col], bb = cb[col];
      const bf16* zr = zt + (size_t)col * NT + (size_t)r * LC;
#pragma unroll
      for (int ii = 0; ii < 2; ++ii) {
        const int t0 = (wave * 2 + ii) * 16 + 4 * kg;
        float x[4];
        hy_gate4<LC>(zr, t0, w0, w1, w2, bb, x);
        u32x2 o;
        o.x = pack_bf16(x[0] * acc[ii][0], x[1] * acc[ii][1]);
        o.y = pack_bf16(x[2] * acc[ii][2], x[3] * acc[ii][3]);
        *(u32x2*)(U + r * USTC + t0) = o;
      }
    }
    __syncthreads();
  }
  {
    int b = tid >> 5, t8 = (tid & 31) * 8;
    *(u32x4*)(yt + (size_t)c * NT + (size_t)b * LC + t8) = *(const u32x4*)(U + b * USTC + t8);
  }
}

constexpr int GL_QE = 0, GL_KE = 8192, GL_KST = 16384, GL_ATT = 24576, GL_ST = 32768, GL_VT = 49152  ;
constexpr int GL_RAW = 81920  , GL_RAWSZ = 18432, GL_SEG = 118784, GL_DEC = 120832;
constexpr int GLA_LDS = 121088;

__device__ __forceinline__ f32x16 mfma32(bf16x8 a, bf16x8 b, f32x16 c) {
  return __builtin_amdgcn_mfma_f32_32x32x16_bf16(a, b, c, 0, 0, 0);
}
__device__ __forceinline__ unsigned short bf16bits(float v) { bf16 h = f2bf(v); return *(unsigned short*)&h; }

struct GlaArgs {
  const bf16* zg; const float* wa2; const float* ba2; float* of; float* ob; int emit_ctx; int pad_;
};

__device__ __forceinline__ void gla_unit(int unit, const GlaArgs& a, char* smem, CvtCtx& cx) {
  const int tid = tid_opaque(), lane = tid & 63, wave = tid >> 6;
  const int dir = unit & 1, h = (unit >> 1) & 3, b = unit >> 3;
  const int lr = lane & 31, lh = lane >> 5;
  const int swl = (lr >> 1) & 7;
  float* outp = dir ? a.ob : a.of;
  __syncthreads();
  const int d = tid & 63, sg = tid >> 6;
  float wa[16];
#pragma unroll
  for (int r = 0; r < 16; ++r) wa[r] = a.wa2[(dir * 16 + r) * 256 + h * 64 + d];
  const float ba = a.ba2[dir * 256 + h * 64 + d];
  { unsigned zz = 0u; asm volatile("" : "+v"(zz));
    for (int q = tid; q < 16384 / 16; q += 512) *(u32x4*)(smem + GL_ST + q * 16) = (u32x4){zz, zz, zz, zz}; }
  f32x16 S;
#pragma unroll
  for (int r = 0; r < 16; ++r) S[r] = 0.f;

  const int qi = tid >> 3, qc = tid & 7;
  const int ai = (tid >> 1) & 63, ac = tid & 1;
  const int vsg = (tid >> 5) & 7, vdq = tid & 31;
  u32x4 pq, pk, pa;
  u32x2 pw0, pw1, pw2, pw3, pw4, pw5, pw6, pw7;

#define GLA_ROW(N_, I_, ROW_)                                                        \
  {                                                                                  \
    const int n_ = (N_);                                                             \
    const int Ls_ = n_ < 4 ? LC : SEQ;                                               \
    const int cn_ = n_ < 4 ? n_ : n_ - 4;                                            \
    const int rb_ = n_ < 4 ? (NL + b * LC) : (b * SEQ);                              \
    const int pos_ = cn_ * 64 + (I_);                                                \
    ROW_ = rb_ + (dir ? (Ls_ - 1 - pos_) : pos_);                                    \
  }
#define GLA_LOAD_RAW(N_)                                                             \
  {                                                                                  \
    int row_;                                                                        \
    GLA_ROW(N_, qi, row_);                                                           \
    const bf16* zr_ = a.zg + (size_t)row_ * GLACOLS;                                 \
    pq = *(const u32x4*)(zr_ + h * 64 + qc * 8);                                     \
    pk = *(const u32x4*)(zr_ + 256 + h * 64 + qc * 8);                               \
    int ra_;                                                                         \
    GLA_ROW(N_, ai, ra_);                                                            \
    pa = *(const u32x4*)(a.zg + (size_t)ra_ * GLACOLS + 1536 + dir * 16 + ac * 8);   \
  }
#define GLA_LOAD_V(N_)                                                               \
  {                                                                                  \
    int rv_;                                                                         \
    GLA_ROW(N_, vsg * 8 + 0, rv_); pw0 = *(const u32x2*)(a.zg + (size_t)rv_ * GLACOLS + 512 + h * 128 + vdq * 4); \
    GLA_ROW(N_, vsg * 8 + 1, rv_); pw1 = *(const u32x2*)(a.zg + (size_t)rv_ * GLACOLS + 512 + h * 128 + vdq * 4); \
    GLA_ROW(N_, vsg * 8 + 2, rv_); pw2 = *(const u32x2*)(a.zg + (size_t)rv_ * GLACOLS + 512 + h * 128 + vdq * 4); \
    GLA_ROW(N_, vsg * 8 + 3, rv_); pw3 = *(const u32x2*)(a.zg + (size_t)rv_ * GLACOLS + 512 + h * 128 + vdq * 4); \
    GLA_ROW(N_, vsg * 8 + 4, rv_); pw4 = *(const u32x2*)(a.zg + (size_t)rv_ * GLACOLS + 512 + h * 128 + vdq * 4); \
    GLA_ROW(N_, vsg * 8 + 5, rv_); pw5 = *(const u32x2*)(a.zg + (size_t)rv_ * GLACOLS + 512 + h * 128 + vdq * 4); \
    GLA_ROW(N_, vsg * 8 + 6, rv_); pw6 = *(const u32x2*)(a.zg + (size_t)rv_ * GLACOLS + 512 + h * 128 + vdq * 4); \
    GLA_ROW(N_, vsg * 8 + 7, rv_); pw7 = *(const u32x2*)(a.zg + (size_t)rv_ * GLACOLS + 512 + h * 128 + vdq * 4); \
  }
#define GLA_STORE_RAW(RB_)                                                           \
  {                                                                                  \
    char* rw_ = smem + GL_RAW + (RB_) * GL_RAWSZ;                                    \
    *(u32x4*)(rw_ + qi * 128 + qc * 16) = pq;                                        \
    *(u32x4*)(rw_ + 8192 + qi * 128 + qc * 16) = pk;                                 \
    if (tid < 128) *(u32x4*)(rw_ + 16384 + ai * 32 + ac * 16) = pa;                  \
  }
#define GLA_STORE_V(VB_)                                                             \
  if (tid < 256) {                                                                   \
    char* vt_ = smem + GL_VT + (VB_) * 16384;                                        \
    u32x4 o;                                                                         \
    o.x = (pw0.x & 0xffffu) | (pw1.x << 16); o.y = (pw2.x & 0xffffu) | (pw3.x << 16); o.z = (pw4.x & 0xffffu) | (pw5.x << 16); o.w = (pw6.x & 0xffffu) | (pw7.x << 16); \
    *(u32x4*)(vt_ + swz(vdq * 4 + 0, vsg)) = o;                                      \
    o.x = (pw0.x >> 16) | (pw1.x & 0xffff0000u); o.y = (pw2.x >> 16) | (pw3.x & 0xffff0000u); o.z = (pw4.x >> 16) | (pw5.x & 0xffff0000u); o.w = (pw6.x >> 16) | (pw7.x & 0xffff0000u); \
    *(u32x4*)(vt_ + swz(vdq * 4 + 1, vsg)) = o;                                      \
    o.x = (pw0.y & 0xffffu) | (pw1.y << 16); o.y = (pw2.y & 0xffffu) | (pw3.y << 16); o.z = (pw4.y & 0xffffu) | (pw5.y << 16); o.w = (pw6.y & 0xffffu) | (pw7.y << 16); \
    *(u32x4*)(vt_ + swz(vdq * 4 + 2, vsg)) = o;                                      \
    o.x = (pw0.y >> 16) | (pw1.y & 0xffff0000u); o.y = (pw2.y >> 16) | (pw3.y & 0xffff0000u); o.z = (pw4.y >> 16) | (pw5.y & 0xffff0000u); o.w = (pw6.y >> 16) | (pw7.y & 0xffff0000u); \
    *(u32x4*)(vt_ + swz(vdq * 4 + 3, vsg)) = o;                                      \
  }
#define GLA_STEP3(RB_)                                                               \
  {                                                                                  \
    const char* ra_ = smem + GL_RAW + (RB_) * GL_RAWSZ + 16384;                      \
    float run = 0.f;                                                                 \
    _Pragma("unroll") for (int ii = 0; ii < 8; ++ii) {                               \
      const int i = sg * 8 + ii;                                                     \
      const u32x4 a0 = *(const u32x4*)(ra_ + i * 32);                                \
      const u32x4 a1 = *(const u32x4*)(ra_ + i * 32 + 16);                           \
      float g = ba;                                                                  \
      g += bflo(a0.x) * wa[0] + bfhi(a0.x) * wa[1] + bflo(a0.y) * wa[2] + bfhi(a0.y) * wa[3]; \
      g += bflo(a0.z) * wa[4] + bfhi(a0.z) * wa[5] + bflo(a0.w) * wa[6] + bfhi(a0.w) * wa[7]; \
      g += bflo(a1.x) * wa[8] + bfhi(a1.x) * wa[9] + bflo(a1.y) * wa[10] + bfhi(a1.y) * wa[11]; \
      g += bflo(a1.z) * wa[12] + bfhi(a1.z) * wa[13] + bflo(a1.w) * wa[14] + bfhi(a1.w) * wa[15]; \
      run += logsigmoid_f(g) * (1.0f / 16.0f);                                       \
      bl[ii] = run;                                                                  \
    }                                                                                \
    *(float*)(smem + GL_SEG + (sg * 64 + d) * 4) = run;                              \
  }
#define GLA_STEP5(RB_)                                                               \
  {                                                                                  \
    const char* rq_ = smem + GL_RAW + (RB_) * GL_RAWSZ;                              \
    float off = 0.f, tot = 0.f;                                                      \
    _Pragma("unroll") for (int s = 0; s < 8; ++s) {                                  \
      float v = *(const float*)(smem + GL_SEG + (s * 64 + d) * 4);                  \
      off += (s < sg) ? v : 0.f;                                                     \
      tot += v;                                                                      \
    }                                                                                \
    float ks[8];                                                                     \
    _Pragma("unroll") for (int ii = 0; ii < 8; ++ii) {                               \
      const int i = sg * 8 + ii;                                                     \
      const float bb = off + bl[ii];                                                 \
      const float qv = bf2f(*(const bf16*)(rq_ + i * 128 + d * 2));                 \
      const float kv = bf2f(*(const bf16*)(rq_ + 8192 + i * 128 + d * 2));          \
      const int eo = swz(i, d >> 3) + (d & 7) * 2;                                   \
      *(unsigned short*)(smem + GL_QE + eo) = bf16bits(qv * 0.125f * __expf(bb));    \
      *(unsigned short*)(smem + GL_KE + eo) = bf16bits(kv * __expf(-bb));            \
      ks[ii] = kv * __expf(tot - bb);                                                \
    }                                                                                \
    u32x4 o;                                                                         \
    o.x = pack_bf16(ks[0], ks[1]); o.y = pack_bf16(ks[2], ks[3]); o.z = pack_bf16(ks[4], ks[5]); o.w = pack_bf16(ks[6], ks[7]); \
    *(u32x4*)(smem + GL_KST + swz(d, sg)) = o;                                       \
    if (sg == 0) *(float*)(smem + GL_DEC + d * 4) = __expf(tot);                     \
  }

  const int tm = wave >> 2, tn = wave & 3;
  float bl[8];
  f32x16 oprev;
#pragma unroll
  for (int r = 0; r < 16; ++r) oprev[r] = 0.f;

  GLA_LOAD_RAW(0); GLA_LOAD_V(0);
  GLA_STORE_RAW(0); GLA_STORE_V(0);
  GLA_LOAD_RAW(1);
  GLA_STORE_RAW(1);
  __syncthreads();
  GLA_STEP3(0);
  __syncthreads();
  GLA_STEP5(0);
  GLA_LOAD_RAW(2); GLA_LOAD_V(1);
  __syncthreads();
  CvtRegs cr; cvt_init(cr);
#pragma unroll 1
  for (int n = 0; n < 36; ++n) {
    const int vb = n & 1;
    const bool has1 = n + 1 < 36;
    cvt_step(cx, cr, lane);
    f32x16 oacc;
#pragma unroll
    for (int r = 0; r < 16; ++r) oacc[r] = 0.f;
#pragma unroll
    for (int r = 0; r < 16; ++r) S[r] *= *(const float*)(smem + GL_DEC + (tm * 32 + rowmap(r, lh)) * 4);
#pragma unroll
    for (int ks4 = 0; ks4 < 4; ++ks4) {
      const int c = ((2 * ks4 + lh) ^ swl) << 4;
      const bf16x8 fq = *(const bf16x8*)(smem + GL_QE + (tm * 32 + lr) * 128 + c);
      const bf16x8 fs = *(const bf16x8*)(smem + GL_ST + (tn * 32 + lr) * 128 + c);
      oacc = mfma32(fq, fs, oacc);
      const bf16x8 fk = *(const bf16x8*)(smem + GL_KST + (tm * 32 + lr) * 128 + c);
      const bf16x8 fv = *(const bf16x8*)(smem + GL_VT + vb * 16384 + (tn * 32 + lr) * 128 + c);
      S = mfma32(fk, fv, S);
    }
    if (wave < 4) {
      const int am = wave >> 1, an = wave & 1;
      f32x16 att;
#pragma unroll
      for (int r = 0; r < 16; ++r) att[r] = 0.f;
#pragma unroll
      for (int ks4 = 0; ks4 < 4; ++ks4) {
        const int c = ((2 * ks4 + lh) ^ swl) << 4;
        const bf16x8 fq = *(const bf16x8*)(smem + GL_QE + (am * 32 + lr) * 128 + c);
        const bf16x8 fk = *(const bf16x8*)(smem + GL_KE + (an * 32 + lr) * 128 + c);
        att = mfma32(fq, fk, att);
      }
      const int s = an * 32 + lr;
#pragma unroll
      for (int r = 0; r < 16; ++r) {
        const int t = am * 32 + rowmap(r, lh);
        const float v = (s <= t) ? att[r] : 0.f;
        *(unsigned short*)(smem + GL_ATT + swz(t, s >> 3) + (s & 7) * 2) = bf16bits(v);
      }
    }
    if (has1) GLA_STEP3((n + 1) & 1);
    __syncthreads();
#pragma unroll
    for (int ks4 = 0; ks4 < 4; ++ks4) {
      const int c = ((2 * ks4 + lh) ^ swl) << 4;
      const bf16x8 fa = *(const bf16x8*)(smem + GL_ATT + (tm * 32 + lr) * 128 + c);
      const bf16x8 fv = *(const bf16x8*)(smem + GL_VT + vb * 16384 + (tn * 32 + lr) * 128 + c);
      oacc = mfma32(fa, fv, oacc);
    }
#pragma unroll
    for (int g = 0; g < 4; ++g) {
      u32x2 o;
      o.x = pack_bf16(S[4 * g + 0], S[4 * g + 1]);
      o.y = pack_bf16(S[4 * g + 2], S[4 * g + 3]);
      *(u32x2*)(smem + GL_ST + swz(tn * 32 + lr, tm * 4 + g) + 8 * lh) = o;
    }
    if (has1) {
      GLA_STEP5((n + 1) & 1);
      GLA_STORE_V((n + 1) & 1);
      if (n + 2 < 36) GLA_STORE_RAW(n & 1);
    }
    if (n > 0 && (n - 1 >= 4 || a.emit_ctx)) {
#pragma unroll
      for (int r = 0; r < 16; ++r) {
        int row;
        GLA_ROW(n - 1, tm * 32 + rowmap(r, lh), row);
        outp[(size_t)row * 512 + h * 128 + tn * 32 + lr] = oprev[r];
      }
    }
    { const int nr = n + 3 < 36 ? n + 3 : 35; GLA_LOAD_RAW(nr); const int nv = n + 2 < 36 ? n + 2 : 35; GLA_LOAD_V(nv); }
    oprev = oacc;
    __syncthreads();
  }
  cvt_finish(cx, cr, lane);
  {
#pragma unroll
    for (int r = 0; r < 16; ++r) {
      int row;
      GLA_ROW(35, tm * 32 + rowmap(r, lh), row);
      outp[(size_t)row * 512 + h * 128 + tn * 32 + lr] = oprev[r];
    }
  }
#undef GLA_ROW
#undef GLA_LOAD_RAW
#undef GLA_LOAD_V
#undef GLA_STORE_RAW
#undef GLA_STORE_V
#undef GLA_STEP3
#undef GLA_STEP5
}


constexpr int CTRL_Q = 0;
constexpr int CTRL_CNT = 128;
constexpr int CTRL_CUR = 640;
constexpr int CTRL_XR = 1152;
constexpr int CTRL_WORDS = 1152 + 256;
constexpr size_t al256(size_t v) { return (v + 255) / 256 * 256; }
namespace wso {
constexpr size_t bar = 0;
constexpr size_t ctrl = al256(bar + (size_t)XCD_BAR_WORDS * 4);
constexpr size_t zero_end = al256(ctrl + (size_t)CTRL_WORDS * 4);
constexpr size_t xs = al256(ctrl + (size_t)CTRL_WORDS * 4);
constexpr size_t mod = al256(xs + (size_t)NT * D * 4);
constexpr size_t abuf = al256(mod + (size_t)DEPTH * 17 * 6 * D * 4);
constexpr size_t zt = al256(abuf + (size_t)NT * D * 2);
constexpr size_t zg = al256(zt + (size_t)HYCOLS * NT * 2);
constexpr size_t yt = al256(zg + (size_t)NT * GLACOLS * 2);
constexpr size_t of = al256(yt + (size_t)HYW * NT * 2);
constexpr size_t ob = al256(of + (size_t)NT * 512 * 4);
constexpr size_t ymix = al256(ob + (size_t)NT * 512 * 4);
constexpr size_t region_end_raw = al256(ymix + (size_t)NT * D * 2);
constexpr size_t region_end = (region_end_raw > zt + al256((size_t)NSLOT * D * 2)) ? region_end_raw : zt + al256((size_t)NSLOT * D * 2);
constexpr size_t hid = region_end;
constexpr size_t gl = al256(hid + (size_t)DEPTH * 2 * SEQ * 64 * 4);
constexpr size_t gc = al256(gl + (size_t)DEPTH * 2 * HYW * GSTR_L * 2);
constexpr size_t logits = al256(gc + (size_t)2 * HYW * GSTR_C * 2);
constexpr size_t tok_e = al256(logits + (size_t)NT * NE * 4);
constexpr size_t tok_gate = al256(tok_e + (size_t)NT * TOPK * 4);
constexpr size_t tok_slot = al256(tok_gate + (size_t)NT * TOPK * 4);
constexpr size_t pad_start = al256(tok_slot + (size_t)NT * TOPK * 4);
constexpr size_t slot_tok = al256(pad_start + (size_t)(NE + 2) * 4);
constexpr size_t blkcnt = al256(slot_tok + (size_t)NSLOT * 4);
constexpr size_t hbuf = al256(blkcnt + (size_t)512 * NE * 4);
constexpr size_t hs = al256(hbuf + (size_t)NSLOT * DE);
constexpr size_t w_in_t = al256(hs + (size_t)NT * DE);
constexpr size_t w_out_t = al256(w_in_t + (size_t)DEPTH * WIN_ROWS * D * 2);
constexpr size_t router_t = al256(w_out_t + (size_t)DEPTH * D * D * 2);
constexpr size_t sh1_t = al256(router_t + (size_t)DEPTH * NE * D * 2);
constexpr size_t sh3_t = al256(sh1_t + (size_t)DEPTH * DE * D);
constexpr size_t sh2_t = al256(sh3_t + (size_t)DEPTH * DE * D);
constexpr size_t e1_t = al256(sh2_t + (size_t)DEPTH * D * DE);
constexpr size_t e3_t = al256(e1_t + (size_t)NE * DE * D);
constexpr size_t e2_t = al256(e3_t + (size_t)NE * DE * D);
constexpr size_t abuf8 = al256(e2_t + (size_t)NE * D * DE);
constexpr size_t w_g8 = al256(abuf8 + (size_t)NT * D);
constexpr size_t total = al256(w_g8 + (size_t)DEPTH * GW_ROWS * D);
constexpr size_t ybuf = zt;
}
struct WS {
  char* b;
  __device__ __forceinline__ unsigned* bar() const { char* q = b; asm volatile("" : "+s"(q)); return (unsigned*)(q + wso::bar); }
  __device__ __forceinline__ int* ctrl() const { char* q = b; asm volatile("" : "+s"(q)); return (int*)(q + wso::ctrl); }
  __device__ __forceinline__ float* xs() const { char* q = b; asm volatile("" : "+s"(q)); return (float*)(q + wso::xs); }
  __device__ __forceinline__ float* mod() const { char* q = b; asm volatile("" : "+s"(q)); return (float*)(q + wso::mod); }
  __device__ __forceinline__ bf16* abuf() const { char* q = b; asm volatile("" : "+s"(q)); return (bf16*)(q + wso::abuf); }
  __device__ __forceinline__ bf16* zt() const { char* q = b; asm volatile("" : "+s"(q)); return (bf16*)(q + wso::zt); }
  __device__ __forceinline__ bf16* zg() const { char* q = b; asm volatile("" : "+s"(q)); return (bf16*)(q + wso::zg); }
  __device__ __forceinline__ bf16* yt() const { char* q = b; asm volatile("" : "+s"(q)); return (bf16*)(q + wso::yt); }
  __device__ __forceinline__ float* of() const { char* q = b; asm volatile("" : "+s"(q)); return (float*)(q + wso::of); }
  __device__ __forceinline__ float* ob() const { char* q = b; asm volatile("" : "+s"(q)); return (float*)(q + wso::ob); }
  __device__ __forceinline__ bf16* ymix() const { char* q = b; asm volatile("" : "+s"(q)); return (bf16*)(q + wso::ymix); }
  __device__ __forceinline__ float* hid() const { char* q = b; asm volatile("" : "+s"(q)); return (float*)(q + wso::hid); }
  __device__ __forceinline__ bf16* gl() const { char* q = b; asm volatile("" : "+s"(q)); return (bf16*)(q + wso::gl); }
  __device__ __forceinline__ bf16* gc() const { char* q = b; asm volatile("" : "+s"(q)); return (bf16*)(q + wso::gc); }
  __device__ __forceinline__ float* logits() const { char* q = b; asm volatile("" : "+s"(q)); return (float*)(q + wso::logits); }
  __device__ __forceinline__ int* tok_e() const { char* q = b; asm volatile("" : "+s"(q)); return (int*)(q + wso::tok_e); }
  __device__ __forceinline__ float* tok_gate() const { char* q = b; asm volatile("" : "+s"(q)); return (float*)(q + wso::tok_gate); }
  __device__ __forceinline__ int* tok_slot() const { char* q = b; asm volatile("" : "+s"(q)); return (int*)(q + wso::tok_slot); }
  __device__ __forceinline__ int* pad_start() const { char* q = b; asm volatile("" : "+s"(q)); return (int*)(q + wso::pad_start); }
  __device__ __forceinline__ int* slot_tok() const { char* q = b; asm volatile("" : "+s"(q)); return (int*)(q + wso::slot_tok); }
  __device__ __forceinline__ int* blkcnt() const { char* q = b; asm volatile("" : "+s"(q)); return (int*)(q + wso::blkcnt); }
  __device__ __forceinline__ unsigned char* hbuf() const { char* q = b; asm volatile("" : "+s"(q)); return (unsigned char*)(q + wso::hbuf); }
  __device__ __forceinline__ unsigned char* hs() const { char* q = b; asm volatile("" : "+s"(q)); return (unsigned char*)(q + wso::hs); }
  __device__ __forceinline__ bf16* w_in_t() const { char* q = b; asm volatile("" : "+s"(q)); return (bf16*)(q + wso::w_in_t); }
  __device__ __forceinline__ bf16* w_out_t() const { char* q = b; asm volatile("" : "+s"(q)); return (bf16*)(q + wso::w_out_t); }
  __device__ __forceinline__ bf16* router_t() const { char* q = b; asm volatile("" : "+s"(q)); return (bf16*)(q + wso::router_t); }
  __device__ __forceinline__ unsigned char* sh1_t() const { char* q = b; asm volatile("" : "+s"(q)); return (unsigned char*)(q + wso::sh1_t); }
  __device__ __forceinline__ unsigned char* sh3_t() const { char* q = b; asm volatile("" : "+s"(q)); return (unsigned char*)(q + wso::sh3_t); }
  __device__ __forceinline__ unsigned char* sh2_t() const { char* q = b; asm volatile("" : "+s"(q)); return (unsigned char*)(q + wso::sh2_t); }
  __device__ __forceinline__ unsigned char* e1_t() const { char* q = b; asm volatile("" : "+s"(q)); return (unsigned char*)(q + wso::e1_t); }
  __device__ __forceinline__ unsigned char* e3_t() const { char* q = b; asm volatile("" : "+s"(q)); return (unsigned char*)(q + wso::e3_t); }
  __device__ __forceinline__ unsigned char* e2_t() const { char* q = b; asm volatile("" : "+s"(q)); return (unsigned char*)(q + wso::e2_t); }
  __device__ __forceinline__ unsigned char* ybuf() const { char* q = b; asm volatile("" : "+s"(q)); return (unsigned char*)(q + wso::ybuf); }
  __device__ __forceinline__ unsigned char* abuf8() const { char* q = b; asm volatile("" : "+s"(q)); return (unsigned char*)(q + wso::abuf8); }
  __device__ __forceinline__ unsigned char* w_g8() const { char* q = b; asm volatile("" : "+s"(q)); return (unsigned char*)(q + wso::w_g8); }
};

constexpr int MEGA_LDS_MAIN = G8_LDS;
constexpr int LDS_TILE_E = MEGA_LDS_MAIN + 16;
constexpr int MEGA_LDS = MEGA_LDS_MAIN + 16 + 4096;

struct MP { Inputs in; WS w; float* out; };

__device__ __forceinline__ void row_load(const float* __restrict__ p, int lane, f32x4 (&v)[4]) {
#pragma unroll
  for (int j = 0; j < 4; ++j) v[j] = *(const f32x4*)(p + j * 256 + lane * 4);
}
__device__ __forceinline__ float row_rinv(const f32x4 (&v)[4], int lane) {
  float ss = 0.f;
#pragma unroll
  for (int j = 0; j < 4; ++j) ss += v[j].x * v[j].x + v[j].y * v[j].y + v[j].z * v[j].z + v[j].w * v[j].w;
  ss = wave_sum(ss, lane);
  return rsqrtf(ss * (1.0f / D) + EPS);
}
__device__ __forceinline__ void row_norm_mod_store(const f32x4 (&v)[4], float rinv, const float* __restrict__ g,
                                                   const float* __restrict__ sh, const float* __restrict__ sc, int lane,
                                                   bf16* __restrict__ dst, unsigned char* __restrict__ dst8 = nullptr) {
#pragma unroll
  for (int j = 0; j < 4; ++j) {
    const int d = j * 256 + lane * 4;
    const f32x4 gv = *(const f32x4*)(g + d), shv = *(const f32x4*)(sh + d), scv = *(const f32x4*)(sc + d);
    const float y0 = v[j].x * rinv * gv.x * (1.f + scv.x) + shv.x, y1 = v[j].y * rinv * gv.y * (1.f + scv.y) + shv.y;
    const float y2 = v[j].z * rinv * gv.z * (1.f + scv.z) + shv.z, y3 = v[j].w * rinv * gv.w * (1.f + scv.w) + shv.w;
    u32x2 o;
    o.x = pack_bf16(y0, y1);
    o.y = pack_bf16(y2, y3);
    *(u32x2*)(dst + d) = o;
    if (dst8) *(unsigned*)(dst8 + d) = pk4_fp8(y0, y1, y2, y3);
  }
}

__device__ __forceinline__ void ph_mod_hid(const MP& p, char* smem, int bid, int nblk) {
  const int tid = tid_opaque(), lane = tid & 63, wave = tid >> 6;
  float* sc = (float*)smem;
  for (int u = bid; u < 192; u += nblk) {
    const int l = u / 96, col0 = (u - l * 96) * 64;
    __syncthreads();
    for (int i = tid; i < 17 * 1024; i += 512) {
      const int r = i >> 10, k = i & 1023;
      const float v = (r < 16) ? p.in.c[r * D + k] : p.in.c_ctx[k];
      sc[i] = silu_f(v);
    }
    __syncthreads();
    const int col = tid & 63, ks = tid >> 6;
    float acc[17];
#pragma unroll
    for (int r = 0; r < 17; ++r) acc[r] = 0.f;
    const float* wp = p.in.ada_w + ((size_t)l * D + ks * 128) * (6 * D) + col0 + col;
#pragma unroll 16
    for (int kk = 0; kk < 128; ++kk) {
      const float wv = wp[(size_t)kk * (6 * D)];
#pragma unroll
      for (int r = 0; r < 17; ++r) acc[r] += sc[r * 1024 + ks * 128 + kk] * wv;
    }
    __syncthreads();
#pragma unroll
    for (int r = 0; r < 17; ++r) sc[(ks * 17 + r) * 64 + col] = acc[r];
    __syncthreads();
    for (int i = tid; i < 17 * 64; i += 512) {
      const int r = i >> 6, cc = i & 63;
      float s = 0.f;
#pragma unroll
      for (int k8 = 0; k8 < 8; ++k8) s += sc[(k8 * 17 + r) * 64 + cc];
      p.w.mod()[((size_t)l * 17 + r) * (6 * D) + col0 + cc] = s + p.in.ada_b[l * 6 * D + col0 + cc];
    }
  }
  for (int it = bid; it * 8 < 4352; it += nblk) {
    const int rid = it * 8 + wave;
    int l, ty, t;
    if (rid < 2048) { l = 0; ty = 0; t = rid; }
    else if (rid < 2304) { l = 0; ty = 1; t = rid - 2048; }
    else { l = 1; ty = 0; t = rid - 2304; }
    const int L = ty ? LC : SEQ;
    const float* w1 = p.in.hy_f_w1 + l * 33 * 64; const float* b1 = p.in.hy_f_b1 + l * 64;
    const float* w2 = p.in.hy_f_w2 + l * 64 * 64; const float* b2 = p.in.hy_f_b2 + l * 64;
    float pv = 0.f;
    if (lane == 0) pv = (float)t / (float)(L - 1);
    else if (lane < 33) {
      const int bi = (lane - 1) & 15;
      const float wph = 2.0f * 3.14159265358979323846f * (float)t / (float)L;
      const float f = 1e-4f + (float)bi * ((15.0f - 1e-4f) / 15.0f);
      pv = (lane <= 16) ? cosf(f * wph) : -sinf(f * wph);
    }
    float a1 = b1[lane];
#pragma unroll
    for (int i = 0; i < 33; ++i) a1 += shl_f(pv, i) * w1[i * 64 + lane];
    const float h1 = sinf(a1);
    float a2 = b2[lane];
#pragma unroll 16
    for (int i = 0; i < 64; ++i) a2 += shl_f(h1, i) * w2[i * 64 + lane];
    p.w.hid()[((size_t)(l * 2 + ty) * SEQ + t) * 64 + lane] = sinf(a2);
  }
}

__device__ __forceinline__ void ph_gtab(const MP& p, char* smem, int bid, int nblk) {
  const int tid = tid_opaque();
  float* wl = (float*)smem;
  for (int u = bid; u < 544; u += nblk) {
    int l, ty, ib, cg;
    if (u < 512) { l = u >> 8; ty = 0; ib = (u >> 5) & 7; cg = u & 31; }
    else { l = 0; ty = 1; ib = 0; cg = u - 512; }
    const int L = ty ? LC : SEQ, gstr = ty ? GSTR_C : GSTR_L;
    const float* hid = p.w.hid() + (size_t)(l * 2 + ty) * SEQ * 64;
    const float* w3 = p.in.hy_f_w3 + (size_t)l * 64 * 2048;
    const float* skip = p.in.hy_skip + l * 2 * 512;
    bf16* G = ty ? p.w.gc() : (p.w.gl() + (size_t)l * 2 * HYW * GSTR_L);
    __syncthreads();
    for (int i = tid; i < 2 * 32 * 64; i += 512) {
      const int dir = i >> 11, cc = (i >> 6) & 31, j = i & 63;
      const int oc = cg * 32 + cc, o = oc >> 9, c = oc & 511;
      wl[i] = w3[(size_t)j * 2048 + o * 1024 + dir * 512 + c];
    }
    __syncthreads();
    const int i = ib * 512 + tid;
    const int dd = i - (L - 1);
    const int t = dd < 0 ? -dd : dd;
    const bool inr = i < 2 * L - 1;
    const int dir = dd > 0 ? 1 : 0;
    float hr[64];
    {
      const float* hp = hid + (size_t)(inr ? t : 0) * 64;
#pragma unroll
      for (int j = 0; j < 16; ++j) { const f32x4 v = *(const f32x4*)(hp + 4 * j); hr[4 * j] = v.x; hr[4 * j + 1] = v.y; hr[4 * j + 2] = v.z; hr[4 * j + 3] = v.w; }
    }
    const float tn = (float)t / (float)(L - 1);
#pragma unroll 1
    for (int cc = 0; cc < 32; ++cc) {
      const int oc = cg * 32 + cc, o = oc >> 9, c = oc & 511;
      const float* wc = wl + (dir * 32 + cc) * 64;
      float s = 0.f;
#pragma unroll
      for (int j = 0; j < 16; ++j) { const f32x4 wv = *(const f32x4*)(wc + 4 * j); s += hr[4 * j] * wv.x + hr[4 * j + 1] * wv.y + hr[4 * j + 2] * wv.z + hr[4 * j + 3] * wv.w; }
      if (dd == 0) {
        const float* wc1 = wl + (32 + cc) * 64;
        float s1 = 0.f;
#pragma unroll
        for (int j = 0; j < 16; ++j) { const f32x4 wv = *(const f32x4*)(wc1 + 4 * j); s1 += hr[4 * j] * wv.x + hr[4 * j + 1] * wv.y + hr[4 * j + 2] * wv.z + hr[4 * j + 3] * wv.w; }
        s += s1;
      }
      const float delta = HY_MIN_DECAY + (float)c * ((HY_MAX_DECAY - HY_MIN_DECAY) / 511.0f);
      float val = s * __expf(-tn * delta);
      if (dd == 0) val += skip[o * 512 + c];
      if (!inr) val = 0.f;
      G[(size_t)oc * gstr + i] = f2bf(val);
    }
  }
}

__device__ __forceinline__ void ph_init_norm1(const MP& p, int bid, int nblk) {
  const int lane = tid_opaque() & 63, wave = tid_opaque() >> 6;
  const float* g = p.in.norm1_g;
  for (int it = bid; it * 8 < SEQ; it += nblk) {
    const int t = it * 8 + wave;
    const float rr = (float)(t >> 6), colp = (float)(t & 63);
    f32x4 e[4];
#pragma unroll
    for (int j = 0; j < 4; ++j) {
      float ev[4];
#pragma unroll
      for (int q = 0; q < 4; ++q) {
        const int i = lane * 4 + q;
        const float omega = 1.0f / powf(10000.0f, (float)i / 256.0f);
        const float a = ((j < 2) ? rr : colp) * omega;
        ev[q] = (j & 1) ? cosf(a) : sinf(a);
      }
      e[j] = (f32x4){ev[0], ev[1], ev[2], ev[3]};
    }
    for (int b = 0; b < NB; ++b) {
      const int row = b * SEQ + t;
      f32x4 v[4];
      row_load(p.in.x + (size_t)row * D, lane, v);
#pragma unroll
      for (int j = 0; j < 4; ++j) { v[j] += e[j]; *(f32x4*)(p.w.xs() + (size_t)row * D + j * 256 + lane * 4) = v[j]; }
      const float rinv = row_rinv(v, lane);
      const float* mb = p.w.mod() + (size_t)b * 6 * D;
      row_norm_mod_store(v, rinv, g, mb, mb + D, lane, p.w.abuf() + (size_t)row * D, p.w.abuf8() + (size_t)row * D);
    }
  }
  for (int it = bid; it * 8 < NC; it += nblk) {
    const int rc = it * 8 + wave, row = NL + rc;
    f32x4 v[4];
    row_load(p.in.ctx + (size_t)rc * D, lane, v);
#pragma unroll
    for (int j = 0; j < 4; ++j) *(f32x4*)(p.w.xs() + (size_t)row * D + j * 256 + lane * 4) = v[j];
    const float rinv = row_rinv(v, lane);
    const float* mb = p.w.mod() + (size_t)16 * 6 * D;
    row_norm_mod_store(v, rinv, g, mb, mb + D, lane, p.w.abuf() + (size_t)row * D, p.w.abuf8() + (size_t)row * D);
  }
}

__device__ __forceinline__ void ph_mixer(const MP& p, char* smem, int l, bool last, int bid, int nblk) {
  int* qctr = p.w.ctrl() + CTRL_Q + 64 * l;
  int* slot = (int*)(smem + MEGA_LDS_MAIN + 8);
  GlaArgs ga;
  ga.zg = p.w.zg(); ga.wa2 = p.in.gla_wa2 + (size_t)l * 2 * 16 * 256; ga.ba2 = p.in.gla_ba2 + (size_t)l * 2 * 256;
  ga.of = p.w.of(); ga.ob = p.w.ob(); ga.emit_ctx = last ? 0 : 1; ga.pad_ = 0;
  const float* cw = p.in.hy_conv_w + (size_t)l * 3 * HYCOLS;
  const float* cb = p.in.hy_conv_b + (size_t)l * HYCOLS;
  const bf16* gl = p.w.gl() + (size_t)l * 2 * HYW * GSTR_L;
  CvtCtx cx;
  cx.w1 = p.in.exp_w1 + (size_t)l * NE * D * DE; cx.w3 = p.in.exp_w3 + (size_t)l * NE * D * DE; cx.w2 = p.in.exp_w2 + (size_t)l * NE * DE * D;
  cx.d1 = p.w.e1_t(); cx.d3 = p.w.e3_t(); cx.d2 = p.w.e2_t();
  cx.gw = __builtin_amdgcn_readfirstlane(bid * 8 + (tid_opaque() >> 6)); cx.nw = nblk * 8; cx.k = 0;
  for (;;) {
    __syncthreads();
    if (tid_opaque() == 0) *slot = atomicAdd(qctr, 1);
    __syncthreads();
    const int u = *slot;
    const int nunits = last ? 640 : 1152;
    if (u >= nunits) break;
    if (u < 128) gla_unit(u, ga, smem, cx);
    else if (u < 640) hyena_latent(u - 128, p.w.zt(), cw, cb, gl, p.w.yt(), smem, cx);
    else hyena_ctx(u - 640, p.w.zt() + NL, cw, cb, p.w.gc(), p.w.yt() + NL, smem);
  }
  {
    const int lane = tid_opaque() & 63;
    CvtRegs cr; cvt_init(cr);
    while (cx.gw + cx.k * cx.nw < CVT_TILES) cvt_step(cx, cr, lane);
    cvt_finish(cx, cr, lane);
  }
}

__device__ __forceinline__ void ph_gla_out(const MP& p, char* smem, int l, int mrows, int bid, int nblk) {
  const int tid = tid_opaque();
  const int lane = tid & 63, wave = tid >> 6;
  {
    const float* gn = p.in.gla_norm_g + l * 128 + (lane & 15) * 8;
    const f32x4 ga = *(const f32x4*)gn, gb = *(const f32x4*)(gn + 4);
    const float* of = p.w.of(); const float* ob = p.w.ob(); const bf16* zg = p.w.zg(); bf16* ymix = p.w.ymix();
#pragma unroll 2
    for (int it = bid; it * 8 < mrows; it += nblk) {
      const int row = it * 8 + wave;
      const size_t base = (size_t)row * 512 + lane * 8;
      const f32x4 a0 = *(const f32x4*)(of + base), a1 = *(const f32x4*)(of + base + 4);
      const f32x4 b0 = *(const f32x4*)(ob + base), b1 = *(const f32x4*)(ob + base + 4);
      const u32x4 rv = *(const u32x4*)(zg + (size_t)row * GLACOLS + 1024 + lane * 8);
      const f32x4 o0 = a0 + b0, o1 = a1 + b1;
      float ss = o0.x * o0.x + o0.y * o0.y + o0.z * o0.z + o0.w * o0.w + o1.x * o1.x + o1.y * o1.y + o1.z * o1.z + o1.w * o1.w;
      ss += shx_f(ss, 1, lane); ss += shx_f(ss, 2, lane); ss += shx_f(ss, 4, lane); ss += shx_f(ss, 8, lane);
      const float rinv = rsqrtf(ss * (1.0f / 128.0f) + EPS);
      u32x4 o;
      o.x = pack_bf16(o0.x * rinv * ga.x * silu_f(bflo(rv.x)), o0.y * rinv * ga.y * silu_f(bfhi(rv.x)));
      o.y = pack_bf16(o0.z * rinv * ga.z * silu_f(bflo(rv.y)), o0.w * rinv * ga.w * silu_f(bfhi(rv.y)));
      o.z = pack_bf16(o1.x * rinv * gb.x * silu_f(bflo(rv.z)), o1.y * rinv * gb.y * silu_f(bfhi(rv.z)));
      o.w = pack_bf16(o1.z * rinv * gb.z * silu_f(bflo(rv.w)), o1.w * rinv * gb.w * silu_f(bfhi(rv.w)));
      *(u32x4*)(ymix + (size_t)row * D + 512 + lane * 8) = o;
    }
  }
  {
    const bf16* yt = p.w.yt(); bf16* ymix = p.w.ymix();
    for (int tt = bid; tt * 64 < mrows; tt += nblk) {
      const int tok0 = tt * 64;
      __syncthreads();
#pragma unroll
      for (int i = 0; i < 8; ++i) {
        const int q = tid + i * 512, c = q >> 3, ch = q & 7;
        const u32x4 v = *(const u32x4*)(yt + (size_t)c * NT + tok0 + ch * 8);
        unsigned* d = (unsigned*)(smem + c * 132 + ch * 16);
        d[0] = v.x; d[1] = v.y; d[2] = v.z; d[3] = v.w;
      }
      __syncthreads();
#pragma unroll
      for (int i = 0; i < 8; ++i) {
        const int c8 = wave * 8 + (lane & 7), t = i * 8 + (lane >> 3);
        const unsigned short* s = (const unsigned short*)(smem + (c8 * 8) * 132 + t * 2);
        const unsigned e0 = s[0], e1 = s[66], e2 = s[132], e3 = s[198], e4 = s[264], e5 = s[330], e6 = s[396], e7 = s[462];
        *(u32x4*)(ymix + (size_t)(tok0 + t) * D + c8 * 8) = (u32x4){e0 | (e1 << 16), e2 | (e3 << 16), e4 | (e5 << 16), e6 | (e7 << 16)};
      }
    }
  }
}

__device__ __forceinline__ void ph_norm2(const MP& p, int l, int mrows, int bid, int nblk) {
  const int lane = tid_opaque() & 63, wave = tid_opaque() >> 6;
  const float* g = p.in.norm2_g + l * D;
  const float* modl = p.w.mod() + (size_t)l * 17 * 6 * D;
  for (int it = bid; it * 8 < mrows; it += nblk) {
    const int row = it * 8 + wave;
    f32x4 v[4];
    row_load(p.w.xs() + (size_t)row * D, lane, v);
    const float rinv = row_rinv(v, lane);
    const float* mb = modl + (size_t)row_batch(row) * 6 * D;
    row_norm_mod_store(v, rinv, g, mb + 3 * D, mb + 4 * D, lane, p.w.abuf() + (size_t)row * D, p.w.abuf8() + (size_t)row * D);
  }
}

__device__ __forceinline__ void ph_route(const MP& p, char* smem, int l, int ntok, int bid, int nblk) {
  const int tid = tid_opaque();
  const int lane = tid & 63, wave = tid >> 6;
  const float* rb = p.in.router_b + l * NE;
  int* lcnt = (int*)smem;
  __syncthreads();
  if (tid < NE) lcnt[tid] = 0;
  __syncthreads();
  const f32x4 bb = *(const f32x4*)(rb + lane * 4);
  const int tpb = (ntok + nblk - 1) / nblk;
  for (int it = wave; it < tpb; it += 8) {
    const int tok = bid * tpb + it;
    if (tok >= ntok) break;
    const f32x4 lg = *(const f32x4*)(p.w.logits() + (size_t)tok * NE + lane * 4);
    const float s0 = sigmoid_f(lg.x), s1 = sigmoid_f(lg.y), s2 = sigmoid_f(lg.z), s3 = sigmoid_f(lg.w);
    const float v0 = s0 + bb.x, v1 = s1 + bb.y, v2 = s2 + bb.z, v3 = s3 + bb.w;
    float m1 = fmaxf(v0, v1), m2 = fminf(v0, v1);
    { float n1 = fmaxf(m1, v2); float n2 = fmaxf(fminf(m1, v2), m2); m1 = n1; m2 = n2; }
    { float n1 = fmaxf(m1, v3); float n2 = fmaxf(fminf(m1, v3), m2); m1 = n1; m2 = n2; }
#pragma unroll
    for (int o = 1; o <= 4; o <<= 1) {
      float a1 = shx_f(m1, o, lane), a2 = shx_f(m2, o, lane);
      float n1 = fmaxf(m1, a1);
      float n2 = fmaxf(fminf(m1, a1), fmaxf(m2, a2));
      m1 = n1; m2 = n2;
    }
    const float gs = m1 + m2;
    const int g = lane >> 3;
    int rank = 0;
#pragma unroll
    for (int gg = 0; gg < 8; ++gg) {
      const float og = __int_as_float(__builtin_amdgcn_readlane(__float_as_int(gs), gg * 8));
      rank += (og > gs || (og == gs && gg < g)) ? 1 : 0;
    }
    unsigned k0, k1, k2, k3;
    {
      const bool sel = rank < 4;
      unsigned u;
      u = __float_as_uint(v0); u = (u & 0x80000000u) ? ~u : (u | 0x80000000u); k0 = sel ? ((u & 0xffffff00u) | (unsigned)(255 - (lane * 4 + 0))) : 0u;
      u = __float_as_uint(v1); u = (u & 0x80000000u) ? ~u : (u | 0x80000000u); k1 = sel ? ((u & 0xffffff00u) | (unsigned)(255 - (lane * 4 + 1))) : 0u;
      u = __float_as_uint(v2); u = (u & 0x80000000u) ? ~u : (u | 0x80000000u); k2 = sel ? ((u & 0xffffff00u) | (unsigned)(255 - (lane * 4 + 2))) : 0u;
      u = __float_as_uint(v3); u = (u & 0x80000000u) ? ~u : (u | 0x80000000u); k3 = sel ? ((u & 0xffffff00u) | (unsigned)(255 - (lane * 4 + 3))) : 0u;
    }
    float gsum = 0.f, myg = 0.f; int mye = 0;
#pragma unroll
    for (int k = 0; k < TOPK; ++k) {
      unsigned m = max(max(k0, k1), max(k2, k3));
      m = max(m, (unsigned)__builtin_amdgcn_update_dpp(0, (int)m, 0x111, 0xf, 0xf, false));
      m = max(m, (unsigned)__builtin_amdgcn_update_dpp(0, (int)m, 0x112, 0xf, 0xf, false));
      m = max(m, (unsigned)__builtin_amdgcn_update_dpp(0, (int)m, 0x114, 0xf, 0xf, false));
      m = max(m, (unsigned)__builtin_amdgcn_update_dpp(0, (int)m, 0x118, 0xf, 0xf, false));
      m = max(m, (unsigned)__builtin_amdgcn_update_dpp(0, (int)m, 0x142, 0xa, 0xf, false));
      m = max(m, (unsigned)__builtin_amdgcn_update_dpp(0, (int)m, 0x143, 0xc, 0xf, false));
      const unsigned wk = (unsigned)__builtin_amdgcn_readlane((int)m, 63);
      const int we = 255 - (int)(wk & 255u);
      const int wl = we >> 2, wi = we & 3;
      const float sv = __int_as_float(__builtin_amdgcn_readlane(__float_as_int(wi == 0 ? s0 : wi == 1 ? s1 : wi == 2 ? s2 : s3), wl));
      if (lane == wl) { if (wi == 0) k0 = 0u; else if (wi == 1) k1 = 0u; else if (wi == 2) k2 = 0u; else k3 = 0u; }
      gsum += sv;
      if (lane == k) { myg = sv; mye = we; }
    }
    if (lane < TOPK) {
      p.w.tok_e()[tok * TOPK + lane] = mye;
      p.w.tok_gate()[tok * TOPK + lane] = myg / gsum * 2.5f;
      atomicAdd(&lcnt[mye], 1);
    }
  }
  __syncthreads();
  if (tid < NE) p.w.blkcnt()[bid * NE + tid] = lcnt[tid];
}

__device__ __forceinline__ void ph_assign(const MP& p, char* smem, int l, int ntok, int bid, int nblk) {
  const int tid = tid_opaque();
  int* ps = (int*)smem;
  int* cur = (int*)smem + 512;
  __syncthreads();
  int* part = (int*)smem + 1024;
  {
    const int eg = tid & 63, bg = tid >> 6;
    const int per = (nblk + 7) >> 3;
    int t0 = 0, t1 = 0, t2 = 0, t3 = 0, b0 = 0, b1 = 0, b2 = 0, b3 = 0;
    const int* src = p.w.blkcnt() + eg * 4;
#pragma unroll 8
    for (int i = 0; i < per; ++i) {
      const int b = bg * per + i;
      if (b < nblk) {
        const u32x4 v = *(const u32x4*)(src + (size_t)b * NE);
        t0 += (int)v.x; t1 += (int)v.y; t2 += (int)v.z; t3 += (int)v.w;
        if (b < bid) { b0 += (int)v.x; b1 += (int)v.y; b2 += (int)v.z; b3 += (int)v.w; }
      }
    }
    int* pt = part + bg * 512 + eg * 4;
    pt[0] = t0; pt[1] = t1; pt[2] = t2; pt[3] = t3;
    pt[256] = b0; pt[257] = b1; pt[258] = b2; pt[259] = b3;
  }
  __syncthreads();
  int before = 0;
  if (tid < NE) {
    int tot = 0;
#pragma unroll
    for (int g = 0; g < 8; ++g) { tot += part[g * 512 + tid]; before += part[g * 512 + 256 + tid]; }
    const int pc = (tot + 255) & ~255;
    const int lane = tid & 63;
    int inc = pc;
#pragma unroll
    for (int o = 1; o < 64; o <<= 1) { const int n = shl_i(inc, lane - o); if (lane >= o) inc += n; }
    ps[tid + 1] = inc;
    if (lane == 63) cur[tid >> 6] = inc;
  }
  __syncthreads();
  if (tid < NE) {
    const int w = tid >> 6;
    int offs = 0;
#pragma unroll
    for (int k = 0; k < 3; ++k) offs += (k < w) ? cur[k] : 0;
    ps[tid + 1] += offs;
    if (tid == 0) ps[0] = 0;
  }
  __syncthreads();
  if (tid < NE) {
    unsigned short* te = (unsigned short*)(smem + LDS_TILE_E);
    for (int t = ps[tid] >> 8; t < (ps[tid + 1] >> 8); ++t) te[t] = (unsigned short)tid;
  }
  if (tid < NE) cur[tid] = ps[tid] + before;
  if (bid == 0 && tid <= NE) p.w.pad_start()[tid] = ps[tid];
  __syncthreads();
  const int tpb = (ntok + nblk - 1) / nblk;
  for (int i = tid; i < tpb * TOPK; i += 512) {
    const int gi = bid * tpb * TOPK + i;
    if (gi >= ntok * TOPK) break;
    const int e = p.w.tok_e()[gi];
    const int slot = atomicAdd(&cur[e], 1);
    p.w.slot_tok()[slot] = gi >> 3;
    p.w.tok_slot()[gi] = slot;
  }
}

__device__ __forceinline__ void ph_combine(const MP& p, int l, int mrows, bool last, int bid, int nblk) {
  const int lane = tid_opaque() & 63, wave = tid_opaque() >> 6;
  const float* modl = p.w.mod() + (size_t)l * 17 * 6 * D;
  for (int it = bid; it * 8 < mrows; it += nblk) {
    const int row = it * 8 + wave;
    const int b = row_batch(row);
    f32x4 v[4], acc[4];
    row_load(p.w.xs() + (size_t)row * D, lane, v);
#pragma unroll
    for (int j = 0; j < 4; ++j) acc[j] = (f32x4){0.f, 0.f, 0.f, 0.f};
    int sl = 0; float gt = 0.f;
    if (lane < TOPK) { sl = p.w.tok_slot()[row * TOPK + lane]; gt = p.w.tok_gate()[row * TOPK + lane]; }
#pragma unroll
    for (int k = 0; k < TOPK; ++k) {
      const int s = shl_i(sl, k);
      const float gk = shl_f(gt, k);
      const unsigned char* yr = p.w.ybuf() + (size_t)s * D + lane * 4;
#pragma unroll
      for (int j = 0; j < 4; ++j) {
        const int y = *(const int*)(yr + j * 256);
        const f32x2v lo = __builtin_amdgcn_cvt_pk_f32_fp8(y, false), hi = __builtin_amdgcn_cvt_pk_f32_fp8(y, true);
        acc[j].x += gk * lo.x; acc[j].y += gk * lo.y; acc[j].z += gk * hi.x; acc[j].w += gk * hi.y;
      }
    }
    const float* g2 = modl + (size_t)b * 6 * D + 5 * D;
#pragma unroll
    for (int j = 0; j < 4; ++j) {
      const f32x4 gv = *(const f32x4*)(g2 + j * 256 + lane * 4);
      v[j] += gv * acc[j];
    }
    const float rinv = row_rinv(v, lane);
    if (last) {
#pragma unroll
      for (int j = 0; j < 4; ++j) {
        const f32x4 fg = *(const f32x4*)(p.in.final_g + j * 256 + lane * 4);
        *(f32x4*)(p.out + (size_t)row * D + j * 256 + lane * 4) = v[j] * rinv * fg;
      }
    } else {
#pragma unroll
      for (int j = 0; j < 4; ++j) *(f32x4*)(p.w.xs() + (size_t)row * D + j * 256 + lane * 4) = v[j];
      const float* mb = p.w.mod() + ((size_t)(l + 1) * 17 + b) * 6 * D;
      row_norm_mod_store(v, rinv, p.in.norm1_g + (l + 1) * D, mb, mb + D, lane, p.w.abuf() + (size_t)row * D, p.w.abuf8() + (size_t)row * D);
    }
  }
}

__global__ void __launch_bounds__(512, 2) k_mega(MP p) {
  extern __shared__ __attribute__((aligned(16))) char smem[];
  const int bid = blockIdx.x, nblk = gridDim.x;
  if (tid_opaque() == 0) *(u32x4*)(smem + MEGA_LDS_MAIN) = (u32x4){0u, 0u, 0u, 0u};
  __syncthreads();
  (void)xcd_barrier_post(p.w.bar(), (volatile LAS unsigned*)(smem + MEGA_LDS_MAIN));

  if (threadIdx.x == 0) {
    const unsigned xcc = xb_xcc_id();
    const int rank = atomicAdd(&p.w.ctrl()[CTRL_XR + 16 * xcc], 1);
    *(int*)(smem + MEGA_LDS_MAIN + 12) = rank;
  }
  ph_mod_hid(p, smem, bid, nblk);
  cvt_job(p.in.w_in, p.w.w_in_t(), D, INCOLS, 1, bid, nblk, HYCOLS);
  cvt_job(p.in.w_in + (size_t)D * INCOLS, p.w.w_in_t() + (size_t)WIN_ROWS * D, D, INCOLS, 1, bid, nblk, HYCOLS);
  cvt8_job(p.in.w_in + HYCOLS, p.w.w_g8(), D, INCOLS, 1, bid, nblk, GLACOLS);
  cvt8_job(p.in.w_in + (size_t)D * INCOLS + HYCOLS, p.w.w_g8() + (size_t)GW_ROWS * D, D, INCOLS, 1, bid, nblk, GLACOLS);
  cvt_job(p.in.w_out, p.w.w_out_t(), D, D, DEPTH, bid, nblk);
  cvt_job(p.in.router_w, p.w.router_t(), D, NE, DEPTH, bid, nblk);
  cvt8_job(p.in.sh_w1, p.w.sh1_t(), D, DE, DEPTH, bid, nblk);
  cvt8_job(p.in.sh_w3, p.w.sh3_t(), D, DE, DEPTH, bid, nblk);
  cvt8_job(p.in.sh_w2, p.w.sh2_t(), DE, D, DEPTH, bid, nblk);
  grid_sync(p.w.bar(), smem + MEGA_LDS_MAIN);
  int vb = bid;
  {
    const int rank = *(const int*)(smem + MEGA_LDS_MAIN + 12);
    const unsigned xcc = xb_xcc_id();
    int npop = 0, xidx = 0, cnt0 = -1; bool equal = true;
    for (int j = 0; j < 16; ++j) {
      const int c = p.w.ctrl()[CTRL_XR + 16 * j];
      if (c > 0) {
        if (cnt0 < 0) cnt0 = c; else if (c != cnt0) equal = false;
        if (j < (int)xcc) ++xidx;
        ++npop;
      }
    }
    if (equal && cnt0 > 0 && npop * cnt0 == nblk && rank < cnt0) vb = xidx * cnt0 + rank;
  }
  ph_gtab(p, smem, bid, nblk);
  ph_init_norm1(p, bid, nblk);
  grid_sync(p.w.bar(), smem + MEGA_LDS_MAIN);

  const int vbu = __builtin_amdgcn_readfirstlane(vb);
#pragma unroll 1
  for (int l0 = 0; l0 < DEPTH; ++l0) {
#define LL opq(l0)
    const bool last = (l0 == DEPTH - 1);
    const int mrows = last ? NL : NT;
#define MODL (p.w.mod() + (size_t)LL * 17 * 6 * D)
    {
      G8InZT g; g.wt = p.w.w_in_t() + (size_t)LL * WIN_ROWS * D; g.A = p.w.abuf(); g.zt = p.w.zt(); g.ntok = last ? NL : NT;
      gemm8_run(g, smem, opq(vbu), nblk);
    }
    {
      G8InG g; g.wt = p.w.w_g8() + (size_t)LL * GW_ROWS * D; g.A = p.w.abuf8(); g.zg = p.w.zg();
      gemm8_run(g, smem, opq(vbu), nblk);
    }
    grid_sync(p.w.bar(), smem + MEGA_LDS_MAIN);
    ph_mixer(p, smem, LL, last, opq(bid), nblk);
    grid_sync(p.w.bar(), smem + MEGA_LDS_MAIN);
    ph_gla_out(p, smem, LL, mrows, opq(bid), nblk);
    grid_sync(p.w.bar(), smem + MEGA_LDS_MAIN);
    {
      G8Out g; g.mrows = mrows; g.ymix = p.w.ymix(); g.wt = p.w.w_out_t() + (size_t)LL * D * D; g.modl = MODL; g.xs = p.w.xs();
      gemm8_run(g, smem, opq(vbu), nblk);
    }
    grid_sync(p.w.bar(), smem + MEGA_LDS_MAIN);
    ph_norm2(p, LL, mrows, opq(bid), nblk);
    grid_sync(p.w.bar(), smem + MEGA_LDS_MAIN);
    {
      G8Router g; g.mrows = mrows; g.A = p.w.abuf(); g.rwt = p.w.router_t() + (size_t)LL * NE * D; g.logits = p.w.logits();
      gemm8_run(g, smem, opq(vbu), nblk);
    }
    {
      G8ShUp g; g.mrows = mrows; g.A8 = p.w.abuf8(); g.s1t = p.w.sh1_t() + (size_t)LL * DE * D; g.s3t = p.w.sh3_t() + (size_t)LL * DE * D; g.hs = p.w.hs();
      gemm8_run(g, smem, opq(vbu), nblk);
    }
    grid_sync(p.w.bar(), smem + MEGA_LDS_MAIN);
    ph_route(p, smem, LL, mrows, opq(bid), nblk);
    grid_sync(p.w.bar(), smem + MEGA_LDS_MAIN);
    ph_assign(p, smem, LL, mrows, opq(bid), nblk);
    grid_sync(p.w.bar(), smem + MEGA_LDS_MAIN);
    {
      G8Up g; g.A8 = p.w.abuf8(); g.slot_tok = p.w.slot_tok(); g.pad_start = p.w.pad_start(); g.w1t = p.w.e1_t(); g.w3t = p.w.e3_t(); g.H = p.w.hbuf(); g.tile_e = (const unsigned short*)(smem + LDS_TILE_E);
      gemm8_run(g, smem, opq(vbu), nblk);
    }
    {
      G8ShDown g; g.mrows = mrows; g.hs = p.w.hs(); g.wt = p.w.sh2_t() + (size_t)LL * D * DE; g.modl = MODL; g.xs = p.w.xs();
      gemm8_run(g, smem, opq(vbu), nblk);
    }
    grid_sync(p.w.bar(), smem + MEGA_LDS_MAIN);
    {
      G8Down g; g.H = p.w.hbuf(); g.pad_start = p.w.pad_start(); g.w2t = p.w.e2_t(); g.Y = p.w.ybuf(); g.tile_e = (const unsigned short*)(smem + LDS_TILE_E);
      gemm8_run(g, smem, opq(vbu), nblk);
    }
    grid_sync(p.w.bar(), smem + MEGA_LDS_MAIN);
    ph_combine(p, LL, mrows, last, opq(bid), nblk);
    if (!last) grid_sync(p.w.bar(), smem + MEGA_LDS_MAIN);
  }
#undef LL
#undef MODL
}

static inline size_t align_up(size_t v, size_t a) { return (v + a - 1) / a * a; }

extern "C" void kernel_launch(void* const* d_in, const int* in_sizes, int n_in, void* d_out, int out_size, void* d_ws,
                              size_t ws_size, hipStream_t stream) {
  MP p;
  memset(&p, 0, sizeof(p));
  const float** ip = (const float**)&p.in;
  for (int i = 0; i < 30; ++i) ip[i] = (const float*)d_in[i];
  p.out = (float*)d_out;

  p.w.b = (char*)d_ws;
  const size_t zero_bytes = wso::zero_end;
  (void)ws_size; (void)n_in; (void)in_sizes; (void)out_size;

  static int grid = 0;
  if (!grid) {
    hipFuncSetAttribute((const void*)k_mega, hipFuncAttributeMaxDynamicSharedMemorySize, MEGA_LDS);
    int dev = 0, cus = 0, per_cu = 0;
    hipGetDevice(&dev);
    hipDeviceGetAttribute(&cus, hipDeviceAttributeMultiprocessorCount, dev);
    hipOccupancyMaxActiveBlocksPerMultiprocessor(&per_cu, k_mega, 512, MEGA_LDS);
    if (cus <= 0) cus = 256;
    grid = per_cu >= 1 ? cus : 0;
    if (grid <= 0) grid = 256;
  }
  hipMemsetAsync(d_ws, 0, zero_bytes, stream);
  hipLaunchKernelGGL(k_mega, dim3(grid), dim3(512), MEGA_LDS, stream, p);
}
```

```cpp
#include <hip/hip_runtime.h>
#include <hip/hip_bf16.h>
#include <stdint.h>
#include <string.h>

typedef __hip_bfloat16 bf16;

constexpr int D = 1024, NB = 16, SEQ = 2048, LC = 256, DEPTH = 2;
constexpr int NL = NB * SEQ, NC = NB * LC, NT = NL + NC;
constexpr int HYW = 512, HYCOLS = 1536, GLACOLS = 1568, INCOLS = 3104;
constexpr int NE = 256, TOPK = 8, DE = 256;
constexpr int NSLOT = NT * TOPK + NE * 256;
constexpr float EPS = 1e-6f;
constexpr float HY_MIN_DECAY = 3.0701134573253945f;
constexpr float HY_MAX_DECAY = 15.350567286626973f;
constexpr int GSTR_L = 4096, GSTR_C = 512;
constexpr int WIN_ROWS = HYCOLS;
constexpr int GW_ROWS = 7 * 256;

__device__ __forceinline__ float bf2f(bf16 v) { return __bfloat162float(v); }
__device__ __forceinline__ bf16 f2bf(float v) { return __float2bfloat16(v); }
__device__ __forceinline__ float silu_f(float x) { return x / (1.f + __expf(-x)); }
__device__ __forceinline__ float sigmoid_f(float x) { return 1.f / (1.f + __expf(-x)); }
__device__ __forceinline__ float logsigmoid_f(float x) { return fminf(x, 0.f) - __logf(1.f + __expf(-fabsf(x))); }

__device__ __forceinline__ float shx_f(float v, int mask, int lane) { return __int_as_float(__builtin_amdgcn_ds_bpermute((lane ^ mask) << 2, __float_as_int(v))); }
__device__ __forceinline__ int shx_i(int v, int mask, int lane) { return __builtin_amdgcn_ds_bpermute((lane ^ mask) << 2, v); }
__device__ __forceinline__ float shl_f(float v, int src) { return __int_as_float(__builtin_amdgcn_ds_bpermute(src << 2, __float_as_int(v))); }
__device__ __forceinline__ int shl_i(int v, int src) { return __builtin_amdgcn_ds_bpermute(src << 2, v); }
__device__ __forceinline__ float wave_sum(float v, int lane) {
#pragma unroll
  for (int o = 32; o > 0; o >>= 1) v += shx_f(v, o, lane);
  return v;
}

struct Inputs {
  const float *x, *c, *ctx, *c_ctx, *ada_w, *ada_b, *norm1_g, *norm2_g, *w_in, *w_out, *hy_conv_w, *hy_conv_b,
      *hy_f_w1, *hy_f_b1, *hy_f_w2, *hy_f_b2, *hy_f_w3, *hy_skip, *gla_wa2, *gla_ba2, *gla_norm_g, *router_w,
      *router_b, *exp_w1, *exp_w3, *exp_w2, *sh_w1, *sh_w3, *sh_w2, *final_g;
};

__device__ __forceinline__ int opq(int v) { asm volatile("" : "+s"(v)); return v; }
__device__ __forceinline__ int tid_opaque() { int t = threadIdx.x; asm volatile("" : "+v"(t)); return t; }
__device__ __forceinline__ int row_batch(int row) { return row < NL ? (row >> 11) : 16; }

#define XB_TMO      128
#define XB_XCNT(j)  (256  + 64 * (j))
#define XB_XSUB(j)  (1280 + 64 * (j))
#define XB_XGEN(j)  (2304 + 64 * (j))
#define XB_TOP      3328
#define XB_TOPGEN   3392
#define XCD_BAR_WORDS 3456
#define XB_SPIN_CAP (1u << 18)
#define LAS __attribute__((address_space(3)))

__device__ __forceinline__ unsigned xb_ld(unsigned* p)              { return __hip_atomic_load(p, __ATOMIC_RELAXED, __HIP_MEMORY_SCOPE_AGENT); }
__device__ __forceinline__ unsigned xb_add(unsigned* p, unsigned v) { return __hip_atomic_fetch_add(p, v, __ATOMIC_RELAXED, __HIP_MEMORY_SCOPE_AGENT); }
__device__ __forceinline__ unsigned xb_xcc_id() { return (unsigned)__builtin_amdgcn_s_getreg((3 << 11) | 20) & 0xFu; }
#define XB_SPIN(cond, bar) do { unsigned _sp = 0; while (cond) { __builtin_amdgcn_s_sleep(1); \
    if ((++_sp & 255u) == 0u) { if (xb_ld(&(bar)[XB_TMO])) break; if (_sp > XB_SPIN_CAP) { atomicAdd(&(bar)[XB_TMO], 1u); break; } } } } while (0)

struct XcdBarrier {
    unsigned* bar; unsigned x;
    volatile LAS unsigned* st;
};

__device__ __forceinline__ XcdBarrier xcd_barrier_post(unsigned* bar, volatile LAS unsigned* st) {
    XcdBarrier b; b.bar = bar; b.x = xb_xcc_id(); b.st = st;
    if (threadIdx.x == 0) (void)xb_add(&bar[XB_XCNT(b.x)], 1u);
    return b;
}
__device__ __forceinline__ void xcd_barrier_complete(unsigned* bar, unsigned x, unsigned& nloc, unsigned& nx) {
    const unsigned G = gridDim.x * gridDim.y * gridDim.z;
    unsigned sum, cnt, mine, sp = 0u;
    for (;;) {
        sum = 0u; cnt = 0u; mine = 0u;
#pragma unroll
        for (unsigned j = 0; j < 16; ++j) { const unsigned c = xb_ld(&bar[XB_XCNT(j)]); sum += c; cnt += (c > 0u) ? 1u : 0u; mine = (j == x) ? c : mine; }
        if (sum == G) break;
        __builtin_amdgcn_s_sleep(1);
        if ((++sp & 255u) == 0u) { if (xb_ld(&bar[XB_TMO])) break; if (sp > XB_SPIN_CAP) { atomicAdd(&bar[XB_TMO], 1u); break; } }
    }
    nloc = mine > 0u ? mine : 1u; nx = cnt > 0u ? cnt : 1u;
}
__device__ __forceinline__ void xcd_barrier(const XcdBarrier& b) {
    asm volatile("s_waitcnt vmcnt(0)" ::: "memory");
    __syncthreads();
    if (threadIdx.x == 0) {
        unsigned* bar = b.bar;
        __builtin_amdgcn_s_waitcnt(0);
        unsigned nloc = b.st[0], nx = b.st[1];
        if (nloc == 0u) { xcd_barrier_complete(bar, b.x, nloc, nx); b.st[0] = nloc; b.st[1] = nx; }
        const unsigned old = xb_add(&bar[XB_XSUB(b.x)], 1u);
        const unsigned gen = old / nloc;
        if (old + 1u == (gen + 1u) * nloc) {
            __builtin_amdgcn_fence(__ATOMIC_RELEASE, "agent");
            asm volatile("s_waitcnt vmcnt(0)" ::: "memory");
            const unsigned og = xb_add(&bar[XB_TOP], 1u);
            const unsigned tg = og / nx;
            if (og + 1u == (tg + 1u) * nx) xb_add(&bar[XB_TOPGEN], 1u);
            else XB_SPIN(xb_ld(&bar[XB_TOPGEN]) == tg, bar);
            __builtin_amdgcn_fence(__ATOMIC_ACQUIRE, "agent");
            xb_add(&bar[XB_XGEN(b.x)], 1u);
            asm volatile("s_waitcnt vmcnt(0)" ::: "memory");
        } else {
            XB_SPIN(xb_ld(&bar[XB_XGEN(b.x)]) == gen, bar);
            __builtin_amdgcn_fence(__ATOMIC_ACQUIRE, "agent");
            asm volatile("s_waitcnt vmcnt(0)" ::: "memory");
        }
    }
    __syncthreads();
}

__device__ __forceinline__ void grid_sync(unsigned* bar0, char* stw) {
  unsigned* q = bar0;
  asm volatile("" : "+s"(q));
  XcdBarrier b; b.bar = q; b.x = xb_xcc_id(); b.st = (volatile LAS unsigned*)stw;
  xcd_barrier(b);
}

typedef __attribute__((ext_vector_type(8))) __bf16 bf16x8;
typedef __attribute__((ext_vector_type(16))) float f32x16;
typedef __attribute__((ext_vector_type(4))) float f32x4;
typedef __attribute__((ext_vector_type(2))) float f32x2v;
typedef __attribute__((ext_vector_type(2))) __bf16 bf16x2v;
typedef __attribute__((ext_vector_type(4))) unsigned int u32x4;
typedef __attribute__((ext_vector_type(2))) unsigned int u32x2;

__device__ __forceinline__ unsigned pack_bf16(float a, float b) {
  f32x2v v = {a, b};
  return __builtin_bit_cast(unsigned, __builtin_convertvector(v, bf16x2v));
}
__device__ __forceinline__ int swz(int row, int chunk) { return row * 128 + ((chunk ^ ((row >> 1) & 7)) << 4); }
__device__ __forceinline__ int rowmap(int reg, int lh) { return (reg & 3) + 8 * (reg >> 2) + 4 * lh; }

__device__ __forceinline__ int find_group(const int* __restrict__ pad_start, int m0) {
  int lo = 0, hi = NE - 1;
  while (lo < hi) {
    int mid = (lo + hi + 1) >> 1;
    if (pad_start[mid] <= m0) lo = mid; else hi = mid - 1;
  }
  return lo;
}

__device__ __forceinline__ void cvt_wave_tile(const float* __restrict__ src, bf16* __restrict__ dst, int K, int N, int kt, int ntile, int lane) {
  const int k0 = kt * 64 + (lane & 7) * 8, n0 = ntile * 32 + (lane >> 3) * 4;
  const float* s = src + (size_t)k0 * N + n0;
  const f32x4 v0 = __builtin_nontemporal_load((const f32x4*)(s)), v1 = __builtin_nontemporal_load((const f32x4*)(s + (size_t)N));
  const f32x4 v2 = __builtin_nontemporal_load((const f32x4*)(s + (size_t)2 * N)), v3 = __builtin_nontemporal_load((const f32x4*)(s + (size_t)3 * N));
  const f32x4 v4 = __builtin_nontemporal_load((const f32x4*)(s + (size_t)4 * N)), v5 = __builtin_nontemporal_load((const f32x4*)(s + (size_t)5 * N));
  const f32x4 v6 = __builtin_nontemporal_load((const f32x4*)(s + (size_t)6 * N)), v7 = __builtin_nontemporal_load((const f32x4*)(s + (size_t)7 * N));
  bf16* d = dst + (size_t)n0 * K + k0;
  *(u32x4*)(d) = (u32x4){pack_bf16(v0.x, v1.x), pack_bf16(v2.x, v3.x), pack_bf16(v4.x, v5.x), pack_bf16(v6.x, v7.x)};
  *(u32x4*)(d + (size_t)K) = (u32x4){pack_bf16(v0.y, v1.y), pack_bf16(v2.y, v3.y), pack_bf16(v4.y, v5.y), pack_bf16(v6.y, v7.y)};
  *(u32x4*)(d + (size_t)2 * K) = (u32x4){pack_bf16(v0.z, v1.z), pack_bf16(v2.z, v3.z), pack_bf16(v4.z, v5.z), pack_bf16(v6.z, v7.z)};
  *(u32x4*)(d + (size_t)3 * K) = (u32x4){pack_bf16(v0.w, v1.w), pack_bf16(v2.w, v3.w), pack_bf16(v4.w, v5.w), pack_bf16(v6.w, v7.w)};
}
typedef __attribute__((ext_vector_type(8))) int i32x8;
typedef __attribute__((ext_vector_type(4))) int i32x4;
__device__ __forceinline__ float clamp_fp8(float x) { return __builtin_amdgcn_fmed3f(x, -448.0f, 448.0f); }
__device__ __forceinline__ unsigned pk4_fp8(float a, float b, float c, float d) {
  a = clamp_fp8(a); b = clamp_fp8(b); c = clamp_fp8(c); d = clamp_fp8(d);
  int w = 0;
  w = __builtin_amdgcn_cvt_pk_fp8_f32(a, b, w, false);
  w = __builtin_amdgcn_cvt_pk_fp8_f32(c, d, w, true);
  return (unsigned)w;
}
__device__ __forceinline__ void cvt8_wave_tile(const float* __restrict__ src, unsigned char* __restrict__ dst, int K, int N, int kt, int ntile, int lane) {
  const int k0 = kt * 64 + (lane & 7) * 8, n0 = ntile * 32 + (lane >> 3) * 4;
  const float* s = src + (size_t)k0 * N + n0;
  const float sc = 16.0f;
  const f32x4 v0 = __builtin_nontemporal_load((const f32x4*)(s)) * sc, v1 = __builtin_nontemporal_load((const f32x4*)(s + (size_t)N)) * sc;
  const f32x4 v2 = __builtin_nontemporal_load((const f32x4*)(s + (size_t)2 * N)) * sc, v3 = __builtin_nontemporal_load((const f32x4*)(s + (size_t)3 * N)) * sc;
  const f32x4 v4 = __builtin_nontemporal_load((const f32x4*)(s + (size_t)4 * N)) * sc, v5 = __builtin_nontemporal_load((const f32x4*)(s + (size_t)5 * N)) * sc;
  const f32x4 v6 = __builtin_nontemporal_load((const f32x4*)(s + (size_t)6 * N)) * sc, v7 = __builtin_nontemporal_load((const f32x4*)(s + (size_t)7 * N)) * sc;
  unsigned char* d = dst + (size_t)n0 * K + k0;
  *(u32x2*)(d) = (u32x2){pk4_fp8(v0.x, v1.x, v2.x, v3.x), pk4_fp8(v4.x, v5.x, v6.x, v7.x)};
  *(u32x2*)(d + (size_t)K) = (u32x2){pk4_fp8(v0.y, v1.y, v2.y, v3.y), pk4_fp8(v4.y, v5.y, v6.y, v7.y)};
  *(u32x2*)(d + (size_t)2 * K) = (u32x2){pk4_fp8(v0.z, v1.z, v2.z, v3.z), pk4_fp8(v4.z, v5.z, v6.z, v7.z)};
  *(u32x2*)(d + (size_t)3 * K) = (u32x2){pk4_fp8(v0.w, v1.w, v2.w, v3.w), pk4_fp8(v4.w, v5.w, v6.w, v7.w)};
}
__device__ __forceinline__ void cvt8_job(const float* __restrict__ src, unsigned char* __restrict__ dst, int K, int N, int nmat, int bid, int nblk, int W = 0) {
  const int tid = tid_opaque(), lane = tid & 63, wave = tid >> 6;
  if (W == 0) W = N;
  const int tk = K >> 6, tn = W >> 5, per = tk * tn;
  const int total = per * nmat;
  for (int u = bid * 8 + wave; u < total; u += nblk * 8) {
    const int mat = u / per, r = u - mat * per;
    const int ntile = r / tk, kt = r - ntile * tk;
    cvt8_wave_tile(src + (size_t)mat * K * N, dst + (size_t)mat * K * W, K, N, kt, ntile, lane);
  }
}

__device__ __forceinline__ void cvt_job(const float* __restrict__ src, bf16* __restrict__ dst, int K, int N, int nmat, int bid, int nblk, int W = 0) {
  const int tid = tid_opaque(), lane = tid & 63, wave = tid >> 6;
  if (W == 0) W = N;
  const int tk = K >> 6, tn = W >> 5, per = tk * tn;
  const int total = per * nmat;
  for (int u = bid * 8 + wave; u < total; u += nblk * 8) {
    const int mat = u / per, r = u - mat * per;
    const int ntile = r / tk, kt = r - ntile * tk;
    cvt_wave_tile(src + (size_t)mat * K * N, dst + (size_t)mat * K * W, K, N, kt, ntile, lane);
  }
}

constexpr int G8_HT = 128 * 64;
constexpr int G8_LDS = 8 * G8_HT * 2;

__device__ __forceinline__ int g8_lds_byte(int r, int c) {
  int st = (r >> 4) * 2 + (c >> 5), rr = r & 15, cc = c & 31, ob = rr * 64 + cc * 2;
  return st * 1024 + (ob ^ (((ob >> 9) & 1) << 5));
}
__device__ __forceinline__ void g8_stage_rc(int b, int& R, int& C) {
  int st = b / 1024, sb = b % 1024, sw = sb ^ (((sb >> 9) & 1) << 5);
  R = (st >> 1) * 16 + sw / 64; C = (st & 1) * 32 + (sw % 64) / 2;
}

typedef f32x4 g8acc_t[2][2][4][2];

template <class P>
__device__ __forceinline__ void gemm8_run(const P& p, char* smem, int bid, int nblk) {
  const int ntl = __builtin_amdgcn_readfirstlane(p.ntiles());
  if (bid >= ntl) return;
  bf16* shm = (bf16*)smem;
#define SA(b, h) (shm + ((b) * 2 + (h)) * G8_HT)
#define SB(b, h) (shm + (4 + (b) * 2 + (h)) * G8_HT)
#define GLDS(SRC, DST) __builtin_amdgcn_global_load_lds((const unsigned*)(SRC), (unsigned*)(DST), 16, 0, 0)
#define STAGE_A(PP, BASE, KT) do { GLDS((BASE) + (oa + (KT) * 64), (char*)(PP) + ldsd); GLDS((BASE) + 64 * P::A_PITCH + (oa + (KT) * 64), (char*)(PP) + ldsd + 8192); } while (0)
#define STAGE_B(PP, BASE, OB, KT) do { \
    if constexpr (P::B_GATHER) { GLDS((BASE) + ((((OB) & 0xffffu) * (unsigned)P::B_PITCH + cc) + (KT) * 64), (char*)(PP) + ldsd); \
                                 GLDS((BASE) + ((((OB) >> 16) * (unsigned)P::B_PITCH + cc) + (KT) * 64), (char*)(PP) + ldsd + 8192); } \
    else { GLDS((BASE) + ((OB) + (KT) * 64), (char*)(PP) + ldsd); GLDS((BASE) + 64 * P::B_PITCH + ((OB) + (KT) * 64), (char*)(PP) + ldsd + 8192); } } while (0)
#define LDA(dst, b, h) for (int m = 0; m < 4; ++m) \
    dst[m] = __builtin_shufflevector(*reinterpret_cast<const i32x4*>((char*)SA(b, h) + aoff + m * 2048), \
                                     *reinterpret_cast<const i32x4*>((char*)SA(b, h) + aoff + m * 2048 + 1024), 0, 1, 2, 3, 4, 5, 6, 7)
#define LDB(dst, b, h) for (int n = 0; n < 2; ++n) \
    dst[n] = __builtin_shufflevector(*reinterpret_cast<const i32x4*>((char*)SB(b, h) + boff + n * 2048), \
                                     *reinterpret_cast<const i32x4*>((char*)SB(b, h) + boff + n * 2048 + 1024), 0, 1, 2, 3, 4, 5, 6, 7)
#define FRAG_LO(x) __builtin_bit_cast(bf16x8, __builtin_shufflevector(x, x, 0, 1, 2, 3))
#define FRAG_HI(x) __builtin_bit_cast(bf16x8, __builtin_shufflevector(x, x, 4, 5, 6, 7))
#define MMA(ai, bj, At_, Bt_) do { __builtin_amdgcn_s_setprio(1); \
    if constexpr (P::FP8) { \
      for (int m = 0; m < 4; ++m) for (int n = 0; n < 2; ++n) \
        asm volatile("v_mfma_scale_f32_16x16x128_f8f6f4 %0, %1, %2, %0, %3, %3 op_sel_hi:[0,0,0]" \
                     : "+v"(acc[ai][bj][m][n]) : "v"(At_[m]), "v"(Bt_[n]), "v"(mxs)); \
    } else { \
      for (int m = 0; m < 4; ++m) for (int n = 0; n < 2; ++n) { \
        acc[ai][bj][m][n] = __builtin_amdgcn_mfma_f32_16x16x32_bf16(FRAG_LO(At_[m]), FRAG_LO(Bt_[n]), acc[ai][bj][m][n], 0, 0, 0); \
        acc[ai][bj][m][n] = __builtin_amdgcn_mfma_f32_16x16x32_bf16(FRAG_HI(At_[m]), FRAG_HI(Bt_[n]), acc[ai][bj][m][n], 0, 0, 0); } \
    } \
    __builtin_amdgcn_s_setprio(0); } while (0)
#define WAIT_V(n) asm volatile("s_waitcnt vmcnt(" #n ")" ::: "memory")
#define WAIT_L(n) asm volatile("s_waitcnt lgkmcnt(" #n ")" ::: "memory")
#define BAR __builtin_amdgcn_s_barrier()
#define SCHED __builtin_amdgcn_sched_barrier(0)

  typename P::Ctx cur, nxt;
  p.tile(bid, cur);
  int aoff, boff, ldsd;
  unsigned oa, cc, ob0, ob1;
  bool wr1;
  {
    const int tid = tid_opaque();
    const int wid = tid >> 6, lane = tid & 63, wr = wid >> 2, wc = wid & 3, fr = lane & 15, fq = lane >> 4;
    aoff = g8_lds_byte(wr * 64 + fr, fq * 8); boff = g8_lds_byte(wc * 32 + fr, fq * 8);
    ldsd = tid * 16; wr1 = (wr == 1);
    int R0, C0;
    g8_stage_rc(tid * 16, R0, C0);
    cc = C0;
    oa = (((R0 >> 2) & 3) * 16 + (R0 >> 4) * 4 + (R0 & 3)) * P::A_PITCH + C0;
    if constexpr (P::B_GATHER) {
      ob0 = p.b_row(cur, 0, R0) | (p.b_row(cur, 0, R0 + 64) << 16);
      ob1 = p.b_row(cur, 1, R0) | (p.b_row(cur, 1, R0 + 64) << 16);
    } else { ob0 = R0 * P::B_PITCH + C0; ob1 = ob0; }
  }
  const bf16* ca0 = p.a_base(cur, 0);
  const bf16* ca1 = p.a_base(cur, 1);
  const bf16* cb0 = p.b_base(cur, 0);
  const bf16* cb1 = p.b_base(cur, 1);

  g8acc_t acc;
#pragma unroll
  for (int a0 = 0; a0 < 2; ++a0)
#pragma unroll
    for (int b0 = 0; b0 < 2; ++b0)
#pragma unroll
      for (int m = 0; m < 4; ++m)
#pragma unroll
        for (int n = 0; n < 2; ++n) acc[a0][b0][m][n] = (f32x4){0.f, 0.f, 0.f, 0.f};
  i32x8 At[4], B0[2], B1[2];
  const int mxs = 0x7F7F7F7F;
  const int nt = opq(P::NKT);
  STAGE_B(SB(0, 0), cb0, ob0, 0); STAGE_A(SA(0, 0), ca0, 0);
  STAGE_B(SB(0, 1), cb1, ob1, 0); STAGE_A(SA(0, 1), ca1, 0);
  if (wr1) BAR;
  WAIT_V(4); BAR;
  STAGE_B(SB(1, 0), cb0, ob0, 1); STAGE_A(SA(1, 0), ca0, 1); STAGE_B(SB(1, 1), cb1, ob1, 1);
  WAIT_V(6); BAR;
#pragma unroll 1
  for (int idx = bid;;) {
    const int nidx = idx + nblk;
    const bool has_next = nidx < ntl;
    if (has_next) p.tile(nidx, nxt); else nxt = cur;
    const bf16* na0 = p.a_base(nxt, 0);
    const bf16* na1 = p.a_base(nxt, 1);
    const bf16* nb0 = p.b_base(nxt, 0);
    const bf16* nb1 = p.b_base(nxt, 1);
    unsigned nob0 = ob0, nob1 = ob1;
    if constexpr (P::B_GATHER) {
      const int t2 = tid_opaque();
      int R0, C0;
      g8_stage_rc(t2 * 16, R0, C0);
      nob0 = p.b_row(nxt, 0, R0) | (p.b_row(nxt, 0, R0 + 64) << 16);
      nob1 = p.b_row(nxt, 1, R0) | (p.b_row(nxt, 1, R0 + 64) << 16);
    }
#pragma unroll 1
    for (int t = 0; t < nt; t += 2) {
      const bool last = (t == nt - 2);
      const bf16* a2h0 = last ? na0 : ca0; const bf16* a2h1 = last ? na1 : ca1;
      const bf16* b2h0 = last ? nb0 : cb0; const bf16* b2h1 = last ? nb1 : cb1;
      const int k2 = last ? 0 : t + 2;
      const unsigned q0 = last ? nob0 : ob0, q1 = last ? nob1 : ob1;
      LDB(B0, 0, 0); SCHED; LDA(At, 0, 0); STAGE_A(SA(1, 1), ca1, t + 1);
      WAIT_L(8); BAR; WAIT_L(0); MMA(0, 0, At, B0); BAR; SCHED;
      LDB(B1, 0, 1); STAGE_B(SB(0, 0), b2h0, q0, k2);
      BAR; WAIT_L(0); MMA(0, 1, At, B1); BAR;
      LDA(At, 0, 1); STAGE_A(SA(0, 0), a2h0, k2);
      BAR; WAIT_L(0); MMA(1, 0, At, B0); BAR; SCHED;
      STAGE_B(SB(0, 1), b2h1, q1, k2);
      WAIT_V(6); BAR; MMA(1, 1, At, B1); BAR;
      LDB(B0, 1, 0); SCHED; LDA(At, 1, 0); STAGE_A(SA(0, 1), a2h1, k2);
      WAIT_L(8); BAR; WAIT_L(0); MMA(0, 0, At, B0); BAR; SCHED;
      LDB(B1, 1, 1); STAGE_B(SB(1, 0), b2h0, q0, k2 + 1);
      BAR; WAIT_L(0); MMA(0, 1, At, B1); BAR;
      LDA(At, 1, 1); STAGE_A(SA(1, 0), a2h0, k2 + 1);
      BAR; WAIT_L(0); MMA(1, 0, At, B0); BAR; SCHED;
      STAGE_B(SB(1, 1), b2h1, q1, k2 + 1);
      WAIT_V(6); BAR; MMA(1, 1, At, B1); BAR;
    }
    if constexpr (P::FP8) asm volatile("s_nop 15\n\ts_nop 15" ::: "memory");
    {
      const int t3 = tid_opaque();
      const int wid = t3 >> 6, lane = t3 & 63;
      p.epi(cur, acc, wid >> 2, wid & 3, lane & 15, lane >> 4);
    }
    if (!has_next) break;
#pragma unroll
    for (int a0 = 0; a0 < 2; ++a0)
#pragma unroll
      for (int b0 = 0; b0 < 2; ++b0)
#pragma unroll
        for (int m = 0; m < 4; ++m)
#pragma unroll
          for (int n = 0; n < 2; ++n) acc[a0][b0][m][n] = (f32x4){0.f, 0.f, 0.f, 0.f};
    cur = nxt; ca0 = na0; ca1 = na1; cb0 = nb0; cb1 = nb1;
    ob0 = nob0; ob1 = nob1;
    idx = nidx;
  }
  WAIT_V(0);
  if (!wr1) BAR;
  BAR;
#undef SA
#undef SB
#undef GLDS
#undef STAGE_A
#undef STAGE_B
#undef LDA
#undef LDB
#undef MMA
#undef FRAG_LO
#undef FRAG_HI
#undef WAIT_V
#undef WAIT_L
#undef BAR
#undef SCHED
}

#define G8_FOR_BLK(AI, BJ, M, N) \
  _Pragma("unroll") for (int AI = 0; AI < 2; ++AI) _Pragma("unroll") for (int BJ = 0; BJ < 2; ++BJ) \
  _Pragma("unroll") for (int M = 0; M < 4; ++M) _Pragma("unroll") for (int N = 0; N < 2; ++N)
#define G8_AIDX(AI, M) ((AI) * 128 + wr * 64 + fq * 16 + (M) * 4)
#define G8_BIDX(BJ, N) ((BJ) * 128 + wc * 32 + (N) * 16 + fr)
__device__ __forceinline__ u32x2 pack4_bf16(const f32x4 v) { return (u32x2){pack_bf16(v.x, v.y), pack_bf16(v.z, v.w)}; }
__device__ __forceinline__ unsigned pack4_fp8(const f32x4 v) { return pk4_fp8(v.x, v.y, v.z, v.w); }
__device__ __forceinline__ u32x4 pack8_bf16(const f32x4 a, const f32x4 b) { return (u32x4){pack_bf16(a.x, a.y), pack_bf16(a.z, a.w), pack_bf16(b.x, b.y), pack_bf16(b.z, b.w)}; }
#define G8_FOR_BLK2(AI, BJ, M2, N) \
  _Pragma("unroll") for (int AI = 0; AI < 2; ++AI) _Pragma("unroll") for (int BJ = 0; BJ < 2; ++BJ) \
  _Pragma("unroll") for (int M2 = 0; M2 < 4; M2 += 2) _Pragma("unroll") for (int N = 0; N < 2; ++N)

struct G8InZT {
  static constexpr int NKT = 16; static constexpr bool B_GATHER = false; static constexpr bool FP8 = false; static constexpr int B_PITCH = D; static constexpr int A_PITCH = D;
  template <class C_> __device__ unsigned b_row(const C_&, int, int) const { return 0u; }
  struct Ctx { int t0, z0; };
  const bf16* wt; const bf16* A; bf16* zt; int ntok;
  __device__ int ntiles() const { return 6 * (ntok / 256); }
  __device__ void tile(int idx, Ctx& c) const { int tt = idx / 6; c.z0 = (idx - tt * 6) * 256; c.t0 = tt * 256; }
  __device__ const bf16* a_base(const Ctx& c, int h) const { return A + (size_t)(c.t0 + h * 128) * D; }
  __device__ unsigned a_off(const Ctx&, int, int r) const { return r * D; }
  __device__ const bf16* b_base(const Ctx& c, int h) const { return wt + (size_t)(c.z0 + h * 128) * D; }
  __device__ unsigned b_off(const Ctx&, int, int r) const { return r * D; }
  __device__ void epi(const Ctx& c, g8acc_t& acc, int wr, int wc, int fr, int fq) const {
    G8_FOR_BLK2(ai, bj, m, n) {
      const int tok = c.t0 + G8_AIDX(ai, m), z = c.z0 + G8_BIDX(bj, n);
      *(u32x4*)(zt + (size_t)z * NT + tok) = pack8_bf16(acc[ai][bj][m][n], acc[ai][bj][m + 1][n]);
    }
  }
};
struct G8InG {
  static constexpr int NKT = 8; static constexpr bool B_GATHER = false; static constexpr bool FP8 = true; static constexpr int B_PITCH = D / 2; static constexpr int A_PITCH = D / 2;
  template <class C_> __device__ unsigned b_row(const C_&, int, int) const { return 0u; }
  struct Ctx { int c0, t0; };
  const unsigned char* wt; const unsigned char* A; bf16* zg;
  __device__ int ntiles() const { return 7 * (NT / 256); }
  __device__ void tile(int idx, Ctx& c) const { int tt = idx / 7; c.t0 = tt * 256; c.c0 = (idx - tt * 7) * 256; }
  __device__ const bf16* a_base(const Ctx& c, int h) const { return (const bf16*)(wt + (size_t)(c.c0 + h * 128) * D); }
  __device__ unsigned a_off(const Ctx&, int, int r) const { return r * (D / 2); }
  __device__ const bf16* b_base(const Ctx& c, int h) const { return (const bf16*)(A + (size_t)(c.t0 + h * 128) * D); }
  __device__ unsigned b_off(const Ctx&, int, int r) const { return r * (D / 2); }
  __device__ void epi(const Ctx& c, g8acc_t& acc, int wr, int wc, int fr, int fq) const {
    const float isc = 1.0f / 16.0f;
    G8_FOR_BLK2(ai, bj, m, n) {
      const int col = c.c0 + G8_AIDX(ai, m), tok = c.t0 + G8_BIDX(bj, n);
      if (col < GLACOLS) *(u32x4*)(zg + (size_t)tok * GLACOLS + col) = pack8_bf16(acc[ai][bj][m][n] * isc, acc[ai][bj][m + 1][n] * isc);
    }
  }
};
struct G8Out {
  static constexpr int NKT = 16; static constexpr bool B_GATHER = false; static constexpr bool FP8 = false; static constexpr int B_PITCH = D; static constexpr int A_PITCH = D;
  template <class C_> __device__ unsigned b_row(const C_&, int, int) const { return 0u; }
  struct Ctx { int c0, t0; };
  int mrows; const bf16* ymix; const bf16* wt; const float* modl; float* xs;
  __device__ int ntiles() const { return (mrows / 256) * 4; }
  __device__ void tile(int idx, Ctx& c) const { c.t0 = (idx >> 2) * 256; c.c0 = (idx & 3) * 256; }
  __device__ const bf16* a_base(const Ctx& c, int h) const { return wt + (size_t)(c.c0 + h * 128) * D; }
  __device__ unsigned a_off(const Ctx&, int, int r) const { return r * D; }
  __device__ const bf16* b_base(const Ctx& c, int h) const { return ymix + (size_t)(c.t0 + h * 128) * D; }
  __device__ unsigned b_off(const Ctx&, int, int r) const { return r * D; }
  __device__ void epi(const Ctx& c, g8acc_t& acc, int wr, int wc, int fr, int fq) const {
    const float* g1 = modl + (size_t)row_batch(c.t0) * 6 * D + 2 * D;
    G8_FOR_BLK(ai, bj, m, n) {
      const int col = c.c0 + G8_AIDX(ai, m), tok = c.t0 + G8_BIDX(bj, n);
      float* xp = xs + (size_t)tok * D + col;
      *(f32x4*)xp = *(const f32x4*)xp + *(const f32x4*)(g1 + col) * acc[ai][bj][m][n];
    }
  }
};
struct G8Router {
  static constexpr int NKT = 16; static constexpr bool B_GATHER = false; static constexpr bool FP8 = false; static constexpr int B_PITCH = D; static constexpr int A_PITCH = D;
  template <class C_> __device__ unsigned b_row(const C_&, int, int) const { return 0u; }
  struct Ctx { int t0; };
  int mrows; const bf16* A; const bf16* rwt; float* logits;
  __device__ int ntiles() const { return mrows / 256; }
  __device__ void tile(int idx, Ctx& c) const { c.t0 = idx * 256; }
  __device__ const bf16* a_base(const Ctx&, int h) const { return rwt + (size_t)(h * 128) * D; }
  __device__ unsigned a_off(const Ctx&, int, int r) const { return r * D; }
  __device__ const bf16* b_base(const Ctx& c, int h) const { return A + (size_t)(c.t0 + h * 128) * D; }
  __device__ unsigned b_off(const Ctx&, int, int r) const { return r * D; }
  __device__ void epi(const Ctx& c, g8acc_t& acc, int wr, int wc, int fr, int fq) const {
    G8_FOR_BLK(ai, bj, m, n) {
      const int e = G8_AIDX(ai, m), tok = c.t0 + G8_BIDX(bj, n);
      *(f32x4*)(logits + (size_t)tok * NE + e) = acc[ai][bj][m][n];
    }
  }
};
struct G8ShUp {
  static constexpr int NKT = 8; static constexpr bool B_GATHER = false; static constexpr bool FP8 = true; static constexpr int B_PITCH = D / 2; static constexpr int A_PITCH = D / 2;
  template <class C_> __device__ unsigned b_row(const C_&, int, int) const { return 0u; }
  struct Ctx { int t0, hb; };
  int mrows; const unsigned char* A8; const unsigned char* s1t; const unsigned char* s3t; unsigned char* hs;
  __device__ int ntiles() const { return (mrows / 256) * 2; }
  __device__ void tile(int idx, Ctx& c) const { c.t0 = (idx >> 1) * 256; c.hb = (idx & 1) * 128; }
  __device__ const bf16* a_base(const Ctx& c, int h) const { return (const bf16*)((h ? s3t : s1t) + (size_t)c.hb * D); }
  __device__ unsigned a_off(const Ctx&, int, int r) const { return r * (D / 2); }
  __device__ const bf16* b_base(const Ctx& c, int h) const { return (const bf16*)(A8 + (size_t)(c.t0 + h * 128) * D); }
  __device__ unsigned b_off(const Ctx&, int, int r) const { return r * (D / 2); }
  __device__ void epi(const Ctx& c, g8acc_t& acc, int wr, int wc, int fr, int fq) const {
    const float isc = 1.0f / 16.0f;
#pragma unroll
    for (int bj = 0; bj < 2; ++bj)
#pragma unroll
      for (int n = 0; n < 2; ++n) {
        const int hcol = c.hb + wr * 64 + fq * 16, tok = c.t0 + G8_BIDX(bj, n);
        u32x4 o;
#pragma unroll
        for (int m = 0; m < 4; ++m) {
          const f32x4 u = acc[0][bj][m][n] * isc, v = acc[1][bj][m][n] * isc;
          const unsigned w = pk4_fp8(silu_f(u.x) * v.x, silu_f(u.y) * v.y, silu_f(u.z) * v.z, silu_f(u.w) * v.w);
          if (m == 0) o.x = w; else if (m == 1) o.y = w; else if (m == 2) o.z = w; else o.w = w;
        }
        *(u32x4*)(hs + (size_t)tok * DE + hcol) = o;
      }
  }
};
struct G8Up {
  static constexpr int NKT = 8; static constexpr bool B_GATHER = true; static constexpr bool FP8 = true; static constexpr int B_PITCH = D / 2; static constexpr int A_PITCH = D / 2;
  struct Ctx { int s0, hb, grp; };
  const unsigned char* A8; const int* slot_tok; const int* pad_start; const unsigned char* w1t; const unsigned char* w3t; unsigned char* H; const unsigned short* tile_e;
  __device__ int ntiles() const { return (pad_start[NE] >> 8) * 2; }
  __device__ void tile(int idx, Ctx& c) const { c.s0 = (idx >> 1) * 256; c.hb = (idx & 1) * 128; c.grp = __builtin_amdgcn_readfirstlane((int)tile_e[idx >> 1]); }
  __device__ const bf16* a_base(const Ctx& c, int h) const { return (const bf16*)((h ? w3t : w1t) + ((size_t)c.grp * DE + c.hb) * D); }
  __device__ unsigned a_off(const Ctx&, int, int r) const { return r * (D / 2); }
  __device__ const bf16* b_base(const Ctx&, int) const { return (const bf16*)A8; }
  __device__ unsigned b_off(const Ctx&, int, int) const { return 0u; }
  __device__ unsigned b_row(const Ctx& c, int h, int r) const { int t = slot_tok[c.s0 + h * 128 + r]; t = (t < 0 || t >= NT) ? 0 : t; return (unsigned)t; }
  __device__ void epi(const Ctx& c, g8acc_t& acc, int wr, int wc, int fr, int fq) const {
    const float isc = 1.0f / 16.0f;
#pragma unroll
    for (int bj = 0; bj < 2; ++bj)
#pragma unroll
      for (int n = 0; n < 2; ++n) {
        const int hcol = c.hb + wr * 64 + fq * 16, slot = c.s0 + G8_BIDX(bj, n);
        u32x4 o;
#pragma unroll
        for (int m = 0; m < 4; ++m) {
          const f32x4 u = acc[0][bj][m][n] * isc, v = acc[1][bj][m][n] * isc;
          const unsigned w = pk4_fp8(silu_f(u.x) * v.x, silu_f(u.y) * v.y, silu_f(u.z) * v.z, silu_f(u.w) * v.w);
          if (m == 0) o.x = w; else if (m == 1) o.y = w; else if (m == 2) o.z = w; else o.w = w;
        }
        *(u32x4*)(H + (size_t)slot * DE + hcol) = o;
      }
  }
};
struct G8ShDown {
  static constexpr int NKT = 2; static constexpr bool B_GATHER = false; static constexpr bool FP8 = true; static constexpr int B_PITCH = DE / 2; static constexpr int A_PITCH = DE / 2;
  template <class C_> __device__ unsigned b_row(const C_&, int, int) const { return 0u; }
  struct Ctx { int c0, t0; };
  int mrows; const unsigned char* hs; const unsigned char* wt; const float* modl; float* xs;
  __device__ int ntiles() const { return (mrows / 256) * 4; }
  __device__ void tile(int idx, Ctx& c) const { c.t0 = (idx >> 2) * 256; c.c0 = (idx & 3) * 256; }
  __device__ const bf16* a_base(const Ctx& c, int h) const { return (const bf16*)(wt + (size_t)(c.c0 + h * 128) * DE); }
  __device__ unsigned a_off(const Ctx&, int, int r) const { return r * (DE / 2); }
  __device__ const bf16* b_base(const Ctx& c, int h) const { return (const bf16*)(hs + (size_t)(c.t0 + h * 128) * DE); }
  __device__ unsigned b_off(const Ctx&, int, int r) const { return r * (DE / 2); }
  __device__ void epi(const Ctx& c, g8acc_t& acc, int wr, int wc, int fr, int fq) const {
    const float* g2 = modl + (size_t)row_batch(c.t0) * 6 * D + 5 * D;
    const float isc = 1.0f / 16.0f;
    G8_FOR_BLK(ai, bj, m, n) {
      const int col = c.c0 + G8_AIDX(ai, m), tok = c.t0 + G8_BIDX(bj, n);
      float* xp = xs + (size_t)tok * D + col;
      *(f32x4*)xp = *(const f32x4*)xp + *(const f32x4*)(g2 + col) * (acc[ai][bj][m][n] * isc);
    }
  }
};
struct G8Down {
  static constexpr int NKT = 2; static constexpr bool B_GATHER = false; static constexpr bool FP8 = true; static constexpr int B_PITCH = DE / 2; static constexpr int A_PITCH = DE / 2;
  struct Ctx { int c0, s0, grp; };
  const unsigned char* H; const int* pad_start; const unsigned char* w2t; unsigned char* Y; const unsigned short* tile_e;
  template <class C_> __device__ unsigned b_row(const C_&, int, int) const { return 0u; }
  __device__ int ntiles() const { return (pad_start[NE] >> 8) * 4; }
  __device__ void tile(int idx, Ctx& c) const { c.s0 = (idx >> 2) * 256; c.c0 = (idx & 3) * 256; c.grp = __builtin_amdgcn_readfirstlane((int)tile_e[idx >> 2]); }
  __device__ const bf16* a_base(const Ctx& c, int h) const { return (const bf16*)(w2t + ((size_t)c.grp * D + c.c0 + h * 128) * DE); }
  __device__ unsigned a_off(const Ctx&, int, int r) const { return r * (DE / 2); }
  __device__ const bf16* b_base(const Ctx& c, int h) const { return (const bf16*)(H + (size_t)(c.s0 + h * 128) * DE); }
  __device__ unsigned b_off(const Ctx&, int, int r) const { return r * (DE / 2); }
  __device__ void epi(const Ctx& c, g8acc_t& acc, int wr, int wc, int fr, int fq) const {
    const float isc = 1.0f / 16.0f;
#pragma unroll
    for (int ai = 0; ai < 2; ++ai)
#pragma unroll
      for (int bj = 0; bj < 2; ++bj)
#pragma unroll
        for (int n = 0; n < 2; ++n) {
          const int col = c.c0 + G8_AIDX(ai, 0), slot = c.s0 + G8_BIDX(bj, n);
          u32x4 o;
          o.x = pack4_fp8(acc[ai][bj][0][n] * isc); o.y = pack4_fp8(acc[ai][bj][1][n] * isc);
          o.z = pack4_fp8(acc[ai][bj][2][n] * isc); o.w = pack4_fp8(acc[ai][bj][3][n] * isc);
          *(u32x4*)(Y + (size_t)slot * D + col) = o;
        }
  }
};

constexpr int CVT_TILES = 3 * NE * 128;
struct CvtCtx { const float* w1; const float* w3; const float* w2; unsigned char* d1; unsigned char* d3; unsigned char* d2; int gw, nw, k; };
struct CvtRegs { int pend; f32x4 r0, r1, r2, r3, r4, r5, r6, r7; };
__device__ __forceinline__ void cvt_locate(const CvtCtx& js, int u, int lane, const float*& s, unsigned char*& d, int& K, int& N) {
  const int job = u >> 15, r = u & 32767, mat = r >> 7, rr = r & 127;
  int kt, ntile;
  if (job < 2) { K = D; N = DE; ntile = rr >> 4; kt = rr & 15; } else { K = DE; N = D; ntile = rr >> 2; kt = rr & 3; }
  const float* s1 = js.w1; const float* s3 = js.w3; const float* s2 = js.w2;
  unsigned char* q1 = js.d1; unsigned char* q3 = js.d3; unsigned char* q2 = js.d2;
  const float* sb = job == 0 ? s1 : (job == 1 ? s3 : s2);
  unsigned char* db = job == 0 ? q1 : (job == 1 ? q3 : q2);
  const int k0 = kt * 64 + (lane & 7) * 8, n0 = ntile * 32 + (lane >> 3) * 4;
  s = sb + (size_t)mat * D * DE + (size_t)k0 * N + n0;
  d = db + (size_t)mat * D * DE + (size_t)n0 * K + k0;
}
__device__ __forceinline__ void cvt_init(CvtRegs& st) {
  st.pend = -1;
  st.r0 = st.r1 = st.r2 = st.r3 = st.r4 = st.r5 = st.r6 = st.r7 = (f32x4){0.f, 0.f, 0.f, 0.f};
}
__device__ __forceinline__ void cvt_finish(const CvtCtx& cx, CvtRegs& st, int lane) {
  if (st.pend < 0) return;
  const float* s; unsigned char* d; int K, N;
  cvt_locate(cx, st.pend, lane, s, d, K, N);
  const float sc = 16.0f;
  const f32x4 v0 = st.r0 * sc, v1 = st.r1 * sc, v2 = st.r2 * sc, v3 = st.r3 * sc, v4 = st.r4 * sc, v5 = st.r5 * sc, v6 = st.r6 * sc, v7 = st.r7 * sc;
  *(u32x2*)(d) = (u32x2){pk4_fp8(v0.x, v1.x, v2.x, v3.x), pk4_fp8(v4.x, v5.x, v6.x, v7.x)};
  *(u32x2*)(d + (size_t)K) = (u32x2){pk4_fp8(v0.y, v1.y, v2.y, v3.y), pk4_fp8(v4.y, v5.y, v6.y, v7.y)};
  *(u32x2*)(d + (size_t)2 * K) = (u32x2){pk4_fp8(v0.z, v1.z, v2.z, v3.z), pk4_fp8(v4.z, v5.z, v6.z, v7.z)};
  *(u32x2*)(d + (size_t)3 * K) = (u32x2){pk4_fp8(v0.w, v1.w, v2.w, v3.w), pk4_fp8(v4.w, v5.w, v6.w, v7.w)};
  st.pend = -1;
}
__device__ __forceinline__ void cvt_step(CvtCtx& cx, CvtRegs& st, int lane) {
  cvt_finish(cx, st, lane);
  const int u = cx.gw + cx.k * cx.nw;
  if (u < CVT_TILES) {
    const float* s; unsigned char* d; int K, N;
    cvt_locate(cx, u, lane, s, d, K, N);
    st.r0 = __builtin_nontemporal_load((const f32x4*)(s));
    st.r1 = __builtin_nontemporal_load((const f32x4*)(s + (size_t)N));
    st.r2 = __builtin_nontemporal_load((const f32x4*)(s + (size_t)2 * N));
    st.r3 = __builtin_nontemporal_load((const f32x4*)(s + (size_t)3 * N));
    st.r4 = __builtin_nontemporal_load((const f32x4*)(s + (size_t)4 * N));
    st.r5 = __builtin_nontemporal_load((const f32x4*)(s + (size_t)5 * N));
    st.r6 = __builtin_nontemporal_load((const f32x4*)(s + (size_t)6 * N));
    st.r7 = __builtin_nontemporal_load((const f32x4*)(s + (size_t)7 * N));
    st.pend = u;
    ++cx.k;
  }
}

constexpr int UST = 2056;
constexpr int HY_U_BYTES = 16 * UST * 2;
constexpr int TCOPY = 2064;
constexpr int HY_T_BYTES = 4 * TCOPY * 4;
constexpr int HY_LDS = HY_U_BYTES + HY_T_BYTES;
constexpr int USTC = 264;
constexpr int TCOPYC = 264;

__device__ __forceinline__ f32x4 mfma16(bf16x8 a, bf16x8 b, f32x4 c) {
  return __builtin_amdgcn_mfma_f32_16x16x32_bf16(a, b, c, 0, 0, 0);
}
__device__ __forceinline__ float bflo(unsigned v) { return __uint_as_float(v << 16); }
__device__ __forceinline__ float bfhi(unsigned v) { return __uint_as_float(v & 0xffff0000u); }
__device__ __forceinline__ float ldbf(const bf16* p) { return bf2f(*p); }

template <int GSTR, int TCP>
__device__ __forceinline__ void hy_load_tables(const bf16* __restrict__ G, int c, unsigned* T) {
  constexpr int NCH = GSTR / 8;
  for (int q = tid_opaque(); q < 2 * NCH; q += 512) {
    int o = q / NCH, ch = q - o * NCH;
    const unsigned* s32 = (const unsigned*)(G + ((size_t)(o * 512 + c)) * GSTR);
    u32x4 a = *(const u32x4*)(s32 + 4 * ch);
    unsigned nx = (ch + 1 < NCH) ? s32[4 * ch + 4] : 0u;
    unsigned* d0 = T + o * 2 * TCP;
    unsigned* d1 = d0 + TCP;
    *(u32x4*)(d0 + 4 * ch) = a;
    u32x4 b;
    b.x = (a.x >> 16) | (a.y << 16); b.y = (a.y >> 16) | (a.z << 16); b.z = (a.z >> 16) | (a.w << 16); b.w = (a.w >> 16) | (nx << 16);
    *(u32x4*)(d1 + 4 * ch) = b;
  }
}

template <int L, int USTR>
__device__ __forceinline__ void hy_load_u(const bf16* __restrict__ z, float w0, float w1, float w2, float bb, bf16* U) {
  constexpr int CPB = L / 8;
  for (int q = tid_opaque(); q < 16 * CPB; q += 512) {
    int b = q / CPB, t8 = (q - b * CPB) * 8;
    const bf16* zr = z + (size_t)b * L + t8;
    u32x4 v = *(const u32x4*)zr;
    float zm = t8 > 0 ? ldbf(zr - 1) : 0.f;
    float zp = t8 + 8 < L ? ldbf(zr + 8) : 0.f;
    float e0 = bflo(v.x), e1 = bfhi(v.x), e2 = bflo(v.y), e3 = bfhi(v.y), e4 = bflo(v.z), e5 = bfhi(v.z), e6 = bflo(v.w), e7 = bfhi(v.w);
    u32x4 o;
    o.x = pack_bf16(w0 * zm + w1 * e0 + w2 * e1 + bb, w0 * e0 + w1 * e1 + w2 * e2 + bb);
    o.y = pack_bf16(w0 * e1 + w1 * e2 + w2 * e3 + bb, w0 * e2 + w1 * e3 + w2 * e4 + bb);
    o.z = pack_bf16(w0 * e3 + w1 * e4 + w2 * e5 + bb, w0 * e4 + w1 * e5 + w2 * e6 + bb);
    o.w = pack_bf16(w0 * e5 + w1 * e6 + w2 * e7 + bb, w0 * e6 + w1 * e7 + w2 * zp + bb);
    *(u32x4*)(U + b * USTR + t8) = o;
  }
}

template <int L>
__device__ __forceinline__ void hy_gate4(const bf16* __restrict__ zr, int t0, float w0, float w1, float w2, float bb, float (&x)[4]) {
  u32x2 v = *(const u32x2*)(zr + t0);
  float zm = t0 > 0 ? ldbf(zr + t0 - 1) : 0.f;
  float zp = t0 + 4 < L ? ldbf(zr + t0 + 4) : 0.f;
  float e0 = bflo(v.x), e1 = bfhi(v.x), e2 = bflo(v.y), e3 = bfhi(v.y);
  x[0] = w0 * zm + w1 * e0 + w2 * e1 + bb;
  x[1] = w0 * e0 + w1 * e1 + w2 * e2 + bb;
  x[2] = w0 * e1 + w1 * e2 + w2 * e3 + bb;
  x[3] = w0 * e2 + w1 * e3 + w2 * zp + bb;
}

__device__ __forceinline__ bf16x8 hy_frag(const unsigned* p) {
  u32x4 v; v.x = p[0]; v.y = p[1]; v.z = p[2]; v.w = p[3];
  return __builtin_bit_cast(bf16x8, v);
}

__device__ __forceinline__ void hyena_latent(int c, const bf16* __restrict__ zt, const float* __restrict__ cw,
                                             const float* __restrict__ cb, const bf16* __restrict__ G,
                                             bf16* __restrict__ yt, char* smem, CvtCtx& cx) {
  const int tid = tid_opaque(), lane = tid & 63, wave = tid >> 6;
  bf16* U = (bf16*)smem;
  unsigned* T = (unsigned*)(smem + HY_U_BYTES);
  __syncthreads();
  hy_load_tables<GSTR_L, TCOPY>(G, c, T);
  hy_load_u<SEQ, UST>(zt + (size_t)c * NT, cw[c], cw[HYCOLS + c], cw[2 * HYCOLS + c], cb[c], U);
  __syncthreads();
  const int r = lane & 15, kg = lane >> 4;
  const int par = (r + 1) & 1;
  const int base_dw = 1023 - (r >> 1) + 4 * kg - 128 * wave;
  const char* ub = smem + (r * UST + 8 * kg) * 2;
  const int tw = wave * 256;
#pragma unroll 1
  for (int order = 0; order < 2; ++order) {
    const unsigned* tb = T + order * 2 * TCOPY + par * TCOPY + base_dw;
    f32x4 acc[16];
#pragma unroll
    for (int i = 0; i < 16; ++i) acc[i] = (f32x4){0.f, 0.f, 0.f, 0.f};
    bf16x8 W[16];
#pragma unroll
    for (int f = -15; f <= 0; ++f) W[f & 15] = hy_frag(tb + 8 * f);
    CvtRegs cr; cvt_init(cr);
#pragma unroll 1
    for (int J = 0; J < 8; ++J) {
      const unsigned* tj = tb + 128 * J;
      const char* uj = ub + 512 * J;
#pragma unroll
      for (int jj = 0; jj < 8; ++jj) {
        if (jj == 0) cvt_step(cx, cr, lane);
        bf16x8 uf = *(const bf16x8*)(uj + 64 * jj);
        acc[15] = mfma16(W[(2 * jj - 15) & 15], uf, acc[15]);
        acc[14] = mfma16(W[(2 * jj - 14) & 15], uf, acc[14]);
        if (J * 8 + jj < 63) {
          W[(2 * jj + 1) & 15] = hy_frag(tj + 8 * (2 * jj + 1));
          W[(2 * jj + 2) & 15] = hy_frag(tj + 8 * (2 * jj + 2));
        }
#pragma unroll
        for (int i = 13; i >= 0; --i) acc[i] = mfma16(W[(2 * jj - i) & 15], uf, acc[i]);
      }
    }
    cvt_finish(cx, cr, lane);
    __syncthreads();
    {
      const int col = (order + 1) * 512 + c;
      const float w0 = cw[col], w1 = cw[HYCOLS + col], w2 = cw[2 * HYCOLS + col], bb = cb[col];
      const bf16* zr = zt + (size_t)col * NT + (size_t)r * SEQ;
      u32x2 gv[16]; unsigned gm[16], gp[16];
#pragma unroll
      for (int i = 0; i < 16; ++i) {
        const int t0 = tw + 16 * i + 4 * kg;
        gv[i] = *(const u32x2*)(zr + t0);
        gm[i] = t0 > 0 ? (unsigned)*(const unsigned short*)(zr + t0 - 1) : 0u;
        gp[i] = t0 + 4 < SEQ ? (unsigned)*(const unsigned short*)(zr + t0 + 4) : 0u;
      }
#pragma unroll
      for (int i = 0; i < 16; ++i) {
        const int t0 = tw + 16 * i + 4 * kg;
        const float zm = __uint_as_float(gm[i] << 16), zp = __uint_as_float(gp[i] << 16);
        const float e0 = bflo(gv[i].x), e1 = bfhi(gv[i].x), e2 = bflo(gv[i].y), e3 = bfhi(gv[i].y);
        const float x0 = w0 * zm + w1 * e0 + w2 * e1 + bb, x1 = w0 * e0 + w1 * e1 + w2 * e2 + bb;
        const float x2 = w0 * e1 + w1 * e2 + w2 * e3 + bb, x3 = w0 * e2 + w1 * e3 + w2 * zp + bb;
        u32x2 o;
        o.x = pack_bf16(x0 * acc[i][0], x1 * acc[i][1]);
        o.y = pack_bf16(x2 * acc[i][2], x3 * acc[i][3]);
        *(u32x2*)(U + r * UST + t0) = o;
      }
    }
    __syncthreads();
  }
  for (int q = tid; q < 16 * 256; q += 512) {
    int b = q >> 8, t8 = (q & 255) * 8;
    *(u32x4*)(yt + (size_t)c * NT + (size_t)b * SEQ + t8) = *(const u32x4*)(U + b * UST + t8);
  }
}

__device__ __forceinline__ void hyena_ctx(int c, const bf16* __restrict__ zt, const float* __restrict__ cw,
                                          const float* __restrict__ cb, const bf16* __restrict__ G,
                                          bf16* __restrict__ yt, char* smem) {
  const int tid = tid_opaque(), lane = tid & 63, wave = tid >> 6;
  bf16* U = (bf16*)smem;
  unsigned* T = (unsigned*)(smem + HY_U_BYTES);
  __syncthreads();
  hy_load_tables<GSTR_C, TCOPYC>(G, c, T);
  hy_load_u<LC, USTC>(zt + (size_t)c * NT, cw[c], cw[HYCOLS + c], cw[2 * HYCOLS + c], cb[c], U);
  __syncthreads();
  const int r = lane & 15, kg = lane >> 4;
  const int par = (r + 1) & 1;
  const int base_dw = (8 * kg - r + 255 - par) >> 1;
  const char* ub = smem + (r * USTC + 8 * kg) * 2;
#pragma unroll 1
  for (int order = 0; order < 2; ++order) {
    const unsigned* tb = T + order * 2 * TCOPYC + par * TCOPYC + base_dw;
    f32x4 acc[2];
    acc[0] = (f32x4){0.f, 0.f, 0.f, 0.f};
    acc[1] = acc[0];
#pragma unroll
    for (int j = 0; j < 8; ++j) {
      bf16x8 uf = *(const bf16x8*)(ub + 64 * j);
#pragma unroll
      for (int ii = 0; ii < 2; ++ii) {
        const int i = wave * 2 + ii;
        acc[ii] = mfma16(hy_frag(tb + 16 * j - 8 * i), uf, acc[ii]);
      }
    }
    __syncthreads();
    {
      const int col = (order + 1) * 512 + c;
      const float w0 = cw[col], w1 = cw[HYCOLS + col], w2 = cw[2 * HYCOLS + col], bb = cb[col];
      const bf16* zr = zt + (size_t)col * NT + (size_t)r * LC;
#pragma unroll
      for (int ii = 0; ii < 2; ++ii) {
        const int t0 = (wave * 2 + ii) * 16 + 4 * kg;
        float x[4];
        hy_gate4<LC>(zr, t0, w0, w1, w2, bb, x);
        u32x2 o;
        o.x = pack_bf16(x[0] * acc[ii][0], x[1] * acc[ii][1]);
        o.y = pack_bf16(x[2] * acc[ii][2], x[3] * acc[ii][3]);
        *(u32x2*)(U + r * USTC + t0) = o;
      }
    }
    __syncthreads();
  }
  {
    int b = tid >> 5, t8 = (tid & 31) * 8;
    *(u32x4*)(yt + (size_t)c * NT + (size_t)b * LC + t8) = *(const u32x4*)(U + b * USTC + t8);
  }
}

constexpr int GL_QE = 0, GL_KE = 8192, GL_KST = 16384, GL_ATT = 24576, GL_ST = 32768, GL_VT = 49152  ;
constexpr int GL_RAW = 81920  , GL_RAWSZ = 18432, GL_SEG = 118784, GL_DEC = 120832;
constexpr int GLA_LDS = 121088;

__device__ __forceinline__ f32x16 mfma32(bf16x8 a, bf16x8 b, f32x16 c) {
  return __builtin_amdgcn_mfma_f32_32x32x16_bf16(a, b, c, 0, 0, 0);
}
__device__ __forceinline__ unsigned short bf16bits(float v) { bf16 h = f2bf(v); return *(unsigned short*)&h; }

struct GlaArgs {
  const bf16* zg; const float* wa2; const float* ba2; float* of; float* ob; int emit_ctx; int pad_;
};

__device__ __forceinline__ void gla_unit(int unit, const GlaArgs& a, char* smem, CvtCtx& cx) {
  const int tid = tid_opaque(), lane = tid & 63, wave = tid >> 6;
  const int dir = unit & 1, h = (unit >> 1) & 3, b = unit >> 3;
  const int lr = lane & 31, lh = lane >> 5;
  const int swl = (lr >> 1) & 7;
  float* outp = dir ? a.ob : a.of;
  __syncthreads();
  const int d = tid & 63, sg = tid >> 6;
  float wa[16];
#pragma unroll
  for (int r = 0; r < 16; ++r) wa[r] = a.wa2[(dir * 16 + r) * 256 + h * 64 + d];
  const float ba = a.ba2[dir * 256 + h * 64 + d];
  { unsigned zz = 0u; asm volatile("" : "+v"(zz));
    for (int q = tid; q < 16384 / 16; q += 512) *(u32x4*)(smem + GL_ST + q * 16) = (u32x4){zz, zz, zz, zz}; }
  f32x16 S;
#pragma unroll
  for (int r = 0; r < 16; ++r) S[r] = 0.f;

  const int qi = tid >> 3, qc = tid & 7;
  const int ai = (tid >> 1) & 63, ac = tid & 1;
  const int vsg = (tid >> 5) & 7, vdq = tid & 31;
  u32x4 pq, pk, pa;
  u32x2 pw0, pw1, pw2, pw3, pw4, pw5, pw6, pw7;

#define GLA_ROW(N_, I_, ROW_)                                                        \
  {                                                                                  \
    const int n_ = (N_);                                                             \
    const int Ls_ = n_ < 4 ? LC : SEQ;                                               \
    const int cn_ = n_ < 4 ? n_ : n_ - 4;                                            \
    const int rb_ = n_ < 4 ? (NL + b * LC) : (b * SEQ);                              \
    const int pos_ = cn_ * 64 + (I_);                                                \
    ROW_ = rb_ + (dir ? (Ls_ - 1 - pos_) : pos_);                                    \
  }
#define GLA_LOAD_RAW(N_)                                                             \
  {                                                                                  \
    int row_;                                                                        \
    GLA_ROW(N_, qi, row_);                                                           \
    const bf16* zr_ = a.zg + (size_t)row_ * GLACOLS;                                 \
    pq = *(const u32x4*)(zr_ + h * 64 + qc * 8);                                     \
    pk = *(const u32x4*)(zr_ + 256 + h * 64 + qc * 8);                               \
    int ra_;                                                                         \
    GLA_ROW(N_, ai, ra_);                                                            \
    pa = *(const u32x4*)(a.zg + (size_t)ra_ * GLACOLS + 1536 + dir * 16 + ac * 8);   \
  }
#define GLA_LOAD_V(N_)                                                               \
  {                                                                                  \
    int rv_;                                                                         \
    GLA_ROW(N_, vsg * 8 + 0, rv_); pw0 = *(const u32x2*)(a.zg + (size_t)rv_ * GLACOLS + 512 + h * 128 + vdq * 4); \
    GLA_ROW(N_, vsg * 8 + 1, rv_); pw1 = *(const u32x2*)(a.zg + (size_t)rv_ * GLACOLS + 512 + h * 128 + vdq * 4); \
    GLA_ROW(N_, vsg * 8 + 2, rv_); pw2 = *(const u32x2*)(a.zg + (size_t)rv_ * GLACOLS + 512 + h * 128 + vdq * 4); \
    GLA_ROW(N_, vsg * 8 + 3, rv_); pw3 = *(const u32x2*)(a.zg + (size_t)rv_ * GLACOLS + 512 + h * 128 + vdq * 4); \
    GLA_ROW(N_, vsg * 8 + 4, rv_); pw4 = *(const u32x2*)(a.zg + (size_t)rv_ * GLACOLS + 512 + h * 128 + vdq * 4); \
    GLA_ROW(N_, vsg * 8 + 5, rv_); pw5 = *(const u32x2*)(a.zg + (size_t)rv_ * GLACOLS + 512 + h * 128 + vdq * 4); \
    GLA_ROW(N_, vsg * 8 + 6, rv_); pw6 = *(const u32x2*)(a.zg + (size_t)rv_ * GLACOLS + 512 + h * 128 + vdq * 4); \
    GLA_ROW(N_, vsg * 8 + 7, rv_); pw7 = *(const u32x2*)(a.zg + (size_t)rv_ * GLACOLS + 512 + h * 128 + vdq * 4); \
  }
#define GLA_STORE_RAW(RB_)                                                           \
  {                                                                                  \
    char* rw_ = smem + GL_RAW + (RB_) * GL_RAWSZ;                                    \
    *(u32x4*)(rw_ + qi * 128 + qc * 16) = pq;                                        \
    *(u32x4*)(rw_ + 8192 + qi * 128 + qc * 16) = pk;                                 \
    if (tid < 128) *(u32x4*)(rw_ + 16384 + ai * 32 + ac * 16) = pa;                  \
  }
#define GLA_STORE_V(VB_)                                                             \
  if (tid < 256) {                                                                   \
    char* vt_ = smem + GL_VT + (VB_) * 16384;                                        \
    u32x4 o;                                                                         \
    o.x = (pw0.x & 0xffffu) | (pw1.x << 16); o.y = (pw2.x & 0xffffu) | (pw3.x << 16); o.z = (pw4.x & 0xffffu) | (pw5.x << 16); o.w = (pw6.x & 0xffffu) | (pw7.x << 16); \
    *(u32x4*)(vt_ + swz(vdq * 4 + 0, vsg)) = o;                                      \
    o.x = (pw0.x >> 16) | (pw1.x & 0xffff0000u); o.y = (pw2.x >> 16) | (pw3.x & 0xffff0000u); o.z = (pw4.x >> 16) | (pw5.x & 0xffff0000u); o.w = (pw6.x >> 16) | (pw7.x & 0xffff0000u); \
    *(u32x4*)(vt_ + swz(vdq * 4 + 1, vsg)) = o;                                      \
    o.x = (pw0.y & 0xffffu) | (pw1.y << 16); o.y = (pw2.y & 0xffffu) | (pw3.y << 16); o.z = (pw4.y & 0xffffu) | (pw5.y << 16); o.w = (pw6.y & 0xffffu) | (pw7.y << 16); \
    *(u32x4*)(vt_ + swz(vdq * 4 + 2, vsg)) = o;                                      \
    o.x = (pw0.y >> 16) | (pw1.y & 0xffff0000u); o.y = (pw2.y >> 16) | (pw3.y & 0xffff0000u); o.z = (pw4.y >> 16) | (pw5.y & 0xffff0000u); o.w = (pw6.y >> 16) | (pw7.y & 0xffff0000u); \
    *(u32x4*)(vt_ + swz(vdq * 4 + 3, vsg)) = o;                                      \
  }
#define GLA_STEP3(RB_)                                                               \
  {                                                                                  \
    const char* ra_ = smem + GL_RAW + (RB_) * GL_RAWSZ + 16384;                      \
    float run = 0.f;                                                                 \
    _Pragma("unroll") for (int ii = 0; ii < 8; ++ii) {                               \
      const int i = sg * 8 + ii;                                                     \
      const u32x4 a0 = *(const u32x4*)(ra_ + i * 32);                                \
      const u32x4 a1 = *(const u32x4*)(ra_ + i * 32 + 16);                           \
      float g = ba;                                                                  \
      g += bflo(a0.x) * wa[0] + bfhi(a0.x) * wa[1] + bflo(a0.y) * wa[2] + bfhi(a0.y) * wa[3]; \
      g += bflo(a0.z) * wa[4] + bfhi(a0.z) * wa[5] + bflo(a0.w) * wa[6] + bfhi(a0.w) * wa[7]; \
      g += bflo(a1.x) * wa[8] + bfhi(a1.x) * wa[9] + bflo(a1.y) * wa[10] + bfhi(a1.y) * wa[11]; \
      g += bflo(a1.z) * wa[12] + bfhi(a1.z) * wa[13] + bflo(a1.w) * wa[14] + bfhi(a1.w) * wa[15]; \
      run += logsigmoid_f(g) * (1.0f / 16.0f);                                       \
      bl[ii] = run;                                                                  \
    }                                                                                \
    *(float*)(smem + GL_SEG + (sg * 64 + d) * 4) = run;                              \
  }
#define GLA_STEP5(RB_)                                                               \
  {                                                                                  \
    const char* rq_ = smem + GL_RAW + (RB_) * GL_RAWSZ;                              \
    float off = 0.f, tot = 0.f;                                                      \
    _Pragma("unroll") for (int s = 0; s < 8; ++s) {                                  \
      float v = *(const float*)(smem + GL_SEG + (s * 64 + d) * 4);                  \
      off += (s < sg) ? v : 0.f;                                                     \
      tot += v;                                                                      \
    }                                                                                \
    float ks[8];                                                                     \
    _Pragma("unroll") for (int ii = 0; ii < 8; ++ii) {                               \
      const int i = sg * 8 + ii;                                                     \
      const float bb = off + bl[ii];                                                 \
      const float qv = bf2f(*(const bf16*)(rq_ + i * 128 + d * 2));                 \
      const float kv = bf2f(*(const bf16*)(rq_ + 8192 + i * 128 + d * 2));          \
      const int eo = swz(i, d >> 3) + (d & 7) * 2;                                   \
      *(unsigned short*)(smem + GL_QE + eo) = bf16bits(qv * 0.125f * __expf(bb));    \
      *(unsigned short*)(smem + GL_KE + eo) = bf16bits(kv * __expf(-bb));            \
      ks[ii] = kv * __expf(tot - bb);                                                \
    }                                                                                \
    u32x4 o;                                                                         \
    o.x = pack_bf16(ks[0], ks[1]); o.y = pack_bf16(ks[2], ks[3]); o.z = pack_bf16(ks[4], ks[5]); o.w = pack_bf16(ks[6], ks[7]); \
    *(u32x4*)(smem + GL_KST + swz(d, sg)) = o;                                       \
    if (sg == 0) *(float*)(smem + GL_DEC + d * 4) = __expf(tot);                     \
  }

  const int tm = wave >> 2, tn = wave & 3;
  float bl[8];
  f32x16 oprev;
#pragma unroll
  for (int r = 0; r < 16; ++r) oprev[r] = 0.f;

  GLA_LOAD_RAW(0); GLA_LOAD_V(0);
  GLA_STORE_RAW(0); GLA_STORE_V(0);
  GLA_LOAD_RAW(1);
  GLA_STORE_RAW(1);
  __syncthreads();
  GLA_STEP3(0);
  __syncthreads();
  GLA_STEP5(0);
  GLA_LOAD_RAW(2); GLA_LOAD_V(1);
  __syncthreads();
  CvtRegs cr; cvt_init(cr);
#pragma unroll 1
  for (int n = 0; n < 36; ++n) {
    const int vb = n & 1;
    const bool has1 = n + 1 < 36;
    cvt_step(cx, cr, lane);
    f32x16 oacc;
#pragma unroll
    for (int r = 0; r < 16; ++r) oacc[r] = 0.f;
#pragma unroll
    for (int r = 0; r < 16; ++r) S[r] *= *(const float*)(smem + GL_DEC + (tm * 32 + rowmap(r, lh)) * 4);
#pragma unroll
    for (int ks4 = 0; ks4 < 4; ++ks4) {
      const int c = ((2 * ks4 + lh) ^ swl) << 4;
      const bf16x8 fq = *(const bf16x8*)(smem + GL_QE + (tm * 32 + lr) * 128 + c);
      const bf16x8 fs = *(const bf16x8*)(smem + GL_ST + (tn * 32 + lr) * 128 + c);
      oacc = mfma32(fq, fs, oacc);
      const bf16x8 fk = *(const bf16x8*)(smem + GL_KST + (tm * 32 + lr) * 128 + c);
      const bf16x8 fv = *(const bf16x8*)(smem + GL_VT + vb * 16384 + (tn * 32 + lr) * 128 + c);
      S = mfma32(fk, fv, S);
    }
    if (wave < 4) {
      const int am = wave >> 1, an = wave & 1;
      f32x16 att;
#pragma unroll
      for (int r = 0; r < 16; ++r) att[r] = 0.f;
#pragma unroll
      for (int ks4 = 0; ks4 < 4; ++ks4) {
        const int c = ((2 * ks4 + lh) ^ swl) << 4;
        const bf16x8 fq = *(const bf16x8*)(smem + GL_QE + (am * 32 + lr) * 128 + c);
        const bf16x8 fk = *(const bf16x8*)(smem + GL_KE + (an * 32 + lr) * 128 + c);
        att = mfma32(fq, fk, att);
      }
      const int s = an * 32 + lr;
#pragma unroll
      for (int r = 0; r < 16; ++r) {
        const int t = am * 32 + rowmap(r, lh);
        const float v = (s <= t) ? att[r] : 0.f;
        *(unsigned short*)(smem + GL_ATT + swz(t, s >> 3) + (s & 7) * 2) = bf16bits(v);
      }
    }
    if (has1) GLA_STEP3((n + 1) & 1);
    __syncthreads();
#pragma unroll
    for (int ks4 = 0; ks4 < 4; ++ks4) {
      const int c = ((2 * ks4 + lh) ^ swl) << 4;
      const bf16x8 fa = *(const bf16x8*)(smem + GL_ATT + (tm * 32 + lr) * 128 + c);
      const bf16x8 fv = *(const bf16x8*)(smem + GL_VT + vb * 16384 + (tn * 32 + lr) * 128 + c);
      oacc = mfma32(fa, fv, oacc);
    }
#pragma unroll
    for (int g = 0; g < 4; ++g) {
      u32x2 o;
      o.x = pack_bf16(S[4 * g + 0], S[4 * g + 1]);
      o.y = pack_bf16(S[4 * g + 2], S[4 * g + 3]);
      *(u32x2*)(smem + GL_ST + swz(tn * 32 + lr, tm * 4 + g) + 8 * lh) = o;
    }
    if (has1) {
      GLA_STEP5((n + 1) & 1);
      GLA_STORE_V((n + 1) & 1);
      if (n + 2 < 36) GLA_STORE_RAW(n & 1);
    }
    if (n > 0 && (n - 1 >= 4 || a.emit_ctx)) {
#pragma unroll
      for (int r = 0; r < 16; ++r) {
        int row;
        GLA_ROW(n - 1, tm * 32 + rowmap(r, lh), row);
        outp[(size_t)row * 512 + h * 128 + tn * 32 + lr] = oprev[r];
      }
    }
    { const int nr = n + 3 < 36 ? n + 3 : 35; GLA_LOAD_RAW(nr); const int nv = n + 2 < 36 ? n + 2 : 35; GLA_LOAD_V(nv); }
    oprev = oacc;
    __syncthreads();
  }
  cvt_finish(cx, cr, lane);
  {
#pragma unroll
    for (int r = 0; r < 16; ++r) {
      int row;
      GLA_ROW(35, tm * 32 + rowmap(r, lh), row);
      outp[(size_t)row * 512 + h * 128 + tn * 32 + lr] = oprev[r];
    }
  }
#undef GLA_ROW
#undef GLA_LOAD_RAW
#undef GLA_LOAD_V
#undef GLA_STORE_RAW
#undef GLA_STORE_V
#undef GLA_STEP3
#undef GLA_STEP5
}


constexpr int CTRL_Q = 0;
constexpr int CTRL_CNT = 128;
constexpr int CTRL_CUR = 640;
constexpr int CTRL_XR = 1152;
constexpr int CTRL_WORDS = 1152 + 256;
constexpr size_t al256(size_t v) { return (v + 255) / 256 * 256; }
namespace wso {
constexpr size_t bar = 0;
constexpr size_t ctrl = al256(bar + (size_t)XCD_BAR_WORDS * 4);
constexpr size_t zero_end = al256(ctrl + (size_t)CTRL_WORDS * 4);
constexpr size_t xs = al256(ctrl + (size_t)CTRL_WORDS * 4);
constexpr size_t mod = al256(xs + (size_t)NT * D * 4);
constexpr size_t abuf = al256(mod + (size_t)DEPTH * 17 * 6 * D * 4);
constexpr size_t zt = al256(abuf + (size_t)NT * D * 2);
constexpr size_t zg = al256(zt + (size_t)HYCOLS * NT * 2);
constexpr size_t yt = al256(zg + (size_t)NT * GLACOLS * 2);
constexpr size_t of = al256(yt + (size_t)HYW * NT * 2);
constexpr size_t ob = al256(of + (size_t)NT * 512 * 4);
constexpr size_t ymix = al256(ob + (size_t)NT * 512 * 4);
constexpr size_t region_end_raw = al256(ymix + (size_t)NT * D * 2);
constexpr size_t region_end = (region_end_raw > zt + al256((size_t)NSLOT * D * 2)) ? region_end_raw : zt + al256((size_t)NSLOT * D * 2);
constexpr size_t hid = region_end;
constexpr size_t gl = al256(hid + (size_t)DEPTH * 2 * SEQ * 64 * 4);
constexpr size_t gc = al256(gl + (size_t)DEPTH * 2 * HYW * GSTR_L * 2);
constexpr size_t logits = al256(gc + (size_t)2 * HYW * GSTR_C * 2);
constexpr size_t tok_e = al256(logits + (size_t)NT * NE * 4);
constexpr size_t tok_gate = al256(tok_e + (size_t)NT * TOPK * 4);
constexpr size_t tok_slot = al256(tok_gate + (size_t)NT * TOPK * 4);
constexpr size_t pad_start = al256(tok_slot + (size_t)NT * TOPK * 4);
constexpr size_t slot_tok = al256(pad_start + (size_t)(NE + 2) * 4);
constexpr size_t blkcnt = al256(slot_tok + (size_t)NSLOT * 4);
constexpr size_t hbuf = al256(blkcnt + (size_t)512 * NE * 4);
constexpr size_t hs = al256(hbuf + (size_t)NSLOT * DE);
constexpr size_t w_in_t = al256(hs + (size_t)NT * DE);
constexpr size_t w_out_t = al256(w_in_t + (size_t)DEPTH * WIN_ROWS * D * 2);
constexpr size_t router_t = al256(w_out_t + (size_t)DEPTH * D * D * 2);
constexpr size_t sh1_t = al256(router_t + (size_t)DEPTH * NE * D * 2);
constexpr size_t sh3_t = al256(sh1_t + (size_t)DEPTH * DE * D);
constexpr size_t sh2_t = al256(sh3_t + (size_t)DEPTH * DE * D);
constexpr size_t e1_t = al256(sh2_t + (size_t)DEPTH * D * DE);
constexpr size_t e3_t = al256(e1_t + (size_t)NE * DE * D);
constexpr size_t e2_t = al256(e3_t + (size_t)NE * DE * D);
constexpr size_t abuf8 = al256(e2_t + (size_t)NE * D * DE);
constexpr size_t w_g8 = al256(abuf8 + (size_t)NT * D);
constexpr size_t total = al256(w_g8 + (size_t)DEPTH * GW_ROWS * D);
constexpr size_t ybuf = zt;
}
struct WS {
  char* b;
  __device__ __forceinline__ unsigned* bar() const { char* q = b; asm volatile("" : "+s"(q)); return (unsigned*)(q + wso::bar); }
  __device__ __forceinline__ int* ctrl() const { char* q = b; asm volatile("" : "+s"(q)); return (int*)(q + wso::ctrl); }
  __device__ __forceinline__ float* xs() const { char* q = b; asm volatile("" : "+s"(q)); return (float*)(q + wso::xs); }
  __device__ __forceinline__ float* mod() const { char* q = b; asm volatile("" : "+s"(q)); return (float*)(q + wso::mod); }
  __device__ __forceinline__ bf16* abuf() const { char* q = b; asm volatile("" : "+s"(q)); return (bf16*)(q + wso::abuf); }
  __device__ __forceinline__ bf16* zt() const { char* q = b; asm volatile("" : "+s"(q)); return (bf16*)(q + wso::zt); }
  __device__ __forceinline__ bf16* zg() const { char* q = b; asm volatile("" : "+s"(q)); return (bf16*)(q + wso::zg); }
  __device__ __forceinline__ bf16* yt() const { char* q = b; asm volatile("" : "+s"(q)); return (bf16*)(q + wso::yt); }
  __device__ __forceinline__ float* of() const { char* q = b; asm volatile("" : "+s"(q)); return (float*)(q + wso::of); }
  __device__ __forceinline__ float* ob() const { char* q = b; asm volatile("" : "+s"(q)); return (float*)(q + wso::ob); }
  __device__ __forceinline__ bf16* ymix() const { char* q = b; asm volatile("" : "+s"(q)); return (bf16*)(q + wso::ymix); }
  __device__ __forceinline__ float* hid() const { char* q = b; asm volatile("" : "+s"(q)); return (float*)(q + wso::hid); }
  __device__ __forceinline__ bf16* gl() const { char* q = b; asm volatile("" : "+s"(q)); return (bf16*)(q + wso::gl); }
  __device__ __forceinline__ bf16* gc() const { char* q = b; asm volatile("" : "+s"(q)); return (bf16*)(q + wso::gc); }
  __device__ __forceinline__ float* logits() const { char* q = b; asm volatile("" : "+s"(q)); return (float*)(q + wso::logits); }
  __device__ __forceinline__ int* tok_e() const { char* q = b; asm volatile("" : "+s"(q)); return (int*)(q + wso::tok_e); }
  __device__ __forceinline__ float* tok_gate() const { char* q = b; asm volatile("" : "+s"(q)); return (float*)(q + wso::tok_gate); }
  __device__ __forceinline__ int* tok_slot() const { char* q = b; asm volatile("" : "+s"(q)); return (int*)(q + wso::tok_slot); }
  __device__ __forceinline__ int* pad_start() const { char* q = b; asm volatile("" : "+s"(q)); return (int*)(q + wso::pad_start); }
  __device__ __forceinline__ int* slot_tok() const { char* q = b; asm volatile("" : "+s"(q)); return (int*)(q + wso::slot_tok); }
  __device__ __forceinline__ int* blkcnt() const { char* q = b; asm volatile("" : "+s"(q)); return (int*)(q + wso::blkcnt); }
  __device__ __forceinline__ unsigned char* hbuf() const { char* q = b; asm volatile("" : "+s"(q)); return (unsigned char*)(q + wso::hbuf); }
  __device__ __forceinline__ unsigned char* hs() const { char* q = b; asm volatile("" : "+s"(q)); return (unsigned char*)(q + wso::hs); }
  __device__ __forceinline__ bf16* w_in_t() const { char* q = b; asm volatile("" : "+s"(q)); return (bf16*)(q + wso::w_in_t); }
  __device__ __forceinline__ bf16* w_out_t() const { char* q = b; asm volatile("" : "+s"(q)); return (bf16*)(q + wso::w_out_t); }
  __device__ __forceinline__ bf16* router_t() const { char* q = b; asm volatile("" : "+s"(q)); return (bf16*)(q + wso::router_t); }
  __device__ __forceinline__ unsigned char* sh1_t() const { char* q = b; asm volatile("" : "+s"(q)); return (unsigned char*)(q + wso::sh1_t); }
  __device__ __forceinline__ unsigned char* sh3_t() const { char* q = b; asm volatile("" : "+s"(q)); return (unsigned char*)(q + wso::sh3_t); }
  __device__ __forceinline__ unsigned char* sh2_t() const { char* q = b; asm volatile("" : "+s"(q)); return (unsigned char*)(q + wso::sh2_t); }
  __device__ __forceinline__ unsigned char* e1_t() const { char* q = b; asm volatile("" : "+s"(q)); return (unsigned char*)(q + wso::e1_t); }
  __device__ __forceinline__ unsigned char* e3_t() const { char* q = b; asm volatile("" : "+s"(q)); return (unsigned char*)(q + wso::e3_t); }
  __device__ __forceinline__ unsigned char* e2_t() const { char* q = b; asm volatile("" : "+s"(q)); return (unsigned char*)(q + wso::e2_t); }
  __device__ __forceinline__ unsigned char* ybuf() const { char* q = b; asm volatile("" : "+s"(q)); return (unsigned char*)(q + wso::ybuf); }
  __device__ __forceinline__ unsigned char* abuf8() const { char* q = b; asm volatile("" : "+s"(q)); return (unsigned char*)(q + wso::abuf8); }
  __device__ __forceinline__ unsigned char* w_g8() const { char* q = b; asm volatile("" : "+s"(q)); return (unsigned char*)(q + wso::w_g8); }
};

constexpr int MEGA_LDS_MAIN = G8_LDS;
constexpr int LDS_TILE_E = MEGA_LDS_MAIN + 16;
constexpr int MEGA_LDS = MEGA_LDS_MAIN + 16 + 4096;

struct MP { Inputs in; WS w; float* out; };

__device__ __forceinline__ void row_load(const float* __restrict__ p, int lane, f32x4 (&v)[4]) {
#pragma unroll
  for (int j = 0; j < 4; ++j) v[j] = *(const f32x4*)(p + j * 256 + lane * 4);
}
__device__ __forceinline__ float row_rinv(const f32x4 (&v)[4], int lane) {
  float ss = 0.f;
#pragma unroll
  for (int j = 0; j < 4; ++j) ss += v[j].x * v[j].x + v[j].y * v[j].y + v[j].z * v[j].z + v[j].w * v[j].w;
  ss = wave_sum(ss, lane);
  return rsqrtf(ss * (1.0f / D) + EPS);
}
__device__ __forceinline__ void row_norm_mod_store(const f32x4 (&v)[4], float rinv, const float* __restrict__ g,
                                                   const float* __restrict__ sh, const float* __restrict__ sc, int lane,
                                                   bf16* __restrict__ dst, unsigned char* __restrict__ dst8 = nullptr) {
#pragma unroll
  for (int j = 0; j < 4; ++j) {
    const int d = j * 256 + lane * 4;
    const f32x4 gv = *(const f32x4*)(g + d), shv = *(const f32x4*)(sh + d), scv = *(const f32x4*)(sc + d);
    const float y0 = v[j].x * rinv * gv.x * (1.f + scv.x) + shv.x, y1 = v[j].y * rinv * gv.y * (1.f + scv.y) + shv.y;
    const float y2 = v[j].z * rinv * gv.z * (1.f + scv.z) + shv.z, y3 = v[j].w * rinv * gv.w * (1.f + scv.w) + shv.w;
    u32x2 o;
    o.x = pack_bf16(y0, y1);
    o.y = pack_bf16(y2, y3);
    *(u32x2*)(dst + d) = o;
    if (dst8) *(unsigned*)(dst8 + d) = pk4_fp8(y0, y1, y2, y3);
  }
}

__device__ __forceinline__ void ph_mod_hid(const MP& p, char* smem, int bid, int nblk) {
  const int tid = tid_opaque(), lane = tid & 63, wave = tid >> 6;
  float* sc = (float*)smem;
  for (int u = bid; u < 192; u += nblk) {
    const int l = u / 96, col0 = (u - l * 96) * 64;
    __syncthreads();
    for (int i = tid; i < 17 * 1024; i += 512) {
      const int r = i >> 10, k = i & 1023;
      const float v = (r < 16) ? p.in.c[r * D + k] : p.in.c_ctx[k];
      sc[i] = silu_f(v);
    }
    __syncthreads();
    const int col = tid & 63, ks = tid >> 6;
    float acc[17];
#pragma unroll
    for (int r = 0; r < 17; ++r) acc[r] = 0.f;
    const float* wp = p.in.ada_w + ((size_t)l * D + ks * 128) * (6 * D) + col0 + col;
#pragma unroll 16
    for (int kk = 0; kk < 128; ++kk) {
      const float wv = wp[(size_t)kk * (6 * D)];
#pragma unroll
      for (int r = 0; r < 17; ++r) acc[r] += sc[r * 1024 + ks * 128 + kk] * wv;
    }
    __syncthreads();
#pragma unroll
    for (int r = 0; r < 17; ++r) sc[(ks * 17 + r) * 64 + col] = acc[r];
    __syncthreads();
    for (int i = tid; i < 17 * 64; i += 512) {
      const int r = i >> 6, cc = i & 63;
      float s = 0.f;
#pragma unroll
      for (int k8 = 0; k8 < 8; ++k8) s += sc[(k8 * 17 + r) * 64 + cc];
      p.w.mod()[((size_t)l * 17 + r) * (6 * D) + col0 + cc] = s + p.in.ada_b[l * 6 * D + col0 + cc];
    }
  }
  for (int it = bid; it * 8 < 4352; it += nblk) {
    const int rid = it * 8 + wave;
    int l, ty, t;
    if (rid < 2048) { l = 0; ty = 0; t = rid; }
    else if (rid < 2304) { l = 0; ty = 1; t = rid - 2048; }
    else { l = 1; ty = 0; t = rid - 2304; }
    const int L = ty ? LC : SEQ;
    const float* w1 = p.in.hy_f_w1 + l * 33 * 64; const float* b1 = p.in.hy_f_b1 + l * 64;
    const float* w2 = p.in.hy_f_w2 + l * 64 * 64; const float* b2 = p.in.hy_f_b2 + l * 64;
    float pv = 0.f;
    if (lane == 0) pv = (float)t / (float)(L - 1);
    else if (lane < 33) {
      const int bi = (lane - 1) & 15;
      const float wph = 2.0f * 3.14159265358979323846f * (float)t / (float)L;
      const float f = 1e-4f + (float)bi * ((15.0f - 1e-4f) / 15.0f);
      pv = (lane <= 16) ? cosf(f * wph) : -sinf(f * wph);
    }
    float a1 = b1[lane];
#pragma unroll
    for (int i = 0; i < 33; ++i) a1 += shl_f(pv, i) * w1[i * 64 + lane];
    const float h1 = sinf(a1);
    float a2 = b2[lane];
#pragma unroll 16
    for (int i = 0; i < 64; ++i) a2 += shl_f(h1, i) * w2[i * 64 + lane];
    p.w.hid()[((size_t)(l * 2 + ty) * SEQ + t) * 64 + lane] = sinf(a2);
  }
}

__device__ __forceinline__ void ph_gtab(const MP& p, char* smem, int bid, int nblk) {
  const int tid = tid_opaque();
  float* wl = (float*)smem;
  for (int u = bid; u < 544; u += nblk) {
    int l, ty, ib, cg;
    if (u < 512) { l = u >> 8; ty = 0; ib = (u >> 5) & 7; cg = u & 31; }
    else { l = 0; ty = 1; ib = 0; cg = u - 512; }
    const int L = ty ? LC : SEQ, gstr = ty ? GSTR_C : GSTR_L;
    const float* hid = p.w.hid() + (size_t)(l * 2 + ty) * SEQ * 64;
    const float* w3 = p.in.hy_f_w3 + (size_t)l * 64 * 2048;
    const float* skip = p.in.hy_skip + l * 2 * 512;
    bf16* G = ty ? p.w.gc() : (p.w.gl() + (size_t)l * 2 * HYW * GSTR_L);
    __syncthreads();
    for (int i = tid; i < 2 * 32 * 64; i += 512) {
      const int dir = i >> 11, cc = (i >> 6) & 31, j = i & 63;
      const int oc = cg * 32 + cc, o = oc >> 9, c = oc & 511;
      wl[i] = w3[(size_t)j * 2048 + o * 1024 + dir * 512 + c];
    }
    __syncthreads();
    const int i = ib * 512 + tid;
    const int dd = i - (L - 1);
    const int t = dd < 0 ? -dd : dd;
    const bool inr = i < 2 * L - 1;
    const int dir = dd > 0 ? 1 : 0;
    float hr[64];
    {
      const float* hp = hid + (size_t)(inr ? t : 0) * 64;
#pragma unroll
      for (int j = 0; j < 16; ++j) { const f32x4 v = *(const f32x4*)(hp + 4 * j); hr[4 * j] = v.x; hr[4 * j + 1] = v.y; hr[4 * j + 2] = v.z; hr[4 * j + 3] = v.w; }
    }
    const float tn = (float)t / (float)(L - 1);
#pragma unroll 1
    for (int cc = 0; cc < 32; ++cc) {
      const int oc = cg * 32 + cc, o = oc >> 9, c = oc & 511;
      const float* wc = wl + (dir * 32 + cc) * 64;
      float s = 0.f;
#pragma unroll
      for (int j = 0; j < 16; ++j) { const f32x4 wv = *(const f32x4*)(wc + 4 * j); s += hr[4 * j] * wv.x + hr[4 * j + 1] * wv.y + hr[4 * j + 2] * wv.z + hr[4 * j + 3] * wv.w; }
      if (dd == 0) {
        const float* wc1 = wl + (32 + cc) * 64;
        float s1 = 0.f;
#pragma unroll
        for (int j = 0; j < 16; ++j) { const f32x4 wv = *(const f32x4*)(wc1 + 4 * j); s1 += hr[4 * j] * wv.x + hr[4 * j + 1] * wv.y + hr[4 * j + 2] * wv.z + hr[4 * j + 3] * wv.w; }
        s += s1;
      }
      const float delta = HY_MIN_DECAY + (float)c * ((HY_MAX_DECAY - HY_MIN_DECAY) / 511.0f);
      float val = s * __expf(-tn * delta);
      if (dd == 0) val += skip[o * 512 + c];
      if (!inr) val = 0.f;
      G[(size_t)oc * gstr + i] = f2bf(val);
    }
  }
}

__device__ __forceinline__ void ph_init_norm1(const MP& p, int bid, int nblk) {
  const int lane = tid_opaque() & 63, wave = tid_opaque() >> 6;
  const float* g = p.in.norm1_g;
  for (int it = bid; it * 8 < SEQ; it += nblk) {
    const int t = it * 8 + wave;
    const float rr = (float)(t >> 6), colp = (float)(t & 63);
    f32x4 e[4];
#pragma unroll
    for (int j = 0; j < 4; ++j) {
      float ev[4];
#pragma unroll
      for (int q = 0; q < 4; ++q) {
        const int i = lane * 4 + q;
        const float omega = 1.0f / powf(10000.0f, (float)i / 256.0f);
        const float a = ((j < 2) ? rr : colp) * omega;
        ev[q] = (j & 1) ? cosf(a) : sinf(a);
      }
      e[j] = (f32x4){ev[0], ev[1], ev[2], ev[3]};
    }
    for (int b = 0; b < NB; ++b) {
      const int row = b * SEQ + t;
      f32x4 v[4];
      row_load(p.in.x + (size_t)row * D, lane, v);
#pragma unroll
      for (int j = 0; j < 4; ++j) { v[j] += e[j]; *(f32x4*)(p.w.xs() + (size_t)row * D + j * 256 + lane * 4) = v[j]; }
      const float rinv = row_rinv(v, lane);
      const float* mb = p.w.mod() + (size_t)b * 6 * D;
      row_norm_mod_store(v, rinv, g, mb, mb + D, lane, p.w.abuf() + (size_t)row * D, p.w.abuf8() + (size_t)row * D);
    }
  }
  for (int it = bid; it * 8 < NC; it += nblk) {
    const int rc = it * 8 + wave, row = NL + rc;
    f32x4 v[4];
    row_load(p.in.ctx + (size_t)rc * D, lane, v);
#pragma unroll
    for (int j = 0; j < 4; ++j) *(f32x4*)(p.w.xs() + (size_t)row * D + j * 256 + lane * 4) = v[j];
    const float rinv = row_rinv(v, lane);
    const float* mb = p.w.mod() + (size_t)16 * 6 * D;
    row_norm_mod_store(v, rinv, g, mb, mb + D, lane, p.w.abuf() + (size_t)row * D, p.w.abuf8() + (size_t)row * D);
  }
}

__device__ __forceinline__ void ph_mixer(const MP& p, char* smem, int l, bool last, int bid, int nblk) {
  int* qctr = p.w.ctrl() + CTRL_Q + 64 * l;
  int* slot = (int*)(smem + MEGA_LDS_MAIN + 8);
  GlaArgs ga;
  ga.zg = p.w.zg(); ga.wa2 = p.in.gla_wa2 + (size_t)l * 2 * 16 * 256; ga.ba2 = p.in.gla_ba2 + (size_t)l * 2 * 256;
  ga.of = p.w.of(); ga.ob = p.w.ob(); ga.emit_ctx = last ? 0 : 1; ga.pad_ = 0;
  const float* cw = p.in.hy_conv_w + (size_t)l * 3 * HYCOLS;
  const float* cb = p.in.hy_conv_b + (size_t)l * HYCOLS;
  const bf16* gl = p.w.gl() + (size_t)l * 2 * HYW * GSTR_L;
  CvtCtx cx;
  cx.w1 = p.in.exp_w1 + (size_t)l * NE * D * DE; cx.w3 = p.in.exp_w3 + (size_t)l * NE * D * DE; cx.w2 = p.in.exp_w2 + (size_t)l * NE * DE * D;
  cx.d1 = p.w.e1_t(); cx.d3 = p.w.e3_t(); cx.d2 = p.w.e2_t();
  cx.gw = __builtin_amdgcn_readfirstlane(bid * 8 + (tid_opaque() >> 6)); cx.nw = nblk * 8; cx.k = 0;
  for (;;) {
    __syncthreads();
    if (tid_opaque() == 0) *slot = atomicAdd(qctr, 1);
    __syncthreads();
    const int u = *slot;
    const int nunits = last ? 640 : 1152;
    if (u >= nunits) break;
    if (u < 128) gla_unit(u, ga, smem, cx);
    else if (u < 640) hyena_latent(u - 128, p.w.zt(), cw, cb, gl, p.w.yt(), smem, cx);
    else hyena_ctx(u - 640, p.w.zt() + NL, cw, cb, p.w.gc(), p.w.yt() + NL, smem);
  }
  {
    const int lane = tid_opaque() & 63;
    CvtRegs cr; cvt_init(cr);
    while (cx.gw + cx.k * cx.nw < CVT_TILES) cvt_step(cx, cr, lane);
    cvt_finish(cx, cr, lane);
  }
}

__device__ __forceinline__ void ph_gla_out(const MP& p, char* smem, int l, int mrows, int bid, int nblk) {
  const int tid = tid_opaque();
  const int lane = tid & 63, wave = tid >> 6;
  {
    const float* gn = p.in.gla_norm_g + l * 128 + (lane & 15) * 8;
    const f32x4 ga = *(const f32x4*)gn, gb = *(const f32x4*)(gn + 4);
    const float* of = p.w.of(); const float* ob = p.w.ob(); const bf16* zg = p.w.zg(); bf16* ymix = p.w.ymix();
#pragma unroll 2
    for (int it = bid; it * 8 < mrows; it += nblk) {
      const int row = it * 8 + wave;
      const size_t base = (size_t)row * 512 + lane * 8;
      const f32x4 a0 = *(const f32x4*)(of + base), a1 = *(const f32x4*)(of + base + 4);
      const f32x4 b0 = *(const f32x4*)(ob + base), b1 = *(const f32x4*)(ob + base + 4);
      const u32x4 rv = *(const u32x4*)(zg + (size_t)row * GLACOLS + 1024 + lane * 8);
      const f32x4 o0 = a0 + b0, o1 = a1 + b1;
      float ss = o0.x * o0.x + o0.y * o0.y + o0.z * o0.z + o0.w * o0.w + o1.x * o1.x + o1.y * o1.y + o1.z * o1.z + o1.w * o1.w;
      ss += shx_f(ss, 1, lane); ss += shx_f(ss, 2, lane); ss += shx_f(ss, 4, lane); ss += shx_f(ss, 8, lane);
      const float rinv = rsqrtf(ss * (1.0f / 128.0f) + EPS);
      u32x4 o;
      o.x = pack_bf16(o0.x * rinv * ga.x * silu_f(bflo(rv.x)), o0.y * rinv * ga.y * silu_f(bfhi(rv.x)));
      o.y = pack_bf16(o0.z * rinv * ga.z * silu_f(bflo(rv.y)), o0.w * rinv * ga.w * silu_f(bfhi(rv.y)));
      o.z = pack_bf16(o1.x * rinv * gb.x * silu_f(bflo(rv.z)), o1.y * rinv * gb.y * silu_f(bfhi(rv.z)));
      o.w = pack_bf16(o1.z * rinv * gb.z * silu_f(bflo(rv.w)), o1.w * rinv * gb.w * silu_f(bfhi(rv.w)));
      *(u32x4*)(ymix + (size_t)row * D + 512 + lane * 8) = o;
    }
  }
  {
    const bf16* yt = p.w.yt(); bf16* ymix = p.w.ymix();
    for (int tt = bid; tt * 64 < mrows; tt += nblk) {
      const int tok0 = tt * 64;
      __syncthreads();
#pragma unroll
      for (int i = 0; i < 8; ++i) {
        const int q = tid + i * 512, c = q >> 3, ch = q & 7;
        const u32x4 v = *(const u32x4*)(yt + (size_t)c * NT + tok0 + ch * 8);
        unsigned* d = (unsigned*)(smem + c * 132 + ch * 16);
        d[0] = v.x; d[1] = v.y; d[2] = v.z; d[3] = v.w;
      }
      __syncthreads();
#pragma unroll
      for (int i = 0; i < 8; ++i) {
        const int c8 = wave * 8 + (lane & 7), t = i * 8 + (lane >> 3);
        const unsigned short* s = (const unsigned short*)(smem + (c8 * 8) * 132 + t * 2);
        const unsigned e0 = s[0], e1 = s[66], e2 = s[132], e3 = s[198], e4 = s[264], e5 = s[330], e6 = s[396], e7 = s[462];
        *(u32x4*)(ymix + (size_t)(tok0 + t) * D + c8 * 8) = (u32x4){e0 | (e1 << 16), e2 | (e3 << 16), e4 | (e5 << 16), e6 | (e7 << 16)};
      }
    }
  }
}

__device__ __forceinline__ void ph_norm2(const MP& p, int l, int mrows, int bid, int nblk) {
  const int lane = tid_opaque() & 63, wave = tid_opaque() >> 6;
  const float* g = p.in.norm2_g + l * D;
  const float* modl = p.w.mod() + (size_t)l * 17 * 6 * D;
  for (int it = bid; it * 8 < mrows; it += nblk) {
    const int row = it * 8 + wave;
    f32x4 v[4];
    row_load(p.w.xs() + (size_t)row * D, lane, v);
    const float rinv = row_rinv(v, lane);
    const float* mb = modl + (size_t)row_batch(row) * 6 * D;
    row_norm_mod_store(v, rinv, g, mb + 3 * D, mb + 4 * D, lane, p.w.abuf() + (size_t)row * D, p.w.abuf8() + (size_t)row * D);
  }
}

__device__ __forceinline__ void ph_route(const MP& p, char* smem, int l, int ntok, int bid, int nblk) {
  const int tid = tid_opaque();
  const int lane = tid & 63, wave = tid >> 6;
  const float* rb = p.in.router_b + l * NE;
  int* lcnt = (int*)smem;
  __syncthreads();
  if (tid < NE) lcnt[tid] = 0;
  __syncthreads();
  const f32x4 bb = *(const f32x4*)(rb + lane * 4);
  const int tpb = (ntok + nblk - 1) / nblk;
  for (int it = wave; it < tpb; it += 8) {
    const int tok = bid * tpb + it;
    if (tok >= ntok) break;
    const f32x4 lg = *(const f32x4*)(p.w.logits() + (size_t)tok * NE + lane * 4);
    const float s0 = sigmoid_f(lg.x), s1 = sigmoid_f(lg.y), s2 = sigmoid_f(lg.z), s3 = sigmoid_f(lg.w);
    const float v0 = s0 + bb.x, v1 = s1 + bb.y, v2 = s2 + bb.z, v3 = s3 + bb.w;
    float m1 = fmaxf(v0, v1), m2 = fminf(v0, v1);
    { float n1 = fmaxf(m1, v2); float n2 = fmaxf(fminf(m1, v2), m2); m1 = n1; m2 = n2; }
    { float n1 = fmaxf(m1, v3); float n2 = fmaxf(fminf(m1, v3), m2); m1 = n1; m2 = n2; }
#pragma unroll
    for (int o = 1; o <= 4; o <<= 1) {
      float a1 = shx_f(m1, o, lane), a2 = shx_f(m2, o, lane);
      float n1 = fmaxf(m1, a1);
      float n2 = fmaxf(fminf(m1, a1), fmaxf(m2, a2));
      m1 = n1; m2 = n2;
    }
    const float gs = m1 + m2;
    const int g = lane >> 3;
    int rank = 0;
#pragma unroll
    for (int gg = 0; gg < 8; ++gg) {
      const float og = __int_as_float(__builtin_amdgcn_readlane(__float_as_int(gs), gg * 8));
      rank += (og > gs || (og == gs && gg < g)) ? 1 : 0;
    }
    unsigned k0, k1, k2, k3;
    {
      const bool sel = rank < 4;
      unsigned u;
      u = __float_as_uint(v0); u = (u & 0x80000000u) ? ~u : (u | 0x80000000u); k0 = sel ? ((u & 0xffffff00u) | (unsigned)(255 - (lane * 4 + 0))) : 0u;
      u = __float_as_uint(v1); u = (u & 0x80000000u) ? ~u : (u | 0x80000000u); k1 = sel ? ((u & 0xffffff00u) | (unsigned)(255 - (lane * 4 + 1))) : 0u;
      u = __float_as_uint(v2); u = (u & 0x80000000u) ? ~u : (u | 0x80000000u); k2 = sel ? ((u & 0xffffff00u) | (unsigned)(255 - (lane * 4 + 2))) : 0u;
      u = __float_as_uint(v3); u = (u & 0x80000000u) ? ~u : (u | 0x80000000u); k3 = sel ? ((u & 0xffffff00u) | (unsigned)(255 - (lane * 4 + 3))) : 0u;
    }
    float gsum = 0.f, myg = 0.f; int mye = 0;
#pragma unroll
    for (int k = 0; k < TOPK; ++k) {
      unsigned m = max(max(k0, k1), max(k2, k3));
      m = max(m, (unsigned)__builtin_amdgcn_update_dpp(0, (int)m, 0x111, 0xf, 0xf, false));
      m = max(m, (unsigned)__builtin_amdgcn_update_dpp(0, (int)m, 0x112, 0xf, 0xf, false));
      m = max(m, (unsigned)__builtin_amdgcn_update_dpp(0, (int)m, 0x114, 0xf, 0xf, false));
      m = max(m, (unsigned)__builtin_amdgcn_update_dpp(0, (int)m, 0x118, 0xf, 0xf, false));
      m = max(m, (unsigned)__builtin_amdgcn_update_dpp(0, (int)m, 0x142, 0xa, 0xf, false));
      m = max(m, (unsigned)__builtin_amdgcn_update_dpp(0, (int)m, 0x143, 0xc, 0xf, false));
      const unsigned wk = (unsigned)__builtin_amdgcn_readlane((int)m, 63);
      const int we = 255 - (int)(wk & 255u);
      const int wl = we >> 2, wi = we & 3;
      const float sv = __int_as_float(__builtin_amdgcn_readlane(__float_as_int(wi == 0 ? s0 : wi == 1 ? s1 : wi == 2 ? s2 : s3), wl));
      if (lane == wl) { if (wi == 0) k0 = 0u; else if (wi == 1) k1 = 0u; else if (wi == 2) k2 = 0u; else k3 = 0u; }
      gsum += sv;
      if (lane == k) { myg = sv; mye = we; }
    }
    if (lane < TOPK) {
      p.w.tok_e()[tok * TOPK + lane] = mye;
      p.w.tok_gate()[tok * TOPK + lane] = myg / gsum * 2.5f;
      atomicAdd(&lcnt[mye], 1);
    }
  }
  __syncthreads();
  if (tid < NE) p.w.blkcnt()[bid * NE + tid] = lcnt[tid];
}

__device__ __forceinline__ void ph_assign(const MP& p, char* smem, int l, int ntok, int bid, int nblk) {
  const int tid = tid_opaque();
  int* ps = (int*)smem;
  int* cur = (int*)smem + 512;
  __syncthreads();
  int* part = (int*)smem + 1024;
  {
    const int eg = tid & 63, bg = tid >> 6;
    const int per = (nblk + 7) >> 3;
    int t0 = 0, t1 = 0, t2 = 0, t3 = 0, b0 = 0, b1 = 0, b2 = 0, b3 = 0;
    const int* src = p.w.blkcnt() + eg * 4;
#pragma unroll 8
    for (int i = 0; i < per; ++i) {
      const int b = bg * per + i;
      if (b < nblk) {
        const u32x4 v = *(const u32x4*)(src + (size_t)b * NE);
        t0 += (int)v.x; t1 += (int)v.y; t2 += (int)v.z; t3 += (int)v.w;
        if (b < bid) { b0 += (int)v.x; b1 += (int)v.y; b2 += (int)v.z; b3 += (int)v.w; }
      }
    }
    int* pt = part + bg * 512 + eg * 4;
    pt[0] = t0; pt[1] = t1; pt[2] = t2; pt[3] = t3;
    pt[256] = b0; pt[257] = b1; pt[258] = b2; pt[259] = b3;
  }
  __syncthreads();
  int before = 0;
  if (tid < NE) {
    int tot = 0;
#pragma unroll
    for (int g = 0; g < 8; ++g) { tot += part[g * 512 + tid]; before += part[g * 512 + 256 + tid]; }
    const int pc = (tot + 255) & ~255;
    const int lane = tid & 63;
    int inc = pc;
#pragma unroll
    for (int o = 1; o < 64; o <<= 1) { const int n = shl_i(inc, lane - o); if (lane >= o) inc += n; }
    ps[tid + 1] = inc;
    if (lane == 63) cur[tid >> 6] = inc;
  }
  __syncthreads();
  if (tid < NE) {
    const int w = tid >> 6;
    int offs = 0;
#pragma unroll
    for (int k = 0; k < 3; ++k) offs += (k < w) ? cur[k] : 0;
    ps[tid + 1] += offs;
    if (tid == 0) ps[0] = 0;
  }
  __syncthreads();
  if (tid < NE) {
    unsigned short* te = (unsigned short*)(smem + LDS_TILE_E);
    for (int t = ps[tid] >> 8; t < (ps[tid + 1] >> 8); ++t) te[t] = (unsigned short)tid;
  }
  if (tid < NE) cur[tid] = ps[tid] + before;
  if (bid == 0 && tid <= NE) p.w.pad_start()[tid] = ps[tid];
  __syncthreads();
  const int tpb = (ntok + nblk - 1) / nblk;
  for (int i = tid; i < tpb * TOPK; i += 512) {
    const int gi = bid * tpb * TOPK + i;
    if (gi >= ntok * TOPK) break;
    const int e = p.w.tok_e()[gi];
    const int slot = atomicAdd(&cur[e], 1);
    p.w.slot_tok()[slot] = gi >> 3;
    p.w.tok_slot()[gi] = slot;
  }
}

__device__ __forceinline__ void ph_combine(const MP& p, int l, int mrows, bool last, int bid, int nblk) {
  const int lane = tid_opaque() & 63, wave = tid_opaque() >> 6;
  const float* modl = p.w.mod() + (size_t)l * 17 * 6 * D;
  for (int it = bid; it * 8 < mrows; it += nblk) {
    const int row = it * 8 + wave;
    const int b = row_batch(row);
    f32x4 v[4], acc[4];
    row_load(p.w.xs() + (size_t)row * D, lane, v);
#pragma unroll
    for (int j = 0; j < 4; ++j) acc[j] = (f32x4){0.f, 0.f, 0.f, 0.f};
    int sl = 0; float gt = 0.f;
    if (lane < TOPK) { sl = p.w.tok_slot()[row * TOPK + lane]; gt = p.w.tok_gate()[row * TOPK + lane]; }
#pragma unroll
    for (int k = 0; k < TOPK; ++k) {
      const int s = shl_i(sl, k);
      const float gk = shl_f(gt, k);
      const unsigned char* yr = p.w.ybuf() + (size_t)s * D + lane * 4;
#pragma unroll
      for (int j = 0; j < 4; ++j) {
        const int y = *(const int*)(yr + j * 256);
        const f32x2v lo = __builtin_amdgcn_cvt_pk_f32_fp8(y, false), hi = __builtin_amdgcn_cvt_pk_f32_fp8(y, true);
        acc[j].x += gk * lo.x; acc[j].y += gk * lo.y; acc[j].z += gk * hi.x; acc[j].w += gk * hi.y;
      }
    }
    const float* g2 = modl + (size_t)b * 6 * D + 5 * D;
#pragma unroll
    for (int j = 0; j < 4; ++j) {
      const f32x4 gv = *(const f32x4*)(g2 + j * 256 + lane * 4);
      v[j] += gv * acc[j];
    }
    const float rinv = row_rinv(v, lane);
    if (last) {
#pragma unroll
      for (int j = 0; j < 4; ++j) {
        const f32x4 fg = *(const f32x4*)(p.in.final_g + j * 256 + lane * 4);
        *(f32x4*)(p.out + (size_t)row * D + j * 256 + lane * 4) = v[j] * rinv * fg;
      }
    } else {
#pragma unroll
      for (int j = 0; j < 4; ++j) *(f32x4*)(p.w.xs() + (size_t)row * D + j * 256 + lane * 4) = v[j];
      const float* mb = p.w.mod() + ((size_t)(l + 1) * 17 + b) * 6 * D;
      row_norm_mod_store(v, rinv, p.in.norm1_g + (l + 1) * D, mb, mb + D, lane, p.w.abuf() + (size_t)row * D, p.w.abuf8() + (size_t)row * D);
    }
  }
}

__global__ void __launch_bounds__(512, 2) k_mega(MP p) {
  extern __shared__ __attribute__((aligned(16))) char smem[];
  const int bid = blockIdx.x, nblk = gridDim.x;
  if (tid_opaque() == 0) *(u32x4*)(smem + MEGA_LDS_MAIN) = (u32x4){0u, 0u, 0u, 0u};
  __syncthreads();
  (void)xcd_barrier_post(p.w.bar(), (volatile LAS unsigned*)(smem + MEGA_LDS_MAIN));

  if (threadIdx.x == 0) {
    const unsigned xcc = xb_xcc_id();
    const int rank = atomicAdd(&p.w.ctrl()[CTRL_XR + 16 * xcc], 1);
    *(int*)(smem + MEGA_LDS_MAIN + 12) = rank;
  }
  ph_mod_hid(p, smem, bid, nblk);
  cvt_job(p.in.w_in, p.w.w_in_t(), D, INCOLS, 1, bid, nblk, HYCOLS);
  cvt_job(p.in.w_in + (size_t)D * INCOLS, p.w.w_in_t() + (size_t)WIN_ROWS * D, D, INCOLS, 1, bid, nblk, HYCOLS);
  cvt8_job(p.in.w_in + HYCOLS, p.w.w_g8(), D, INCOLS, 1, bid, nblk, GLACOLS);
  cvt8_job(p.in.w_in + (size_t)D * INCOLS + HYCOLS, p.w.w_g8() + (size_t)GW_ROWS * D, D, INCOLS, 1, bid, nblk, GLACOLS);
  cvt_job(p.in.w_out, p.w.w_out_t(), D, D, DEPTH, bid, nblk);
  cvt_job(p.in.router_w, p.w.router_t(), D, NE, DEPTH, bid, nblk);
  cvt8_job(p.in.sh_w1, p.w.sh1_t(), D, DE, DEPTH, bid, nblk);
  cvt8_job(p.in.sh_w3, p.w.sh3_t(), D, DE, DEPTH, bid, nblk);
  cvt8_job(p.in.sh_w2, p.w.sh2_t(), DE, D, DEPTH, bid, nblk);
  grid_sync(p.w.bar(), smem + MEGA_LDS_MAIN);
  int vb = bid;
  {
    const int rank = *(const int*)(smem + MEGA_LDS_MAIN + 12);
    const unsigned xcc = xb_xcc_id();
    int npop = 0, xidx = 0, cnt0 = -1; bool equal = true;
    for (int j = 0; j < 16; ++j) {
      const int c = p.w.ctrl()[CTRL_XR + 16 * j];
      if (c > 0) {
        if (cnt0 < 0) cnt0 = c; else if (c != cnt0) equal = false;
        if (j < (int)xcc) ++xidx;
        ++npop;
      }
    }
    if (equal && cnt0 > 0 && npop * cnt0 == nblk && rank < cnt0) vb = xidx * cnt0 + rank;
  }
  ph_gtab(p, smem, bid, nblk);
  ph_init_norm1(p, bid, nblk);
  grid_sync(p.w.bar(), smem + MEGA_LDS_MAIN);

  const int vbu = __builtin_amdgcn_readfirstlane(vb);
#pragma unroll 1
  for (int l0 = 0; l0 < DEPTH; ++l0) {
#define LL opq(l0)
    const bool last = (l0 == DEPTH - 1);
    const int mrows = last ? NL : NT;
#define MODL (p.w.mod() + (size_t)LL * 17 * 6 * D)
    {
      G8InZT g; g.wt = p.w.w_in_t() + (size_t)LL * WIN_ROWS * D; g.A = p.w.abuf(); g.zt = p.w.zt(); g.ntok = last ? NL : NT;
      gemm8_run(g, smem, opq(vbu), nblk);
    }
    {
      G8InG g; g.wt = p.w.w_g8() + (size_t)LL * GW_ROWS * D; g.A = p.w.abuf8(); g.zg = p.w.zg();
      gemm8_run(g, smem, opq(vbu), nblk);
    }
    grid_sync(p.w.bar(), smem + MEGA_LDS_MAIN);
    ph_mixer(p, smem, LL, last, opq(bid), nblk);
    grid_sync(p.w.bar(), smem + MEGA_LDS_MAIN);
    ph_gla_out(p, smem, LL, mrows, opq(bid), nblk);
    grid_sync(p.w.bar(), smem + MEGA_LDS_MAIN);
    {
      G8Out g; g.mrows = mrows; g.ymix = p.w.ymix(); g.wt = p.w.w_out_t() + (size_t)LL * D * D; g.modl = MODL; g.xs = p.w.xs();
      gemm8_run(g, smem, opq(vbu), nblk);
    }
    grid_sync(p.w.bar(), smem + MEGA_LDS_MAIN);
    ph_norm2(p, LL, mrows, opq(bid), nblk);
    grid_sync(p.w.bar(), smem + MEGA_LDS_MAIN);
    {
      G8Router g; g.mrows = mrows; g.A = p.w.abuf(); g.rwt = p.w.router_t() + (size_t)LL * NE * D; g.logits = p.w.logits();
      gemm8_run(g, smem, opq(vbu), nblk);
    }
    {
      G8ShUp g; g.mrows = mrows; g.A8 = p.w.abuf8(); g.s1t = p.w.sh1_t() + (size_t)LL * DE * D; g.s3t = p.w.sh3_t() + (size_t)LL * DE * D; g.hs = p.w.hs();
      gemm8_run(g, smem, opq(vbu), nblk);
    }
    grid_sync(p.w.bar(), smem + MEGA_LDS_MAIN);
    ph_route(p, smem, LL, mrows, opq(bid), nblk);
    grid_sync(p.w.bar(), smem + MEGA_LDS_MAIN);
    ph_assign(p, smem, LL, mrows, opq(bid), nblk);
    grid_sync(p.w.bar(), smem + MEGA_LDS_MAIN);
    {
      G8Up g; g.A8 = p.w.abuf8(); g.slot_tok = p.w.slot_tok(); g.pad_start = p.w.pad_start(); g.w1t = p.w.e1_t(); g.w3t = p.w.e3_t(); g.H = p.w.hbuf(); g.tile_e = (const unsigned short*)(smem + LDS_TILE_E);
      gemm8_run(g, smem, opq(vbu), nblk);
    }
    {
      G8ShDown g; g.mrows = mrows; g.hs = p.w.hs(); g.wt = p.w.sh2_t() + (size_t)LL * D * DE; g.modl = MODL; g.xs = p.w.xs();
      gemm8_run(g, smem, opq(vbu), nblk);
    }
    grid_sync(p.w.bar(), smem + MEGA_LDS_MAIN);
    {
      G8Down g; g.H = p.w.hbuf(); g.pad_start = p.w.pad_start(); g.w2t = p.w.e2_t(); g.Y = p.w.ybuf(); g.tile_e = (const unsigned short*)(smem + LDS_TILE_E);
      gemm8_run(g, smem, opq(vbu), nblk);
    }
    grid_sync(p.w.bar(), smem + MEGA_LDS_MAIN);
    ph_combine(p, LL, mrows, last, opq(bid), nblk);
    if (!last) grid_sync(p.w.bar(), smem + MEGA_LDS_MAIN);
  }
#undef LL
#undef MODL
}

static inline size_t align_up(size_t v, size_t a) { return (v + a - 1) / a * a; }

extern "C" void kernel_launch(void* const* d_in, const int* in_sizes, int n_in, void* d_out, int out_size, void* d_ws,
                              size_t ws_size, hipStream_t stream) {
  MP p;
  memset(&p, 0, sizeof(p));
  const float** ip = (const float**)&p.in;
  for (int i = 0; i < 30; ++i) ip[i] = (const float*)d_in[i];
  p.out = (float*)d_out;

  p.w.b = (char*)d_ws;
  const size_t zero_bytes = wso::zero_end;
  (void)ws_size; (void)n_in; (void)in_sizes; (void)out_size;

  static int grid = 0;
  if (!grid) {
    hipFuncSetAttribute((const void*)k_mega, hipFuncAttributeMaxDynamicSharedMemorySize, MEGA_LDS);
    int dev = 0, cus = 0, per_cu = 0;
    hipGetDevice(&dev);
    hipDeviceGetAttribute(&cus, hipDeviceAttributeMultiprocessorCount, dev);
    hipOccupancyMaxActiveBlocksPerMultiprocessor(&per_cu, k_mega, 512, MEGA_LDS);
    if (cus <= 0) cus = 256;
    grid = per_cu >= 1 ? cus : 0;
    if (grid <= 0) grid = 256;
  }
  hipMemsetAsync(d_ws, 0, zero_bytes, stream);
  hipLaunchKernelGGL(k_mega, dim3(grid), dim3(512), MEGA_LDS, stream, p);
}
```

```cpp
#include <hip/hip_runtime.h>
#include <hip/hip_bf16.h>
#include <stdint.h>
#include <string.h>

typedef __hip_bfloat16 bf16;

constexpr int D = 1024, NB = 16, SEQ = 2048, LC = 256, DEPTH = 2;
constexpr int NL = NB * SEQ, NC = NB * LC, NT = NL + NC;
constexpr int HYW = 512, HYCOLS = 1536, GLACOLS = 1568, INCOLS = 3104;
constexpr int NE = 256, TOPK = 8, DE = 256;
constexpr int NSLOT = NT * TOPK + NE * 256;
constexpr float EPS = 1e-6f;
constexpr float HY_MIN_DECAY = 3.0701134573253945f;
constexpr float HY_MAX_DECAY = 15.350567286626973f;
constexpr int GSTR_L = 4096, GSTR_C = 512;
constexpr int WIN_ROWS = HYCOLS;
constexpr int GW_ROWS = 7 * 256;

__device__ __forceinline__ float bf2f(bf16 v) { return __bfloat162float(v); }
__device__ __forceinline__ bf16 f2bf(float v) { return __float2bfloat16(v); }
__device__ __forceinline__ float silu_f(float x) { return x / (1.f + __expf(-x)); }
__device__ __forceinline__ float sigmoid_f(float x) { return 1.f / (1.f + __expf(-x)); }
__device__ __forceinline__ float logsigmoid_f(float x) { return fminf(x, 0.f) - __logf(1.f + __expf(-fabsf(x))); }

__device__ __forceinline__ float shx_f(float v, int mask, int lane) { return __int_as_float(__builtin_amdgcn_ds_bpermute((lane ^ mask) << 2, __float_as_int(v))); }
__device__ __forceinline__ int shx_i(int v, int mask, int lane) { return __builtin_amdgcn_ds_bpermute((lane ^ mask) << 2, v); }
__device__ __forceinline__ float shl_f(float v, int src) { return __int_as_float(__builtin_amdgcn_ds_bpermute(src << 2, __float_as_int(v))); }
__device__ __forceinline__ int shl_i(int v, int src) { return __builtin_amdgcn_ds_bpermute(src << 2, v); }
__device__ __forceinline__ float wave_sum(float v, int lane) {
#pragma unroll
  for (int o = 32; o > 0; o >>= 1) v += shx_f(v, o, lane);
  return v;
}

struct Inputs {
  const float *x, *c, *ctx, *c_ctx, *ada_w, *ada_b, *norm1_g, *norm2_g, *w_in, *w_out, *hy_conv_w, *hy_conv_b,
      *hy_f_w1, *hy_f_b1, *hy_f_w2, *hy_f_b2, *hy_f_w3, *hy_skip, *gla_wa2, *gla_ba2, *gla_norm_g, *router_w,
      *router_b, *exp_w1, *exp_w3, *exp_w2, *sh_w1, *sh_w3, *sh_w2, *final_g;
};

__device__ __forceinline__ int opq(int v) { asm volatile("" : "+s"(v)); return v; }
__device__ __forceinline__ int tid_opaque() { int t = threadIdx.x; asm volatile("" : "+v"(t)); return t; }
__device__ __forceinline__ int row_batch(int row) { return row < NL ? (row >> 11) : 16; }

#define XB_TMO      128
#define XB_XCNT(j)  (256  + 64 * (j))
#define XB_XSUB(j)  (1280 + 64 * (j))
#define XB_XGEN(j)  (2304 + 64 * (j))
#define XB_TOP      3328
#define XB_TOPGEN   3392
#define XCD_BAR_WORDS 3456
#define XB_SPIN_CAP (1u << 18)
#define LAS __attribute__((address_space(3)))

__device__ __forceinline__ unsigned xb_ld(unsigned* p)              { return __hip_atomic_load(p, __ATOMIC_RELAXED, __HIP_MEMORY_SCOPE_AGENT); }
__device__ __forceinline__ unsigned xb_add(unsigned* p, unsigned v) { return __hip_atomic_fetch_add(p, v, __ATOMIC_RELAXED, __HIP_MEMORY_SCOPE_AGENT); }
__device__ __forceinline__ unsigned xb_xcc_id() { return (unsigned)__builtin_amdgcn_s_getreg((3 << 11) | 20) & 0xFu; }
#define XB_SPIN(cond, bar) do { unsigned _sp = 0; while (cond) { __builtin_amdgcn_s_sleep(1); \
    if ((++_sp & 255u) == 0u) { if (xb_ld(&(bar)[XB_TMO])) break; if (_sp > XB_SPIN_CAP) { atomicAdd(&(bar)[XB_TMO], 1u); break; } } } } while (0)

struct XcdBarrier {
    unsigned* bar; unsigned x;
    volatile LAS unsigned* st;
};

__device__ __forceinline__ XcdBarrier xcd_barrier_post(unsigned* bar, volatile LAS unsigned* st) {
    XcdBarrier b; b.bar = bar; b.x = xb_xcc_id(); b.st = st;
    if (threadIdx.x == 0) (void)xb_add(&bar[XB_XCNT(b.x)], 1u);
    return b;
}
__device__ __forceinline__ void xcd_barrier_complete(unsigned* bar, unsigned x, unsigned& nloc, unsigned& nx) {
    const unsigned G = gridDim.x * gridDim.y * gridDim.z;
    unsigned sum, cnt, mine, sp = 0u;
    for (;;) {
        sum = 0u; cnt = 0u; mine = 0u;
#pragma unroll
        for (unsigned j = 0; j < 16; ++j) { const unsigned c = xb_ld(&bar[XB_XCNT(j)]); sum += c; cnt += (c > 0u) ? 1u : 0u; mine = (j == x) ? c : mine; }
        if (sum == G) break;
        __builtin_amdgcn_s_sleep(1);
        if ((++sp & 255u) == 0u) { if (xb_ld(&bar[XB_TMO])) break; if (sp > XB_SPIN_CAP) { atomicAdd(&bar[XB_TMO], 1u); break; } }
    }
    nloc = mine > 0u ? mine : 1u; nx = cnt > 0u ? cnt : 1u;
}
__device__ __forceinline__ void xcd_barrier(const XcdBarrier& b) {
    asm volatile("s_waitcnt vmcnt(0)" ::: "memory");
    __syncthreads();
    if (threadIdx.x == 0) {
        unsigned* bar = b.bar;
        __builtin_amdgcn_s_waitcnt(0);
        unsigned nloc = b.st[0], nx = b.st[1];
        if (nloc == 0u) { xcd_barrier_complete(bar, b.x, nloc, nx); b.st[0] = nloc; b.st[1] = nx; }
        const unsigned old = xb_add(&bar[XB_XSUB(b.x)], 1u);
        const unsigned gen = old / nloc;
        if (old + 1u == (gen + 1u) * nloc) {
            __builtin_amdgcn_fence(__ATOMIC_RELEASE, "agent");
            asm volatile("s_waitcnt vmcnt(0)" ::: "memory");
            const unsigned og = xb_add(&bar[XB_TOP], 1u);
            const unsigned tg = og / nx;
            if (og + 1u == (tg + 1u) * nx) xb_add(&bar[XB_TOPGEN], 1u);
            else XB_SPIN(xb_ld(&bar[XB_TOPGEN]) == tg, bar);
            __builtin_amdgcn_fence(__ATOMIC_ACQUIRE, "agent");
            xb_add(&bar[XB_XGEN(b.x)], 1u);
            asm volatile("s_waitcnt vmcnt(0)" ::: "memory");
        } else {
            XB_SPIN(xb_ld(&bar[XB_XGEN(b.x)]) == gen, bar);
            __builtin_amdgcn_fence(__ATOMIC_ACQUIRE, "agent");
            asm volatile("s_waitcnt vmcnt(0)" ::: "memory");
        }
    }
    __syncthreads();
}

__device__ __forceinline__ void grid_sync(unsigned* bar0, char* stw) {
  unsigned* q = bar0;
  asm volatile("" : "+s"(q));
  XcdBarrier b; b.bar = q; b.x = xb_xcc_id(); b.st = (volatile LAS unsigned*)stw;
  xcd_barrier(b);
}

typedef __attribute__((ext_vector_type(8))) __bf16 bf16x8;
typedef __attribute__((ext_vector_type(16))) float f32x16;
typedef __attribute__((ext_vector_type(4))) float f32x4;
typedef __attribute__((ext_vector_type(2))) float f32x2v;
typedef __attribute__((ext_vector_type(2))) __bf16 bf16x2v;
typedef __attribute__((ext_vector_type(4))) unsigned int u32x4;
typedef __attribute__((ext_vector_type(2))) unsigned int u32x2;

__device__ __forceinline__ unsigned pack_bf16(float a, float b) {
  f32x2v v = {a, b};
  return __builtin_bit_cast(unsigned, __builtin_convertvector(v, bf16x2v));
}
__device__ __forceinline__ int swz(int row, int chunk) { return row * 128 + ((chunk ^ ((row >> 1) & 7)) << 4); }
__device__ __forceinline__ int rowmap(int reg, int lh) { return (reg & 3) + 8 * (reg >> 2) + 4 * lh; }

__device__ __forceinline__ int find_group(const int* __restrict__ pad_start, int m0) {
  int lo = 0, hi = NE - 1;
  while (lo < hi) {
    int mid = (lo + hi + 1) >> 1;
    if (pad_start[mid] <= m0) lo = mid; else hi = mid - 1;
  }
  return lo;
}

__device__ __forceinline__ void cvt_wave_tile(const float* __restrict__ src, bf16* __restrict__ dst, int K, int N, int kt, int ntile, int lane) {
  const int k0 = kt * 64 + (lane & 7) * 8, n0 = ntile * 32 + (lane >> 3) * 4;
  const float* s = src + (size_t)k0 * N + n0;
  const f32x4 v0 = __builtin_nontemporal_load((const f32x4*)(s)), v1 = __builtin_nontemporal_load((const f32x4*)(s + (size_t)N));
  const f32x4 v2 = __builtin_nontemporal_load((const f32x4*)(s + (size_t)2 * N)), v3 = __builtin_nontemporal_load((const f32x4*)(s + (size_t)3 * N));
  const f32x4 v4 = __builtin_nontemporal_load((const f32x4*)(s + (size_t)4 * N)), v5 = __builtin_nontemporal_load((const f32x4*)(s + (size_t)5 * N));
  const f32x4 v6 = __builtin_nontemporal_load((const f32x4*)(s + (size_t)6 * N)), v7 = __builtin_nontemporal_load((const f32x4*)(s + (size_t)7 * N));
  bf16* d = dst + (size_t)n0 * K + k0;
  *(u32x4*)(d) = (u32x4){pack_bf16(v0.x, v1.x), pack_bf16(v2.x, v3.x), pack_bf16(v4.x, v5.x), pack_bf16(v6.x, v7.x)};
  *(u32x4*)(d + (size_t)K) = (u32x4){pack_bf16(v0.y, v1.y), pack_bf16(v2.y, v3.y), pack_bf16(v4.y, v5.y), pack_bf16(v6.y, v7.y)};
  *(u32x4*)(d + (size_t)2 * K) = (u32x4){pack_bf16(v0.z, v1.z), pack_bf16(v2.z, v3.z), pack_bf16(v4.z, v5.z), pack_bf16(v6.z, v7.z)};
  *(u32x4*)(d + (size_t)3 * K) = (u32x4){pack_bf16(v0.w, v1.w), pack_bf16(v2.w, v3.w), pack_bf16(v4.w, v5.w), pack_bf16(v6.w, v7.w)};
}
typedef __attribute__((ext_vector_type(8))) int i32x8;
typedef __attribute__((ext_vector_type(4))) int i32x4;
__device__ __forceinline__ float clamp_fp8(float x) { return __builtin_amdgcn_fmed3f(x, -448.0f, 448.0f); }
__device__ __forceinline__ unsigned pk4_fp8(float a, float b, float c, float d) {
  a = clamp_fp8(a); b = clamp_fp8(b); c = clamp_fp8(c); d = clamp_fp8(d);
  int w = 0;
  w = __builtin_amdgcn_cvt_pk_fp8_f32(a, b, w, false);
  w = __builtin_amdgcn_cvt_pk_fp8_f32(c, d, w, true);
  return (unsigned)w;
}
__device__ __forceinline__ void cvt8_wave_tile(const float* __restrict__ src, unsigned char* __restrict__ dst, int K, int N, int kt, int ntile, int lane) {
  const int k0 = kt * 64 + (lane & 7) * 8, n0 = ntile * 32 + (lane >> 3) * 4;
  const float* s = src + (size_t)k0 * N + n0;
  const float sc = 16.0f;
  const f32x4 v0 = __builtin_nontemporal_load((const f32x4*)(s)) * sc, v1 = __builtin_nontemporal_load((const f32x4*)(s + (size_t)N)) * sc;
  const f32x4 v2 = __builtin_nontemporal_load((const f32x4*)(s + (size_t)2 * N)) * sc, v3 = __builtin_nontemporal_load((const f32x4*)(s + (size_t)3 * N)) * sc;
  const f32x4 v4 = __builtin_nontemporal_load((const f32x4*)(s + (size_t)4 * N)) * sc, v5 = __builtin_nontemporal_load((const f32x4*)(s + (size_t)5 * N)) * sc;
  const f32x4 v6 = __builtin_nontemporal_load((const f32x4*)(s + (size_t)6 * N)) * sc, v7 = __builtin_nontemporal_load((const f32x4*)(s + (size_t)7 * N)) * sc;
  unsigned char* d = dst + (size_t)n0 * K + k0;
  *(u32x2*)(d) = (u32x2){pk4_fp8(v0.x, v1.x, v2.x, v3.x), pk4_fp8(v4.x, v5.x, v6.x, v7.x)};
  *(u32x2*)(d + (size_t)K) = (u32x2){pk4_fp8(v0.y, v1.y, v2.y, v3.y), pk4_fp8(v4.y, v5.y, v6.y, v7.y)};
  *(u32x2*)(d + (size_t)2 * K) = (u32x2){pk4_fp8(v0.z, v1.z, v2.z, v3.z), pk4_fp8(v4.z, v5.z, v6.z, v7.z)};
  *(u32x2*)(d + (size_t)3 * K) = (u32x2){pk4_fp8(v0.w, v1.w, v2.w, v3.w), pk4_fp8(v4.w, v5.w, v6.w, v7.w)};
}
__device__ __forceinline__ void cvt8_job(const float* __restrict__ src, unsigned char* __restrict__ dst, int K, int N, int nmat, int bid, int nblk, int W = 0) {
  const int tid = tid_opaque(), lane = tid & 63, wave = tid >> 6;
  if (W == 0) W = N;
  const int tk = K >> 6, tn = W >> 5, per = tk * tn;
  const int total = per * nmat;
  for (int u = bid * 8 + wave; u < total; u += nblk * 8) {
    const int mat = u / per, r = u - mat * per;
    const int ntile = r / tk, kt = r - ntile * tk;
    cvt8_wave_tile(src + (size_t)mat * K * N, dst + (size_t)mat * K * W, K, N, kt, ntile, lane);
  }
}

__device__ __forceinline__ void cvt_job(const float* __restrict__ src, bf16* __restrict__ dst, int K, int N, int nmat, int bid, int nblk, int W = 0) {
  const int tid = tid_opaque(), lane = tid & 63, wave = tid >> 6;
  if (W == 0) W = N;
  const int tk = K >> 6, tn = W >> 5, per = tk * tn;
  const int total = per * nmat;
  for (int u = bid * 8 + wave; u < total; u += nblk * 8) {
    const int mat = u / per, r = u - mat * per;
    const int ntile = r / tk, kt = r - ntile * tk;
    cvt_wave_tile(src + (size_t)mat * K * N, dst + (size_t)mat * K * W, K, N, kt, ntile, lane);
  }
}

constexpr int G8_HT = 128 * 64;
constexpr int G8_LDS = 8 * G8_HT * 2;

__device__ __forceinline__ int g8_lds_byte(int r, int c) {
  int st = (r >> 4) * 2 + (c >> 5), rr = r & 15, cc = c & 31, ob = rr * 64 + cc * 2;
  return st * 1024 + (ob ^ (((ob >> 9) & 1) << 5));
}
__device__ __forceinline__ void g8_stage_rc(int b, int& R, int& C) {
  int st = b / 1024, sb = b % 1024, sw = sb ^ (((sb >> 9) & 1) << 5);
  R = (st >> 1) * 16 + sw / 64; C = (st & 1) * 32 + (sw % 64) / 2;
}

typedef f32x4 g8acc_t[2][2][4][2];

template <class P>
__device__ __forceinline__ void gemm8_run(const P& p, char* smem, int bid, int nblk) {
  const int ntl = __builtin_amdgcn_readfirstlane(p.ntiles());
  if (bid >= ntl) return;
  bf16* shm = (bf16*)smem;
#define SA(b, h) (shm + ((b) * 2 + (h)) * G8_HT)
#define SB(b, h) (shm + (4 + (b) * 2 + (h)) * G8_HT)
#define GLDS(SRC, DST) __builtin_amdgcn_global_load_lds((const unsigned*)(SRC), (unsigned*)(DST), 16, 0, 0)
#define STAGE_A(PP, BASE, KT) do { GLDS((BASE) + (oa + (KT) * 64), (char*)(PP) + ldsd); GLDS((BASE) + 64 * P::A_PITCH + (oa + (KT) * 64), (char*)(PP) + ldsd + 8192); } while (0)
#define STAGE_B(PP, BASE, OB, KT) do { \
    if constexpr (P::B_GATHER) { GLDS((BASE) + ((((OB) & 0xffffu) * (unsigned)P::B_PITCH + cc) + (KT) * 64), (char*)(PP) + ldsd); \
                                 GLDS((BASE) + ((((OB) >> 16) * (unsigned)P::B_PITCH + cc) + (KT) * 64), (char*)(PP) + ldsd + 8192); } \
    else { GLDS((BASE) + ((OB) + (KT) * 64), (char*)(PP) + ldsd); GLDS((BASE) + 64 * P::B_PITCH + ((OB) + (KT) * 64), (char*)(PP) + ldsd + 8192); } } while (0)
#define LDA(dst, b, h) for (int m = 0; m < 4; ++m) \
    dst[m] = __builtin_shufflevector(*reinterpret_cast<const i32x4*>((char*)SA(b, h) + aoff + m * 2048), \
                                     *reinterpret_cast<const i32x4*>((char*)SA(b, h) + aoff + m * 2048 + 1024), 0, 1, 2, 3, 4, 5, 6, 7)
#define LDB(dst, b, h) for (int n = 0; n < 2; ++n) \
    dst[n] = __builtin_shufflevector(*reinterpret_cast<const i32x4*>((char*)SB(b, h) + boff + n * 2048), \
                                     *reinterpret_cast<const i32x4*>((char*)SB(b, h) + boff + n * 2048 + 1024), 0, 1, 2, 3, 4, 5, 6, 7)
#define FRAG_LO(x) __builtin_bit_cast(bf16x8, __builtin_shufflevector(x, x, 0, 1, 2, 3))
#define FRAG_HI(x) __builtin_bit_cast(bf16x8, __builtin_shufflevector(x, x, 4, 5, 6, 7))
#define MMA(ai, bj, At_, Bt_) do { __builtin_amdgcn_s_setprio(1); \
    if constexpr (P::FP8) { \
      for (int m = 0; m < 4; ++m) for (int n = 0; n < 2; ++n) \
        asm volatile("v_mfma_f32_16x16x128_f8f6f4 %0, %1, %2, %0" \
                     : "+v"(acc[ai][bj][m][n]) : "v"(At_[m]), "v"(Bt_[n])); \
    } else { \
      for (int m = 0; m < 4; ++m) for (int n = 0; n < 2; ++n) { \
        acc[ai][bj][m][n] = __builtin_amdgcn_mfma_f32_16x16x32_bf16(FRAG_LO(At_[m]), FRAG_LO(Bt_[n]), acc[ai][bj][m][n], 0, 0, 0); \
        acc[ai][bj][m][n] = __builtin_amdgcn_mfma_f32_16x16x32_bf16(FRAG_HI(At_[m]), FRAG_HI(Bt_[n]), acc[ai][bj][m][n], 0, 0, 0); } \
    } \
    __builtin_amdgcn_s_setprio(0); } while (0)
#define WAIT_V(n) asm volatile("s_waitcnt vmcnt(" #n ")" ::: "memory")
#define WAIT_L(n) asm volatile("s_waitcnt lgkmcnt(" #n ")" ::: "memory")
#define BAR __builtin_amdgcn_s_barrier()
#define SCHED __builtin_amdgcn_sched_barrier(0)

  typename P::Ctx cur, nxt;
  p.tile(bid, cur);
  int aoff, boff, ldsd;
  unsigned oa, cc, ob0, ob1;
  bool wr1;
  {
    const int tid = tid_opaque();
    const int wid = tid >> 6, lane = tid & 63, wr = wid >> 2, wc = wid & 3, fr = lane & 15, fq = lane >> 4;
    aoff = g8_lds_byte(wr * 64 + fr, fq * 8); boff = g8_lds_byte(wc * 32 + fr, fq * 8);
    ldsd = tid * 16; wr1 = (wr == 1);
    int R0, C0;
    g8_stage_rc(tid * 16, R0, C0);
    cc = C0;
    oa = (((R0 >> 2) & 3) * 16 + (R0 >> 4) * 4 + (R0 & 3)) * P::A_PITCH + C0;
    if constexpr (P::B_GATHER) {
      ob0 = p.b_row(cur, 0, R0) | (p.b_row(cur, 0, R0 + 64) << 16);
      ob1 = p.b_row(cur, 1, R0) | (p.b_row(cur, 1, R0 + 64) << 16);
    } else { ob0 = R0 * P::B_PITCH + C0; ob1 = ob0; }
  }
  const bf16* ca0 = p.a_base(cur, 0);
  const bf16* ca1 = p.a_base(cur, 1);
  const bf16* cb0 = p.b_base(cur, 0);
  const bf16* cb1 = p.b_base(cur, 1);

  g8acc_t acc;
#pragma unroll
  for (int a0 = 0; a0 < 2; ++a0)
#pragma unroll
    for (int b0 = 0; b0 < 2; ++b0)
#pragma unroll
      for (int m = 0; m < 4; ++m)
#pragma unroll
        for (int n = 0; n < 2; ++n) acc[a0][b0][m][n] = (f32x4){0.f, 0.f, 0.f, 0.f};
  i32x8 At[4], B0[2], B1[2];
  const int mxs = 0x7F7F7F7F;
  const int nt = opq(P::NKT);
  STAGE_B(SB(0, 0), cb0, ob0, 0); STAGE_A(SA(0, 0), ca0, 0);
  STAGE_B(SB(0, 1), cb1, ob1, 0); STAGE_A(SA(0, 1), ca1, 0);
  if (wr1) BAR;
  WAIT_V(4); BAR;
  STAGE_B(SB(1, 0), cb0, ob0, 1); STAGE_A(SA(1, 0), ca0, 1); STAGE_B(SB(1, 1), cb1, ob1, 1);
  WAIT_V(6); BAR;
#pragma unroll 1
  for (int idx = bid;;) {
    const int nidx = idx + nblk;
    const bool has_next = nidx < ntl;
    if (has_next) p.tile(nidx, nxt); else nxt = cur;
    const bf16* na0 = p.a_base(nxt, 0);
    const bf16* na1 = p.a_base(nxt, 1);
    const bf16* nb0 = p.b_base(nxt, 0);
    const bf16* nb1 = p.b_base(nxt, 1);
    unsigned nob0 = ob0, nob1 = ob1;
    if constexpr (P::B_GATHER) {
      const int t2 = tid_opaque();
      int R0, C0;
      g8_stage_rc(t2 * 16, R0, C0);
      nob0 = p.b_row(nxt, 0, R0) | (p.b_row(nxt, 0, R0 + 64) << 16);
      nob1 = p.b_row(nxt, 1, R0) | (p.b_row(nxt, 1, R0 + 64) << 16);
    }
#pragma unroll 1
    for (int t = 0; t < nt; t += 2) {
      const bool last = (t == nt - 2);
      const bf16* a2h0 = last ? na0 : ca0; const bf16* a2h1 = last ? na1 : ca1;
      const bf16* b2h0 = last ? nb0 : cb0; const bf16* b2h1 = last ? nb1 : cb1;
      const int k2 = last ? 0 : t + 2;
      const unsigned q0 = last ? nob0 : ob0, q1 = last ? nob1 : ob1;
      LDB(B0, 0, 0); SCHED; LDA(At, 0, 0); STAGE_A(SA(1, 1), ca1, t + 1);
      WAIT_L(8); BAR; WAIT_L(0); MMA(0, 0, At, B0); BAR; SCHED;
      LDB(B1, 0, 1); STAGE_B(SB(0, 0), b2h0, q0, k2);
      BAR; WAIT_L(0); MMA(0, 1, At, B1); BAR;
      LDA(At, 0, 1); STAGE_A(SA(0, 0), a2h0, k2);
      BAR; WAIT_L(0); MMA(1, 0, At, B0); BAR; SCHED;
      STAGE_B(SB(0, 1), b2h1, q1, k2);
      WAIT_V(6); BAR; MMA(1, 1, At, B1); BAR;
      LDB(B0, 1, 0); SCHED; LDA(At, 1, 0); STAGE_A(SA(0, 1), a2h1, k2);
      WAIT_L(8); BAR; WAIT_L(0); MMA(0, 0, At, B0); BAR; SCHED;
      LDB(B1, 1, 1); STAGE_B(SB(1, 0), b2h0, q0, k2 + 1);
      BAR; WAIT_L(0); MMA(0, 1, At, B1); BAR;
      LDA(At, 1, 1); STAGE_A(SA(1, 0), a2h0, k2 + 1);
      BAR; WAIT_L(0); MMA(1, 0, At, B0); BAR; SCHED;
      STAGE_B(SB(1, 1), b2h1, q1, k2 + 1);
      WAIT_V(6); BAR; MMA(1, 1, At, B1); BAR;
    }
    if constexpr (P::FP8) asm volatile("s_nop 15\n\ts_nop 15" ::: "memory");
    {
      const int t3 = tid_opaque();
      const int wid = t3 >> 6, lane = t3 & 63;
      p.epi(cur, acc, wid >> 2, wid & 3, lane & 15, lane >> 4);
    }
    if (!has_next) break;
#pragma unroll
    for (int a0 = 0; a0 < 2; ++a0)
#pragma unroll
      for (int b0 = 0; b0 < 2; ++b0)
#pragma unroll
        for (int m = 0; m < 4; ++m)
#pragma unroll
          for (int n = 0; n < 2; ++n) acc[a0][b0][m][n] = (f32x4){0.f, 0.f, 0.f, 0.f};
    cur = nxt; ca0 = na0; ca1 = na1; cb0 = nb0; cb1 = nb1;
    ob0 = nob0; ob1 = nob1;
    idx = nidx;
  }
  WAIT_V(0);
  if (!wr1) BAR;
  BAR;
#undef SA
#undef SB
#undef GLDS
#undef STAGE_A
#undef STAGE_B
#undef LDA
#undef LDB
#undef MMA
#undef FRAG_LO
#undef FRAG_HI
#undef WAIT_V
#undef WAIT_L
#undef BAR
#undef SCHED
}

#define G8_FOR_BLK(AI, BJ, M, N) \
  _Pragma("unroll") for (int AI = 0; AI < 2; ++AI) _Pragma("unroll") for (int BJ = 0; BJ < 2; ++BJ) \
  _Pragma("unroll") for (int M = 0; M < 4; ++M) _Pragma("unroll") for (int N = 0; N < 2; ++N)
#define G8_AIDX(AI, M) ((AI) * 128 + wr * 64 + fq * 16 + (M) * 4)
#define G8_BIDX(BJ, N) ((BJ) * 128 + wc * 32 + (N) * 16 + fr)
__device__ __forceinline__ u32x2 pack4_bf16(const f32x4 v) { return (u32x2){pack_bf16(v.x, v.y), pack_bf16(v.z, v.w)}; }
__device__ __forceinline__ unsigned pack4_fp8(const f32x4 v) { return pk4_fp8(v.x, v.y, v.z, v.w); }
__device__ __forceinline__ u32x4 pack8_bf16(const f32x4 a, const f32x4 b) { return (u32x4){pack_bf16(a.x, a.y), pack_bf16(a.z, a.w), pack_bf16(b.x, b.y), pack_bf16(b.z, b.w)}; }
#define G8_FOR_BLK2(AI, BJ, M2, N) \
  _Pragma("unroll") for (int AI = 0; AI < 2; ++AI) _Pragma("unroll") for (int BJ = 0; BJ < 2; ++BJ) \
  _Pragma("unroll") for (int M2 = 0; M2 < 4; M2 += 2) _Pragma("unroll") for (int N = 0; N < 2; ++N)

struct G8InZT {
  static constexpr int NKT = 16; static constexpr bool B_GATHER = false; static constexpr bool FP8 = false; static constexpr int B_PITCH = D; static constexpr int A_PITCH = D;
  template <class C_> __device__ unsigned b_row(const C_&, int, int) const { return 0u; }
  struct Ctx { int t0, z0; };
  const bf16* wt; const bf16* A; bf16* zt; int ntok;
  __device__ int ntiles() const { return 6 * (ntok / 256); }
  __device__ void tile(int idx, Ctx& c) const { int tt = idx / 6; c.z0 = (idx - tt * 6) * 256; c.t0 = tt * 256; }
  __device__ const bf16* a_base(const Ctx& c, int h) const { return A + (size_t)(c.t0 + h * 128) * D; }
  __device__ unsigned a_off(const Ctx&, int, int r) const { return r * D; }
  __device__ const bf16* b_base(const Ctx& c, int h) const { return wt + (size_t)(c.z0 + h * 128) * D; }
  __device__ unsigned b_off(const Ctx&, int, int r) const { return r * D; }
  __device__ void epi(const Ctx& c, g8acc_t& acc, int wr, int wc, int fr, int fq) const {
    G8_FOR_BLK2(ai, bj, m, n) {
      const int tok = c.t0 + G8_AIDX(ai, m), z = c.z0 + G8_BIDX(bj, n);
      *(u32x4*)(zt + (size_t)z * NT + tok) = pack8_bf16(acc[ai][bj][m][n], acc[ai][bj][m + 1][n]);
    }
  }
};
struct G8InG {
  static constexpr int NKT = 8; static constexpr bool B_GATHER = false; static constexpr bool FP8 = true; static constexpr int B_PITCH = D / 2; static constexpr int A_PITCH = D / 2;
  template <class C_> __device__ unsigned b_row(const C_&, int, int) const { return 0u; }
  struct Ctx { int c0, t0; };
  const unsigned char* wt; const unsigned char* A; bf16* zg;
  __device__ int ntiles() const { return 7 * (NT / 256); }
  __device__ void tile(int idx, Ctx& c) const { int tt = idx / 7; c.t0 = tt * 256; c.c0 = (idx - tt * 7) * 256; }
  __device__ const bf16* a_base(const Ctx& c, int h) const { return (const bf16*)(wt + (size_t)(c.c0 + h * 128) * D); }
  __device__ unsigned a_off(const Ctx&, int, int r) const { return r * (D / 2); }
  __device__ const bf16* b_base(const Ctx& c, int h) const { return (const bf16*)(A + (size_t)(c.t0 + h * 128) * D); }
  __device__ unsigned b_off(const Ctx&, int, int r) const { return r * (D / 2); }
  __device__ void epi(const Ctx& c, g8acc_t& acc, int wr, int wc, int fr, int fq) const {
    const float isc = 1.0f / 16.0f;
    G8_FOR_BLK2(ai, bj, m, n) {
      const int col = c.c0 + G8_AIDX(ai, m), tok = c.t0 + G8_BIDX(bj, n);
      if (col < GLACOLS) *(u32x4*)(zg + (size_t)tok * GLACOLS + col) = pack8_bf16(acc[ai][bj][m][n] * isc, acc[ai][bj][m + 1][n] * isc);
    }
  }
};
struct G8Out {
  static constexpr int NKT = 16; static constexpr bool B_GATHER = false; static constexpr bool FP8 = false; static constexpr int B_PITCH = D; static constexpr int A_PITCH = D;
  template <class C_> __device__ unsigned b_row(const C_&, int, int) const { return 0u; }
  struct Ctx { int c0, t0; };
  int mrows; const bf16* ymix; const bf16* wt; const float* modl; float* xs;
  __device__ int ntiles() const { return (mrows / 256) * 4; }
  __device__ void tile(int idx, Ctx& c) const { c.t0 = (idx >> 2) * 256; c.c0 = (idx & 3) * 256; }
  __device__ const bf16* a_base(const Ctx& c, int h) const { return wt + (size_t)(c.c0 + h * 128) * D; }
  __device__ unsigned a_off(const Ctx&, int, int r) const { return r * D; }
  __device__ const bf16* b_base(const Ctx& c, int h) const { return ymix + (size_t)(c.t0 + h * 128) * D; }
  __device__ unsigned b_off(const Ctx&, int, int r) const { return r * D; }
  __device__ void epi(const Ctx& c, g8acc_t& acc, int wr, int wc, int fr, int fq) const {
    const float* g1 = modl + (size_t)row_batch(c.t0) * 6 * D + 2 * D;
    G8_FOR_BLK(ai, bj, m, n) {
      const int col = c.c0 + G8_AIDX(ai, m), tok = c.t0 + G8_BIDX(bj, n);
      float* xp = xs + (size_t)tok * D + col;
      *(f32x4*)xp = *(const f32x4*)xp + *(const f32x4*)(g1 + col) * acc[ai][bj][m][n];
    }
  }
};
struct G8Router {
  static constexpr int NKT = 16; static constexpr bool B_GATHER = false; static constexpr bool FP8 = false; static constexpr int B_PITCH = D; static constexpr int A_PITCH = D;
  template <class C_> __device__ unsigned b_row(const C_&, int, int) const { return 0u; }
  struct Ctx { int t0; };
  int mrows; const bf16* A; const bf16* rwt; float* logits;
  __device__ int ntiles() const { return mrows / 256; }
  __device__ void tile(int idx, Ctx& c) const { c.t0 = idx * 256; }
  __device__ const bf16* a_base(const Ctx&, int h) const { return rwt + (size_t)(h * 128) * D; }
  __device__ unsigned a_off(const Ctx&, int, int r) const { return r * D; }
  __device__ const bf16* b_base(const Ctx& c, int h) const { return A + (size_t)(c.t0 + h * 128) * D; }
  __device__ unsigned b_off(const Ctx&, int, int r) const { return r * D; }
  __device__ void epi(const Ctx& c, g8acc_t& acc, int wr, int wc, int fr, int fq) const {
    G8_FOR_BLK(ai, bj, m, n) {
      const int e = G8_AIDX(ai, m), tok = c.t0 + G8_BIDX(bj, n);
      *(f32x4*)(logits + (size_t)tok * NE + e) = acc[ai][bj][m][n];
    }
  }
};
struct G8ShUp {
  static constexpr int NKT = 8; static constexpr bool B_GATHER = false; static constexpr bool FP8 = true; static constexpr int B_PITCH = D / 2; static constexpr int A_PITCH = D / 2;
  template <class C_> __device__ unsigned b_row(const C_&, int, int) const { return 0u; }
  struct Ctx { int t0, hb; };
  int mrows; const unsigned char* A8; const unsigned char* s1t; const unsigned char* s3t; unsigned char* hs;
  __device__ int ntiles() const { return (mrows / 256) * 2; }
  __device__ void tile(int idx, Ctx& c) const { c.t0 = (idx >> 1) * 256; c.hb = (idx & 1) * 128; }
  __device__ const bf16* a_base(const Ctx& c, int h) const { return (const bf16*)((h ? s3t : s1t) + (size_t)c.hb * D); }
  __device__ unsigned a_off(const Ctx&, int, int r) const { return r * (D / 2); }
  __device__ const bf16* b_base(const Ctx& c, int h) const { return (const bf16*)(A8 + (size_t)(c.t0 + h * 128) * D); }
  __device__ unsigned b_off(const Ctx&, int, int r) const { return r * (D / 2); }
  __device__ void epi(const Ctx& c, g8acc_t& acc, int wr, int wc, int fr, int fq) const {
    const float isc = 1.0f / 16.0f;
#pragma unroll
    for (int bj = 0; bj < 2; ++bj)
#pragma unroll
      for (int n = 0; n < 2; ++n) {
        const int hcol = c.hb + wr * 64 + fq * 16, tok = c.t0 + G8_BIDX(bj, n);
        u32x4 o;
#pragma unroll
        for (int m = 0; m < 4; ++m) {
          const f32x4 u = acc[0][bj][m][n] * isc, v = acc[1][bj][m][n] * isc;
          const unsigned w = pk4_fp8(silu_f(u.x) * v.x, silu_f(u.y) * v.y, silu_f(u.z) * v.z, silu_f(u.w) * v.w);
          if (m == 0) o.x = w; else if (m == 1) o.y = w; else if (m == 2) o.z = w; else o.w = w;
        }
        *(u32x4*)(hs + (size_t)tok * DE + hcol) = o;
      }
  }
};
struct G8Up {
  static constexpr int NKT = 8; static constexpr bool B_GATHER = true; static constexpr bool FP8 = true; static constexpr int B_PITCH = D / 2; static constexpr int A_PITCH = D / 2;
  struct Ctx { int s0, hb, grp; };
  const unsigned char* A8; const int* slot_tok; const int* pad_start; const unsigned char* w1t; const unsigned char* w3t; unsigned char* H; const unsigned short* tile_e;
  __device__ int ntiles() const { return (pad_start[NE] >> 8) * 2; }
  __device__ void tile(int idx, Ctx& c) const { c.s0 = (idx >> 1) * 256; c.hb = (idx & 1) * 128; c.grp = __builtin_amdgcn_readfirstlane((int)tile_e[idx >> 1]); }
  __device__ const bf16* a_base(const Ctx& c, int h) const { return (const bf16*)((h ? w3t : w1t) + ((size_t)c.grp * DE + c.hb) * D); }
  __device__ unsigned a_off(const Ctx&, int, int r) const { return r * (D / 2); }
  __device__ const bf16* b_base(const Ctx&, int) const { return (const bf16*)A8; }
  __device__ unsigned b_off(const Ctx&, int, int) const { return 0u; }
  __device__ unsigned b_row(const Ctx& c, int h, int r) const { int t = slot_tok[c.s0 + h * 128 + r]; t = (t < 0 || t >= NT) ? 0 : t; return (unsigned)t; }
  __device__ void epi(const Ctx& c, g8acc_t& acc, int wr, int wc, int fr, int fq) const {
    const float isc = 1.0f / 16.0f;
#pragma unroll
    for (int bj = 0; bj < 2; ++bj)
#pragma unroll
      for (int n = 0; n < 2; ++n) {
        const int hcol = c.hb + wr * 64 + fq * 16, slot = c.s0 + G8_BIDX(bj, n);
        u32x4 o;
#pragma unroll
        for (int m = 0; m < 4; ++m) {
          const f32x4 u = acc[0][bj][m][n] * isc, v = acc[1][bj][m][n] * isc;
          const unsigned w = pk4_fp8(silu_f(u.x) * v.x, silu_f(u.y) * v.y, silu_f(u.z) * v.z, silu_f(u.w) * v.w);
          if (m == 0) o.x = w; else if (m == 1) o.y = w; else if (m == 2) o.z = w; else o.w = w;
        }
        *(u32x4*)(H + (size_t)slot * DE + hcol) = o;
      }
  }
};
struct G8ShDown {
  static constexpr int NKT = 2; static constexpr bool B_GATHER = false; static constexpr bool FP8 = true; static constexpr int B_PITCH = DE / 2; static constexpr int A_PITCH = DE / 2;
  template <class C_> __device__ unsigned b_row(const C_&, int, int) const { return 0u; }
  struct Ctx { int c0, t0; };
  int mrows; const unsigned char* hs; const unsigned char* wt; const float* modl; float* xs;
  __device__ int ntiles() const { return (mrows / 256) * 4; }
  __device__ void tile(int idx, Ctx& c) const { c.t0 = (idx >> 2) * 256; c.c0 = (idx & 3) * 256; }
  __device__ const bf16* a_base(const Ctx& c, int h) const { return (const bf16*)(wt + (size_t)(c.c0 + h * 128) * DE); }
  __device__ unsigned a_off(const Ctx&, int, int r) const { return r * (DE / 2); }
  __device__ const bf16* b_base(const Ctx& c, int h) const { return (const bf16*)(hs + (size_t)(c.t0 + h * 128) * DE); }
  __device__ unsigned b_off(const Ctx&, int, int r) const { return r * (DE / 2); }
  __device__ void epi(const Ctx& c, g8acc_t& acc, int wr, int wc, int fr, int fq) const {
    const float* g2 = modl + (size_t)row_batch(c.t0) * 6 * D + 5 * D;
    const float isc = 1.0f / 16.0f;
    G8_FOR_BLK(ai, bj, m, n) {
      const int col = c.c0 + G8_AIDX(ai, m), tok = c.t0 + G8_BIDX(bj, n);
      float* xp = xs + (size_t)tok * D + col;
      *(f32x4*)xp = *(const f32x4*)xp + *(const f32x4*)(g2 + col) * (acc[ai][bj][m][n] * isc);
    }
  }
};
struct G8Down {
  static constexpr int NKT = 2; static constexpr bool B_GATHER = false; static constexpr bool FP8 = true; static constexpr int B_PITCH = DE / 2; static constexpr int A_PITCH = DE / 2;
  struct Ctx { int c0, s0, grp; };
  const unsigned char* H; const int* pad_start; const unsigned char* w2t; unsigned char* Y; const unsigned short* tile_e;
  template <class C_> __device__ unsigned b_row(const C_&, int, int) const { return 0u; }
  __device__ int ntiles() const { return (pad_start[NE] >> 8) * 4; }
  __device__ void tile(int idx, Ctx& c) const { c.s0 = (idx >> 2) * 256; c.c0 = (idx & 3) * 256; c.grp = __builtin_amdgcn_readfirstlane((int)tile_e[idx >> 2]); }
  __device__ const bf16* a_base(const Ctx& c, int h) const { return (const bf16*)(w2t + ((size_t)c.grp * D + c.c0 + h * 128) * DE); }
  __device__ unsigned a_off(const Ctx&, int, int r) const { return r * (DE / 2); }
  __device__ const bf16* b_base(const Ctx& c, int h) const { return (const bf16*)(H + (size_t)(c.s0 + h * 128) * DE); }
  __device__ unsigned b_off(const Ctx&, int, int r) const { return r * (DE / 2); }
  __device__ void epi(const Ctx& c, g8acc_t& acc, int wr, int wc, int fr, int fq) const {
    const float isc = 1.0f / 16.0f;
#pragma unroll
    for (int ai = 0; ai < 2; ++ai)
#pragma unroll
      for (int bj = 0; bj < 2; ++bj)
#pragma unroll
        for (int n = 0; n < 2; ++n) {
          const int col = c.c0 + G8_AIDX(ai, 0), slot = c.s0 + G8_BIDX(bj, n);
          u32x4 o;
          o.x = pack4_fp8(acc[ai][bj][0][n] * isc); o.y = pack4_fp8(acc[ai][bj][1][n] * isc);
          o.z = pack4_fp8(acc[ai][bj][2][n] * isc); o.w = pack4_fp8(acc[ai][bj][3][n] * isc);
          *(u32x4*)(Y + (size_t)slot * D + col) = o;
        }
  }
};

constexpr int CVT_TILES = 3 * NE * 128;
struct CvtCtx { const float* w1; const float* w3; const float* w2; unsigned char* d1; unsigned char* d3; unsigned char* d2; };
struct CvtRegs { int pend; f32x4 r0, r1, r2, r3, r4, r5, r6, r7; };
__device__ __forceinline__ void cvt_locate(const CvtCtx& js, int u, int lane, const float*& s, unsigned char*& d, int& K, int& N) {
  const int job = u >> 15, r = u & 32767, mat = r >> 7, rr = r & 127;
  int kt, ntile;
  if (job < 2) { K = D; N = DE; ntile = rr >> 4; kt = rr & 15; } else { K = DE; N = D; ntile = rr >> 2; kt = rr & 3; }
  const float* s1 = js.w1; const float* s3 = js.w3; const float* s2 = js.w2;
  unsigned char* q1 = js.d1; unsigned char* q3 = js.d3; unsigned char* q2 = js.d2;
  const float* sb = job == 0 ? s1 : (job == 1 ? s3 : s2);
  unsigned char* db = job == 0 ? q1 : (job == 1 ? q3 : q2);
  const int k0 = kt * 64 + (lane & 7) * 8, n0 = ntile * 32 + (lane >> 3) * 4;
  s = sb + (size_t)mat * D * DE + (size_t)k0 * N + n0;
  d = db + (size_t)mat * D * DE + (size_t)n0 * K + k0;
}
__device__ __forceinline__ void cvt_init(CvtRegs& st) {
  st.pend = -1;
  st.r0 = st.r1 = st.r2 = st.r3 = st.r4 = st.r5 = st.r6 = st.r7 = (f32x4){0.f, 0.f, 0.f, 0.f};
}
__device__ __forceinline__ void cvt_finish(const CvtCtx& cx, CvtRegs& st, int lane) {
  if (st.pend < 0) return;
  const float* s; unsigned char* d; int K, N;
  cvt_locate(cx, st.pend, lane, s, d, K, N);
  const float sc = 16.0f;
  const f32x4 v0 = st.r0 * sc, v1 = st.r1 * sc, v2 = st.r2 * sc, v3 = st.r3 * sc, v4 = st.r4 * sc, v5 = st.r5 * sc, v6 = st.r6 * sc, v7 = st.r7 * sc;
  *(u32x2*)(d) = (u32x2){pk4_fp8(v0.x, v1.x, v2.x, v3.x), pk4_fp8(v4.x, v5.x, v6.x, v7.x)};
  *(u32x2*)(d + (size_t)K) = (u32x2){pk4_fp8(v0.y, v1.y, v2.y, v3.y), pk4_fp8(v4.y, v5.y, v6.y, v7.y)};
  *(u32x2*)(d + (size_t)2 * K) = (u32x2){pk4_fp8(v0.z, v1.z, v2.z, v3.z), pk4_fp8(v4.z, v5.z, v6.z, v7.z)};
  *(u32x2*)(d + (size_t)3 * K) = (u32x2){pk4_fp8(v0.w, v1.w, v2.w, v3.w), pk4_fp8(v4.w, v5.w, v6.w, v7.w)};
  st.pend = -1;
}
constexpr int CVT_GLA_TILES = 128 * 36 * 2 * 8;
static_assert(CVT_GLA_TILES + 512 * 2 * 3 * 8 == CVT_TILES, "tile ownership must cover every tile exactly once");
__device__ __forceinline__ void cvt_step(const CvtCtx& cx, CvtRegs& st, int lane, int u) {
  cvt_finish(cx, st, lane);
  const float* s; unsigned char* d; int K, N;
  cvt_locate(cx, u, lane, s, d, K, N);
  st.r0 = __builtin_nontemporal_load((const f32x4*)(s));
  st.r1 = __builtin_nontemporal_load((const f32x4*)(s + (size_t)N));
  st.r2 = __builtin_nontemporal_load((const f32x4*)(s + (size_t)2 * N));
  st.r3 = __builtin_nontemporal_load((const f32x4*)(s + (size_t)3 * N));
  st.r4 = __builtin_nontemporal_load((const f32x4*)(s + (size_t)4 * N));
  st.r5 = __builtin_nontemporal_load((const f32x4*)(s + (size_t)5 * N));
  st.r6 = __builtin_nontemporal_load((const f32x4*)(s + (size_t)6 * N));
  st.r7 = __builtin_nontemporal_load((const f32x4*)(s + (size_t)7 * N));
  st.pend = u;
}

constexpr int UST = 2056;
constexpr int HY_U_BYTES = 16 * UST * 2;
constexpr int TCOPY = 2064;
constexpr int HY_T_BYTES = 4 * TCOPY * 4;
constexpr int HY_LDS = HY_U_BYTES + HY_T_BYTES;
constexpr int USTC = 264;
constexpr int TCOPYC = 264;

__device__ __forceinline__ f32x4 mfma16(bf16x8 a, bf16x8 b, f32x4 c) {
  return __builtin_amdgcn_mfma_f32_16x16x32_bf16(a, b, c, 0, 0, 0);
}
__device__ __forceinline__ float bflo(unsigned v) { return __uint_as_float(v << 16); }
__device__ __forceinline__ float bfhi(unsigned v) { return __uint_as_float(v & 0xffff0000u); }
__device__ __forceinline__ float ldbf(const bf16* p) { return bf2f(*p); }

template <int GSTR, int TCP>
__device__ __forceinline__ void hy_load_tables(const bf16* __restrict__ G, int c, unsigned* T) {
  constexpr int NCH = GSTR / 8;
  for (int q = tid_opaque(); q < 2 * NCH; q += 512) {
    int o = q / NCH, ch = q - o * NCH;
    const unsigned* s32 = (const unsigned*)(G + ((size_t)(o * 512 + c)) * GSTR);
    u32x4 a = *(const u32x4*)(s32 + 4 * ch);
    unsigned nx = (ch + 1 < NCH) ? s32[4 * ch + 4] : 0u;
    unsigned* d0 = T + o * 2 * TCP;
    unsigned* d1 = d0 + TCP;
    *(u32x4*)(d0 + 4 * ch) = a;
    u32x4 b;
    b.x = (a.x >> 16) | (a.y << 16); b.y = (a.y >> 16) | (a.z << 16); b.z = (a.z >> 16) | (a.w << 16); b.w = (a.w >> 16) | (nx << 16);
    *(u32x4*)(d1 + 4 * ch) = b;
  }
}

template <int L, int USTR>
__device__ __forceinline__ void hy_load_u(const bf16* __restrict__ z, float w0, float w1, float w2, float bb, bf16* U) {
  constexpr int CPB = L / 8;
  for (int q = tid_opaque(); q < 16 * CPB; q += 512) {
    int b = q / CPB, t8 = (q - b * CPB) * 8;
    const bf16* zr = z + (size_t)b * L + t8;
    u32x4 v = *(const u32x4*)zr;
    float zm = t8 > 0 ? ldbf(zr - 1) : 0.f;
    float zp = t8 + 8 < L ? ldbf(zr + 8) : 0.f;
    float e0 = bflo(v.x), e1 = bfhi(v.x), e2 = bflo(v.y), e3 = bfhi(v.y), e4 = bflo(v.z), e5 = bfhi(v.z), e6 = bflo(v.w), e7 = bfhi(v.w);
    u32x4 o;
    o.x = pack_bf16(w0 * zm + w1 * e0 + w2 * e1 + bb, w0 * e0 + w1 * e1 + w2 * e2 + bb);
    o.y = pack_bf16(w0 * e1 + w1 * e2 + w2 * e3 + bb, w0 * e2 + w1 * e3 + w2 * e4 + bb);
    o.z = pack_bf16(w0 * e3 + w1 * e4 + w2 * e5 + bb, w0 * e4 + w1 * e5 + w2 * e6 + bb);
    o.w = pack_bf16(w0 * e5 + w1 * e6 + w2 * e7 + bb, w0 * e6 + w1 * e7 + w2 * zp + bb);
    *(u32x4*)(U + b * USTR + t8) = o;
  }
}

template <int L>
__device__ __forceinline__ void hy_gate4(const bf16* __restrict__ zr, int t0, float w0, float w1, float w2, float bb, float (&x)[4]) {
  u32x2 v = *(const u32x2*)(zr + t0);
  float zm = t0 > 0 ? ldbf(zr + t0 - 1) : 0.f;
  float zp = t0 + 4 < L ? ldbf(zr + t0 + 4) : 0.f;
  float e0 = bflo(v.x), e1 = bfhi(v.x), e2 = bflo(v.y), e3 = bfhi(v.y);
  x[0] = w0 * zm + w1 * e0 + w2 * e1 + bb;
  x[1] = w0 * e0 + w1 * e1 + w2 * e2 + bb;
  x[2] = w0 * e1 + w1 * e2 + w2 * e3 + bb;
  x[3] = w0 * e2 + w1 * e3 + w2 * zp + bb;
}

__device__ __forceinline__ bf16x8 hy_frag(const unsigned* p) {
  u32x4 v; v.x = p[0]; v.y = p[1]; v.z = p[2]; v.w = p[3];
  return __builtin_bit_cast(bf16x8, v);
}

__device__ __forceinline__ void hyena_latent(int c, const bf16* __restrict__ zt, const float* __restrict__ cw,
                                             const float* __restrict__ cb, const bf16* __restrict__ G,
                                             bf16* __restrict__ yt, char* smem, const CvtCtx& cx) {
  const int tid = tid_opaque(), lane = tid & 63, wave = tid >> 6;
  bf16* U = (bf16*)smem;
  unsigned* T = (unsigned*)(smem + HY_U_BYTES);
  __syncthreads();
  hy_load_tables<GSTR_L, TCOPY>(G, c, T);
  hy_load_u<SEQ, UST>(zt + (size_t)c * NT, cw[c], cw[HYCOLS + c], cw[2 * HYCOLS + c], cb[c], U);
  __syncthreads();
  const int r = lane & 15, kg = lane >> 4;
  const int par = (r + 1) & 1;
  const int base_dw = 1023 - (r >> 1) + 4 * kg - 128 * wave;
  const char* ub = smem + (r * UST + 8 * kg) * 2;
  const int tw = wave * 256;
#pragma unroll 1
  for (int order = 0; order < 2; ++order) {
    const unsigned* tb = T + order * 2 * TCOPY + par * TCOPY + base_dw;
    f32x4 acc[16];
#pragma unroll
    for (int i = 0; i < 16; ++i) acc[i] = (f32x4){0.f, 0.f, 0.f, 0.f};
    bf16x8 W[16];
#pragma unroll
    for (int f = -15; f <= 0; ++f) W[f & 15] = hy_frag(tb + 8 * f);
    CvtRegs cr; cvt_init(cr);
    const int wv = __builtin_amdgcn_readfirstlane(wave);
#pragma unroll 1
    for (int J = 0; J < 8; ++J) {
      const unsigned* tj = tb + 128 * J;
      const char* uj = ub + 512 * J;
#pragma unroll
      for (int jj = 0; jj < 8; ++jj) {
        if (jj == 0 && (J == 0 || J == 3 || J == 6)) cvt_step(cx, cr, lane, CVT_GLA_TILES + ((c * 2 + order) * 3 + J / 3) * 8 + wv);
        bf16x8 uf = *(const bf16x8*)(uj + 64 * jj);
        acc[15] = mfma16(W[(2 * jj - 15) & 15], uf, acc[15]);
        acc[14] = mfma16(W[(2 * jj - 14) & 15], uf, acc[14]);
        if (J * 8 + jj < 63) {
          W[(2 * jj + 1) & 15] = hy_frag(tj + 8 * (2 * jj + 1));
          W[(2 * jj + 2) & 15] = hy_frag(tj + 8 * (2 * jj + 2));
        }
#pragma unroll
        for (int i = 13; i >= 0; --i) acc[i] = mfma16(W[(2 * jj - i) & 15], uf, acc[i]);
      }
    }
    cvt_finish(cx, cr, lane);
    __syncthreads();
    {
      const int col = (order + 1) * 512 + c;
      const float w0 = cw[col], w1 = cw[HYCOLS + col], w2 = cw[2 * HYCOLS + col], bb = cb[col];
      const bf16* zr = zt + (size_t)col * NT + (size_t)r * SEQ;
      u32x2 gv[16]; unsigned gm[16], gp[16];
#pragma unroll
      for (int i = 0; i < 16; ++i) {
        const int t0 = tw + 16 * i + 4 * kg;
        gv[i] = *(const u32x2*)(zr + t0);
        gm[i] = t0 > 0 ? (unsigned)*(const unsigned short*)(zr + t0 - 1) : 0u;
        gp[i] = t0 + 4 < SEQ ? (unsigned)*(const unsigned short*)(zr + t0 + 4) : 0u;
      }
#pragma unroll
      for (int i = 0; i < 16; ++i) {
        const int t0 = tw + 16 * i + 4 * kg;
        const float zm = __uint_as_float(gm[i] << 16), zp = __uint_as_float(gp[i] << 16);
        const float e0 = bflo(gv[i].x), e1 = bfhi(gv[i].x), e2 = bflo(gv[i].y), e3 = bfhi(gv[i].y);
        const float x0 = w0 * zm + w1 * e0 + w2 * e1 + bb, x1 = w0 * e0 + w1 * e1 + w2 * e2 + bb;
        const float x2 = w0 * e1 + w1 * e2 + w2 * e3 + bb, x3 = w0 * e2 + w1 * e3 + w2 * zp + bb;
        u32x2 o;
        o.x = pack_bf16(x0 * acc[i][0], x1 * acc[i][1]);
        o.y = pack_bf16(x2 * acc[i][2], x3 * acc[i][3]);
        *(u32x2*)(U + r * UST + t0) = o;
      }
    }
    __syncthreads();
  }
  for (int q = tid; q < 16 * 256; q += 512) {
    int b = q >> 8, t8 = (q & 255) * 8;
    *(u32x4*)(yt + (size_t)c * NT + (size_t)b * SEQ + t8) = *(const u32x4*)(U + b * UST + t8);
  }
}

__device__ __forceinline__ void hyena_ctx(int c, const bf16* __restrict__ zt, const float* __restrict__ cw,
                                          const float* __restrict__ cb, const bf16* __restrict__ G,
                                          bf16* __restrict__ yt, char* smem) {
  const int tid = tid_opaque(), lane = tid & 63, wave = tid >> 6;
  bf16* U = (bf16*)smem;
  unsigned* T = (unsigned*)(smem + HY_U_BYTES);
  __syncthreads();
  hy_load_tables<GSTR_C, TCOPYC>(G, c, T);
  hy_load_u<LC, USTC>(zt + (size_t)c * NT, cw[c], cw[HYCOLS + c], cw[2 * HYCOLS + c], cb[c], U);
  __syncthreads();
  const int r = lane & 15, kg = lane >> 4;
  const int par = (r + 1) & 1;
  const int base_dw = (8 * kg - r + 255 - par) >> 1;
  const char* ub = smem + (r * USTC + 8 * kg) * 2;
#pragma unroll 1
  for (int order = 0; order < 2; ++order) {
    const unsigned* tb = T + order * 2 * TCOPYC + par * TCOPYC + base_dw;
    f32x4 acc[2];
    acc[0] = (f32x4){0.f, 0.f, 0.f, 0.f};
    acc[1] = acc[0];
#pragma unroll
    for (int j = 0; j < 8; ++j) {
      bf16x8 uf = *(const bf16x8*)(ub + 64 * j);
#pragma unroll
      for (int ii = 0; ii < 2; ++ii) {
        const int i = wave * 2 + ii;
        acc[ii] = mfma16(hy_frag(tb + 16 * j - 8 * i), uf, acc[ii]);
      }
    }
    __syncthreads();
    {
      const int col = (order + 1) * 512 + c;
      const float w0 = cw[col], w1 = cw[HYCOLS + col], w2 = cw[2 * HYCOLS + col], bb = cb[col];
      const bf16* zr = zt + (size_t)col * NT + (size_t)r * LC;
#pragma unroll
      for (int ii = 0; ii < 2; ++ii) {
        const int t0 = (wave * 2 + ii) * 16 + 4 * kg;
        float x[4];
        hy_gate4<LC>(zr, t0, w0, w1, w2, bb, x);
        u32x2 o;
        o.x = pack_bf16(x[0] * acc[ii][0], x[1] * acc[ii][1]);
        o.y = pack_bf16(x[2] * acc[ii][2], x[3] * acc[ii][3]);
        *(u32x2*)(U + r * USTC + t0) = o;
      }
    }
    __syncthreads();
  }
  {
    int b = tid >> 5, t8 = (tid & 31) * 8;
    *(u32x4*)(yt + (size_t)c * NT + (size_t)b * LC + t8) = *(const u32x4*)(U + b * USTC + t8);
  }
}

constexpr int GL_QE = 0, GL_KE = 8192, GL_KST = 16384, GL_ATT = 24576, GL_ST = 32768, GL_VT = 49152  ;
constexpr int GL_RAW = 81920  , GL_RAWSZ = 18432, GL_SEG = 118784, GL_DEC = 120832;
constexpr int GLA_LDS = 121088;

__device__ __forceinline__ f32x16 mfma32(bf16x8 a, bf16x8 b, f32x16 c) {
  return __builtin_amdgcn_mfma_f32_32x32x16_bf16(a, b, c, 0, 0, 0);
}
__device__ __forceinline__ unsigned short bf16bits(float v) { bf16 h = f2bf(v); return *(unsigned short*)&h; }

struct GlaArgs {
  const bf16* zg; const float* wa2; const float* ba2; float* of; float* ob; int emit_ctx; int pad_;
};

__device__ __forceinline__ void gla_unit(int unit, const GlaArgs& a, char* smem, const CvtCtx& cx) {
  const int tid = tid_opaque(), lane = tid & 63, wave = tid >> 6;
  const int dir = unit & 1, h = (unit >> 1) & 3, b = unit >> 3;
  const int lr = lane & 31, lh = lane >> 5;
  const int swl = (lr >> 1) & 7;
  float* outp = dir ? a.ob : a.of;
  __syncthreads();
  const int d = tid & 63, sg = tid >> 6;
  float wa[16];
#pragma unroll
  for (int r = 0; r < 16; ++r) wa[r] = a.wa2[(dir * 16 + r) * 256 + h * 64 + d];
  const float ba = a.ba2[dir * 256 + h * 64 + d];
  { unsigned zz = 0u; asm volatile("" : "+v"(zz));
    for (int q = tid; q < 16384 / 16; q += 512) *(u32x4*)(smem + GL_ST + q * 16) = (u32x4){zz, zz, zz, zz}; }
  f32x16 S;
#pragma unroll
  for (int r = 0; r < 16; ++r) S[r] = 0.f;

  const int qi = tid >> 3, qc = tid & 7;
  const int ai = (tid >> 1) & 63, ac = tid & 1;
  const int vsg = (tid >> 5) & 7, vdq = tid & 31;
  u32x4 pq, pk, pa;
  u32x2 pw0, pw1, pw2, pw3, pw4, pw5, pw6, pw7;

#define GLA_ROW(N_, I_, ROW_)                                                        \
  {                                                                                  \
    const int n_ = (N_);                                                             \
    const int Ls_ = n_ < 4 ? LC : SEQ;                                               \
    const int cn_ = n_ < 4 ? n_ : n_ - 4;                                            \
    const int rb_ = n_ < 4 ? (NL + b * LC) : (b * SEQ);                              \
    const int pos_ = cn_ * 64 + (I_);                                                \
    ROW_ = rb_ + (dir ? (Ls_ - 1 - pos_) : pos_);                                    \
  }
#define GLA_LOAD_RAW(N_)                                                             \
  {                                                                                  \
    int row_;                                                                        \
    GLA_ROW(N_, qi, row_);                                                           \
    const bf16* zr_ = a.zg + (size_t)row_ * GLACOLS;                                 \
    pq = *(const u32x4*)(zr_ + h * 64 + qc * 8);                                     \
    pk = *(const u32x4*)(zr_ + 256 + h * 64 + qc * 8);                               \
    int ra_;                                                                         \
    GLA_ROW(N_, ai, ra_);                                                            \
    pa = *(const u32x4*)(a.zg + (size_t)ra_ * GLACOLS + 1536 + dir * 16 + ac * 8);   \
  }
#define GLA_LOAD_V(N_)                                                               \
  {                                                                                  \
    int rv_;                                                                         \
    GLA_ROW(N_, vsg * 8 + 0, rv_); pw0 = *(const u32x2*)(a.zg + (size_t)rv_ * GLACOLS + 512 + h * 128 + vdq * 4); \
    GLA_ROW(N_, vsg * 8 + 1, rv_); pw1 = *(const u32x2*)(a.zg + (size_t)rv_ * GLACOLS + 512 + h * 128 + vdq * 4); \
    GLA_ROW(N_, vsg * 8 + 2, rv_); pw2 = *(const u32x2*)(a.zg + (size_t)rv_ * GLACOLS + 512 + h * 128 + vdq * 4); \
    GLA_ROW(N_, vsg * 8 + 3, rv_); pw3 = *(const u32x2*)(a.zg + (size_t)rv_ * GLACOLS + 512 + h * 128 + vdq * 4); \
    GLA_ROW(N_, vsg * 8 + 4, rv_); pw4 = *(const u32x2*)(a.zg + (size_t)rv_ * GLACOLS + 512 + h * 128 + vdq * 4); \
    GLA_ROW(N_, vsg * 8 + 5, rv_); pw5 = *(const u32x2*)(a.zg + (size_t)rv_ * GLACOLS + 512 + h * 128 + vdq * 4); \
    GLA_ROW(N_, vsg * 8 + 6, rv_); pw6 = *(const u32x2*)(a.zg + (size_t)rv_ * GLACOLS + 512 + h * 128 + vdq * 4); \
    GLA_ROW(N_, vsg * 8 + 7, rv_); pw7 = *(const u32x2*)(a.zg + (size_t)rv_ * GLACOLS + 512 + h * 128 + vdq * 4); \
  }
#define GLA_STORE_RAW(RB_)                                                           \
  {                                                                                  \
    char* rw_ = smem + GL_RAW + (RB_) * GL_RAWSZ;                                    \
    *(u32x4*)(rw_ + qi * 128 + qc * 16) = pq;                                        \
    *(u32x4*)(rw_ + 8192 + qi * 128 + qc * 16) = pk;                                 \
    if (tid < 128) *(u32x4*)(rw_ + 16384 + ai * 32 + ac * 16) = pa;                  \
  }
#define GLA_STORE_V(VB_)                                                             \
  if (tid < 256) {                                                                   \
    char* vt_ = smem + GL_VT + (VB_) * 16384;                                        \
    u32x4 o;                                                                         \
    o.x = (pw0.x & 0xffffu) | (pw1.x << 16); o.y = (pw2.x & 0xffffu) | (pw3.x << 16); o.z = (pw4.x & 0xffffu) | (pw5.x << 16); o.w = (pw6.x & 0xffffu) | (pw7.x << 16); \
    *(u32x4*)(vt_ + swz(vdq * 4 + 0, vsg)) = o;                                      \
    o.x = (pw0.x >> 16) | (pw1.x & 0xffff0000u); o.y = (pw2.x >> 16) | (pw3.x & 0xffff0000u); o.z = (pw4.x >> 16) | (pw5.x & 0xffff0000u); o.w = (pw6.x >> 16) | (pw7.x & 0xffff0000u); \
    *(u32x4*)(vt_ + swz(vdq * 4 + 1, vsg)) = o;                                      \
    o.x = (pw0.y & 0xffffu) | (pw1.y << 16); o.y = (pw2.y & 0xffffu) | (pw3.y << 16); o.z = (pw4.y & 0xffffu) | (pw5.y << 16); o.w = (pw6.y & 0xffffu) | (pw7.y << 16); \
    *(u32x4*)(vt_ + swz(vdq * 4 + 2, vsg)) = o;                                      \
    o.x = (pw0.y >> 16) | (pw1.y & 0xffff0000u); o.y = (pw2.y >> 16) | (pw3.y & 0xffff0000u); o.z = (pw4.y >> 16) | (pw5.y & 0xffff0000u); o.w = (pw6.y >> 16) | (pw7.y & 0xffff0000u); \
    *(u32x4*)(vt_ + swz(vdq * 4 + 3, vsg)) = o;                                      \
  }
#define GLA_STEP3(RB_)                                                               \
  {                                                                                  \
    const char* ra_ = smem + GL_RAW + (RB_) * GL_RAWSZ + 16384;                      \
    float run = 0.f;                                                                 \
    _Pragma("unroll") for (int ii = 0; ii < 8; ++ii) {                               \
      const int i = sg * 8 + ii;                                                     \
      const u32x4 a0 = *(const u32x4*)(ra_ + i * 32);                                \
      const u32x4 a1 = *(const u32x4*)(ra_ + i * 32 + 16);                           \
      float g = ba;                                                                  \
      g += bflo(a0.x) * wa[0] + bfhi(a0.x) * wa[1] + bflo(a0.y) * wa[2] + bfhi(a0.y) * wa[3]; \
      g += bflo(a0.z) * wa[4] + bfhi(a0.z) * wa[5] + bflo(a0.w) * wa[6] + bfhi(a0.w) * wa[7]; \
      g += bflo(a1.x) * wa[8] + bfhi(a1.x) * wa[9] + bflo(a1.y) * wa[10] + bfhi(a1.y) * wa[11]; \
      g += bflo(a1.z) * wa[12] + bfhi(a1.z) * wa[13] + bflo(a1.w) * wa[14] + bfhi(a1.w) * wa[15]; \
      run += logsigmoid_f(g) * (1.0f / 16.0f);                                       \
      bl[ii] = run;                                                                  \
    }                                                                                \
    *(float*)(smem + GL_SEG + (sg * 64 + d) * 4) = run;                              \
  }
#define GLA_STEP5(RB_)                                                               \
  {                                                                                  \
    const char* rq_ = smem + GL_RAW + (RB_) * GL_RAWSZ;                              \
    float off = 0.f, tot = 0.f;                                                      \
    _Pragma("unroll") for (int s = 0; s < 8; ++s) {                                  \
      float v = *(const float*)(smem + GL_SEG + (s * 64 + d) * 4);                  \
      off += (s < sg) ? v : 0.f;                                                     \
      tot += v;                                                                      \
    }                                                                                \
    float ks[8];                                                                     \
    _Pragma("unroll") for (int ii = 0; ii < 8; ++ii) {                               \
      const int i = sg * 8 + ii;                                                     \
      const float bb = off + bl[ii];                                                 \
      const float qv = bf2f(*(const bf16*)(rq_ + i * 128 + d * 2));                 \
      const float kv = bf2f(*(const bf16*)(rq_ + 8192 + i * 128 + d * 2));          \
      const int eo = swz(i, d >> 3) + (d & 7) * 2;                                   \
      *(unsigned short*)(smem + GL_QE + eo) = bf16bits(qv * 0.125f * __expf(bb));    \
      *(unsigned short*)(smem + GL_KE + eo) = bf16bits(kv * __expf(-bb));            \
      ks[ii] = kv * __expf(tot - bb);                                                \
    }                                                                                \
    u32x4 o;                                                                         \
    o.x = pack_bf16(ks[0], ks[1]); o.y = pack_bf16(ks[2], ks[3]); o.z = pack_bf16(ks[4], ks[5]); o.w = pack_bf16(ks[6], ks[7]); \
    *(u32x4*)(smem + GL_KST + swz(d, sg)) = o;                                       \
    if (sg == 0) *(float*)(smem + GL_DEC + d * 4) = __expf(tot);                     \
  }

  const int tm = wave >> 2, tn = wave & 3;
  float bl[8];
  f32x16 oprev;
#pragma unroll
  for (int r = 0; r < 16; ++r) oprev[r] = 0.f;

  GLA_LOAD_RAW(0); GLA_LOAD_V(0);
  GLA_STORE_RAW(0); GLA_STORE_V(0);
  GLA_LOAD_RAW(1);
  GLA_STORE_RAW(1);
  __syncthreads();
  GLA_STEP3(0);
  __syncthreads();
  GLA_STEP5(0);
  GLA_LOAD_RAW(2); GLA_LOAD_V(1);
  __syncthreads();
  CvtRegs cr; cvt_init(cr);
  const int cvt_u0 = __builtin_amdgcn_readfirstlane(unit * 36 * 16 + wave);
#pragma unroll 1
  for (int n = 0; n < 36; ++n) {
    const int vb = n & 1;
    const bool has1 = n + 1 < 36;
    cvt_step(cx, cr, lane, cvt_u0 + n * 16);
    f32x16 oacc;
#pragma unroll
    for (int r = 0; r < 16; ++r) oacc[r] = 0.f;
#pragma unroll
    for (int r = 0; r < 16; ++r) S[r] *= *(const float*)(smem + GL_DEC + (tm * 32 + rowmap(r, lh)) * 4);
#pragma unroll
    for (int ks4 = 0; ks4 < 4; ++ks4) {
      const int c = ((2 * ks4 + lh) ^ swl) << 4;
      const bf16x8 fq = *(const bf16x8*)(smem + GL_QE + (tm * 32 + lr) * 128 + c);
      const bf16x8 fs = *(const bf16x8*)(smem + GL_ST + (tn * 32 + lr) * 128 + c);
      oacc = mfma32(fq, fs, oacc);
      const bf16x8 fk = *(const bf16x8*)(smem + GL_KST + (tm * 32 + lr) * 128 + c);
      const bf16x8 fv = *(const bf16x8*)(smem + GL_VT + vb * 16384 + (tn * 32 + lr) * 128 + c);
      S = mfma32(fk, fv, S);
    }
    if (wave < 4) {
      const int am = wave >> 1, an = wave & 1;
      f32x16 att;
#pragma unroll
      for (int r = 0; r < 16; ++r) att[r] = 0.f;
#pragma unroll
      for (int ks4 = 0; ks4 < 4; ++ks4) {
        const int c = ((2 * ks4 + lh) ^ swl) << 4;
        const bf16x8 fq = *(const bf16x8*)(smem + GL_QE + (am * 32 + lr) * 128 + c);
        const bf16x8 fk = *(const bf16x8*)(smem + GL_KE + (an * 32 + lr) * 128 + c);
        att = mfma32(fq, fk, att);
      }
      const int s = an * 32 + lr;
#pragma unroll
      for (int r = 0; r < 16; ++r) {
        const int t = am * 32 + rowmap(r, lh);
        const float v = (s <= t) ? att[r] : 0.f;
        *(unsigned short*)(smem + GL_ATT + swz(t, s >> 3) + (s & 7) * 2) = bf16bits(v);
      }
    }
    if (has1) GLA_STEP3((n + 1) & 1);
    __syncthreads();
    cvt_step(cx, cr, lane, cvt_u0 + n * 16 + 8);
#pragma unroll
    for (int ks4 = 0; ks4 < 4; ++ks4) {
      const int c = ((2 * ks4 + lh) ^ swl) << 4;
      const bf16x8 fa = *(const bf16x8*)(smem + GL_ATT + (tm * 32 + lr) * 128 + c);
      const bf16x8 fv = *(const bf16x8*)(smem + GL_VT + vb * 16384 + (tn * 32 + lr) * 128 + c);
      oacc = mfma32(fa, fv, oacc);
    }
#pragma unroll
    for (int g = 0; g < 4; ++g) {
      u32x2 o;
      o.x = pack_bf16(S[4 * g + 0], S[4 * g + 1]);
      o.y = pack_bf16(S[4 * g + 2], S[4 * g + 3]);
      *(u32x2*)(smem + GL_ST + swz(tn * 32 + lr, tm * 4 + g) + 8 * lh) = o;
    }
    if (has1) {
      GLA_STEP5((n + 1) & 1);
      GLA_STORE_V((n + 1) & 1);
      if (n + 2 < 36) GLA_STORE_RAW(n & 1);
    }
    if (n > 0 && (n - 1 >= 4 || a.emit_ctx)) {
#pragma unroll
      for (int r = 0; r < 16; ++r) {
        int row;
        GLA_ROW(n - 1, tm * 32 + rowmap(r, lh), row);
        outp[(size_t)row * 512 + h * 128 + tn * 32 + lr] = oprev[r];
      }
    }
    { const int nr = n + 3 < 36 ? n + 3 : 35; GLA_LOAD_RAW(nr); const int nv = n + 2 < 36 ? n + 2 : 35; GLA_LOAD_V(nv); }
    oprev = oacc;
    __syncthreads();
  }
  cvt_finish(cx, cr, lane);
  {
#pragma unroll
    for (int r = 0; r < 16; ++r) {
      int row;
      GLA_ROW(35, tm * 32 + rowmap(r, lh), row);
      outp[(size_t)row * 512 + h * 128 + tn * 32 + lr] = oprev[r];
    }
  }
#undef GLA_ROW
#undef GLA_LOAD_RAW
#undef GLA_LOAD_V
#undef GLA_STORE_RAW
#undef GLA_STORE_V
#undef GLA_STEP3
#undef GLA_STEP5
}


constexpr int CTRL_Q = 0;
constexpr int CTRL_CNT = 128;
constexpr int CTRL_CUR = 640;
constexpr int CTRL_XR = 1152;
constexpr int CTRL_WORDS = 1152 + 256;
constexpr size_t al256(size_t v) { return (v + 255) / 256 * 256; }
namespace wso {
constexpr size_t bar = 0;
constexpr size_t ctrl = al256(bar + (size_t)XCD_BAR_WORDS * 4);
constexpr size_t zero_end = al256(ctrl + (size_t)CTRL_WORDS * 4);
constexpr size_t xs = al256(ctrl + (size_t)CTRL_WORDS * 4);
constexpr size_t mod = al256(xs + (size_t)NT * D * 4);
constexpr size_t abuf = al256(mod + (size_t)DEPTH * 17 * 6 * D * 4);
constexpr size_t zt = al256(abuf + (size_t)NT * D * 2);
constexpr size_t zg = al256(zt + (size_t)HYCOLS * NT * 2);
constexpr size_t yt = al256(zg + (size_t)NT * GLACOLS * 2);
constexpr size_t of = al256(yt + (size_t)HYW * NT * 2);
constexpr size_t ob = al256(of + (size_t)NT * 512 * 4);
constexpr size_t ymix = al256(ob + (size_t)NT * 512 * 4);
constexpr size_t region_end_raw = al256(ymix + (size_t)NT * D * 2);
constexpr size_t region_end = (region_end_raw > zt + al256((size_t)NSLOT * D * 2)) ? region_end_raw : zt + al256((size_t)NSLOT * D * 2);
constexpr size_t hid = region_end;
constexpr size_t gl = al256(hid + (size_t)DEPTH * 2 * SEQ * 64 * 4);
constexpr size_t gc = al256(gl + (size_t)DEPTH * 2 * HYW * GSTR_L * 2);
constexpr size_t logits = al256(gc + (size_t)2 * HYW * GSTR_C * 2);
constexpr size_t tok_e = al256(logits + (size_t)NT * NE * 4);
constexpr size_t tok_gate = al256(tok_e + (size_t)NT * TOPK * 4);
constexpr size_t tok_slot = al256(tok_gate + (size_t)NT * TOPK * 4);
constexpr size_t pad_start = al256(tok_slot + (size_t)NT * TOPK * 4);
constexpr size_t slot_tok = al256(pad_start + (size_t)(NE + 2) * 4);
constexpr size_t blkcnt = al256(slot_tok + (size_t)NSLOT * 4);
constexpr size_t hbuf = al256(blkcnt + (size_t)512 * NE * 4);
constexpr size_t hs = al256(hbuf + (size_t)NSLOT * DE);
constexpr size_t w_in_t = al256(hs + (size_t)NT * DE);
constexpr size_t w_out_t = al256(w_in_t + (size_t)DEPTH * WIN_ROWS * D * 2);
constexpr size_t router_t = al256(w_out_t + (size_t)DEPTH * D * D * 2);
constexpr size_t sh1_t = al256(router_t + (size_t)DEPTH * NE * D * 2);
constexpr size_t sh3_t = al256(sh1_t + (size_t)DEPTH * DE * D);
constexpr size_t sh2_t = al256(sh3_t + (size_t)DEPTH * DE * D);
constexpr size_t e1_t = al256(sh2_t + (size_t)DEPTH * D * DE);
constexpr size_t e3_t = al256(e1_t + (size_t)NE * DE * D);
constexpr size_t e2_t = al256(e3_t + (size_t)NE * DE * D);
constexpr size_t abuf8 = al256(e2_t + (size_t)NE * D * DE);
constexpr size_t w_g8 = al256(abuf8 + (size_t)NT * D);
constexpr size_t total = al256(w_g8 + (size_t)DEPTH * GW_ROWS * D);
constexpr size_t ybuf = zt;
}
struct WS {
  char* b;
  __device__ __forceinline__ unsigned* bar() const { char* q = b; asm volatile("" : "+s"(q)); return (unsigned*)(q + wso::bar); }
  __device__ __forceinline__ int* ctrl() const { char* q = b; asm volatile("" : "+s"(q)); return (int*)(q + wso::ctrl); }
  __device__ __forceinline__ float* xs() const { char* q = b; asm volatile("" : "+s"(q)); return (float*)(q + wso::xs); }
  __device__ __forceinline__ float* mod() const { char* q = b; asm volatile("" : "+s"(q)); return (float*)(q + wso::mod); }
  __device__ __forceinline__ bf16* abuf() const { char* q = b; asm volatile("" : "+s"(q)); return (bf16*)(q + wso::abuf); }
  __device__ __forceinline__ bf16* zt() const { char* q = b; asm volatile("" : "+s"(q)); return (bf16*)(q + wso::zt); }
  __device__ __forceinline__ bf16* zg() const { char* q = b; asm volatile("" : "+s"(q)); return (bf16*)(q + wso::zg); }
  __device__ __forceinline__ bf16* yt() const { char* q = b; asm volatile("" : "+s"(q)); return (bf16*)(q + wso::yt); }
  __device__ __forceinline__ float* of() const { char* q = b; asm volatile("" : "+s"(q)); return (float*)(q + wso::of); }
  __device__ __forceinline__ float* ob() const { char* q = b; asm volatile("" : "+s"(q)); return (float*)(q + wso::ob); }
  __device__ __forceinline__ bf16* ymix() const { char* q = b; asm volatile("" : "+s"(q)); return (bf16*)(q + wso::ymix); }
  __device__ __forceinline__ float* hid() const { char* q = b; asm volatile("" : "+s"(q)); return (float*)(q + wso::hid); }
  __device__ __forceinline__ bf16* gl() const { char* q = b; asm volatile("" : "+s"(q)); return (bf16*)(q + wso::gl); }
  __device__ __forceinline__ bf16* gc() const { char* q = b; asm volatile("" : "+s"(q)); return (bf16*)(q + wso::gc); }
  __device__ __forceinline__ float* logits() const { char* q = b; asm volatile("" : "+s"(q)); return (float*)(q + wso::logits); }
  __device__ __forceinline__ int* tok_e() const { char* q = b; asm volatile("" : "+s"(q)); return (int*)(q + wso::tok_e); }
  __device__ __forceinline__ float* tok_gate() const { char* q = b; asm volatile("" : "+s"(q)); return (float*)(q + wso::tok_gate); }
  __device__ __forceinline__ int* tok_slot() const { char* q = b; asm volatile("" : "+s"(q)); return (int*)(q + wso::tok_slot); }
  __device__ __forceinline__ int* pad_start() const { char* q = b; asm volatile("" : "+s"(q)); return (int*)(q + wso::pad_start); }
  __device__ __forceinline__ int* slot_tok() const { char* q = b; asm volatile("" : "+s"(q)); return (int*)(q + wso::slot_tok); }
  __device__ __forceinline__ int* blkcnt() const { char* q = b; asm volatile("" : "+s"(q)); return (int*)(q + wso::blkcnt); }
  __device__ __forceinline__ unsigned char* hbuf() const { char* q = b; asm volatile("" : "+s"(q)); return (unsigned char*)(q + wso::hbuf); }
  __device__ __forceinline__ unsigned char* hs() const { char* q = b; asm volatile("" : "+s"(q)); return (unsigned char*)(q + wso::hs); }
  __device__ __forceinline__ bf16* w_in_t() const { char* q = b; asm volatile("" : "+s"(q)); return (bf16*)(q + wso::w_in_t); }
  __device__ __forceinline__ bf16* w_out_t() const { char* q = b; asm volatile("" : "+s"(q)); return (bf16*)(q + wso::w_out_t); }
  __device__ __forceinline__ bf16* router_t() const { char* q = b; asm volatile("" : "+s"(q)); return (bf16*)(q + wso::router_t); }
  __device__ __forceinline__ unsigned char* sh1_t() const { char* q = b; asm volatile("" : "+s"(q)); return (unsigned char*)(q + wso::sh1_t); }
  __device__ __forceinline__ unsigned char* sh3_t() const { char* q = b; asm volatile("" : "+s"(q)); return (unsigned char*)(q + wso::sh3_t); }
  __device__ __forceinline__ unsigned char* sh2_t() const { char* q = b; asm volatile("" : "+s"(q)); return (unsigned char*)(q + wso::sh2_t); }
  __device__ __forceinline__ unsigned char* e1_t() const { char* q = b; asm volatile("" : "+s"(q)); return (unsigned char*)(q + wso::e1_t); }
  __device__ __forceinline__ unsigned char* e3_t() const { char* q = b; asm volatile("" : "+s"(q)); return (unsigned char*)(q + wso::e3_t); }
  __device__ __forceinline__ unsigned char* e2_t() const { char* q = b; asm volatile("" : "+s"(q)); return (unsigned char*)(q + wso::e2_t); }
  __device__ __forceinline__ unsigned char* ybuf() const { char* q = b; asm volatile("" : "+s"(q)); return (unsigned char*)(q + wso::ybuf); }
  __device__ __forceinline__ unsigned char* abuf8() const { char* q = b; asm volatile("" : "+s"(q)); return (unsigned char*)(q + wso::abuf8); }
  __device__ __forceinline__ unsigned char* w_g8() const { char* q = b; asm volatile("" : "+s"(q)); return (unsigned char*)(q + wso::w_g8); }
};

constexpr int MEGA_LDS_MAIN = G8_LDS;
constexpr int LDS_TILE_E = MEGA_LDS_MAIN + 16;
constexpr int MEGA_LDS = MEGA_LDS_MAIN + 16 + 4096;

struct MP { Inputs in; WS w; float* out; };

__device__ __forceinline__ void row_load(const float* __restrict__ p, int lane, f32x4 (&v)[4]) {
#pragma unroll
  for (int j = 0; j < 4; ++j) v[j] = *(const f32x4*)(p + j * 256 + lane * 4);
}
__device__ __forceinline__ float row_rinv(const f32x4 (&v)[4], int lane) {
  float ss = 0.f;
#pragma unroll
  for (int j = 0; j < 4; ++j) ss += v[j].x * v[j].x + v[j].y * v[j].y + v[j].z * v[j].z + v[j].w * v[j].w;
  ss = wave_sum(ss, lane);
  return rsqrtf(ss * (1.0f / D) + EPS);
}
__device__ __forceinline__ void row_norm_mod_store(const f32x4 (&v)[4], float rinv, const float* __restrict__ g,
                                                   const float* __restrict__ sh, const float* __restrict__ sc, int lane,
                                                   bf16* __restrict__ dst, unsigned char* __restrict__ dst8 = nullptr) {
#pragma unroll
  for (int j = 0; j < 4; ++j) {
    const int d = j * 256 + lane * 4;
    const f32x4 gv = *(const f32x4*)(g + d), shv = *(const f32x4*)(sh + d), scv = *(const f32x4*)(sc + d);
    const float y0 = v[j].x * rinv * gv.x * (1.f + scv.x) + shv.x, y1 = v[j].y * rinv * gv.y * (1.f + scv.y) + shv.y;
    const float y2 = v[j].z * rinv * gv.z * (1.f + scv.z) + shv.z, y3 = v[j].w * rinv * gv.w * (1.f + scv.w) + shv.w;
    u32x2 o;
    o.x = pack_bf16(y0, y1);
    o.y = pack_bf16(y2, y3);
    *(u32x2*)(dst + d) = o;
    if (dst8) *(unsigned*)(dst8 + d) = pk4_fp8(y0, y1, y2, y3);
  }
}

__device__ __forceinline__ void ph_mod_hid(const MP& p, char* smem, int bid, int nblk) {
  const int tid = tid_opaque(), lane = tid & 63, wave = tid >> 6;
  float* sc = (float*)smem;
  for (int u = bid; u < 192; u += nblk) {
    const int l = u / 96, col0 = (u - l * 96) * 64;
    __syncthreads();
    for (int i = tid; i < 17 * 1024; i += 512) {
      const int r = i >> 10, k = i & 1023;
      const float v = (r < 16) ? p.in.c[r * D + k] : p.in.c_ctx[k];
      sc[i] = silu_f(v);
    }
    __syncthreads();
    const int col = tid & 63, ks = tid >> 6;
    float acc[17];
#pragma unroll
    for (int r = 0; r < 17; ++r) acc[r] = 0.f;
    const float* wp = p.in.ada_w + ((size_t)l * D + ks * 128) * (6 * D) + col0 + col;
#pragma unroll 16
    for (int kk = 0; kk < 128; ++kk) {
      const float wv = wp[(size_t)kk * (6 * D)];
#pragma unroll
      for (int r = 0; r < 17; ++r) acc[r] += sc[r * 1024 + ks * 128 + kk] * wv;
    }
    __syncthreads();
#pragma unroll
    for (int r = 0; r < 17; ++r) sc[(ks * 17 + r) * 64 + col] = acc[r];
    __syncthreads();
    for (int i = tid; i < 17 * 64; i += 512) {
      const int r = i >> 6, cc = i & 63;
      float s = 0.f;
#pragma unroll
      for (int k8 = 0; k8 < 8; ++k8) s += sc[(k8 * 17 + r) * 64 + cc];
      p.w.mod()[((size_t)l * 17 + r) * (6 * D) + col0 + cc] = s + p.in.ada_b[l * 6 * D + col0 + cc];
    }
  }
  for (int it = bid; it * 8 < 4352; it += nblk) {
    const int rid = it * 8 + wave;
    int l, ty, t;
    if (rid < 2048) { l = 0; ty = 0; t = rid; }
    else if (rid < 2304) { l = 0; ty = 1; t = rid - 2048; }
    else { l = 1; ty = 0; t = rid - 2304; }
    const int L = ty ? LC : SEQ;
    const float* w1 = p.in.hy_f_w1 + l * 33 * 64; const float* b1 = p.in.hy_f_b1 + l * 64;
    const float* w2 = p.in.hy_f_w2 + l * 64 * 64; const float* b2 = p.in.hy_f_b2 + l * 64;
    float pv = 0.f;
    if (lane == 0) pv = (float)t / (float)(L - 1);
    else if (lane < 33) {
      const int bi = (lane - 1) & 15;
      const float wph = 2.0f * 3.14159265358979323846f * (float)t / (float)L;
      const float f = 1e-4f + (float)bi * ((15.0f - 1e-4f) / 15.0f);
      pv = (lane <= 16) ? cosf(f * wph) : -sinf(f * wph);
    }
    float a1 = b1[lane];
#pragma unroll
    for (int i = 0; i < 33; ++i) a1 += shl_f(pv, i) * w1[i * 64 + lane];
    const float h1 = sinf(a1);
    float a2 = b2[lane];
#pragma unroll 16
    for (int i = 0; i < 64; ++i) a2 += shl_f(h1, i) * w2[i * 64 + lane];
    p.w.hid()[((size_t)(l * 2 + ty) * SEQ + t) * 64 + lane] = sinf(a2);
  }
}

__device__ __forceinline__ void ph_gtab(const MP& p, char* smem, int bid, int nblk) {
  const int tid = tid_opaque();
  float* wl = (float*)smem;
  for (int u = bid; u < 544; u += nblk) {
    int l, ty, ib, cg;
    if (u < 512) { l = u >> 8; ty = 0; ib = (u >> 5) & 7; cg = u & 31; }
    else { l = 0; ty = 1; ib = 0; cg = u - 512; }
    const int L = ty ? LC : SEQ, gstr = ty ? GSTR_C : GSTR_L;
    const float* hid = p.w.hid() + (size_t)(l * 2 + ty) * SEQ * 64;
    const float* w3 = p.in.hy_f_w3 + (size_t)l * 64 * 2048;
    const float* skip = p.in.hy_skip + l * 2 * 512;
    bf16* G = ty ? p.w.gc() : (p.w.gl() + (size_t)l * 2 * HYW * GSTR_L);
    __syncthreads();
    for (int i = tid; i < 2 * 32 * 64; i += 512) {
      const int dir = i >> 11, cc = (i >> 6) & 31, j = i & 63;
      const int oc = cg * 32 + cc, o = oc >> 9, c = oc & 511;
      wl[i] = w3[(size_t)j * 2048 + o * 1024 + dir * 512 + c];
    }
    __syncthreads();
    const int i = ib * 512 + tid;
    const int dd = i - (L - 1);
    const int t = dd < 0 ? -dd : dd;
    const bool inr = i < 2 * L - 1;
    const int dir = dd > 0 ? 1 : 0;
    float hr[64];
    {
      const float* hp = hid + (size_t)(inr ? t : 0) * 64;
#pragma unroll
      for (int j = 0; j < 16; ++j) { const f32x4 v = *(const f32x4*)(hp + 4 * j); hr[4 * j] = v.x; hr[4 * j + 1] = v.y; hr[4 * j + 2] = v.z; hr[4 * j + 3] = v.w; }
    }
    const float tn = (float)t / (float)(L - 1);
#pragma unroll 1
    for (int cc = 0; cc < 32; ++cc) {
      const int oc = cg * 32 + cc, o = oc >> 9, c = oc & 511;
      const float* wc = wl + (dir * 32 + cc) * 64;
      float s = 0.f;
#pragma unroll
      for (int j = 0; j < 16; ++j) { const f32x4 wv = *(const f32x4*)(wc + 4 * j); s += hr[4 * j] * wv.x + hr[4 * j + 1] * wv.y + hr[4 * j + 2] * wv.z + hr[4 * j + 3] * wv.w; }
      if (dd == 0) {
        const float* wc1 = wl + (32 + cc) * 64;
        float s1 = 0.f;
#pragma unroll
        for (int j = 0; j < 16; ++j) { const f32x4 wv = *(const f32x4*)(wc1 + 4 * j); s1 += hr[4 * j] * wv.x + hr[4 * j + 1] * wv.y + hr[4 * j + 2] * wv.z + hr[4 * j + 3] * wv.w; }
        s += s1;
      }
      const float delta = HY_MIN_DECAY + (float)c * ((HY_MAX_DECAY - HY_MIN_DECAY) / 511.0f);
      float val = s * __expf(-tn * delta);
      if (dd == 0) val += skip[o * 512 + c];
      if (!inr) val = 0.f;
      G[(size_t)oc * gstr + i] = f2bf(val);
    }
  }
}

__device__ __forceinline__ void ph_init_norm1(const MP& p, int bid, int nblk) {
  const int lane = tid_opaque() & 63, wave = tid_opaque() >> 6;
  const float* g = p.in.norm1_g;
  for (int it = bid; it * 8 < SEQ; it += nblk) {
    const int t = it * 8 + wave;
    const float rr = (float)(t >> 6), colp = (float)(t & 63);
    f32x4 e[4];
#pragma unroll
    for (int j = 0; j < 4; ++j) {
      float ev[4];
#pragma unroll
      for (int q = 0; q < 4; ++q) {
        const int i = lane * 4 + q;
        const float omega = 1.0f / powf(10000.0f, (float)i / 256.0f);
        const float a = ((j < 2) ? rr : colp) * omega;
        ev[q] = (j & 1) ? cosf(a) : sinf(a);
      }
      e[j] = (f32x4){ev[0], ev[1], ev[2], ev[3]};
    }
    for (int b = 0; b < NB; ++b) {
      const int row = b * SEQ + t;
      f32x4 v[4];
      row_load(p.in.x + (size_t)row * D, lane, v);
#pragma unroll
      for (int j = 0; j < 4; ++j) { v[j] += e[j]; *(f32x4*)(p.w.xs() + (size_t)row * D + j * 256 + lane * 4) = v[j]; }
      const float rinv = row_rinv(v, lane);
      const float* mb = p.w.mod() + (size_t)b * 6 * D;
      row_norm_mod_store(v, rinv, g, mb, mb + D, lane, p.w.abuf() + (size_t)row * D, p.w.abuf8() + (size_t)row * D);
    }
  }
  for (int it = bid; it * 8 < NC; it += nblk) {
    const int rc = it * 8 + wave, row = NL + rc;
    f32x4 v[4];
    row_load(p.in.ctx + (size_t)rc * D, lane, v);
#pragma unroll
    for (int j = 0; j < 4; ++j) *(f32x4*)(p.w.xs() + (size_t)row * D + j * 256 + lane * 4) = v[j];
    const float rinv = row_rinv(v, lane);
    const float* mb = p.w.mod() + (size_t)16 * 6 * D;
    row_norm_mod_store(v, rinv, g, mb, mb + D, lane, p.w.abuf() + (size_t)row * D, p.w.abuf8() + (size_t)row * D);
  }
}

__device__ __forceinline__ void ph_mixer(const MP& p, char* smem, int l, bool last, int bid, int nblk) {
  int* qctr = p.w.ctrl() + CTRL_Q + 64 * l;
  int* slot = (int*)(smem + MEGA_LDS_MAIN + 8);
  GlaArgs ga;
  ga.zg = p.w.zg(); ga.wa2 = p.in.gla_wa2 + (size_t)l * 2 * 16 * 256; ga.ba2 = p.in.gla_ba2 + (size_t)l * 2 * 256;
  ga.of = p.w.of(); ga.ob = p.w.ob(); ga.emit_ctx = last ? 0 : 1; ga.pad_ = 0;
  const float* cw = p.in.hy_conv_w + (size_t)l * 3 * HYCOLS;
  const float* cb = p.in.hy_conv_b + (size_t)l * HYCOLS;
  const bf16* gl = p.w.gl() + (size_t)l * 2 * HYW * GSTR_L;
  CvtCtx cx;
  cx.w1 = p.in.exp_w1 + (size_t)l * NE * D * DE; cx.w3 = p.in.exp_w3 + (size_t)l * NE * D * DE; cx.w2 = p.in.exp_w2 + (size_t)l * NE * DE * D;
  cx.d1 = p.w.e1_t(); cx.d3 = p.w.e3_t(); cx.d2 = p.w.e2_t();
  for (;;) {
    __syncthreads();
    if (tid_opaque() == 0) *slot = atomicAdd(qctr, 1);
    __syncthreads();
    const int u = *slot;
    const int nunits = last ? 640 : 1152;
    if (u >= nunits) break;
    if (u < 128) gla_unit(u, ga, smem, cx);
    else if (u < 640) hyena_latent(u - 128, p.w.zt(), cw, cb, gl, p.w.yt(), smem, cx);
    else hyena_ctx(u - 640, p.w.zt() + NL, cw, cb, p.w.gc(), p.w.yt() + NL, smem);
  }
}

__device__ __forceinline__ void ph_gla_out(const MP& p, char* smem, int l, int mrows, int bid, int nblk) {
  const int tid = tid_opaque();
  const int lane = tid & 63, wave = tid >> 6;
  {
    const float* gn = p.in.gla_norm_g + l * 128 + (lane & 15) * 8;
    const f32x4 ga = *(const f32x4*)gn, gb = *(const f32x4*)(gn + 4);
    const float* of = p.w.of(); const float* ob = p.w.ob(); const bf16* zg = p.w.zg(); bf16* ymix = p.w.ymix();
#pragma unroll 2
    for (int it = bid; it * 8 < mrows; it += nblk) {
      const int row = it * 8 + wave;
      const size_t base = (size_t)row * 512 + lane * 8;
      const f32x4 a0 = *(const f32x4*)(of + base), a1 = *(const f32x4*)(of + base + 4);
      const f32x4 b0 = *(const f32x4*)(ob + base), b1 = *(const f32x4*)(ob + base + 4);
      const u32x4 rv = *(const u32x4*)(zg + (size_t)row * GLACOLS + 1024 + lane * 8);
      const f32x4 o0 = a0 + b0, o1 = a1 + b1;
      float ss = o0.x * o0.x + o0.y * o0.y + o0.z * o0.z + o0.w * o0.w + o1.x * o1.x + o1.y * o1.y + o1.z * o1.z + o1.w * o1.w;
      ss += shx_f(ss, 1, lane); ss += shx_f(ss, 2, lane); ss += shx_f(ss, 4, lane); ss += shx_f(ss, 8, lane);
      const float rinv = rsqrtf(ss * (1.0f / 128.0f) + EPS);
      u32x4 o;
      o.x = pack_bf16(o0.x * rinv * ga.x * silu_f(bflo(rv.x)), o0.y * rinv * ga.y * silu_f(bfhi(rv.x)));
      o.y = pack_bf16(o0.z * rinv * ga.z * silu_f(bflo(rv.y)), o0.w * rinv * ga.w * silu_f(bfhi(rv.y)));
      o.z = pack_bf16(o1.x * rinv * gb.x * silu_f(bflo(rv.z)), o1.y * rinv * gb.y * silu_f(bfhi(rv.z)));
      o.w = pack_bf16(o1.z * rinv * gb.z * silu_f(bflo(rv.w)), o1.w * rinv * gb.w * silu_f(bfhi(rv.w)));
      *(u32x4*)(ymix + (size_t)row * D + 512 + lane * 8) = o;
    }
  }
  {
    const bf16* yt = p.w.yt(); bf16* ymix = p.w.ymix();
    for (int tt = bid; tt * 64 < mrows; tt += nblk) {
      const int tok0 = tt * 64;
      __syncthreads();
#pragma unroll
      for (int i = 0; i < 8; ++i) {
        const int q = tid + i * 512, c = q >> 3, ch = q & 7;
        const u32x4 v = *(const u32x4*)(yt + (size_t)c * NT + tok0 + ch * 8);
        unsigned* d = (unsigned*)(smem + c * 132 + ch * 16);
        d[0] = v.x; d[1] = v.y; d[2] = v.z; d[3] = v.w;
      }
      __syncthreads();
#pragma unroll
      for (int i = 0; i < 8; ++i) {
        const int c8 = wave * 8 + (lane & 7), t = i * 8 + (lane >> 3);
        const unsigned short* s = (const unsigned short*)(smem + (c8 * 8) * 132 + t * 2);
        const unsigned e0 = s[0], e1 = s[66], e2 = s[132], e3 = s[198], e4 = s[264], e5 = s[330], e6 = s[396], e7 = s[462];
        *(u32x4*)(ymix + (size_t)(tok0 + t) * D + c8 * 8) = (u32x4){e0 | (e1 << 16), e2 | (e3 << 16), e4 | (e5 << 16), e6 | (e7 << 16)};
      }
    }
  }
}

__device__ __forceinline__ void ph_norm2(const MP& p, int l, int mrows, int bid, int nblk) {
  const int lane = tid_opaque() & 63, wave = tid_opaque() >> 6;
  const float* g = p.in.norm2_g + l * D;
  const float* modl = p.w.mod() + (size_t)l * 17 * 6 * D;
  for (int it = bid; it * 8 < mrows; it += nblk) {
    const int row = it * 8 + wave;
    f32x4 v[4];
    row_load(p.w.xs() + (size_t)row * D, lane, v);
    const float rinv = row_rinv(v, lane);
    const float* mb = modl + (size_t)row_batch(row) * 6 * D;
    row_norm_mod_store(v, rinv, g, mb + 3 * D, mb + 4 * D, lane, p.w.abuf() + (size_t)row * D, p.w.abuf8() + (size_t)row * D);
  }
}

__device__ __forceinline__ void ph_route(const MP& p, char* smem, int l, int ntok, int bid, int nblk) {
  const int tid = tid_opaque();
  const int lane = tid & 63, wave = tid >> 6;
  const float* rb = p.in.router_b + l * NE;
  int* lcnt = (int*)smem;
  __syncthreads();
  if (tid < NE) lcnt[tid] = 0;
  __syncthreads();
  const f32x4 bb = *(const f32x4*)(rb + lane * 4);
  const int tpb = (ntok + nblk - 1) / nblk;
  for (int it = wave; it < tpb; it += 8) {
    const int tok = bid * tpb + it;
    if (tok >= ntok) break;
    const f32x4 lg = *(const f32x4*)(p.w.logits() + (size_t)tok * NE + lane * 4);
    const float s0 = sigmoid_f(lg.x), s1 = sigmoid_f(lg.y), s2 = sigmoid_f(lg.z), s3 = sigmoid_f(lg.w);
    const float v0 = s0 + bb.x, v1 = s1 + bb.y, v2 = s2 + bb.z, v3 = s3 + bb.w;
    float m1 = fmaxf(v0, v1), m2 = fminf(v0, v1);
    { float n1 = fmaxf(m1, v2); float n2 = fmaxf(fminf(m1, v2), m2); m1 = n1; m2 = n2; }
    { float n1 = fmaxf(m1, v3); float n2 = fmaxf(fminf(m1, v3), m2); m1 = n1; m2 = n2; }
#pragma unroll
    for (int o = 1; o <= 4; o <<= 1) {
      float a1 = shx_f(m1, o, lane), a2 = shx_f(m2, o, lane);
      float n1 = fmaxf(m1, a1);
      float n2 = fmaxf(fminf(m1, a1), fmaxf(m2, a2));
      m1 = n1; m2 = n2;
    }
    const float gs = m1 + m2;
    const int g = lane >> 3;
    int rank = 0;
#pragma unroll
    for (int gg = 0; gg < 8; ++gg) {
      const float og = __int_as_float(__builtin_amdgcn_readlane(__float_as_int(gs), gg * 8));
      rank += (og > gs || (og == gs && gg < g)) ? 1 : 0;
    }
    unsigned k0, k1, k2, k3;
    {
      const bool sel = rank < 4;
      unsigned u;
      u = __float_as_uint(v0); u = (u & 0x80000000u) ? ~u : (u | 0x80000000u); k0 = sel ? ((u & 0xffffff00u) | (unsigned)(255 - (lane * 4 + 0))) : 0u;
      u = __float_as_uint(v1); u = (u & 0x80000000u) ? ~u : (u | 0x80000000u); k1 = sel ? ((u & 0xffffff00u) | (unsigned)(255 - (lane * 4 + 1))) : 0u;
      u = __float_as_uint(v2); u = (u & 0x80000000u) ? ~u : (u | 0x80000000u); k2 = sel ? ((u & 0xffffff00u) | (unsigned)(255 - (lane * 4 + 2))) : 0u;
      u = __float_as_uint(v3); u = (u & 0x80000000u) ? ~u : (u | 0x80000000u); k3 = sel ? ((u & 0xffffff00u) | (unsigned)(255 - (lane * 4 + 3))) : 0u;
    }
    float gsum = 0.f, myg = 0.f; int mye = 0;
#pragma unroll
    for (int k = 0; k < TOPK; ++k) {
      unsigned m = max(max(k0, k1), max(k2, k3));
      m = max(m, (unsigned)__builtin_amdgcn_update_dpp(0, (int)m, 0x111, 0xf, 0xf, false));
      m = max(m, (unsigned)__builtin_amdgcn_update_dpp(0, (int)m, 0x112, 0xf, 0xf, false));
      m = max(m, (unsigned)__builtin_amdgcn_update_dpp(0, (int)m, 0x114, 0xf, 0xf, false));
      m = max(m, (unsigned)__builtin_amdgcn_update_dpp(0, (int)m, 0x118, 0xf, 0xf, false));
      m = max(m, (unsigned)__builtin_amdgcn_update_dpp(0, (int)m, 0x142, 0xa, 0xf, false));
      m = max(m, (unsigned)__builtin_amdgcn_update_dpp(0, (int)m, 0x143, 0xc, 0xf, false));
      const unsigned wk = (unsigned)__builtin_amdgcn_readlane((int)m, 63);
      const int we = 255 - (int)(wk & 255u);
      const int wl = we >> 2, wi = we & 3;
      const float sv = __int_as_float(__builtin_amdgcn_readlane(__float_as_int(wi == 0 ? s0 : wi == 1 ? s1 : wi == 2 ? s2 : s3), wl));
      if (lane == wl) { if (wi == 0) k0 = 0u; else if (wi == 1) k1 = 0u; else if (wi == 2) k2 = 0u; else k3 = 0u; }
      gsum += sv;
      if (lane == k) { myg = sv; mye = we; }
    }
    if (lane < TOPK) {
      p.w.tok_e()[tok * TOPK + lane] = mye;
      p.w.tok_gate()[tok * TOPK + lane] = myg / gsum * 2.5f;
      atomicAdd(&lcnt[mye], 1);
    }
  }
  __syncthreads();
  if (tid < NE) p.w.blkcnt()[bid * NE + tid] = lcnt[tid];
}

__device__ __forceinline__ void ph_assign(const MP& p, char* smem, int l, int ntok, int bid, int nblk) {
  const int tid = tid_opaque();
  int* ps = (int*)smem;
  int* cur = (int*)smem + 512;
  __syncthreads();
  int* part = (int*)smem + 1024;
  {
    const int eg = tid & 63, bg = tid >> 6;
    const int per = (nblk + 7) >> 3;
    int t0 = 0, t1 = 0, t2 = 0, t3 = 0, b0 = 0, b1 = 0, b2 = 0, b3 = 0;
    const int* src = p.w.blkcnt() + eg * 4;
#pragma unroll 8
    for (int i = 0; i < per; ++i) {
      const int b = bg * per + i;
      if (b < nblk) {
        const u32x4 v = *(const u32x4*)(src + (size_t)b * NE);
        t0 += (int)v.x; t1 += (int)v.y; t2 += (int)v.z; t3 += (int)v.w;
        if (b < bid) { b0 += (int)v.x; b1 += (int)v.y; b2 += (int)v.z; b3 += (int)v.w; }
      }
    }
    int* pt = part + bg * 512 + eg * 4;
    pt[0] = t0; pt[1] = t1; pt[2] = t2; pt[3] = t3;
    pt[256] = b0; pt[257] = b1; pt[258] = b2; pt[259] = b3;
  }
  __syncthreads();
  int before = 0;
  if (tid < NE) {
    int tot = 0;
#pragma unroll
    for (int g = 0; g < 8; ++g) { tot += part[g * 512 + tid]; before += part[g * 512 + 256 + tid]; }
    const int pc = (tot + 255) & ~255;
    const int lane = tid & 63;
    int inc = pc;
#pragma unroll
    for (int o = 1; o < 64; o <<= 1) { const int n = shl_i(inc, lane - o); if (lane >= o) inc += n; }
    ps[tid + 1] = inc;
    if (lane == 63) cur[tid >> 6] = inc;
  }
  __syncthreads();
  if (tid < NE) {
    const int w = tid >> 6;
    int offs = 0;
#pragma unroll
    for (int k = 0; k < 3; ++k) offs += (k < w) ? cur[k] : 0;
    ps[tid + 1] += offs;
    if (tid == 0) ps[0] = 0;
  }
  __syncthreads();
  if (tid < NE) {
    unsigned short* te = (unsigned short*)(smem + LDS_TILE_E);
    for (int t = ps[tid] >> 8; t < (ps[tid + 1] >> 8); ++t) te[t] = (unsigned short)tid;
  }
  if (tid < NE) cur[tid] = ps[tid] + before;
  if (bid == 0 && tid <= NE) p.w.pad_start()[tid] = ps[tid];
  __syncthreads();
  const int tpb = (ntok + nblk - 1) / nblk;
  for (int i = tid; i < tpb * TOPK; i += 512) {
    const int gi = bid * tpb * TOPK + i;
    if (gi >= ntok * TOPK) break;
    const int e = p.w.tok_e()[gi];
    const int slot = atomicAdd(&cur[e], 1);
    p.w.slot_tok()[slot] = gi >> 3;
    p.w.tok_slot()[gi] = slot;
  }
}

__device__ __forceinline__ void ph_combine(const MP& p, int l, int mrows, bool last, int bid, int nblk) {
  const int lane = tid_opaque() & 63, wave = tid_opaque() >> 6;
  const float* modl = p.w.mod() + (size_t)l * 17 * 6 * D;
  for (int it = bid; it * 8 < mrows; it += nblk) {
    const int row = it * 8 + wave;
    const int b = row_batch(row);
    f32x4 v[4], acc[4];
    row_load(p.w.xs() + (size_t)row * D, lane, v);
#pragma unroll
    for (int j = 0; j < 4; ++j) acc[j] = (f32x4){0.f, 0.f, 0.f, 0.f};
    int sl = 0; float gt = 0.f;
    if (lane < TOPK) { sl = p.w.tok_slot()[row * TOPK + lane]; gt = p.w.tok_gate()[row * TOPK + lane]; }
#pragma unroll
    for (int k = 0; k < TOPK; ++k) {
      const int s = shl_i(sl, k);
      const float gk = shl_f(gt, k);
      const unsigned char* yr = p.w.ybuf() + (size_t)s * D + lane * 4;
#pragma unroll
      for (int j = 0; j < 4; ++j) {
        const int y = *(const int*)(yr + j * 256);
        const f32x2v lo = __builtin_amdgcn_cvt_pk_f32_fp8(y, false), hi = __builtin_amdgcn_cvt_pk_f32_fp8(y, true);
        acc[j].x += gk * lo.x; acc[j].y += gk * lo.y; acc[j].z += gk * hi.x; acc[j].w += gk * hi.y;
      }
    }
    const float* g2 = modl + (size_t)b * 6 * D + 5 * D;
#pragma unroll
    for (int j = 0; j < 4; ++j) {
      const f32x4 gv = *(const f32x4*)(g2 + j * 256 + lane * 4);
      v[j] += gv * acc[j];
    }
    const float rinv = row_rinv(v, lane);
    if (last) {
#pragma unroll
      for (int j = 0; j < 4; ++j) {
        const f32x4 fg = *(const f32x4*)(p.in.final_g + j * 256 + lane * 4);
        *(f32x4*)(p.out + (size_t)row * D + j * 256 + lane * 4) = v[j] * rinv * fg;
      }
    } else {
#pragma unroll
      for (int j = 0; j < 4; ++j) *(f32x4*)(p.w.xs() + (size_t)row * D + j * 256 + lane * 4) = v[j];
      const float* mb = p.w.mod() + ((size_t)(l + 1) * 17 + b) * 6 * D;
      row_norm_mod_store(v, rinv, p.in.norm1_g + (l + 1) * D, mb, mb + D, lane, p.w.abuf() + (size_t)row * D, p.w.abuf8() + (size_t)row * D);
    }
  }
}

__global__ void __launch_bounds__(512, 2) k_mega(MP p) {
  extern __shared__ __attribute__((aligned(16))) char smem[];
  const int bid = blockIdx.x, nblk = gridDim.x;
  if (tid_opaque() == 0) *(u32x4*)(smem + MEGA_LDS_MAIN) = (u32x4){0u, 0u, 0u, 0u};
  __syncthreads();
  (void)xcd_barrier_post(p.w.bar(), (volatile LAS unsigned*)(smem + MEGA_LDS_MAIN));

  if (threadIdx.x == 0) {
    const unsigned xcc = xb_xcc_id();
    const int rank = atomicAdd(&p.w.ctrl()[CTRL_XR + 16 * xcc], 1);
    *(int*)(smem + MEGA_LDS_MAIN + 12) = rank;
  }
  ph_mod_hid(p, smem, bid, nblk);
  cvt_job(p.in.w_in, p.w.w_in_t(), D, INCOLS, 1, bid, nblk, HYCOLS);
  cvt_job(p.in.w_in + (size_t)D * INCOLS, p.w.w_in_t() + (size_t)WIN_ROWS * D, D, INCOLS, 1, bid, nblk, HYCOLS);
  cvt8_job(p.in.w_in + HYCOLS, p.w.w_g8(), D, INCOLS, 1, bid, nblk, GLACOLS);
  cvt8_job(p.in.w_in + (size_t)D * INCOLS + HYCOLS, p.w.w_g8() + (size_t)GW_ROWS * D, D, INCOLS, 1, bid, nblk, GLACOLS);
  cvt_job(p.in.w_out, p.w.w_out_t(), D, D, DEPTH, bid, nblk);
  cvt_job(p.in.router_w, p.w.router_t(), D, NE, DEPTH, bid, nblk);
  cvt8_job(p.in.sh_w1, p.w.sh1_t(), D, DE, DEPTH, bid, nblk);
  cvt8_job(p.in.sh_w3, p.w.sh3_t(), D, DE, DEPTH, bid, nblk);
  cvt8_job(p.in.sh_w2, p.w.sh2_t(), DE, D, DEPTH, bid, nblk);
  grid_sync(p.w.bar(), smem + MEGA_LDS_MAIN);
  int vb = bid;
  {
    const int rank = *(const int*)(smem + MEGA_LDS_MAIN + 12);
    const unsigned xcc = xb_xcc_id();
    int npop = 0, xidx = 0, cnt0 = -1; bool equal = true;
    for (int j = 0; j < 16; ++j) {
      const int c = p.w.ctrl()[CTRL_XR + 16 * j];
      if (c > 0) {
        if (cnt0 < 0) cnt0 = c; else if (c != cnt0) equal = false;
        if (j < (int)xcc) ++xidx;
        ++npop;
      }
    }
    if (equal && cnt0 > 0 && npop * cnt0 == nblk && rank < cnt0) vb = xidx * cnt0 + rank;
  }
  ph_gtab(p, smem, bid, nblk);
  ph_init_norm1(p, bid, nblk);
  grid_sync(p.w.bar(), smem + MEGA_LDS_MAIN);

  const int vbu = __builtin_amdgcn_readfirstlane(vb);
#pragma unroll 1
  for (int l0 = 0; l0 < DEPTH; ++l0) {
#define LL opq(l0)
    const bool last = (l0 == DEPTH - 1);
    const int mrows = last ? NL : NT;
#define MODL (p.w.mod() + (size_t)LL * 17 * 6 * D)
    {
      G8InZT g; g.wt = p.w.w_in_t() + (size_t)LL * WIN_ROWS * D; g.A = p.w.abuf(); g.zt = p.w.zt(); g.ntok = last ? NL : NT;
      gemm8_run(g, smem, opq(vbu), nblk);
    }
    {
      G8InG g; g.wt = p.w.w_g8() + (size_t)LL * GW_ROWS * D; g.A = p.w.abuf8(); g.zg = p.w.zg();
      gemm8_run(g, smem, opq(vbu), nblk);
    }
    grid_sync(p.w.bar(), smem + MEGA_LDS_MAIN);
    ph_mixer(p, smem, LL, last, opq(bid), nblk);
    grid_sync(p.w.bar(), smem + MEGA_LDS_MAIN);
    ph_gla_out(p, smem, LL, mrows, opq(bid), nblk);
    grid_sync(p.w.bar(), smem + MEGA_LDS_MAIN);
    {
      G8Out g; g.mrows = mrows; g.ymix = p.w.ymix(); g.wt = p.w.w_out_t() + (size_t)LL * D * D; g.modl = MODL; g.xs = p.w.xs();
      gemm8_run(g, smem, opq(vbu), nblk);
    }
    grid_sync(p.w.bar(), smem + MEGA_LDS_MAIN);
    ph_norm2(p, LL, mrows, opq(bid), nblk);
    grid_sync(p.w.bar(), smem + MEGA_LDS_MAIN);
    {
      G8Router g; g.mrows = mrows; g.A = p.w.abuf(); g.rwt = p.w.router_t() + (size_t)LL * NE * D; g.logits = p.w.logits();
      gemm8_run(g, smem, opq(vbu), nblk);
    }
    {
      G8ShUp g; g.mrows = mrows; g.A8 = p.w.abuf8(); g.s1t = p.w.sh1_t() + (size_t)LL * DE * D; g.s3t = p.w.sh3_t() + (size_t)LL * DE * D; g.hs = p.w.hs();
      gemm8_run(g, smem, opq(vbu), nblk);
    }
    grid_sync(p.w.bar(), smem + MEGA_LDS_MAIN);
    ph_route(p, smem, LL, mrows, opq(bid), nblk);
    grid_sync(p.w.bar(), smem + MEGA_LDS_MAIN);
    ph_assign(p, smem, LL, mrows, opq(bid), nblk);
    grid_sync(p.w.bar(), smem + MEGA_LDS_MAIN);
    {
      G8Up g; g.A8 = p.w.abuf8(); g.slot_tok = p.w.slot_tok(); g.pad_start = p.w.pad_start(); g.w1t = p.w.e1_t(); g.w3t = p.w.e3_t(); g.H = p.w.hbuf(); g.tile_e = (const unsigned short*)(smem + LDS_TILE_E);
      gemm8_run(g, smem, opq(vbu), nblk);
    }
    {
      G8ShDown g; g.mrows = mrows; g.hs = p.w.hs(); g.wt = p.w.sh2_t() + (size_t)LL * D * DE; g.modl = MODL; g.xs = p.w.xs();
      gemm8_run(g, smem, opq(vbu), nblk);
    }
    grid_sync(p.w.bar(), smem + MEGA_LDS_MAIN);
    {
      G8Down g; g.H = p.w.hbuf(); g.pad_start = p.w.pad_start(); g.w2t = p.w.e2_t(); g.Y = p.w.ybuf(); g.tile_e = (const unsigned short*)(smem + LDS_TILE_E);
      gemm8_run(g, smem, opq(vbu), nblk);
    }
    grid_sync(p.w.bar(), smem + MEGA_LDS_MAIN);
    ph_combine(p, LL, mrows, last, opq(bid), nblk);
    if (!last) grid_sync(p.w.bar(), smem + MEGA_LDS_MAIN);
  }
#undef LL
#undef MODL
}

static inline size_t align_up(size_t v, size_t a) { return (v + a - 1) / a * a; }

extern "C" void kernel_launch(void* const* d_in, const int* in_sizes, int n_in, void* d_out, int out_size, void* d_ws,
                              size_t ws_size, hipStream_t stream) {
  MP p;
  memset(&p, 0, sizeof(p));
  const float** ip = (const float**)&p.in;
  for (int i = 0; i < 30; ++i) ip[i] = (const float*)d_in[i];
  p.out = (float*)d_out;

  p.w.b = (char*)d_ws;
  const size_t zero_bytes = wso::zero_end;
  (void)ws_size; (void)n_in; (void)in_sizes; (void)out_size;

  static int grid = 0;
  if (!grid) {
    hipFuncSetAttribute((const void*)k_mega, hipFuncAttributeMaxDynamicSharedMemorySize, MEGA_LDS);
    int dev = 0, cus = 0, per_cu = 0;
    hipGetDevice(&dev);
    hipDeviceGetAttribute(&cus, hipDeviceAttributeMultiprocessorCount, dev);
    hipOccupancyMaxActiveBlocksPerMultiprocessor(&per_cu, k_mega, 512, MEGA_LDS);
    if (cus <= 0) cus = 256;
    grid = per_cu >= 1 ? cus : 0;
    if (grid <= 0) grid = 256;
  }
  hipMemsetAsync(d_ws, 0, zero_bytes, stream);
  hipLaunchKernelGGL(k_mega, dim3(grid), dim3(512), MEGA_LDS, stream, p);
}
```

```cpp
#include <hip/hip_runtime.h>
#include <hip/hip_bf16.h>
#include <stdint.h>
#include <string.h>

typedef __hip_bfloat16 bf16;

constexpr int D = 1024, NB = 16, SEQ = 2048, LC = 256, DEPTH = 2;
constexpr int NL = NB * SEQ, NC = NB * LC, NT = NL + NC;
constexpr int HYW = 512, HYCOLS = 1536, GLACOLS = 1568, INCOLS = 3104;
constexpr int NE = 256, TOPK = 8, DE = 256;
constexpr int NSLOT = NT * TOPK + NE * 256;
constexpr float EPS = 1e-6f;
constexpr float HY_MIN_DECAY = 3.0701134573253945f;
constexpr float HY_MAX_DECAY = 15.350567286626973f;
constexpr int GSTR_L = 4096, GSTR_C = 512;
constexpr int WIN_ROWS = HYCOLS;
constexpr int GW_ROWS = 7 * 256;

__device__ __forceinline__ float bf2f(bf16 v) { return __bfloat162float(v); }
__device__ __forceinline__ bf16 f2bf(float v) { return __float2bfloat16(v); }
__device__ __forceinline__ float silu_f(float x) { return x / (1.f + __expf(-x)); }
__device__ __forceinline__ float sigmoid_f(float x) { return 1.f / (1.f + __expf(-x)); }
__device__ __forceinline__ float logsigmoid_f(float x) { return fminf(x, 0.f) - __logf(1.f + __expf(-fabsf(x))); }

__device__ __forceinline__ float shx_f(float v, int mask, int lane) { return __int_as_float(__builtin_amdgcn_ds_bpermute((lane ^ mask) << 2, __float_as_int(v))); }
__device__ __forceinline__ int shx_i(int v, int mask, int lane) { return __builtin_amdgcn_ds_bpermute((lane ^ mask) << 2, v); }
__device__ __forceinline__ float shl_f(float v, int src) { return __int_as_float(__builtin_amdgcn_ds_bpermute(src << 2, __float_as_int(v))); }
__device__ __forceinline__ int shl_i(int v, int src) { return __builtin_amdgcn_ds_bpermute(src << 2, v); }
__device__ __forceinline__ float wave_sum(float v, int lane) {
#pragma unroll
  for (int o = 32; o > 0; o >>= 1) v += shx_f(v, o, lane);
  return v;
}

struct Inputs {
  const float *x, *c, *ctx, *c_ctx, *ada_w, *ada_b, *norm1_g, *norm2_g, *w_in, *w_out, *hy_conv_w, *hy_conv_b,
      *hy_f_w1, *hy_f_b1, *hy_f_w2, *hy_f_b2, *hy_f_w3, *hy_skip, *gla_wa2, *gla_ba2, *gla_norm_g, *router_w,
      *router_b, *exp_w1, *exp_w3, *exp_w2, *sh_w1, *sh_w3, *sh_w2, *final_g;
};

__device__ __forceinline__ int opq(int v) { asm volatile("" : "+s"(v)); return v; }
__device__ __forceinline__ int tid_opaque() { int t = threadIdx.x; asm volatile("" : "+v"(t)); return t; }
__device__ __forceinline__ int row_batch(int row) { return row < NL ? (row >> 11) : 16; }

#define XB_TMO      128
#define XB_XCNT(j)  (256  + 64 * (j))
#define XB_XSUB(j)  (1280 + 64 * (j))
#define XB_XGEN(j)  (2304 + 64 * (j))
#define XB_TOP      3328
#define XB_TOPGEN   3392
#define XCD_BAR_WORDS 3456
#define XB_SPIN_CAP (1u << 18)
#define LAS __attribute__((address_space(3)))

__device__ __forceinline__ unsigned xb_ld(unsigned* p)              { return __hip_atomic_load(p, __ATOMIC_RELAXED, __HIP_MEMORY_SCOPE_AGENT); }
__device__ __forceinline__ unsigned xb_add(unsigned* p, unsigned v) { return __hip_atomic_fetch_add(p, v, __ATOMIC_RELAXED, __HIP_MEMORY_SCOPE_AGENT); }
__device__ __forceinline__ unsigned xb_xcc_id() { return (unsigned)__builtin_amdgcn_s_getreg((3 << 11) | 20) & 0xFu; }
#define XB_SPIN(cond, bar) do { unsigned _sp = 0; while (cond) { __builtin_amdgcn_s_sleep(1); \
    if ((++_sp & 255u) == 0u) { if (xb_ld(&(bar)[XB_TMO])) break; if (_sp > XB_SPIN_CAP) { atomicAdd(&(bar)[XB_TMO], 1u); break; } } } } while (0)

struct XcdBarrier {
    unsigned* bar; unsigned x;
    volatile LAS unsigned* st;
};

__device__ __forceinline__ XcdBarrier xcd_barrier_post(unsigned* bar, volatile LAS unsigned* st) {
    XcdBarrier b; b.bar = bar; b.x = xb_xcc_id(); b.st = st;
    if (threadIdx.x == 0) (void)xb_add(&bar[XB_XCNT(b.x)], 1u);
    return b;
}
__device__ __forceinline__ void xcd_barrier_complete(unsigned* bar, unsigned x, unsigned& nloc, unsigned& nx) {
    const unsigned G = gridDim.x * gridDim.y * gridDim.z;
    unsigned sum, cnt, mine, sp = 0u;
    for (;;) {
        sum = 0u; cnt = 0u; mine = 0u;
#pragma unroll
        for (unsigned j = 0; j < 16; ++j) { const unsigned c = xb_ld(&bar[XB_XCNT(j)]); sum += c; cnt += (c > 0u) ? 1u : 0u; mine = (j == x) ? c : mine; }
        if (sum == G) break;
        __builtin_amdgcn_s_sleep(1);
        if ((++sp & 255u) == 0u) { if (xb_ld(&bar[XB_TMO])) break; if (sp > XB_SPIN_CAP) { atomicAdd(&bar[XB_TMO], 1u); break; } }
    }
    nloc = mine > 0u ? mine : 1u; nx = cnt > 0u ? cnt : 1u;
}
__device__ __forceinline__ void xcd_barrier(const XcdBarrier& b) {
    asm volatile("s_waitcnt vmcnt(0)" ::: "memory");
    __syncthreads();
    if (threadIdx.x == 0) {
        unsigned* bar = b.bar;
        __builtin_amdgcn_s_waitcnt(0);
        unsigned nloc = b.st[0], nx = b.st[1];
        if (nloc == 0u) { xcd_barrier_complete(bar, b.x, nloc, nx); b.st[0] = nloc; b.st[1] = nx; }
        const unsigned old = xb_add(&bar[XB_XSUB(b.x)], 1u);
        const unsigned gen = old / nloc;
        if (old + 1u == (gen + 1u) * nloc) {
            __builtin_amdgcn_fence(__ATOMIC_RELEASE, "agent");
            asm volatile("s_waitcnt vmcnt(0)" ::: "memory");
            const unsigned og = xb_add(&bar[XB_TOP], 1u);
            const unsigned tg = og / nx;
            if (og + 1u == (tg + 1u) * nx) xb_add(&bar[XB_TOPGEN], 1u);
            else XB_SPIN(xb_ld(&bar[XB_TOPGEN]) == tg, bar);
            __builtin_amdgcn_fence(__ATOMIC_ACQUIRE, "agent");
            xb_add(&bar[XB_XGEN(b.x)], 1u);
            asm volatile("s_waitcnt vmcnt(0)" ::: "memory");
        } else {
            XB_SPIN(xb_ld(&bar[XB_XGEN(b.x)]) == gen, bar);
            __builtin_amdgcn_fence(__ATOMIC_ACQUIRE, "agent");
            asm volatile("s_waitcnt vmcnt(0)" ::: "memory");
        }
    }
    __syncthreads();
}

__device__ __forceinline__ void grid_sync(unsigned* bar0, char* stw) {
  unsigned* q = bar0;
  asm volatile("" : "+s"(q));
  XcdBarrier b; b.bar = q; b.x = xb_xcc_id(); b.st = (volatile LAS unsigned*)stw;
  xcd_barrier(b);
}

typedef __attribute__((ext_vector_type(8))) __bf16 bf16x8;
typedef __attribute__((ext_vector_type(16))) float f32x16;
typedef __attribute__((ext_vector_type(4))) float f32x4;
typedef __attribute__((ext_vector_type(2))) float f32x2v;
typedef __attribute__((ext_vector_type(2))) __bf16 bf16x2v;
typedef __attribute__((ext_vector_type(4))) unsigned int u32x4;
typedef __attribute__((ext_vector_type(2))) unsigned int u32x2;

__device__ __forceinline__ unsigned pack_bf16(float a, float b) {
  f32x2v v = {a, b};
  return __builtin_bit_cast(unsigned, __builtin_convertvector(v, bf16x2v));
}
__device__ __forceinline__ f32x4 xs_load4(const bf16* p) {
  const u32x2 w = *(const u32x2*)p;
  return (f32x4){__uint_as_float(w.x << 16), __uint_as_float(w.x & 0xffff0000u), __uint_as_float(w.y << 16), __uint_as_float(w.y & 0xffff0000u)};
}
__device__ __forceinline__ void xs_store4(bf16* p, const f32x4 v) {
  u32x2 w; w.x = pack_bf16(v.x, v.y); w.y = pack_bf16(v.z, v.w);
  *(u32x2*)p = w;
}
__device__ __forceinline__ int swz(int row, int chunk) { return row * 128 + ((chunk ^ ((row >> 1) & 7)) << 4); }
__device__ __forceinline__ int rowmap(int reg, int lh) { return (reg & 3) + 8 * (reg >> 2) + 4 * lh; }

__device__ __forceinline__ int find_group(const int* __restrict__ pad_start, int m0) {
  int lo = 0, hi = NE - 1;
  while (lo < hi) {
    int mid = (lo + hi + 1) >> 1;
    if (pad_start[mid] <= m0) lo = mid; else hi = mid - 1;
  }
  return lo;
}

__device__ __forceinline__ void cvt_wave_tile(const float* __restrict__ src, bf16* __restrict__ dst, int K, int N, int kt, int ntile, int lane) {
  const int k0 = kt * 64 + (lane & 7) * 8, n0 = ntile * 32 + (lane >> 3) * 4;
  const float* s = src + (size_t)k0 * N + n0;
  const f32x4 v0 = __builtin_nontemporal_load((const f32x4*)(s)), v1 = __builtin_nontemporal_load((const f32x4*)(s + (size_t)N));
  const f32x4 v2 = __builtin_nontemporal_load((const f32x4*)(s + (size_t)2 * N)), v3 = __builtin_nontemporal_load((const f32x4*)(s + (size_t)3 * N));
  const f32x4 v4 = __builtin_nontemporal_load((const f32x4*)(s + (size_t)4 * N)), v5 = __builtin_nontemporal_load((const f32x4*)(s + (size_t)5 * N));
  const f32x4 v6 = __builtin_nontemporal_load((const f32x4*)(s + (size_t)6 * N)), v7 = __builtin_nontemporal_load((const f32x4*)(s + (size_t)7 * N));
  bf16* d = dst + (size_t)n0 * K + k0;
  *(u32x4*)(d) = (u32x4){pack_bf16(v0.x, v1.x), pack_bf16(v2.x, v3.x), pack_bf16(v4.x, v5.x), pack_bf16(v6.x, v7.x)};
  *(u32x4*)(d + (size_t)K) = (u32x4){pack_bf16(v0.y, v1.y), pack_bf16(v2.y, v3.y), pack_bf16(v4.y, v5.y), pack_bf16(v6.y, v7.y)};
  *(u32x4*)(d + (size_t)2 * K) = (u32x4){pack_bf16(v0.z, v1.z), pack_bf16(v2.z, v3.z), pack_bf16(v4.z, v5.z), pack_bf16(v6.z, v7.z)};
  *(u32x4*)(d + (size_t)3 * K) = (u32x4){pack_bf16(v0.w, v1.w), pack_bf16(v2.w, v3.w), pack_bf16(v4.w, v5.w), pack_bf16(v6.w, v7.w)};
}
typedef __attribute__((ext_vector_type(8))) int i32x8;
typedef __attribute__((ext_vector_type(4))) int i32x4;
__device__ __forceinline__ float clamp_fp8(float x) { return __builtin_amdgcn_fmed3f(x, -448.0f, 448.0f); }
__device__ __forceinline__ unsigned pk4_fp8(float a, float b, float c, float d) {
  a = clamp_fp8(a); b = clamp_fp8(b); c = clamp_fp8(c); d = clamp_fp8(d);
  int w = 0;
  w = __builtin_amdgcn_cvt_pk_fp8_f32(a, b, w, false);
  w = __builtin_amdgcn_cvt_pk_fp8_f32(c, d, w, true);
  return (unsigned)w;
}
__device__ __forceinline__ void cvt8_wave_tile(const float* __restrict__ src, unsigned char* __restrict__ dst, int K, int N, int kt, int ntile, int lane) {
  const int k0 = kt * 64 + (lane & 7) * 8, n0 = ntile * 32 + (lane >> 3) * 4;
  const float* s = src + (size_t)k0 * N + n0;
  const float sc = 16.0f;
  const f32x4 v0 = __builtin_nontemporal_load((const f32x4*)(s)) * sc, v1 = __builtin_nontemporal_load((const f32x4*)(s + (size_t)N)) * sc;
  const f32x4 v2 = __builtin_nontemporal_load((const f32x4*)(s + (size_t)2 * N)) * sc, v3 = __builtin_nontemporal_load((const f32x4*)(s + (size_t)3 * N)) * sc;
  const f32x4 v4 = __builtin_nontemporal_load((const f32x4*)(s + (size_t)4 * N)) * sc, v5 = __builtin_nontemporal_load((const f32x4*)(s + (size_t)5 * N)) * sc;
  const f32x4 v6 = __builtin_nontemporal_load((const f32x4*)(s + (size_t)6 * N)) * sc, v7 = __builtin_nontemporal_load((const f32x4*)(s + (size_t)7 * N)) * sc;
  unsigned char* d = dst + (size_t)n0 * K + k0;
  *(u32x2*)(d) = (u32x2){pk4_fp8(v0.x, v1.x, v2.x, v3.x), pk4_fp8(v4.x, v5.x, v6.x, v7.x)};
  *(u32x2*)(d + (size_t)K) = (u32x2){pk4_fp8(v0.y, v1.y, v2.y, v3.y), pk4_fp8(v4.y, v5.y, v6.y, v7.y)};
  *(u32x2*)(d + (size_t)2 * K) = (u32x2){pk4_fp8(v0.z, v1.z, v2.z, v3.z), pk4_fp8(v4.z, v5.z, v6.z, v7.z)};
  *(u32x2*)(d + (size_t)3 * K) = (u32x2){pk4_fp8(v0.w, v1.w, v2.w, v3.w), pk4_fp8(v4.w, v5.w, v6.w, v7.w)};
}
__device__ __forceinline__ void cvt8_job(const float* __restrict__ src, unsigned char* __restrict__ dst, int K, int N, int nmat, int bid, int nblk, int W = 0) {
  const int tid = tid_opaque(), lane = tid & 63, wave = tid >> 6;
  if (W == 0) W = N;
  const int tk = K >> 6, tn = W >> 5, per = tk * tn;
  const int total = per * nmat;
  for (int u = bid * 8 + wave; u < total; u += nblk * 8) {
    const int mat = u / per, r = u - mat * per;
    const int ntile = r / tk, kt = r - ntile * tk;
    cvt8_wave_tile(src + (size_t)mat * K * N, dst + (size_t)mat * K * W, K, N, kt, ntile, lane);
  }
}

__device__ __forceinline__ void cvt_job(const float* __restrict__ src, bf16* __restrict__ dst, int K, int N, int nmat, int bid, int nblk, int W = 0) {
  const int tid = tid_opaque(), lane = tid & 63, wave = tid >> 6;
  if (W == 0) W = N;
  const int tk = K >> 6, tn = W >> 5, per = tk * tn;
  const int total = per * nmat;
  for (int u = bid * 8 + wave; u < total; u += nblk * 8) {
    const int mat = u / per, r = u - mat * per;
    const int ntile = r / tk, kt = r - ntile * tk;
    cvt_wave_tile(src + (size_t)mat * K * N, dst + (size_t)mat * K * W, K, N, kt, ntile, lane);
  }
}

constexpr int G8_HT = 128 * 64;
constexpr int G8_LDS = 8 * G8_HT * 2;

__device__ __forceinline__ int g8_lds_byte(int r, int c) {
  int st = (r >> 4) * 2 + (c >> 5), rr = r & 15, cc = c & 31, ob = rr * 64 + cc * 2;
  return st * 1024 + (ob ^ (((ob >> 9) & 1) << 5));
}
__device__ __forceinline__ void g8_stage_rc(int b, int& R, int& C) {
  int st = b / 1024, sb = b % 1024, sw = sb ^ (((sb >> 9) & 1) << 5);
  R = (st >> 1) * 16 + sw / 64; C = (st & 1) * 32 + (sw % 64) / 2;
}

typedef f32x4 g8acc_t[2][2][4][2];

template <class P>
__device__ __forceinline__ void gemm8_run(const P& p, char* smem, int bid, int nblk) {
  const int ntl = __builtin_amdgcn_readfirstlane(p.ntiles());
  if (bid >= ntl) return;
  bf16* shm = (bf16*)smem;
#define SA(b, h) (shm + ((b) * 2 + (h)) * G8_HT)
#define SB(b, h) (shm + (4 + (b) * 2 + (h)) * G8_HT)
#define GLDS(SRC, DST) __builtin_amdgcn_global_load_lds((const unsigned*)(SRC), (unsigned*)(DST), 16, 0, 0)
#define STAGE_A(PP, BASE, KT) do { GLDS((BASE) + (oa + (KT) * 64), (char*)(PP) + ldsd); GLDS((BASE) + 64 * P::A_PITCH + (oa + (KT) * 64), (char*)(PP) + ldsd + 8192); } while (0)
#define STAGE_B(PP, BASE, OB, KT) do { \
    if constexpr (P::B_GATHER) { GLDS((BASE) + ((((OB) & 0xffffu) * (unsigned)P::B_PITCH + cc) + (KT) * 64), (char*)(PP) + ldsd); \
                                 GLDS((BASE) + ((((OB) >> 16) * (unsigned)P::B_PITCH + cc) + (KT) * 64), (char*)(PP) + ldsd + 8192); } \
    else { GLDS((BASE) + ((OB) + (KT) * 64), (char*)(PP) + ldsd); GLDS((BASE) + 64 * P::B_PITCH + ((OB) + (KT) * 64), (char*)(PP) + ldsd + 8192); } } while (0)
#define LDA(dst, b, h) for (int m = 0; m < 4; ++m) \
    dst[m] = __builtin_shufflevector(*reinterpret_cast<const i32x4*>((char*)SA(b, h) + aoff + m * 2048), \
                                     *reinterpret_cast<const i32x4*>((char*)SA(b, h) + aoff + m * 2048 + 1024), 0, 1, 2, 3, 4, 5, 6, 7)
#define LDB(dst, b, h) for (int n = 0; n < 2; ++n) \
    dst[n] = __builtin_shufflevector(*reinterpret_cast<const i32x4*>((char*)SB(b, h) + boff + n * 2048), \
                                     *reinterpret_cast<const i32x4*>((char*)SB(b, h) + boff + n * 2048 + 1024), 0, 1, 2, 3, 4, 5, 6, 7)
#define FRAG_LO(x) __builtin_bit_cast(bf16x8, __builtin_shufflevector(x, x, 0, 1, 2, 3))
#define FRAG_HI(x) __builtin_bit_cast(bf16x8, __builtin_shufflevector(x, x, 4, 5, 6, 7))
#define MMA(ai, bj, At_, Bt_) do { __builtin_amdgcn_s_setprio(1); \
    if constexpr (P::FP8) { \
      for (int m = 0; m < 4; ++m) for (int n = 0; n < 2; ++n) \
        asm volatile("v_mfma_f32_16x16x128_f8f6f4 %0, %1, %2, %0" \
                     : "+v"(acc[ai][bj][m][n]) : "v"(At_[m]), "v"(Bt_[n])); \
    } else { \
      for (int m = 0; m < 4; ++m) for (int n = 0; n < 2; ++n) { \
        acc[ai][bj][m][n] = __builtin_amdgcn_mfma_f32_16x16x32_bf16(FRAG_LO(At_[m]), FRAG_LO(Bt_[n]), acc[ai][bj][m][n], 0, 0, 0); \
        acc[ai][bj][m][n] = __builtin_amdgcn_mfma_f32_16x16x32_bf16(FRAG_HI(At_[m]), FRAG_HI(Bt_[n]), acc[ai][bj][m][n], 0, 0, 0); } \
    } \
    __builtin_amdgcn_s_setprio(0); } while (0)
#define WAIT_V(n) asm volatile("s_waitcnt vmcnt(" #n ")" ::: "memory")
#define WAIT_L(n) asm volatile("s_waitcnt lgkmcnt(" #n ")" ::: "memory")
#define BAR __builtin_amdgcn_s_barrier()
#define SCHED __builtin_amdgcn_sched_barrier(0)

  typename P::Ctx cur, nxt;
  p.tile(bid, cur);
  int aoff, boff, ldsd;
  unsigned oa, cc, ob0, ob1;
  bool wr1;
  {
    const int tid = tid_opaque();
    const int wid = tid >> 6, lane = tid & 63, wr = wid >> 2, wc = wid & 3, fr = lane & 15, fq = lane >> 4;
    aoff = g8_lds_byte(wr * 64 + fr, fq * 8); boff = g8_lds_byte(wc * 32 + fr, fq * 8);
    ldsd = tid * 16; wr1 = (wr == 1);
    int R0, C0;
    g8_stage_rc(tid * 16, R0, C0);
    cc = C0;
    oa = (((R0 >> 2) & 3) * 16 + (R0 >> 4) * 4 + (R0 & 3)) * P::A_PITCH + C0;
    if constexpr (P::B_GATHER) {
      ob0 = p.b_row(cur, 0, R0) | (p.b_row(cur, 0, R0 + 64) << 16);
      ob1 = p.b_row(cur, 1, R0) | (p.b_row(cur, 1, R0 + 64) << 16);
    } else { ob0 = R0 * P::B_PITCH + C0; ob1 = ob0; }
  }
  const bf16* ca0 = p.a_base(cur, 0);
  const bf16* ca1 = p.a_base(cur, 1);
  const bf16* cb0 = p.b_base(cur, 0);
  const bf16* cb1 = p.b_base(cur, 1);

  g8acc_t acc;
#pragma unroll
  for (int a0 = 0; a0 < 2; ++a0)
#pragma unroll
    for (int b0 = 0; b0 < 2; ++b0)
#pragma unroll
      for (int m = 0; m < 4; ++m)
#pragma unroll
        for (int n = 0; n < 2; ++n) acc[a0][b0][m][n] = (f32x4){0.f, 0.f, 0.f, 0.f};
  i32x8 At[4], B0[2], B1[2];
  const int mxs = 0x7F7F7F7F;
  const int nt = opq(P::NKT);
  STAGE_B(SB(0, 0), cb0, ob0, 0); STAGE_A(SA(0, 0), ca0, 0);
  STAGE_B(SB(0, 1), cb1, ob1, 0); STAGE_A(SA(0, 1), ca1, 0);
  if (wr1) BAR;
  WAIT_V(4); BAR;
  STAGE_B(SB(1, 0), cb0, ob0, 1); STAGE_A(SA(1, 0), ca0, 1); STAGE_B(SB(1, 1), cb1, ob1, 1);
  WAIT_V(6); BAR;
#pragma unroll 1
  for (int idx = bid;;) {
    const int nidx = idx + nblk;
    const bool has_next = nidx < ntl;
    if (has_next) p.tile(nidx, nxt); else nxt = cur;
    const bf16* na0 = p.a_base(nxt, 0);
    const bf16* na1 = p.a_base(nxt, 1);
    const bf16* nb0 = p.b_base(nxt, 0);
    const bf16* nb1 = p.b_base(nxt, 1);
    unsigned nob0 = ob0, nob1 = ob1;
    if constexpr (P::B_GATHER) {
      const int t2 = tid_opaque();
      int R0, C0;
      g8_stage_rc(t2 * 16, R0, C0);
      nob0 = p.b_row(nxt, 0, R0) | (p.b_row(nxt, 0, R0 + 64) << 16);
      nob1 = p.b_row(nxt, 1, R0) | (p.b_row(nxt, 1, R0 + 64) << 16);
    }
#pragma unroll 1
    for (int t = 0; t < nt; t += 2) {
      const bool last = (t == nt - 2);
      const bf16* a2h0 = last ? na0 : ca0; const bf16* a2h1 = last ? na1 : ca1;
      const bf16* b2h0 = last ? nb0 : cb0; const bf16* b2h1 = last ? nb1 : cb1;
      const int k2 = last ? 0 : t + 2;
      const unsigned q0 = last ? nob0 : ob0, q1 = last ? nob1 : ob1;
      LDB(B0, 0, 0); SCHED; LDA(At, 0, 0); STAGE_A(SA(1, 1), ca1, t + 1);
      WAIT_L(8); BAR; WAIT_L(0); MMA(0, 0, At, B0); BAR; SCHED;
      LDB(B1, 0, 1); STAGE_B(SB(0, 0), b2h0, q0, k2);
      BAR; WAIT_L(0); MMA(0, 1, At, B1); BAR;
      LDA(At, 0, 1); STAGE_A(SA(0, 0), a2h0, k2);
      BAR; WAIT_L(0); MMA(1, 0, At, B0); BAR; SCHED;
      STAGE_B(SB(0, 1), b2h1, q1, k2);
      WAIT_V(6); BAR; MMA(1, 1, At, B1); BAR;
      LDB(B0, 1, 0); SCHED; LDA(At, 1, 0); STAGE_A(SA(0, 1), a2h1, k2);
      WAIT_L(8); BAR; WAIT_L(0); MMA(0, 0, At, B0); BAR; SCHED;
      LDB(B1, 1, 1); STAGE_B(SB(1, 0), b2h0, q0, k2 + 1);
      BAR; WAIT_L(0); MMA(0, 1, At, B1); BAR;
      LDA(At, 1, 1); STAGE_A(SA(1, 0), a2h0, k2 + 1);
      BAR; WAIT_L(0); MMA(1, 0, At, B0); BAR; SCHED;
      STAGE_B(SB(1, 1), b2h1, q1, k2 + 1);
      WAIT_V(6); BAR; MMA(1, 1, At, B1); BAR;
    }
    if constexpr (P::FP8) asm volatile("s_nop 15\n\ts_nop 15" ::: "memory");
    {
      const int t3 = tid_opaque();
      const int wid = t3 >> 6, lane = t3 & 63;
      p.epi(cur, acc, wid >> 2, wid & 3, lane & 15, lane >> 4);
    }
    if (!has_next) break;
#pragma unroll
    for (int a0 = 0; a0 < 2; ++a0)
#pragma unroll
      for (int b0 = 0; b0 < 2; ++b0)
#pragma unroll
        for (int m = 0; m < 4; ++m)
#pragma unroll
          for (int n = 0; n < 2; ++n) acc[a0][b0][m][n] = (f32x4){0.f, 0.f, 0.f, 0.f};
    cur = nxt; ca0 = na0; ca1 = na1; cb0 = nb0; cb1 = nb1;
    ob0 = nob0; ob1 = nob1;
    idx = nidx;
  }
  WAIT_V(0);
  if (!wr1) BAR;
  BAR;
#undef SA
#undef SB
#undef GLDS
#undef STAGE_A
#undef STAGE_B
#undef LDA
#undef LDB
#undef MMA
#undef FRAG_LO
#undef FRAG_HI
#undef WAIT_V
#undef WAIT_L
#undef BAR
#undef SCHED
}

#define G8_FOR_BLK(AI, BJ, M, N) \
  _Pragma("unroll") for (int AI = 0; AI < 2; ++AI) _Pragma("unroll") for (int BJ = 0; BJ < 2; ++BJ) \
  _Pragma("unroll") for (int M = 0; M < 4; ++M) _Pragma("unroll") for (int N = 0; N < 2; ++N)
#define G8_AIDX(AI, M) ((AI) * 128 + wr * 64 + fq * 16 + (M) * 4)
#define G8_BIDX(BJ, N) ((BJ) * 128 + wc * 32 + (N) * 16 + fr)
__device__ __forceinline__ u32x2 pack4_bf16(const f32x4 v) { return (u32x2){pack_bf16(v.x, v.y), pack_bf16(v.z, v.w)}; }
__device__ __forceinline__ unsigned pack4_fp8(const f32x4 v) { return pk4_fp8(v.x, v.y, v.z, v.w); }
__device__ __forceinline__ u32x4 pack8_bf16(const f32x4 a, const f32x4 b) { return (u32x4){pack_bf16(a.x, a.y), pack_bf16(a.z, a.w), pack_bf16(b.x, b.y), pack_bf16(b.z, b.w)}; }
#define G8_FOR_BLK2(AI, BJ, M2, N) \
  _Pragma("unroll") for (int AI = 0; AI < 2; ++AI) _Pragma("unroll") for (int BJ = 0; BJ < 2; ++BJ) \
  _Pragma("unroll") for (int M2 = 0; M2 < 4; M2 += 2) _Pragma("unroll") for (int N = 0; N < 2; ++N)

struct G8InZT {
  static constexpr int NKT = 16; static constexpr bool B_GATHER = false; static constexpr bool FP8 = false; static constexpr int B_PITCH = D; static constexpr int A_PITCH = D;
  template <class C_> __device__ unsigned b_row(const C_&, int, int) const { return 0u; }
  struct Ctx { int t0, z0; };
  const bf16* wt; const bf16* A; bf16* zt; int ntok;
  __device__ int ntiles() const { return 6 * (ntok / 256); }
  __device__ void tile(int idx, Ctx& c) const { int tt = idx / 6; c.z0 = (idx - tt * 6) * 256; c.t0 = tt * 256; }
  __device__ const bf16* a_base(const Ctx& c, int h) const { return A + (size_t)(c.t0 + h * 128) * D; }
  __device__ unsigned a_off(const Ctx&, int, int r) const { return r * D; }
  __device__ const bf16* b_base(const Ctx& c, int h) const { return wt + (size_t)(c.z0 + h * 128) * D; }
  __device__ unsigned b_off(const Ctx&, int, int r) const { return r * D; }
  __device__ void epi(const Ctx& c, g8acc_t& acc, int wr, int wc, int fr, int fq) const {
    G8_FOR_BLK2(ai, bj, m, n) {
      const int tok = c.t0 + G8_AIDX(ai, m), z = c.z0 + G8_BIDX(bj, n);
      *(u32x4*)(zt + (size_t)z * NT + tok) = pack8_bf16(acc[ai][bj][m][n], acc[ai][bj][m + 1][n]);
    }
  }
};
struct G8InG {
  static constexpr int NKT = 8; static constexpr bool B_GATHER = false; static constexpr bool FP8 = true; static constexpr int B_PITCH = D / 2; static constexpr int A_PITCH = D / 2;
  template <class C_> __device__ unsigned b_row(const C_&, int, int) const { return 0u; }
  struct Ctx { int c0, t0; };
  const unsigned char* wt; const unsigned char* A; bf16* zg;
  __device__ int ntiles() const { return 7 * (NT / 256); }
  __device__ void tile(int idx, Ctx& c) const { int tt = idx / 7; c.t0 = tt * 256; c.c0 = (idx - tt * 7) * 256; }
  __device__ const bf16* a_base(const Ctx& c, int h) const { return (const bf16*)(wt + (size_t)(c.c0 + h * 128) * D); }
  __device__ unsigned a_off(const Ctx&, int, int r) const { return r * (D / 2); }
  __device__ const bf16* b_base(const Ctx& c, int h) const { return (const bf16*)(A + (size_t)(c.t0 + h * 128) * D); }
  __device__ unsigned b_off(const Ctx&, int, int r) const { return r * (D / 2); }
  __device__ void epi(const Ctx& c, g8acc_t& acc, int wr, int wc, int fr, int fq) const {
    const float isc = 1.0f / 16.0f;
    G8_FOR_BLK2(ai, bj, m, n) {
      const int col = c.c0 + G8_AIDX(ai, m), tok = c.t0 + G8_BIDX(bj, n);
      if (col < GLACOLS) *(u32x4*)(zg + (size_t)tok * GLACOLS + col) = pack8_bf16(acc[ai][bj][m][n] * isc, acc[ai][bj][m + 1][n] * isc);
    }
  }
};
struct G8Out {
  static constexpr int NKT = 16; static constexpr bool B_GATHER = false; static constexpr bool FP8 = false; static constexpr int B_PITCH = D; static constexpr int A_PITCH = D;
  template <class C_> __device__ unsigned b_row(const C_&, int, int) const { return 0u; }
  struct Ctx { int c0, t0; };
  int mrows; const bf16* ymix; const bf16* wt; const float* modl; bf16* xs;
  __device__ int ntiles() const { return (mrows / 256) * 4; }
  __device__ void tile(int idx, Ctx& c) const { c.t0 = (idx >> 2) * 256; c.c0 = (idx & 3) * 256; }
  __device__ const bf16* a_base(const Ctx& c, int h) const { return wt + (size_t)(c.c0 + h * 128) * D; }
  __device__ unsigned a_off(const Ctx&, int, int r) const { return r * D; }
  __device__ const bf16* b_base(const Ctx& c, int h) const { return ymix + (size_t)(c.t0 + h * 128) * D; }
  __device__ unsigned b_off(const Ctx&, int, int r) const { return r * D; }
  __device__ void epi(const Ctx& c, g8acc_t& acc, int wr, int wc, int fr, int fq) const {
    const float* g1 = modl + (size_t)row_batch(c.t0) * 6 * D + 2 * D;
    G8_FOR_BLK(ai, bj, m, n) {
      const int col = c.c0 + G8_AIDX(ai, m), tok = c.t0 + G8_BIDX(bj, n);
      bf16* xp = xs + (size_t)tok * D + col;
      xs_store4(xp, xs_load4(xp) + *(const f32x4*)(g1 + col) * acc[ai][bj][m][n]);
    }
  }
};
struct G8Router {
  static constexpr int NKT = 16; static constexpr bool B_GATHER = false; static constexpr bool FP8 = false; static constexpr int B_PITCH = D; static constexpr int A_PITCH = D;
  template <class C_> __device__ unsigned b_row(const C_&, int, int) const { return 0u; }
  struct Ctx { int t0; };
  int mrows; const bf16* A; const bf16* rwt; float* logits;
  __device__ int ntiles() const { return mrows / 256; }
  __device__ void tile(int idx, Ctx& c) const { c.t0 = idx * 256; }
  __device__ const bf16* a_base(const Ctx&, int h) const { return rwt + (size_t)(h * 128) * D; }
  __device__ unsigned a_off(const Ctx&, int, int r) const { return r * D; }
  __device__ const bf16* b_base(const Ctx& c, int h) const { return A + (size_t)(c.t0 + h * 128) * D; }
  __device__ unsigned b_off(const Ctx&, int, int r) const { return r * D; }
  __device__ void epi(const Ctx& c, g8acc_t& acc, int wr, int wc, int fr, int fq) const {
    G8_FOR_BLK(ai, bj, m, n) {
      const int e = G8_AIDX(ai, m), tok = c.t0 + G8_BIDX(bj, n);
      *(f32x4*)(logits + (size_t)tok * NE + e) = acc[ai][bj][m][n];
    }
  }
};
struct G8ShUp {
  static constexpr int NKT = 8; static constexpr bool B_GATHER = false; static constexpr bool FP8 = true; static constexpr int B_PITCH = D / 2; static constexpr int A_PITCH = D / 2;
  template <class C_> __device__ unsigned b_row(const C_&, int, int) const { return 0u; }
  struct Ctx { int t0, hb; };
  int mrows; const unsigned char* A8; const unsigned char* s1t; const unsigned char* s3t; unsigned char* hs;
  __device__ int ntiles() const { return (mrows / 256) * 2; }
  __device__ void tile(int idx, Ctx& c) const { c.t0 = (idx >> 1) * 256; c.hb = (idx & 1) * 128; }
  __device__ const bf16* a_base(const Ctx& c, int h) const { return (const bf16*)((h ? s3t : s1t) + (size_t)c.hb * D); }
  __device__ unsigned a_off(const Ctx&, int, int r) const { return r * (D / 2); }
  __device__ const bf16* b_base(const Ctx& c, int h) const { return (const bf16*)(A8 + (size_t)(c.t0 + h * 128) * D); }
  __device__ unsigned b_off(const Ctx&, int, int r) const { return r * (D / 2); }
  __device__ void epi(const Ctx& c, g8acc_t& acc, int wr, int wc, int fr, int fq) const {
    const float isc = 1.0f / 16.0f;
#pragma unroll
    for (int bj = 0; bj < 2; ++bj)
#pragma unroll
      for (int n = 0; n < 2; ++n) {
        const int hcol = c.hb + wr * 64 + fq * 16, tok = c.t0 + G8_BIDX(bj, n);
        u32x4 o;
#pragma unroll
        for (int m = 0; m < 4; ++m) {
          const f32x4 u = acc[0][bj][m][n] * isc, v = acc[1][bj][m][n] * isc;
          const unsigned w = pk4_fp8(silu_f(u.x) * v.x, silu_f(u.y) * v.y, silu_f(u.z) * v.z, silu_f(u.w) * v.w);
          if (m == 0) o.x = w; else if (m == 1) o.y = w; else if (m == 2) o.z = w; else o.w = w;
        }
        *(u32x4*)(hs + (size_t)tok * DE + hcol) = o;
      }
  }
};
struct G8Up {
  static constexpr int NKT = 8; static constexpr bool B_GATHER = true; static constexpr bool FP8 = true; static constexpr int B_PITCH = D / 2; static constexpr int A_PITCH = D / 2;
  struct Ctx { int s0, hb, grp; };
  const unsigned char* A8; const int* slot_tok; const int* pad_start; const unsigned char* w1t; const unsigned char* w3t; unsigned char* H; const unsigned short* tile_e;
  __device__ int ntiles() const { return (pad_start[NE] >> 8) * 2; }
  __device__ void tile(int idx, Ctx& c) const { c.s0 = (idx >> 1) * 256; c.hb = (idx & 1) * 128; c.grp = __builtin_amdgcn_readfirstlane((int)tile_e[idx >> 1]); }
  __device__ const bf16* a_base(const Ctx& c, int h) const { return (const bf16*)((h ? w3t : w1t) + ((size_t)c.grp * DE + c.hb) * D); }
  __device__ unsigned a_off(const Ctx&, int, int r) const { return r * (D / 2); }
  __device__ const bf16* b_base(const Ctx&, int) const { return (const bf16*)A8; }
  __device__ unsigned b_off(const Ctx&, int, int) const { return 0u; }
  __device__ unsigned b_row(const Ctx& c, int h, int r) const { int t = slot_tok[c.s0 + h * 128 + r]; t = (t < 0 || t >= NT) ? 0 : t; return (unsigned)t; }
  __device__ void epi(const Ctx& c, g8acc_t& acc, int wr, int wc, int fr, int fq) const {
    const float isc = 1.0f / 16.0f;
#pragma unroll
    for (int bj = 0; bj < 2; ++bj)
#pragma unroll
      for (int n = 0; n < 2; ++n) {
        const int hcol = c.hb + wr * 64 + fq * 16, slot = c.s0 + G8_BIDX(bj, n);
        u32x4 o;
#pragma unroll
        for (int m = 0; m < 4; ++m) {
          const f32x4 u = acc[0][bj][m][n] * isc, v = acc[1][bj][m][n] * isc;
          const unsigned w = pk4_fp8(silu_f(u.x) * v.x, silu_f(u.y) * v.y, silu_f(u.z) * v.z, silu_f(u.w) * v.w);
          if (m == 0) o.x = w; else if (m == 1) o.y = w; else if (m == 2) o.z = w; else o.w = w;
        }
        *(u32x4*)(H + (size_t)slot * DE + hcol) = o;
      }
  }
};
struct G8ShDown {
  static constexpr int NKT = 2; static constexpr bool B_GATHER = false; static constexpr bool FP8 = true; static constexpr int B_PITCH = DE / 2; static constexpr int A_PITCH = DE / 2;
  template <class C_> __device__ unsigned b_row(const C_&, int, int) const { return 0u; }
  struct Ctx { int c0, t0; };
  int mrows; const unsigned char* hs; const unsigned char* wt; const float* modl; bf16* xs;
  __device__ int ntiles() const { return (mrows / 256) * 4; }
  __device__ void tile(int idx, Ctx& c) const { c.t0 = (idx >> 2) * 256; c.c0 = (idx & 3) * 256; }
  __device__ const bf16* a_base(const Ctx& c, int h) const { return (const bf16*)(wt + (size_t)(c.c0 + h * 128) * DE); }
  __device__ unsigned a_off(const Ctx&, int, int r) const { return r * (DE / 2); }
  __device__ const bf16* b_base(const Ctx& c, int h) const { return (const bf16*)(hs + (size_t)(c.t0 + h * 128) * DE); }
  __device__ unsigned b_off(const Ctx&, int, int r) const { return r * (DE / 2); }
  __device__ void epi(const Ctx& c, g8acc_t& acc, int wr, int wc, int fr, int fq) const {
    const float* g2 = modl + (size_t)row_batch(c.t0) * 6 * D + 5 * D;
    const float isc = 1.0f / 16.0f;
    G8_FOR_BLK(ai, bj, m, n) {
      const int col = c.c0 + G8_AIDX(ai, m), tok = c.t0 + G8_BIDX(bj, n);
      bf16* xp = xs + (size_t)tok * D + col;
      xs_store4(xp, xs_load4(xp) + *(const f32x4*)(g2 + col) * (acc[ai][bj][m][n] * isc));
    }
  }
};
struct G8Down {
  static constexpr int NKT = 2; static constexpr bool B_GATHER = false; static constexpr bool FP8 = true; static constexpr int B_PITCH = DE / 2; static constexpr int A_PITCH = DE / 2;
  struct Ctx { int c0, s0, grp; };
  const unsigned char* H; const int* pad_start; const unsigned char* w2t; unsigned char* Y; const unsigned short* tile_e;
  template <class C_> __device__ unsigned b_row(const C_&, int, int) const { return 0u; }
  __device__ int ntiles() const { return (pad_start[NE] >> 8) * 4; }
  __device__ void tile(int idx, Ctx& c) const { c.s0 = (idx >> 2) * 256; c.c0 = (idx & 3) * 256; c.grp = __builtin_amdgcn_readfirstlane((int)tile_e[idx >> 2]); }
  __device__ const bf16* a_base(const Ctx& c, int h) const { return (const bf16*)(w2t + ((size_t)c.grp * D + c.c0 + h * 128) * DE); }
  __device__ unsigned a_off(const Ctx&, int, int r) const { return r * (DE / 2); }
  __device__ const bf16* b_base(const Ctx& c, int h) const { return (const bf16*)(H + (size_t)(c.s0 + h * 128) * DE); }
  __device__ unsigned b_off(const Ctx&, int, int r) const { return r * (DE / 2); }
  __device__ void epi(const Ctx& c, g8acc_t& acc, int wr, int wc, int fr, int fq) const {
    const float isc = 1.0f / 16.0f;
#pragma unroll
    for (int ai = 0; ai < 2; ++ai)
#pragma unroll
      for (int bj = 0; bj < 2; ++bj)
#pragma unroll
        for (int n = 0; n < 2; ++n) {
          const int col = c.c0 + G8_AIDX(ai, 0), slot = c.s0 + G8_BIDX(bj, n);
          u32x4 o;
          o.x = pack4_fp8(acc[ai][bj][0][n] * isc); o.y = pack4_fp8(acc[ai][bj][1][n] * isc);
          o.z = pack4_fp8(acc[ai][bj][2][n] * isc); o.w = pack4_fp8(acc[ai][bj][3][n] * isc);
          *(u32x4*)(Y + (size_t)slot * D + col) = o;
        }
  }
};

constexpr int CVT_TILES = 3 * NE * 128;
struct CvtCtx { const float* w1; const float* w3; const float* w2; unsigned char* d1; unsigned char* d3; unsigned char* d2; };
struct CvtRegs { int pend; f32x4 r0, r1, r2, r3, r4, r5, r6, r7; };
__device__ __forceinline__ void cvt_locate(const CvtCtx& js, int u, int lane, const float*& s, unsigned char*& d, int& K, int& N) {
  const int job = u >> 15, r = u & 32767, mat = r >> 7, rr = r & 127;
  int kt, ntile;
  if (job < 2) { K = D; N = DE; ntile = rr >> 4; kt = rr & 15; } else { K = DE; N = D; ntile = rr >> 2; kt = rr & 3; }
  const float* s1 = js.w1; const float* s3 = js.w3; const float* s2 = js.w2;
  unsigned char* q1 = js.d1; unsigned char* q3 = js.d3; unsigned char* q2 = js.d2;
  const float* sb = job == 0 ? s1 : (job == 1 ? s3 : s2);
  unsigned char* db = job == 0 ? q1 : (job == 1 ? q3 : q2);
  const int k0 = kt * 64 + (lane & 7) * 8, n0 = ntile * 32 + (lane >> 3) * 4;
  s = sb + (size_t)mat * D * DE + (size_t)k0 * N + n0;
  d = db + (size_t)mat * D * DE + (size_t)n0 * K + k0;
}
__device__ __forceinline__ void cvt_init(CvtRegs& st) {
  st.pend = -1;
  st.r0 = st.r1 = st.r2 = st.r3 = st.r4 = st.r5 = st.r6 = st.r7 = (f32x4){0.f, 0.f, 0.f, 0.f};
}
__device__ __forceinline__ void cvt_finish(const CvtCtx& cx, CvtRegs& st, int lane) {
  if (st.pend < 0) return;
  const float* s; unsigned char* d; int K, N;
  cvt_locate(cx, st.pend, lane, s, d, K, N);
  const float sc = 16.0f;
  const f32x4 v0 = st.r0 * sc, v1 = st.r1 * sc, v2 = st.r2 * sc, v3 = st.r3 * sc, v4 = st.r4 * sc, v5 = st.r5 * sc, v6 = st.r6 * sc, v7 = st.r7 * sc;
  *(u32x2*)(d) = (u32x2){pk4_fp8(v0.x, v1.x, v2.x, v3.x), pk4_fp8(v4.x, v5.x, v6.x, v7.x)};
  *(u32x2*)(d + (size_t)K) = (u32x2){pk4_fp8(v0.y, v1.y, v2.y, v3.y), pk4_fp8(v4.y, v5.y, v6.y, v7.y)};
  *(u32x2*)(d + (size_t)2 * K) = (u32x2){pk4_fp8(v0.z, v1.z, v2.z, v3.z), pk4_fp8(v4.z, v5.z, v6.z, v7.z)};
  *(u32x2*)(d + (size_t)3 * K) = (u32x2){pk4_fp8(v0.w, v1.w, v2.w, v3.w), pk4_fp8(v4.w, v5.w, v6.w, v7.w)};
  st.pend = -1;
}
constexpr int CVT_GLA_TILES = 128 * 36 * 2 * 8;
static_assert(CVT_GLA_TILES + 512 * 2 * 3 * 8 == CVT_TILES, "tile ownership must cover every tile exactly once");
__device__ __forceinline__ void cvt_step(const CvtCtx& cx, CvtRegs& st, int lane, int u) {
  cvt_finish(cx, st, lane);
  const float* s; unsigned char* d; int K, N;
  cvt_locate(cx, u, lane, s, d, K, N);
  st.r0 = __builtin_nontemporal_load((const f32x4*)(s));
  st.r1 = __builtin_nontemporal_load((const f32x4*)(s + (size_t)N));
  st.r2 = __builtin_nontemporal_load((const f32x4*)(s + (size_t)2 * N));
  st.r3 = __builtin_nontemporal_load((const f32x4*)(s + (size_t)3 * N));
  st.r4 = __builtin_nontemporal_load((const f32x4*)(s + (size_t)4 * N));
  st.r5 = __builtin_nontemporal_load((const f32x4*)(s + (size_t)5 * N));
  st.r6 = __builtin_nontemporal_load((const f32x4*)(s + (size_t)6 * N));
  st.r7 = __builtin_nontemporal_load((const f32x4*)(s + (size_t)7 * N));
  st.pend = u;
}

constexpr int UST = 2056;
constexpr int HY_U_BYTES = 16 * UST * 2;
constexpr int TCOPY = 2064;
constexpr int HY_T_BYTES = 4 * TCOPY * 4;
constexpr int HY_LDS = HY_U_BYTES + HY_T_BYTES;
constexpr int USTC = 264;
constexpr int TCOPYC = 264;

__device__ __forceinline__ f32x4 mfma16(bf16x8 a, bf16x8 b, f32x4 c) {
  return __builtin_amdgcn_mfma_f32_16x16x32_bf16(a, b, c, 0, 0, 0);
}
__device__ __forceinline__ float bflo(unsigned v) { return __uint_as_float(v << 16); }
__device__ __forceinline__ float bfhi(unsigned v) { return __uint_as_float(v & 0xffff0000u); }
__device__ __forceinline__ float ldbf(const bf16* p) { return bf2f(*p); }

template <int GSTR, int TCP>
__device__ __forceinline__ void hy_load_tables(const bf16* __restrict__ G, int c, unsigned* T) {
  constexpr int NCH = GSTR / 8;
  for (int q = tid_opaque(); q < 2 * NCH; q += 512) {
    int o = q / NCH, ch = q - o * NCH;
    const unsigned* s32 = (const unsigned*)(G + ((size_t)(o * 512 + c)) * GSTR);
    u32x4 a = *(const u32x4*)(s32 + 4 * ch);
    unsigned nx = (ch + 1 < NCH) ? s32[4 * ch + 4] : 0u;
    unsigned* d0 = T + o * 2 * TCP;
    unsigned* d1 = d0 + TCP;
    *(u32x4*)(d0 + 4 * ch) = a;
    u32x4 b;
    b.x = (a.x >> 16) | (a.y << 16); b.y = (a.y >> 16) | (a.z << 16); b.z = (a.z >> 16) | (a.w << 16); b.w = (a.w >> 16) | (nx << 16);
    *(u32x4*)(d1 + 4 * ch) = b;
  }
}

template <int L, int USTR>
__device__ __forceinline__ void hy_load_u(const bf16* __restrict__ z, float w0, float w1, float w2, float bb, bf16* U) {
  constexpr int CPB = L / 8;
  for (int q = tid_opaque(); q < 16 * CPB; q += 512) {
    int b = q / CPB, t8 = (q - b * CPB) * 8;
    const bf16* zr = z + (size_t)b * L + t8;
    u32x4 v = *(const u32x4*)zr;
    float zm = t8 > 0 ? ldbf(zr - 1) : 0.f;
    float zp = t8 + 8 < L ? ldbf(zr + 8) : 0.f;
    float e0 = bflo(v.x), e1 = bfhi(v.x), e2 = bflo(v.y), e3 = bfhi(v.y), e4 = bflo(v.z), e5 = bfhi(v.z), e6 = bflo(v.w), e7 = bfhi(v.w);
    u32x4 o;
    o.x = pack_bf16(w0 * zm + w1 * e0 + w2 * e1 + bb, w0 * e0 + w1 * e1 + w2 * e2 + bb);
    o.y = pack_bf16(w0 * e1 + w1 * e2 + w2 * e3 + bb, w0 * e2 + w1 * e3 + w2 * e4 + bb);
    o.z = pack_bf16(w0 * e3 + w1 * e4 + w2 * e5 + bb, w0 * e4 + w1 * e5 + w2 * e6 + bb);
    o.w = pack_bf16(w0 * e5 + w1 * e6 + w2 * e7 + bb, w0 * e6 + w1 * e7 + w2 * zp + bb);
    *(u32x4*)(U + b * USTR + t8) = o;
  }
}

template <int L>
__device__ __forceinline__ void hy_gate4(const bf16* __restrict__ zr, int t0, float w0, float w1, float w2, float bb, float (&x)[4]) {
  u32x2 v = *(const u32x2*)(zr + t0);
  float zm = t0 > 0 ? ldbf(zr + t0 - 1) : 0.f;
  float zp = t0 + 4 < L ? ldbf(zr + t0 + 4) : 0.f;
  float e0 = bflo(v.x), e1 = bfhi(v.x), e2 = bflo(v.y), e3 = bfhi(v.y);
  x[0] = w0 * zm + w1 * e0 + w2 * e1 + bb;
  x[1] = w0 * e0 + w1 * e1 + w2 * e2 + bb;
  x[2] = w0 * e1 + w1 * e2 + w2 * e3 + bb;
  x[3] = w0 * e2 + w1 * e3 + w2 * zp + bb;
}

__device__ __forceinline__ bf16x8 hy_frag(const unsigned* p) {
  u32x4 v; v.x = p[0]; v.y = p[1]; v.z = p[2]; v.w = p[3];
  return __builtin_bit_cast(bf16x8, v);
}

__device__ __forceinline__ void hyena_latent(int c, const bf16* __restrict__ zt, const float* __restrict__ cw,
                                             const float* __restrict__ cb, const bf16* __restrict__ G,
                                             bf16* __restrict__ yt, char* smem, const CvtCtx& cx) {
  const int tid = tid_opaque(), lane = tid & 63, wave = tid >> 6;
  bf16* U = (bf16*)smem;
  unsigned* T = (unsigned*)(smem + HY_U_BYTES);
  __syncthreads();
  hy_load_tables<GSTR_L, TCOPY>(G, c, T);
  hy_load_u<SEQ, UST>(zt + (size_t)c * NT, cw[c], cw[HYCOLS + c], cw[2 * HYCOLS + c], cb[c], U);
  __syncthreads();
  const int r = lane & 15, kg = lane >> 4;
  const int par = (r + 1) & 1;
  const int base_dw = 1023 - (r >> 1) + 4 * kg - 128 * wave;
  const char* ub = smem + (r * UST + 8 * kg) * 2;
  const int tw = wave * 256;
#pragma unroll 1
  for (int order = 0; order < 2; ++order) {
    const unsigned* tb = T + order * 2 * TCOPY + par * TCOPY + base_dw;
    f32x4 acc[16];
#pragma unroll
    for (int i = 0; i < 16; ++i) acc[i] = (f32x4){0.f, 0.f, 0.f, 0.f};
    bf16x8 W[16];
#pragma unroll
    for (int f = -15; f <= 0; ++f) W[f & 15] = hy_frag(tb + 8 * f);
    CvtRegs cr; cvt_init(cr);
    const int wv = __builtin_amdgcn_readfirstlane(wave);
#pragma unroll 1
    for (int J = 0; J < 8; ++J) {
      const unsigned* tj = tb + 128 * J;
      const char* uj = ub + 512 * J;
#pragma unroll
      for (int jj = 0; jj < 8; ++jj) {
        if (jj == 0 && (J == 0 || J == 3 || J == 6)) cvt_step(cx, cr, lane, CVT_GLA_TILES + ((c * 2 + order) * 3 + J / 3) * 8 + wv);
        bf16x8 uf = *(const bf16x8*)(uj + 64 * jj);
        acc[15] = mfma16(W[(2 * jj - 15) & 15], uf, acc[15]);
        acc[14] = mfma16(W[(2 * jj - 14) & 15], uf, acc[14]);
        if (J * 8 + jj < 63) {
          W[(2 * jj + 1) & 15] = hy_frag(tj + 8 * (2 * jj + 1));
          W[(2 * jj + 2) & 15] = hy_frag(tj + 8 * (2 * jj + 2));
        }
#pragma unroll
        for (int i = 13; i >= 0; --i) acc[i] = mfma16(W[(2 * jj - i) & 15], uf, acc[i]);
      }
    }
    cvt_finish(cx, cr, lane);
    __syncthreads();
    {
      const int col = (order + 1) * 512 + c;
      const float w0 = cw[col], w1 = cw[HYCOLS + col], w2 = cw[2 * HYCOLS + col], bb = cb[col];
      const bf16* zr = zt + (size_t)col * NT + (size_t)r * SEQ;
      u32x2 gv[16]; unsigned gm[16], gp[16];
#pragma unroll
      for (int i = 0; i < 16; ++i) {
        const int t0 = tw + 16 * i + 4 * kg;
        gv[i] = *(const u32x2*)(zr + t0);
        gm[i] = t0 > 0 ? (unsigned)*(const unsigned short*)(zr + t0 - 1) : 0u;
        gp[i] = t0 + 4 < SEQ ? (unsigned)*(const unsigned short*)(zr + t0 + 4) : 0u;
      }
#pragma unroll
      for (int i = 0; i < 16; ++i) {
        const int t0 = tw + 16 * i + 4 * kg;
        const float zm = __uint_as_float(gm[i] << 16), zp = __uint_as_float(gp[i] << 16);
        const float e0 = bflo(gv[i].x), e1 = bfhi(gv[i].x), e2 = bflo(gv[i].y), e3 = bfhi(gv[i].y);
        const float x0 = w0 * zm + w1 * e0 + w2 * e1 + bb, x1 = w0 * e0 + w1 * e1 + w2 * e2 + bb;
        const float x2 = w0 * e1 + w1 * e2 + w2 * e3 + bb, x3 = w0 * e2 + w1 * e3 + w2 * zp + bb;
        u32x2 o;
        o.x = pack_bf16(x0 * acc[i][0], x1 * acc[i][1]);
        o.y = pack_bf16(x2 * acc[i][2], x3 * acc[i][3]);
        *(u32x2*)(U + r * UST + t0) = o;
      }
    }
    __syncthreads();
  }
  for (int q = tid; q < 16 * 256; q += 512) {
    int b = q >> 8, t8 = (q & 255) * 8;
    *(u32x4*)(yt + (size_t)c * NT + (size_t)b * SEQ + t8) = *(const u32x4*)(U + b * UST + t8);
  }
}

__device__ __forceinline__ void hyena_ctx(int c, const bf16* __restrict__ zt, const float* __restrict__ cw,
                                          const float* __restrict__ cb, const bf16* __restrict__ G,
                                          bf16* __restrict__ yt, char* smem) {
  const int tid = tid_opaque(), lane = tid & 63, wave = tid >> 6;
  bf16* U = (bf16*)smem;
  unsigned* T = (unsigned*)(smem + HY_U_BYTES);
  __syncthreads();
  hy_load_tables<GSTR_C, TCOPYC>(G, c, T);
  hy_load_u<LC, USTC>(zt + (size_t)c * NT, cw[c], cw[HYCOLS + c], cw[2 * HYCOLS + c], cb[c], U);
  __syncthreads();
  const int r = lane & 15, kg = lane >> 4;
  const int par = (r + 1) & 1;
  const int base_dw = (8 * kg - r + 255 - par) >> 1;
  const char* ub = smem + (r * USTC + 8 * kg) * 2;
#pragma unroll 1
  for (int order = 0; order < 2; ++order) {
    const unsigned* tb = T + order * 2 * TCOPYC + par * TCOPYC + base_dw;
    f32x4 acc[2];
    acc[0] = (f32x4){0.f, 0.f, 0.f, 0.f};
    acc[1] = acc[0];
#pragma unroll
    for (int j = 0; j < 8; ++j) {
      bf16x8 uf = *(const bf16x8*)(ub + 64 * j);
#pragma unroll
      for (int ii = 0; ii < 2; ++ii) {
        const int i = wave * 2 + ii;
        acc[ii] = mfma16(hy_frag(tb + 16 * j - 8 * i), uf, acc[ii]);
      }
    }
    __syncthreads();
    {
      const int col = (order + 1) * 512 + c;
      const float w0 = cw[col], w1 = cw[HYCOLS + col], w2 = cw[2 * HYCOLS + col], bb = cb[col];
      const bf16* zr = zt + (size_t)col * NT + (size_t)r * LC;
#pragma unroll
      for (int ii = 0; ii < 2; ++ii) {
        const int t0 = (wave * 2 + ii) * 16 + 4 * kg;
        float x[4];
        hy_gate4<LC>(zr, t0, w0, w1, w2, bb, x);
        u32x2 o;
        o.x = pack_bf16(x[0] * acc[ii][0], x[1] * acc[ii][1]);
        o.y = pack_bf16(x[2] * acc[ii][2], x[3] * acc[ii][3]);
        *(u32x2*)(U + r * USTC + t0) = o;
      }
    }
    __syncthreads();
  }
  {
    int b = tid >> 5, t8 = (tid & 31) * 8;
    *(u32x4*)(yt + (size_t)c * NT + (size_t)b * LC + t8) = *(const u32x4*)(U + b * USTC + t8);
  }
}

constexpr int GL_QE = 0, GL_KE = 8192, GL_KST = 16384, GL_ATT = 24576, GL_ST = 32768, GL_VT = 49152  ;
constexpr int GL_RAW = 81920  , GL_RAWSZ = 18432, GL_SEG = 118784, GL_DEC = 120832;
constexpr int GLA_LDS = 121088;

__device__ __forceinline__ f32x16 mfma32(bf16x8 a, bf16x8 b, f32x16 c) {
  return __builtin_amdgcn_mfma_f32_32x32x16_bf16(a, b, c, 0, 0, 0);
}
__device__ __forceinline__ unsigned short bf16bits(float v) { bf16 h = f2bf(v); return *(unsigned short*)&h; }

struct GlaArgs {
  const bf16* zg; const float* wa2; const float* ba2; float* of; float* ob; int emit_ctx; int pad_;
};

__device__ __forceinline__ void gla_unit(int unit, const GlaArgs& a, char* smem, const CvtCtx& cx) {
  const int tid = tid_opaque(), lane = tid & 63, wave = tid >> 6;
  const int dir = unit & 1, h = (unit >> 1) & 3, b = unit >> 3;
  const int lr = lane & 31, lh = lane >> 5;
  const int swl = (lr >> 1) & 7;
  float* outp = dir ? a.ob : a.of;
  __syncthreads();
  const int d = tid & 63, sg = tid >> 6;
  float wa[16];
#pragma unroll
  for (int r = 0; r < 16; ++r) wa[r] = a.wa2[(dir * 16 + r) * 256 + h * 64 + d];
  const float ba = a.ba2[dir * 256 + h * 64 + d];
  { unsigned zz = 0u; asm volatile("" : "+v"(zz));
    for (int q = tid; q < 16384 / 16; q += 512) *(u32x4*)(smem + GL_ST + q * 16) = (u32x4){zz, zz, zz, zz}; }
  f32x16 S;
#pragma unroll
  for (int r = 0; r < 16; ++r) S[r] = 0.f;

  const int qi = tid >> 3, qc = tid & 7;
  const int ai = (tid >> 1) & 63, ac = tid & 1;
  const int vsg = (tid >> 5) & 7, vdq = tid & 31;
  u32x4 pq, pk, pa;
  u32x2 pw0, pw1, pw2, pw3, pw4, pw5, pw6, pw7;

#define GLA_ROW(N_, I_, ROW_)                                                        \
  {                                                                                  \
    const int n_ = (N_);                                                             \
    const int Ls_ = n_ < 4 ? LC : SEQ;                                               \
    const int cn_ = n_ < 4 ? n_ : n_ - 4;                                            \
    const int rb_ = n_ < 4 ? (NL + b * LC) : (b * SEQ);                              \
    const int pos_ = cn_ * 64 + (I_);                                                \
    ROW_ = rb_ + (dir ? (Ls_ - 1 - pos_) : pos_);                                    \
  }
#define GLA_LOAD_RAW(N_)                                                             \
  {                                                                                  \
    int row_;                                                                        \
    GLA_ROW(N_, qi, row_);                                                           \
    const bf16* zr_ = a.zg + (size_t)row_ * GLACOLS;                                 \
    pq = *(const u32x4*)(zr_ + h * 64 + qc * 8);                                     \
    pk = *(const u32x4*)(zr_ + 256 + h * 64 + qc * 8);                               \
    int ra_;                                                                         \
    GLA_ROW(N_, ai, ra_);                                                            \
    pa = *(const u32x4*)(a.zg + (size_t)ra_ * GLACOLS + 1536 + dir * 16 + ac * 8);   \
  }
#define GLA_LOAD_V(N_)                                                               \
  {                                                                                  \
    int rv_;                                                                         \
    GLA_ROW(N_, vsg * 8 + 0, rv_); pw0 = *(const u32x2*)(a.zg + (size_t)rv_ * GLACOLS + 512 + h * 128 + vdq * 4); \
    GLA_ROW(N_, vsg * 8 + 1, rv_); pw1 = *(const u32x2*)(a.zg + (size_t)rv_ * GLACOLS + 512 + h * 128 + vdq * 4); \
    GLA_ROW(N_, vsg * 8 + 2, rv_); pw2 = *(const u32x2*)(a.zg + (size_t)rv_ * GLACOLS + 512 + h * 128 + vdq * 4); \
    GLA_ROW(N_, vsg * 8 + 3, rv_); pw3 = *(const u32x2*)(a.zg + (size_t)rv_ * GLACOLS + 512 + h * 128 + vdq * 4); \
    GLA_ROW(N_, vsg * 8 + 4, rv_); pw4 = *(const u32x2*)(a.zg + (size_t)rv_ * GLACOLS + 512 + h * 128 + vdq * 4); \
    GLA_ROW(N_, vsg * 8 + 5, rv_); pw5 = *(const u32x2*)(a.zg + (size_t)rv_ * GLACOLS + 512 + h * 128 + vdq * 4); \
    GLA_ROW(N_, vsg * 8 + 6, rv_); pw6 = *(const u32x2*)(a.zg + (size_t)rv_ * GLACOLS + 512 + h * 128 + vdq * 4); \
    GLA_ROW(N_, vsg * 8 + 7, rv_); pw7 = *(const u32x2*)(a.zg + (size_t)rv_ * GLACOLS + 512 + h * 128 + vdq * 4); \
  }
#define GLA_STORE_RAW(RB_)                                                           \
  {                                                                                  \
    char* rw_ = smem + GL_RAW + (RB_) * GL_RAWSZ;                                    \
    *(u32x4*)(rw_ + qi * 128 + qc * 16) = pq;                                        \
    *(u32x4*)(rw_ + 8192 + qi * 128 + qc * 16) = pk;                                 \
    if (tid < 128) *(u32x4*)(rw_ + 16384 + ai * 32 + ac * 16) = pa;                  \
  }
#define GLA_STORE_V(VB_)                                                             \
  if (tid < 256) {                                                                   \
    char* vt_ = smem + GL_VT + (VB_) * 16384;                                        \
    u32x4 o;                                                                         \
    o.x = (pw0.x & 0xffffu) | (pw1.x << 16); o.y = (pw2.x & 0xffffu) | (pw3.x << 16); o.z = (pw4.x & 0xffffu) | (pw5.x << 16); o.w = (pw6.x & 0xffffu) | (pw7.x << 16); \
    *(u32x4*)(vt_ + swz(vdq * 4 + 0, vsg)) = o;                                      \
    o.x = (pw0.x >> 16) | (pw1.x & 0xffff0000u); o.y = (pw2.x >> 16) | (pw3.x & 0xffff0000u); o.z = (pw4.x >> 16) | (pw5.x & 0xffff0000u); o.w = (pw6.x >> 16) | (pw7.x & 0xffff0000u); \
    *(u32x4*)(vt_ + swz(vdq * 4 + 1, vsg)) = o;                                      \
    o.x = (pw0.y & 0xffffu) | (pw1.y << 16); o.y = (pw2.y & 0xffffu) | (pw3.y << 16); o.z = (pw4.y & 0xffffu) | (pw5.y << 16); o.w = (pw6.y & 0xffffu) | (pw7.y << 16); \
    *(u32x4*)(vt_ + swz(vdq * 4 + 2, vsg)) = o;                                      \
    o.x = (pw0.y >> 16) | (pw1.y & 0xffff0000u); o.y = (pw2.y >> 16) | (pw3.y & 0xffff0000u); o.z = (pw4.y >> 16) | (pw5.y & 0xffff0000u); o.w = (pw6.y >> 16) | (pw7.y & 0xffff0000u); \
    *(u32x4*)(vt_ + swz(vdq * 4 + 3, vsg)) = o;                                      \
  }
#define GLA_STEP3(RB_)                                                               \
  {                                                                                  \
    const char* ra_ = smem + GL_RAW + (RB_) * GL_RAWSZ + 16384;                      \
    float run = 0.f;                                                                 \
    _Pragma("unroll") for (int ii = 0; ii < 8; ++ii) {                               \
      const int i = sg * 8 + ii;                                                     \
      const u32x4 a0 = *(const u32x4*)(ra_ + i * 32);                                \
      const u32x4 a1 = *(const u32x4*)(ra_ + i * 32 + 16);                           \
      float g = ba;                                                                  \
      g += bflo(a0.x) * wa[0] + bfhi(a0.x) * wa[1] + bflo(a0.y) * wa[2] + bfhi(a0.y) * wa[3]; \
      g += bflo(a0.z) * wa[4] + bfhi(a0.z) * wa[5] + bflo(a0.w) * wa[6] + bfhi(a0.w) * wa[7]; \
      g += bflo(a1.x) * wa[8] + bfhi(a1.x) * wa[9] + bflo(a1.y) * wa[10] + bfhi(a1.y) * wa[11]; \
      g += bflo(a1.z) * wa[12] + bfhi(a1.z) * wa[13] + bflo(a1.w) * wa[14] + bfhi(a1.w) * wa[15]; \
      run += logsigmoid_f(g) * (1.0f / 16.0f);                                       \
      bl[ii] = run;                                                                  \
    }                                                                                \
    *(float*)(smem + GL_SEG + (sg * 64 + d) * 4) = run;                              \
  }
#define GLA_STEP5(RB_)                                                               \
  {                                                                                  \
    const char* rq_ = smem + GL_RAW + (RB_) * GL_RAWSZ;                              \
    float off = 0.f, tot = 0.f;                                                      \
    _Pragma("unroll") for (int s = 0; s < 8; ++s) {                                  \
      float v = *(const float*)(smem + GL_SEG + (s * 64 + d) * 4);                  \
      off += (s < sg) ? v : 0.f;                                                     \
      tot += v;                                                                      \
    }                                                                                \
    float ks[8];                                                                     \
    _Pragma("unroll") for (int ii = 0; ii < 8; ++ii) {                               \
      const int i = sg * 8 + ii;                                                     \
      const float bb = off + bl[ii];                                                 \
      const float qv = bf2f(*(const bf16*)(rq_ + i * 128 + d * 2));                 \
      const float kv = bf2f(*(const bf16*)(rq_ + 8192 + i * 128 + d * 2));          \
      const int eo = swz(i, d >> 3) + (d & 7) * 2;                                   \
      *(unsigned short*)(smem + GL_QE + eo) = bf16bits(qv * 0.125f * __expf(bb));    \
      *(unsigned short*)(smem + GL_KE + eo) = bf16bits(kv * __expf(-bb));            \
      ks[ii] = kv * __expf(tot - bb);                                                \
    }                                                                                \
    u32x4 o;                                                                         \
    o.x = pack_bf16(ks[0], ks[1]); o.y = pack_bf16(ks[2], ks[3]); o.z = pack_bf16(ks[4], ks[5]); o.w = pack_bf16(ks[6], ks[7]); \
    *(u32x4*)(smem + GL_KST + swz(d, sg)) = o;                                       \
    if (sg == 0) *(float*)(smem + GL_DEC + d * 4) = __expf(tot);                     \
  }

  const int tm = wave >> 2, tn = wave & 3;
  float bl[8];
  f32x16 oprev;
#pragma unroll
  for (int r = 0; r < 16; ++r) oprev[r] = 0.f;

  GLA_LOAD_RAW(0); GLA_LOAD_V(0);
  GLA_STORE_RAW(0); GLA_STORE_V(0);
  GLA_LOAD_RAW(1);
  GLA_STORE_RAW(1);
  __syncthreads();
  GLA_STEP3(0);
  __syncthreads();
  GLA_STEP5(0);
  GLA_LOAD_RAW(2); GLA_LOAD_V(1);
  __syncthreads();
  CvtRegs cr; cvt_init(cr);
  const int cvt_u0 = __builtin_amdgcn_readfirstlane(unit * 36 * 16 + wave);
#pragma unroll 1
  for (int n = 0; n < 36; ++n) {
    const int vb = n & 1;
    const bool has1 = n + 1 < 36;
    cvt_step(cx, cr, lane, cvt_u0 + n * 16);
    f32x16 oacc;
#pragma unroll
    for (int r = 0; r < 16; ++r) oacc[r] = 0.f;
#pragma unroll
    for (int r = 0; r < 16; ++r) S[r] *= *(const float*)(smem + GL_DEC + (tm * 32 + rowmap(r, lh)) * 4);
#pragma unroll
    for (int ks4 = 0; ks4 < 4; ++ks4) {
      const int c = ((2 * ks4 + lh) ^ swl) << 4;
      const bf16x8 fq = *(const bf16x8*)(smem + GL_QE + (tm * 32 + lr) * 128 + c);
      const bf16x8 fs = *(const bf16x8*)(smem + GL_ST + (tn * 32 + lr) * 128 + c);
      oacc = mfma32(fq, fs, oacc);
      const bf16x8 fk = *(const bf16x8*)(smem + GL_KST + (tm * 32 + lr) * 128 + c);
      const bf16x8 fv = *(const bf16x8*)(smem + GL_VT + vb * 16384 + (tn * 32 + lr) * 128 + c);
      S = mfma32(fk, fv, S);
    }
    if (wave < 4) {
      const int am = wave >> 1, an = wave & 1;
      f32x16 att;
#pragma unroll
      for (int r = 0; r < 16; ++r) att[r] = 0.f;
#pragma unroll
      for (int ks4 = 0; ks4 < 4; ++ks4) {
        const int c = ((2 * ks4 + lh) ^ swl) << 4;
        const bf16x8 fq = *(const bf16x8*)(smem + GL_QE + (am * 32 + lr) * 128 + c);
        const bf16x8 fk = *(const bf16x8*)(smem + GL_KE + (an * 32 + lr) * 128 + c);
        att = mfma32(fq, fk, att);
      }
      const int s = an * 32 + lr;
#pragma unroll
      for (int r = 0; r < 16; ++r) {
        const int t = am * 32 + rowmap(r, lh);
        const float v = (s <= t) ? att[r] : 0.f;
        *(unsigned short*)(smem + GL_ATT + swz(t, s >> 3) + (s & 7) * 2) = bf16bits(v);
      }
    }
    if (has1) GLA_STEP3((n + 1) & 1);
    __syncthreads();
    cvt_step(cx, cr, lane, cvt_u0 + n * 16 + 8);
#pragma unroll
    for (int ks4 = 0; ks4 < 4; ++ks4) {
      const int c = ((2 * ks4 + lh) ^ swl) << 4;
      const bf16x8 fa = *(const bf16x8*)(smem + GL_ATT + (tm * 32 + lr) * 128 + c);
      const bf16x8 fv = *(const bf16x8*)(smem + GL_VT + vb * 16384 + (tn * 32 + lr) * 128 + c);
      oacc = mfma32(fa, fv, oacc);
    }
#pragma unroll
    for (int g = 0; g < 4; ++g) {
      u32x2 o;
      o.x = pack_bf16(S[4 * g + 0], S[4 * g + 1]);
      o.y = pack_bf16(S[4 * g + 2], S[4 * g + 3]);
      *(u32x2*)(smem + GL_ST + swz(tn * 32 + lr, tm * 4 + g) + 8 * lh) = o;
    }
    if (has1) {
      GLA_STEP5((n + 1) & 1);
      GLA_STORE_V((n + 1) & 1);
      if (n + 2 < 36) GLA_STORE_RAW(n & 1);
    }
    if (n > 0 && (n - 1 >= 4 || a.emit_ctx)) {
#pragma unroll
      for (int r = 0; r < 16; ++r) {
        int row;
        GLA_ROW(n - 1, tm * 32 + rowmap(r, lh), row);
        outp[(size_t)row * 512 + h * 128 + tn * 32 + lr] = oprev[r];
      }
    }
    { const int nr = n + 3 < 36 ? n + 3 : 35; GLA_LOAD_RAW(nr); const int nv = n + 2 < 36 ? n + 2 : 35; GLA_LOAD_V(nv); }
    oprev = oacc;
    __syncthreads();
  }
  cvt_finish(cx, cr, lane);
  {
#pragma unroll
    for (int r = 0; r < 16; ++r) {
      int row;
      GLA_ROW(35, tm * 32 + rowmap(r, lh), row);
      outp[(size_t)row * 512 + h * 128 + tn * 32 + lr] = oprev[r];
    }
  }
#undef GLA_ROW
#undef GLA_LOAD_RAW
#undef GLA_LOAD_V
#undef GLA_STORE_RAW
#undef GLA_STORE_V
#undef GLA_STEP3
#undef GLA_STEP5
}


constexpr int CTRL_Q = 0;
constexpr int CTRL_CNT = 128;
constexpr int CTRL_CUR = 640;
constexpr int CTRL_XR = 1152;
constexpr int CTRL_WORDS = 1152 + 256;
constexpr size_t al256(size_t v) { return (v + 255) / 256 * 256; }
namespace wso {
constexpr size_t bar = 0;
constexpr size_t ctrl = al256(bar + (size_t)XCD_BAR_WORDS * 4);
constexpr size_t zero_end = al256(ctrl + (size_t)CTRL_WORDS * 4);
constexpr size_t xs = al256(ctrl + (size_t)CTRL_WORDS * 4);
constexpr size_t mod = al256(xs + (size_t)NT * D * 4);
constexpr size_t abuf = al256(mod + (size_t)DEPTH * 17 * 6 * D * 4);
constexpr size_t zt = al256(abuf + (size_t)NT * D * 2);
constexpr size_t zg = al256(zt + (size_t)HYCOLS * NT * 2);
constexpr size_t yt = al256(zg + (size_t)NT * GLACOLS * 2);
constexpr size_t of = al256(yt + (size_t)HYW * NT * 2);
constexpr size_t ob = al256(of + (size_t)NT * 512 * 4);
constexpr size_t ymix = al256(ob + (size_t)NT * 512 * 4);
constexpr size_t region_end_raw = al256(ymix + (size_t)NT * D * 2);
constexpr size_t region_end = (region_end_raw > zt + al256((size_t)NSLOT * D * 2)) ? region_end_raw : zt + al256((size_t)NSLOT * D * 2);
constexpr size_t hid = region_end;
constexpr size_t gl = al256(hid + (size_t)DEPTH * 2 * SEQ * 64 * 4);
constexpr size_t gc = al256(gl + (size_t)DEPTH * 2 * HYW * GSTR_L * 2);
constexpr size_t logits = al256(gc + (size_t)2 * HYW * GSTR_C * 2);
constexpr size_t tok_e = al256(logits + (size_t)NT * NE * 4);
constexpr size_t tok_gate = al256(tok_e + (size_t)NT * TOPK * 4);
constexpr size_t tok_slot = al256(tok_gate + (size_t)NT * TOPK * 4);
constexpr size_t pad_start = al256(tok_slot + (size_t)NT * TOPK * 4);
constexpr size_t slot_tok = al256(pad_start + (size_t)(NE + 2) * 4);
constexpr size_t blkcnt = al256(slot_tok + (size_t)NSLOT * 4);
constexpr size_t hbuf = al256(blkcnt + (size_t)512 * NE * 4);
constexpr size_t hs = al256(hbuf + (size_t)NSLOT * DE);
constexpr size_t w_in_t = al256(hs + (size_t)NT * DE);
constexpr size_t w_out_t = al256(w_in_t + (size_t)DEPTH * WIN_ROWS * D * 2);
constexpr size_t router_t = al256(w_out_t + (size_t)DEPTH * D * D * 2);
constexpr size_t sh1_t = al256(router_t + (size_t)DEPTH * NE * D * 2);
constexpr size_t sh3_t = al256(sh1_t + (size_t)DEPTH * DE * D);
constexpr size_t sh2_t = al256(sh3_t + (size_t)DEPTH * DE * D);
constexpr size_t e1_t = al256(sh2_t + (size_t)DEPTH * D * DE);
constexpr size_t e3_t = al256(e1_t + (size_t)NE * DE * D);
constexpr size_t e2_t = al256(e3_t + (size_t)NE * DE * D);
constexpr size_t abuf8 = al256(e2_t + (size_t)NE * D * DE);
constexpr size_t w_g8 = al256(abuf8 + (size_t)NT * D);
constexpr size_t total = al256(w_g8 + (size_t)DEPTH * GW_ROWS * D);
constexpr size_t ybuf = zt;
}
struct WS {
  char* b;
  __device__ __forceinline__ unsigned* bar() const { char* q = b; asm volatile("" : "+s"(q)); return (unsigned*)(q + wso::bar); }
  __device__ __forceinline__ int* ctrl() const { char* q = b; asm volatile("" : "+s"(q)); return (int*)(q + wso::ctrl); }
  __device__ __forceinline__ bf16* xs() const { char* q = b; asm volatile("" : "+s"(q)); return (bf16*)(q + wso::xs); }
  __device__ __forceinline__ float* mod() const { char* q = b; asm volatile("" : "+s"(q)); return (float*)(q + wso::mod); }
  __device__ __forceinline__ bf16* abuf() const { char* q = b; asm volatile("" : "+s"(q)); return (bf16*)(q + wso::abuf); }
  __device__ __forceinline__ bf16* zt() const { char* q = b; asm volatile("" : "+s"(q)); return (bf16*)(q + wso::zt); }
  __device__ __forceinline__ bf16* zg() const { char* q = b; asm volatile("" : "+s"(q)); return (bf16*)(q + wso::zg); }
  __device__ __forceinline__ bf16* yt() const { char* q = b; asm volatile("" : "+s"(q)); return (bf16*)(q + wso::yt); }
  __device__ __forceinline__ float* of() const { char* q = b; asm volatile("" : "+s"(q)); return (float*)(q + wso::of); }
  __device__ __forceinline__ float* ob() const { char* q = b; asm volatile("" : "+s"(q)); return (float*)(q + wso::ob); }
  __device__ __forceinline__ bf16* ymix() const { char* q = b; asm volatile("" : "+s"(q)); return (bf16*)(q + wso::ymix); }
  __device__ __forceinline__ float* hid() const { char* q = b; asm volatile("" : "+s"(q)); return (float*)(q + wso::hid); }
  __device__ __forceinline__ bf16* gl() const { char* q = b; asm volatile("" : "+s"(q)); return (bf16*)(q + wso::gl); }
  __device__ __forceinline__ bf16* gc() const { char* q = b; asm volatile("" : "+s"(q)); return (bf16*)(q + wso::gc); }
  __device__ __forceinline__ float* logits() const { char* q = b; asm volatile("" : "+s"(q)); return (float*)(q + wso::logits); }
  __device__ __forceinline__ int* tok_e() const { char* q = b; asm volatile("" : "+s"(q)); return (int*)(q + wso::tok_e); }
  __device__ __forceinline__ float* tok_gate() const { char* q = b; asm volatile("" : "+s"(q)); return (float*)(q + wso::tok_gate); }
  __device__ __forceinline__ int* tok_slot() const { char* q = b; asm volatile("" : "+s"(q)); return (int*)(q + wso::tok_slot); }
  __device__ __forceinline__ int* pad_start() const { char* q = b; asm volatile("" : "+s"(q)); return (int*)(q + wso::pad_start); }
  __device__ __forceinline__ int* slot_tok() const { char* q = b; asm volatile("" : "+s"(q)); return (int*)(q + wso::slot_tok); }
  __device__ __forceinline__ int* blkcnt() const { char* q = b; asm volatile("" : "+s"(q)); return (int*)(q + wso::blkcnt); }
  __device__ __forceinline__ unsigned char* hbuf() const { char* q = b; asm volatile("" : "+s"(q)); return (unsigned char*)(q + wso::hbuf); }
  __device__ __forceinline__ unsigned char* hs() const { char* q = b; asm volatile("" : "+s"(q)); return (unsigned char*)(q + wso::hs); }
  __device__ __forceinline__ bf16* w_in_t() const { char* q = b; asm volatile("" : "+s"(q)); return (bf16*)(q + wso::w_in_t); }
  __device__ __forceinline__ bf16* w_out_t() const { char* q = b; asm volatile("" : "+s"(q)); return (bf16*)(q + wso::w_out_t); }
  __device__ __forceinline__ bf16* router_t() const { char* q = b; asm volatile("" : "+s"(q)); return (bf16*)(q + wso::router_t); }
  __device__ __forceinline__ unsigned char* sh1_t() const { char* q = b; asm volatile("" : "+s"(q)); return (unsigned char*)(q + wso::sh1_t); }
  __device__ __forceinline__ unsigned char* sh3_t() const { char* q = b; asm volatile("" : "+s"(q)); return (unsigned char*)(q + wso::sh3_t); }
  __device__ __forceinline__ unsigned char* sh2_t() const { char* q = b; asm volatile("" : "+s"(q)); return (unsigned char*)(q + wso::sh2_t); }
  __device__ __forceinline__ unsigned char* e1_t() const { char* q = b; asm volatile("" : "+s"(q)); return (unsigned char*)(q + wso::e1_t); }
  __device__ __forceinline__ unsigned char* e3_t() const { char* q = b; asm volatile("" : "+s"(q)); return (unsigned char*)(q + wso::e3_t); }
  __device__ __forceinline__ unsigned char* e2_t() const { char* q = b; asm volatile("" : "+s"(q)); return (unsigned char*)(q + wso::e2_t); }
  __device__ __forceinline__ unsigned char* ybuf() const { char* q = b; asm volatile("" : "+s"(q)); return (unsigned char*)(q + wso::ybuf); }
  __device__ __forceinline__ unsigned char* abuf8() const { char* q = b; asm volatile("" : "+s"(q)); return (unsigned char*)(q + wso::abuf8); }
  __device__ __forceinline__ unsigned char* w_g8() const { char* q = b; asm volatile("" : "+s"(q)); return (unsigned char*)(q + wso::w_g8); }
};

constexpr int MEGA_LDS_MAIN = G8_LDS;
constexpr int LDS_TILE_E = MEGA_LDS_MAIN + 16;
constexpr int MEGA_LDS = MEGA_LDS_MAIN + 16 + 4096;

struct MP { Inputs in; WS w; float* out; };

__device__ __forceinline__ void row_load(const float* __restrict__ p, int lane, f32x4 (&v)[4]) {
#pragma unroll
  for (int j = 0; j < 4; ++j) v[j] = *(const f32x4*)(p + j * 256 + lane * 4);
}
__device__ __forceinline__ void row_load_xs(const bf16* __restrict__ p, int lane, f32x4 (&v)[4]) {
#pragma unroll
  for (int j = 0; j < 4; ++j) v[j] = xs_load4(p + j * 256 + lane * 4);
}
__device__ __forceinline__ float row_rinv(const f32x4 (&v)[4], int lane) {
  float ss = 0.f;
#pragma unroll
  for (int j = 0; j < 4; ++j) ss += v[j].x * v[j].x + v[j].y * v[j].y + v[j].z * v[j].z + v[j].w * v[j].w;
  ss = wave_sum(ss, lane);
  return rsqrtf(ss * (1.0f / D) + EPS);
}
__device__ __forceinline__ void row_norm_mod_store(const f32x4 (&v)[4], float rinv, const float* __restrict__ g,
                                                   const float* __restrict__ sh, const float* __restrict__ sc, int lane,
                                                   bf16* __restrict__ dst, unsigned char* __restrict__ dst8 = nullptr) {
#pragma unroll
  for (int j = 0; j < 4; ++j) {
    const int d = j * 256 + lane * 4;
    const f32x4 gv = *(const f32x4*)(g + d), shv = *(const f32x4*)(sh + d), scv = *(const f32x4*)(sc + d);
    const float y0 = v[j].x * rinv * gv.x * (1.f + scv.x) + shv.x, y1 = v[j].y * rinv * gv.y * (1.f + scv.y) + shv.y;
    const float y2 = v[j].z * rinv * gv.z * (1.f + scv.z) + shv.z, y3 = v[j].w * rinv * gv.w * (1.f + scv.w) + shv.w;
    u32x2 o;
    o.x = pack_bf16(y0, y1);
    o.y = pack_bf16(y2, y3);
    *(u32x2*)(dst + d) = o;
    if (dst8) *(unsigned*)(dst8 + d) = pk4_fp8(y0, y1, y2, y3);
  }
}

__device__ __forceinline__ void ph_mod_hid(const MP& p, char* smem, int bid, int nblk) {
  const int tid = tid_opaque(), lane = tid & 63, wave = tid >> 6;
  float* sc = (float*)smem;
  for (int u = bid; u < 192; u += nblk) {
    const int l = u / 96, col0 = (u - l * 96) * 64;
    __syncthreads();
    for (int i = tid; i < 17 * 1024; i += 512) {
      const int r = i >> 10, k = i & 1023;
      const float v = (r < 16) ? p.in.c[r * D + k] : p.in.c_ctx[k];
      sc[i] = silu_f(v);
    }
    __syncthreads();
    const int col = tid & 63, ks = tid >> 6;
    float acc[17];
#pragma unroll
    for (int r = 0; r < 17; ++r) acc[r] = 0.f;
    const float* wp = p.in.ada_w + ((size_t)l * D + ks * 128) * (6 * D) + col0 + col;
#pragma unroll 16
    for (int kk = 0; kk < 128; ++kk) {
      const float wv = wp[(size_t)kk * (6 * D)];
#pragma unroll
      for (int r = 0; r < 17; ++r) acc[r] += sc[r * 1024 + ks * 128 + kk] * wv;
    }
    __syncthreads();
#pragma unroll
    for (int r = 0; r < 17; ++r) sc[(ks * 17 + r) * 64 + col] = acc[r];
    __syncthreads();
    for (int i = tid; i < 17 * 64; i += 512) {
      const int r = i >> 6, cc = i & 63;
      float s = 0.f;
#pragma unroll
      for (int k8 = 0; k8 < 8; ++k8) s += sc[(k8 * 17 + r) * 64 + cc];
      p.w.mod()[((size_t)l * 17 + r) * (6 * D) + col0 + cc] = s + p.in.ada_b[l * 6 * D + col0 + cc];
    }
  }
  for (int it = bid; it * 8 < 4352; it += nblk) {
    const int rid = it * 8 + wave;
    int l, ty, t;
    if (rid < 2048) { l = 0; ty = 0; t = rid; }
    else if (rid < 2304) { l = 0; ty = 1; t = rid - 2048; }
    else { l = 1; ty = 0; t = rid - 2304; }
    const int L = ty ? LC : SEQ;
    const float* w1 = p.in.hy_f_w1 + l * 33 * 64; const float* b1 = p.in.hy_f_b1 + l * 64;
    const float* w2 = p.in.hy_f_w2 + l * 64 * 64; const float* b2 = p.in.hy_f_b2 + l * 64;
    float pv = 0.f;
    if (lane == 0) pv = (float)t / (float)(L - 1);
    else if (lane < 33) {
      const int bi = (lane - 1) & 15;
      const float wph = 2.0f * 3.14159265358979323846f * (float)t / (float)L;
      const float f = 1e-4f + (float)bi * ((15.0f - 1e-4f) / 15.0f);
      pv = (lane <= 16) ? cosf(f * wph) : -sinf(f * wph);
    }
    float a1 = b1[lane];
#pragma unroll
    for (int i = 0; i < 33; ++i) a1 += shl_f(pv, i) * w1[i * 64 + lane];
    const float h1 = sinf(a1);
    float a2 = b2[lane];
#pragma unroll 16
    for (int i = 0; i < 64; ++i) a2 += shl_f(h1, i) * w2[i * 64 + lane];
    p.w.hid()[((size_t)(l * 2 + ty) * SEQ + t) * 64 + lane] = sinf(a2);
  }
}

__device__ __forceinline__ void ph_gtab(const MP& p, char* smem, int bid, int nblk) {
  const int tid = tid_opaque();
  float* wl = (float*)smem;
  for (int u = bid; u < 544; u += nblk) {
    int l, ty, ib, cg;
    if (u < 512) { l = u >> 8; ty = 0; ib = (u >> 5) & 7; cg = u & 31; }
    else { l = 0; ty = 1; ib = 0; cg = u - 512; }
    const int L = ty ? LC : SEQ, gstr = ty ? GSTR_C : GSTR_L;
    const float* hid = p.w.hid() + (size_t)(l * 2 + ty) * SEQ * 64;
    const float* w3 = p.in.hy_f_w3 + (size_t)l * 64 * 2048;
    const float* skip = p.in.hy_skip + l * 2 * 512;
    bf16* G = ty ? p.w.gc() : (p.w.gl() + (size_t)l * 2 * HYW * GSTR_L);
    __syncthreads();
    for (int i = tid; i < 2 * 32 * 64; i += 512) {
      const int dir = i >> 11, cc = (i >> 6) & 31, j = i & 63;
      const int oc = cg * 32 + cc, o = oc >> 9, c = oc & 511;
      wl[i] = w3[(size_t)j * 2048 + o * 1024 + dir * 512 + c];
    }
    __syncthreads();
    const int i = ib * 512 + tid;
    const int dd = i - (L - 1);
    const int t = dd < 0 ? -dd : dd;
    const bool inr = i < 2 * L - 1;
    const int dir = dd > 0 ? 1 : 0;
    float hr[64];
    {
      const float* hp = hid + (size_t)(inr ? t : 0) * 64;
#pragma unroll
      for (int j = 0; j < 16; ++j) { const f32x4 v = *(const f32x4*)(hp + 4 * j); hr[4 * j] = v.x; hr[4 * j + 1] = v.y; hr[4 * j + 2] = v.z; hr[4 * j + 3] = v.w; }
    }
    const float tn = (float)t / (float)(L - 1);
#pragma unroll 1
    for (int cc = 0; cc < 32; ++cc) {
      const int oc = cg * 32 + cc, o = oc >> 9, c = oc & 511;
      const float* wc = wl + (dir * 32 + cc) * 64;
      float s = 0.f;
#pragma unroll
      for (int j = 0; j < 16; ++j) { const f32x4 wv = *(const f32x4*)(wc + 4 * j); s += hr[4 * j] * wv.x + hr[4 * j + 1] * wv.y + hr[4 * j + 2] * wv.z + hr[4 * j + 3] * wv.w; }
      if (dd == 0) {
        const float* wc1 = wl + (32 + cc) * 64;
        float s1 = 0.f;
#pragma unroll
        for (int j = 0; j < 16; ++j) { const f32x4 wv = *(const f32x4*)(wc1 + 4 * j); s1 += hr[4 * j] * wv.x + hr[4 * j + 1] * wv.y + hr[4 * j + 2] * wv.z + hr[4 * j + 3] * wv.w; }
        s += s1;
      }
      const float delta = HY_MIN_DECAY + (float)c * ((HY_MAX_DECAY - HY_MIN_DECAY) / 511.0f);
      float val = s * __expf(-tn * delta);
      if (dd == 0) val += skip[o * 512 + c];
      if (!inr) val = 0.f;
      G[(size_t)oc * gstr + i] = f2bf(val);
    }
  }
}

__device__ __forceinline__ void ph_init_norm1(const MP& p, int bid, int nblk) {
  const int lane = tid_opaque() & 63, wave = tid_opaque() >> 6;
  const float* g = p.in.norm1_g;
  for (int it = bid; it * 8 < SEQ; it += nblk) {
    const int t = it * 8 + wave;
    const float rr = (float)(t >> 6), colp = (float)(t & 63);
    f32x4 e[4];
#pragma unroll
    for (int j = 0; j < 4; ++j) {
      float ev[4];
#pragma unroll
      for (int q = 0; q < 4; ++q) {
        const int i = lane * 4 + q;
        const float omega = 1.0f / powf(10000.0f, (float)i / 256.0f);
        const float a = ((j < 2) ? rr : colp) * omega;
        ev[q] = (j & 1) ? cosf(a) : sinf(a);
      }
      e[j] = (f32x4){ev[0], ev[1], ev[2], ev[3]};
    }
    for (int b = 0; b < NB; ++b) {
      const int row = b * SEQ + t;
      f32x4 v[4];
      row_load(p.in.x + (size_t)row * D, lane, v);
#pragma unroll
      for (int j = 0; j < 4; ++j) { v[j] += e[j]; xs_store4(p.w.xs() + (size_t)row * D + j * 256 + lane * 4, v[j]); }
      const float rinv = row_rinv(v, lane);
      const float* mb = p.w.mod() + (size_t)b * 6 * D;
      row_norm_mod_store(v, rinv, g, mb, mb + D, lane, p.w.abuf() + (size_t)row * D, p.w.abuf8() + (size_t)row * D);
    }
  }
  for (int it = bid; it * 8 < NC; it += nblk) {
    const int rc = it * 8 + wave, row = NL + rc;
    f32x4 v[4];
    row_load(p.in.ctx + (size_t)rc * D, lane, v);
#pragma unroll
    for (int j = 0; j < 4; ++j) xs_store4(p.w.xs() + (size_t)row * D + j * 256 + lane * 4, v[j]);
    const float rinv = row_rinv(v, lane);
    const float* mb = p.w.mod() + (size_t)16 * 6 * D;
    row_norm_mod_store(v, rinv, g, mb, mb + D, lane, p.w.abuf() + (size_t)row * D, p.w.abuf8() + (size_t)row * D);
  }
}

__device__ __forceinline__ void ph_mixer(const MP& p, char* smem, int l, bool last, int bid, int nblk) {
  int* qctr = p.w.ctrl() + CTRL_Q + 64 * l;
  int* slot = (int*)(smem + MEGA_LDS_MAIN + 8);
  GlaArgs ga;
  ga.zg = p.w.zg(); ga.wa2 = p.in.gla_wa2 + (size_t)l * 2 * 16 * 256; ga.ba2 = p.in.gla_ba2 + (size_t)l * 2 * 256;
  ga.of = p.w.of(); ga.ob = p.w.ob(); ga.emit_ctx = last ? 0 : 1; ga.pad_ = 0;
  const float* cw = p.in.hy_conv_w + (size_t)l * 3 * HYCOLS;
  const float* cb = p.in.hy_conv_b + (size_t)l * HYCOLS;
  const bf16* gl = p.w.gl() + (size_t)l * 2 * HYW * GSTR_L;
  CvtCtx cx;
  cx.w1 = p.in.exp_w1 + (size_t)l * NE * D * DE; cx.w3 = p.in.exp_w3 + (size_t)l * NE * D * DE; cx.w2 = p.in.exp_w2 + (size_t)l * NE * DE * D;
  cx.d1 = p.w.e1_t(); cx.d3 = p.w.e3_t(); cx.d2 = p.w.e2_t();
  for (;;) {
    __syncthreads();
    if (tid_opaque() == 0) *slot = atomicAdd(qctr, 1);
    __syncthreads();
    const int u = *slot;
    const int nunits = last ? 640 : 1152;
    if (u >= nunits) break;
    if (u < 128) gla_unit(u, ga, smem, cx);
    else if (u < 640) hyena_latent(u - 128, p.w.zt(), cw, cb, gl, p.w.yt(), smem, cx);
    else hyena_ctx(u - 640, p.w.zt() + NL, cw, cb, p.w.gc(), p.w.yt() + NL, smem);
  }
}

__device__ __forceinline__ void ph_gla_out(const MP& p, char* smem, int l, int mrows, int bid, int nblk) {
  const int tid = tid_opaque();
  const int lane = tid & 63, wave = tid >> 6;
  {
    const float* gn = p.in.gla_norm_g + l * 128 + (lane & 15) * 8;
    const f32x4 ga = *(const f32x4*)gn, gb = *(const f32x4*)(gn + 4);
    const float* of = p.w.of(); const float* ob = p.w.ob(); const bf16* zg = p.w.zg(); bf16* ymix = p.w.ymix();
#pragma unroll 2
    for (int it = bid; it * 8 < mrows; it += nblk) {
      const int row = it * 8 + wave;
      const size_t base = (size_t)row * 512 + lane * 8;
      const f32x4 a0 = *(const f32x4*)(of + base), a1 = *(const f32x4*)(of + base + 4);
      const f32x4 b0 = *(const f32x4*)(ob + base), b1 = *(const f32x4*)(ob + base + 4);
      const u32x4 rv = *(const u32x4*)(zg + (size_t)row * GLACOLS + 1024 + lane * 8);
      const f32x4 o0 = a0 + b0, o1 = a1 + b1;
      float ss = o0.x * o0.x + o0.y * o0.y + o0.z * o0.z + o0.w * o0.w + o1.x * o1.x + o1.y * o1.y + o1.z * o1.z + o1.w * o1.w;
      ss += shx_f(ss, 1, lane); ss += shx_f(ss, 2, lane); ss += shx_f(ss, 4, lane); ss += shx_f(ss, 8, lane);
      const float rinv = rsqrtf(ss * (1.0f / 128.0f) + EPS);
      u32x4 o;
      o.x = pack_bf16(o0.x * rinv * ga.x * silu_f(bflo(rv.x)), o0.y * rinv * ga.y * silu_f(bfhi(rv.x)));
      o.y = pack_bf16(o0.z * rinv * ga.z * silu_f(bflo(rv.y)), o0.w * rinv * ga.w * silu_f(bfhi(rv.y)));
      o.z = pack_bf16(o1.x * rinv * gb.x * silu_f(bflo(rv.z)), o1.y * rinv * gb.y * silu_f(bfhi(rv.z)));
      o.w = pack_bf16(o1.z * rinv * gb.z * silu_f(bflo(rv.w)), o1.w * rinv * gb.w * silu_f(bfhi(rv.w)));
      *(u32x4*)(ymix + (size_t)row * D + 512 + lane * 8) = o;
    }
  }
  {
    const bf16* yt = p.w.yt(); bf16* ymix = p.w.ymix();
    for (int tt = bid; tt * 64 < mrows; tt += nblk) {
      const int tok0 = tt * 64;
      __syncthreads();
#pragma unroll
      for (int i = 0; i < 8; ++i) {
        const int q = tid + i * 512, c = q >> 3, ch = q & 7;
        const u32x4 v = *(const u32x4*)(yt + (size_t)c * NT + tok0 + ch * 8);
        unsigned* d = (unsigned*)(smem + c * 132 + ch * 16);
        d[0] = v.x; d[1] = v.y; d[2] = v.z; d[3] = v.w;
      }
      __syncthreads();
#pragma unroll
      for (int i = 0; i < 8; ++i) {
        const int c8 = wave * 8 + (lane & 7), t = i * 8 + (lane >> 3);
        const unsigned short* s = (const unsigned short*)(smem + (c8 * 8) * 132 + t * 2);
        const unsigned e0 = s[0], e1 = s[66], e2 = s[132], e3 = s[198], e4 = s[264], e5 = s[330], e6 = s[396], e7 = s[462];
        *(u32x4*)(ymix + (size_t)(tok0 + t) * D + c8 * 8) = (u32x4){e0 | (e1 << 16), e2 | (e3 << 16), e4 | (e5 << 16), e6 | (e7 << 16)};
      }
    }
  }
}

__device__ __forceinline__ void ph_norm2(const MP& p, int l, int mrows, int bid, int nblk) {
  const int lane = tid_opaque() & 63, wave = tid_opaque() >> 6;
  const float* g = p.in.norm2_g + l * D;
  const float* modl = p.w.mod() + (size_t)l * 17 * 6 * D;
  for (int it = bid; it * 8 < mrows; it += nblk) {
    const int row = it * 8 + wave;
    f32x4 v[4];
    row_load_xs(p.w.xs() + (size_t)row * D, lane, v);
    const float rinv = row_rinv(v, lane);
    const float* mb = modl + (size_t)row_batch(row) * 6 * D;
    row_norm_mod_store(v, rinv, g, mb + 3 * D, mb + 4 * D, lane, p.w.abuf() + (size_t)row * D, p.w.abuf8() + (size_t)row * D);
  }
}

__device__ __forceinline__ void ph_route(const MP& p, char* smem, int l, int ntok, int bid, int nblk) {
  const int tid = tid_opaque();
  const int lane = tid & 63, wave = tid >> 6;
  const float* rb = p.in.router_b + l * NE;
  int* lcnt = (int*)smem;
  __syncthreads();
  if (tid < NE) lcnt[tid] = 0;
  __syncthreads();
  const f32x4 bb = *(const f32x4*)(rb + lane * 4);
  const int tpb = (ntok + nblk - 1) / nblk;
  for (int it = wave; it < tpb; it += 8) {
    const int tok = bid * tpb + it;
    if (tok >= ntok) break;
    const f32x4 lg = *(const f32x4*)(p.w.logits() + (size_t)tok * NE + lane * 4);
    const float s0 = sigmoid_f(lg.x), s1 = sigmoid_f(lg.y), s2 = sigmoid_f(lg.z), s3 = sigmoid_f(lg.w);
    const float v0 = s0 + bb.x, v1 = s1 + bb.y, v2 = s2 + bb.z, v3 = s3 + bb.w;
    float m1 = fmaxf(v0, v1), m2 = fminf(v0, v1);
    { float n1 = fmaxf(m1, v2); float n2 = fmaxf(fminf(m1, v2), m2); m1 = n1; m2 = n2; }
    { float n1 = fmaxf(m1, v3); float n2 = fmaxf(fminf(m1, v3), m2); m1 = n1; m2 = n2; }
#pragma unroll
    for (int o = 1; o <= 4; o <<= 1) {
      float a1 = shx_f(m1, o, lane), a2 = shx_f(m2, o, lane);
      float n1 = fmaxf(m1, a1);
      float n2 = fmaxf(fminf(m1, a1), fmaxf(m2, a2));
      m1 = n1; m2 = n2;
    }
    const float gs = m1 + m2;
    const int g = lane >> 3;
    int rank = 0;
#pragma unroll
    for (int gg = 0; gg < 8; ++gg) {
      const float og = __int_as_float(__builtin_amdgcn_readlane(__float_as_int(gs), gg * 8));
      rank += (og > gs || (og == gs && gg < g)) ? 1 : 0;
    }
    unsigned k0, k1, k2, k3;
    {
      const bool sel = rank < 4;
      unsigned u;
      u = __float_as_uint(v0); u = (u & 0x80000000u) ? ~u : (u | 0x80000000u); k0 = sel ? ((u & 0xffffff00u) | (unsigned)(255 - (lane * 4 + 0))) : 0u;
      u = __float_as_uint(v1); u = (u & 0x80000000u) ? ~u : (u | 0x80000000u); k1 = sel ? ((u & 0xffffff00u) | (unsigned)(255 - (lane * 4 + 1))) : 0u;
      u = __float_as_uint(v2); u = (u & 0x80000000u) ? ~u : (u | 0x80000000u); k2 = sel ? ((u & 0xffffff00u) | (unsigned)(255 - (lane * 4 + 2))) : 0u;
      u = __float_as_uint(v3); u = (u & 0x80000000u) ? ~u : (u | 0x80000000u); k3 = sel ? ((u & 0xffffff00u) | (unsigned)(255 - (lane * 4 + 3))) : 0u;
    }
    float gsum = 0.f, myg = 0.f; int mye = 0;
#pragma unroll
    for (int k = 0; k < TOPK; ++k) {
      unsigned m = max(max(k0, k1), max(k2, k3));
      m = max(m, (unsigned)__builtin_amdgcn_update_dpp(0, (int)m, 0x111, 0xf, 0xf, false));
      m = max(m, (unsigned)__builtin_amdgcn_update_dpp(0, (int)m, 0x112, 0xf, 0xf, false));
      m = max(m, (unsigned)__builtin_amdgcn_update_dpp(0, (int)m, 0x114, 0xf, 0xf, false));
      m = max(m, (unsigned)__builtin_amdgcn_update_dpp(0, (int)m, 0x118, 0xf, 0xf, false));
      m = max(m, (unsigned)__builtin_amdgcn_update_dpp(0, (int)m, 0x142, 0xa, 0xf, false));
      m = max(m, (unsigned)__builtin_amdgcn_update_dpp(0, (int)m, 0x143, 0xc, 0xf, false));
      const unsigned wk = (unsigned)__builtin_amdgcn_readlane((int)m, 63);
      const int we = 255 - (int)(wk & 255u);
      const int wl = we >> 2, wi = we & 3;
      const float sv = __int_as_float(__builtin_amdgcn_readlane(__float_as_int(wi == 0 ? s0 : wi == 1 ? s1 : wi == 2 ? s2 : s3), wl));
      if (lane == wl) { if (wi == 0) k0 = 0u; else if (wi == 1) k1 = 0u; else if (wi == 2) k2 = 0u; else k3 = 0u; }
      gsum += sv;
      if (lane == k) { myg = sv; mye = we; }
    }
    if (lane < TOPK) {
      p.w.tok_e()[tok * TOPK + lane] = mye;
      p.w.tok_gate()[tok * TOPK + lane] = myg / gsum * 2.5f;
      atomicAdd(&lcnt[mye], 1);
    }
  }
  __syncthreads();
  if (tid < NE) p.w.blkcnt()[bid * NE + tid] = lcnt[tid];
}

__device__ __forceinline__ void ph_assign(const MP& p, char* smem, int l, int ntok, int bid, int nblk) {
  const int tid = tid_opaque();
  int* ps = (int*)smem;
  int* cur = (int*)smem + 512;
  __syncthreads();
  int* part = (int*)smem + 1024;
  {
    const int eg = tid & 63, bg = tid >> 6;
    const int per = (nblk + 7) >> 3;
    int t0 = 0, t1 = 0, t2 = 0, t3 = 0, b0 = 0, b1 = 0, b2 = 0, b3 = 0;
    const int* src = p.w.blkcnt() + eg * 4;
#pragma unroll 8
    for (int i = 0; i < per; ++i) {
      const int b = bg * per + i;
      if (b < nblk) {
        const u32x4 v = *(const u32x4*)(src + (size_t)b * NE);
        t0 += (int)v.x; t1 += (int)v.y; t2 += (int)v.z; t3 += (int)v.w;
        if (b < bid) { b0 += (int)v.x; b1 += (int)v.y; b2 += (int)v.z; b3 += (int)v.w; }
      }
    }
    int* pt = part + bg * 512 + eg * 4;
    pt[0] = t0; pt[1] = t1; pt[2] = t2; pt[3] = t3;
    pt[256] = b0; pt[257] = b1; pt[258] = b2; pt[259] = b3;
  }
  __syncthreads();
  int before = 0;
  if (tid < NE) {
    int tot = 0;
#pragma unroll
    for (int g = 0; g < 8; ++g) { tot += part[g * 512 + tid]; before += part[g * 512 + 256 + tid]; }
    const int pc = (tot + 255) & ~255;
    const int lane = tid & 63;
    int inc = pc;
#pragma unroll
    for (int o = 1; o < 64; o <<= 1) { const int n = shl_i(inc, lane - o); if (lane >= o) inc += n; }
    ps[tid + 1] = inc;
    if (lane == 63) cur[tid >> 6] = inc;
  }
  __syncthreads();
  if (tid < NE) {
    const int w = tid >> 6;
    int offs = 0;
#pragma unroll
    for (int k = 0; k < 3; ++k) offs += (k < w) ? cur[k] : 0;
    ps[tid + 1] += offs;
    if (tid == 0) ps[0] = 0;
  }
  __syncthreads();
  if (tid < NE) {
    unsigned short* te = (unsigned short*)(smem + LDS_TILE_E);
    for (int t = ps[tid] >> 8; t < (ps[tid + 1] >> 8); ++t) te[t] = (unsigned short)tid;
  }
  if (tid < NE) cur[tid] = ps[tid] + before;
  if (bid == 0 && tid <= NE) p.w.pad_start()[tid] = ps[tid];
  __syncthreads();
  const int tpb = (ntok + nblk - 1) / nblk;
  for (int i = tid; i < tpb * TOPK; i += 512) {
    const int gi = bid * tpb * TOPK + i;
    if (gi >= ntok * TOPK) break;
    const int e = p.w.tok_e()[gi];
    const int slot = atomicAdd(&cur[e], 1);
    p.w.slot_tok()[slot] = gi >> 3;
    p.w.tok_slot()[gi] = slot;
  }
}

__device__ __forceinline__ void ph_combine(const MP& p, int l, int mrows, bool last, int bid, int nblk) {
  const int lane = tid_opaque() & 63, wave = tid_opaque() >> 6;
  const float* modl = p.w.mod() + (size_t)l * 17 * 6 * D;
  for (int it = bid; it * 8 < mrows; it += nblk) {
    const int row = it * 8 + wave;
    const int b = row_batch(row);
    f32x4 v[4], acc[4];
    row_load_xs(p.w.xs() + (size_t)row * D, lane, v);
#pragma unroll
    for (int j = 0; j < 4; ++j) acc[j] = (f32x4){0.f, 0.f, 0.f, 0.f};
    int sl = 0; float gt = 0.f;
    if (lane < TOPK) { sl = p.w.tok_slot()[row * TOPK + lane]; gt = p.w.tok_gate()[row * TOPK + lane]; }
#pragma unroll
    for (int k = 0; k < TOPK; ++k) {
      const int s = shl_i(sl, k);
      const float gk = shl_f(gt, k);
      const unsigned char* yr = p.w.ybuf() + (size_t)s * D + lane * 4;
#pragma unroll
      for (int j = 0; j < 4; ++j) {
        const int y = *(const int*)(yr + j * 256);
        const f32x2v lo = __builtin_amdgcn_cvt_pk_f32_fp8(y, false), hi = __builtin_amdgcn_cvt_pk_f32_fp8(y, true);
        acc[j].x += gk * lo.x; acc[j].y += gk * lo.y; acc[j].z += gk * hi.x; acc[j].w += gk * hi.y;
      }
    }
    const float* g2 = modl + (size_t)b * 6 * D + 5 * D;
#pragma unroll
    for (int j = 0; j < 4; ++j) {
      const f32x4 gv = *(const f32x4*)(g2 + j * 256 + lane * 4);
      v[j] += gv * acc[j];
    }
    const float rinv = row_rinv(v, lane);
    if (last) {
#pragma unroll
      for (int j = 0; j < 4; ++j) {
        const f32x4 fg = *(const f32x4*)(p.in.final_g + j * 256 + lane * 4);
        *(f32x4*)(p.out + (size_t)row * D + j * 256 + lane * 4) = v[j] * rinv * fg;
      }
    } else {
#pragma unroll
      for (int j = 0; j < 4; ++j) xs_store4(p.w.xs() + (size_t)row * D + j * 256 + lane * 4, v[j]);
      const float* mb = p.w.mod() + ((size_t)(l + 1) * 17 + b) * 6 * D;
      row_norm_mod_store(v, rinv, p.in.norm1_g + (l + 1) * D, mb, mb + D, lane, p.w.abuf() + (size_t)row * D, p.w.abuf8() + (size_t)row * D);
    }
  }
}

__global__ void __launch_bounds__(512, 2) k_mega(MP p) {
  extern __shared__ __attribute__((aligned(16))) char smem[];
  const int bid = blockIdx.x, nblk = gridDim.x;
  if (tid_opaque() == 0) *(u32x4*)(smem + MEGA_LDS_MAIN) = (u32x4){0u, 0u, 0u, 0u};
  __syncthreads();
  (void)xcd_barrier_post(p.w.bar(), (volatile LAS unsigned*)(smem + MEGA_LDS_MAIN));

  if (threadIdx.x == 0) {
    const unsigned xcc = xb_xcc_id();
    const int rank = atomicAdd(&p.w.ctrl()[CTRL_XR + 16 * xcc], 1);
    *(int*)(smem + MEGA_LDS_MAIN + 12) = rank;
  }
  ph_mod_hid(p, smem, bid, nblk);
  cvt_job(p.in.w_in, p.w.w_in_t(), D, INCOLS, 1, bid, nblk, HYCOLS);
  cvt_job(p.in.w_in + (size_t)D * INCOLS, p.w.w_in_t() + (size_t)WIN_ROWS * D, D, INCOLS, 1, bid, nblk, HYCOLS);
  cvt8_job(p.in.w_in + HYCOLS, p.w.w_g8(), D, INCOLS, 1, bid, nblk, GLACOLS);
  cvt8_job(p.in.w_in + (size_t)D * INCOLS + HYCOLS, p.w.w_g8() + (size_t)GW_ROWS * D, D, INCOLS, 1, bid, nblk, GLACOLS);
  cvt_job(p.in.w_out, p.w.w_out_t(), D, D, DEPTH, bid, nblk);
  cvt_job(p.in.router_w, p.w.router_t(), D, NE, DEPTH, bid, nblk);
  cvt8_job(p.in.sh_w1, p.w.sh1_t(), D, DE, DEPTH, bid, nblk);
  cvt8_job(p.in.sh_w3, p.w.sh3_t(), D, DE, DEPTH, bid, nblk);
  cvt8_job(p.in.sh_w2, p.w.sh2_t(), DE, D, DEPTH, bid, nblk);
  grid_sync(p.w.bar(), smem + MEGA_LDS_MAIN);
  int vb = bid;
  {
    const int rank = *(const int*)(smem + MEGA_LDS_MAIN + 12);
    const unsigned xcc = xb_xcc_id();
    int npop = 0, xidx = 0, cnt0 = -1; bool equal = true;
    for (int j = 0; j < 16; ++j) {
      const int c = p.w.ctrl()[CTRL_XR + 16 * j];
      if (c > 0) {
        if (cnt0 < 0) cnt0 = c; else if (c != cnt0) equal = false;
        if (j < (int)xcc) ++xidx;
        ++npop;
      }
    }
    if (equal && cnt0 > 0 && npop * cnt0 == nblk && rank < cnt0) vb = xidx * cnt0 + rank;
  }
  ph_gtab(p, smem, bid, nblk);
  ph_init_norm1(p, bid, nblk);
  grid_sync(p.w.bar(), smem + MEGA_LDS_MAIN);

  const int vbu = __builtin_amdgcn_readfirstlane(vb);
#pragma unroll 1
  for (int l0 = 0; l0 < DEPTH; ++l0) {
#define LL opq(l0)
    const bool last = (l0 == DEPTH - 1);
    const int mrows = last ? NL : NT;
#define MODL (p.w.mod() + (size_t)LL * 17 * 6 * D)
    {
      G8InZT g; g.wt = p.w.w_in_t() + (size_t)LL * WIN_ROWS * D; g.A = p.w.abuf(); g.zt = p.w.zt(); g.ntok = last ? NL : NT;
      gemm8_run(g, smem, opq(vbu), nblk);
    }
    {
      G8InG g; g.wt = p.w.w_g8() + (size_t)LL * GW_ROWS * D; g.A = p.w.abuf8(); g.zg = p.w.zg();
      gemm8_run(g, smem, opq(vbu), nblk);
    }
    grid_sync(p.w.bar(), smem + MEGA_LDS_MAIN);
    ph_mixer(p, smem, LL, last, opq(bid), nblk);
    grid_sync(p.w.bar(), smem + MEGA_LDS_MAIN);
    ph_gla_out(p, smem, LL, mrows, opq(bid), nblk);
    grid_sync(p.w.bar(), smem + MEGA_LDS_MAIN);
    {
      G8Out g; g.mrows = mrows; g.ymix = p.w.ymix(); g.wt = p.w.w_out_t() + (size_t)LL * D * D; g.modl = MODL; g.xs = p.w.xs();
      gemm8_run(g, smem, opq(vbu), nblk);
    }
    grid_sync(p.w.bar(), smem + MEGA_LDS_MAIN);
    ph_norm2(p, LL, mrows, opq(bid), nblk);
    grid_sync(p.w.bar(), smem + MEGA_LDS_MAIN);
    {
      G8Router g; g.mrows = mrows; g.A = p.w.abuf(); g.rwt = p.w.router_t() + (size_t)LL * NE * D; g.logits = p.w.logits();
      gemm8_run(g, smem, opq(vbu), nblk);
    }
    {
      G8ShUp g; g.mrows = mrows; g.A8 = p.w.abuf8(); g.s1t = p.w.sh1_t() + (size_t)LL * DE * D; g.s3t = p.w.sh3_t() + (size_t)LL * DE * D; g.hs = p.w.hs();
      gemm8_run(g, smem, opq(vbu), nblk);
    }
    grid_sync(p.w.bar(), smem + MEGA_LDS_MAIN);
    ph_route(p, smem, LL, mrows, opq(bid), nblk);
    grid_sync(p.w.bar(), smem + MEGA_LDS_MAIN);
    ph_assign(p, smem, LL, mrows, opq(bid), nblk);
    grid_sync(p.w.bar(), smem + MEGA_LDS_MAIN);
    {
      G8Up g; g.A8 = p.w.abuf8(); g.slot_tok = p.w.slot_tok(); g.pad_start = p.w.pad_start(); g.w1t = p.w.e1_t(); g.w3t = p.w.e3_t(); g.H = p.w.hbuf(); g.tile_e = (const unsigned short*)(smem + LDS_TILE_E);
      gemm8_run(g, smem, opq(vbu), nblk);
    }
    {
      G8ShDown g; g.mrows = mrows; g.hs = p.w.hs(); g.wt = p.w.sh2_t() + (size_t)LL * D * DE; g.modl = MODL; g.xs = p.w.xs();
      gemm8_run(g, smem, opq(vbu), nblk);
    }
    grid_sync(p.w.bar(), smem + MEGA_LDS_MAIN);
    {
      G8Down g; g.H = p.w.hbuf(); g.pad_start = p.w.pad_start(); g.w2t = p.w.e2_t(); g.Y = p.w.ybuf(); g.tile_e = (const unsigned short*)(smem + LDS_TILE_E);
      gemm8_run(g, smem, opq(vbu), nblk);
    }
    grid_sync(p.w.bar(), smem + MEGA_LDS_MAIN);
    ph_combine(p, LL, mrows, last, opq(bid), nblk);
    if (!last) grid_sync(p.w.bar(), smem + MEGA_LDS_MAIN);
  }
#undef LL
#undef MODL
}

static inline size_t align_up(size_t v, size_t a) { return (v + a - 1) / a * a; }

extern "C" void kernel_launch(void* const* d_in, const int* in_sizes, int n_in, void* d_out, int out_size, void* d_ws,
                              size_t ws_size, hipStream_t stream) {
  MP p;
  memset(&p, 0, sizeof(p));
  const float** ip = (const float**)&p.in;
  for (int i = 0; i < 30; ++i) ip[i] = (const float*)d_in[i];
  p.out = (float*)d_out;

  p.w.b = (char*)d_ws;
  const size_t zero_bytes = wso::zero_end;
  (void)ws_size; (void)n_in; (void)in_sizes; (void)out_size;

  static int grid = 0;
  if (!grid) {
    hipFuncSetAttribute((const void*)k_mega, hipFuncAttributeMaxDynamicSharedMemorySize, MEGA_LDS);
    int dev = 0, cus = 0, per_cu = 0;
    hipGetDevice(&dev);
    hipDeviceGetAttribute(&cus, hipDeviceAttributeMultiprocessorCount, dev);
    hipOccupancyMaxActiveBlocksPerMultiprocessor(&per_cu, k_mega, 512, MEGA_LDS);
    if (cus <= 0) cus = 256;
    grid = per_cu >= 1 ? cus : 0;
    if (grid <= 0) grid = 256;
  }
  hipMemsetAsync(d_ws, 0, zero_bytes, stream);
  hipLaunchKernelGGL(k_mega, dim3(grid), dim3(512), MEGA_LDS, stream, p);
}
```

```cpp
#include <hip/hip_runtime.h>
#include <hip/hip_bf16.h>
#include <stdint.h>
#include <string.h>

typedef __hip_bfloat16 bf16;

constexpr int D = 1024, NB = 16, SEQ = 2048, LC = 256, DEPTH = 2;
constexpr int NL = NB * SEQ, NC = NB * LC, NT = NL + NC;
constexpr int HYW = 512, HYCOLS = 1536, GLACOLS = 1568, INCOLS = 3104;
constexpr int NE = 256, TOPK = 8, DE = 256;
constexpr int NSLOT = NT * TOPK + NE * 256;
constexpr float EPS = 1e-6f;
constexpr float HY_MIN_DECAY = 3.0701134573253945f;
constexpr float HY_MAX_DECAY = 15.350567286626973f;
constexpr int GSTR_L = 4096, GSTR_C = 512;
constexpr int WIN_ROWS = HYCOLS;
constexpr int GW_ROWS = 7 * 256;

__device__ __forceinline__ float bf2f(bf16 v) { return __bfloat162float(v); }
__device__ __forceinline__ bf16 f2bf(float v) { return __float2bfloat16(v); }
__device__ __forceinline__ float silu_f(float x) { return x / (1.f + __expf(-x)); }
__device__ __forceinline__ float sigmoid_f(float x) { return 1.f / (1.f + __expf(-x)); }
__device__ __forceinline__ float logsigmoid_f(float x) { return fminf(x, 0.f) - __logf(1.f + __expf(-fabsf(x))); }

__device__ __forceinline__ float shx_f(float v, int mask, int lane) { return __int_as_float(__builtin_amdgcn_ds_bpermute((lane ^ mask) << 2, __float_as_int(v))); }
__device__ __forceinline__ int shx_i(int v, int mask, int lane) { return __builtin_amdgcn_ds_bpermute((lane ^ mask) << 2, v); }
__device__ __forceinline__ float shl_f(float v, int src) { return __int_as_float(__builtin_amdgcn_ds_bpermute(src << 2, __float_as_int(v))); }
__device__ __forceinline__ int shl_i(int v, int src) { return __builtin_amdgcn_ds_bpermute(src << 2, v); }
__device__ __forceinline__ float wave_sum(float v, int lane) {
#pragma unroll
  for (int o = 32; o > 0; o >>= 1) v += shx_f(v, o, lane);
  return v;
}

struct Inputs {
  const float *x, *c, *ctx, *c_ctx, *ada_w, *ada_b, *norm1_g, *norm2_g, *w_in, *w_out, *hy_conv_w, *hy_conv_b,
      *hy_f_w1, *hy_f_b1, *hy_f_w2, *hy_f_b2, *hy_f_w3, *hy_skip, *gla_wa2, *gla_ba2, *gla_norm_g, *router_w,
      *router_b, *exp_w1, *exp_w3, *exp_w2, *sh_w1, *sh_w3, *sh_w2, *final_g;
};

__device__ __forceinline__ int opq(int v) { asm volatile("" : "+s"(v)); return v; }
__device__ __forceinline__ int tid_opaque() { int t = threadIdx.x; asm volatile("" : "+v"(t)); return t; }
__device__ __forceinline__ int row_batch(int row) { return row < NL ? (row >> 11) : 16; }

#define XB_TMO      128
#define XB_XCNT(j)  (256  + 64 * (j))
#define XB_XSUB(j)  (1280 + 64 * (j))
#define XB_XGEN(j)  (2304 + 64 * (j))
#define XB_TOP      3328
#define XB_TOPGEN   3392
#define XCD_BAR_WORDS 3456
#define XB_SPIN_CAP (1u << 18)
#define LAS __attribute__((address_space(3)))

__device__ __forceinline__ unsigned xb_ld(unsigned* p)              { return __hip_atomic_load(p, __ATOMIC_RELAXED, __HIP_MEMORY_SCOPE_AGENT); }
__device__ __forceinline__ unsigned xb_add(unsigned* p, unsigned v) { return __hip_atomic_fetch_add(p, v, __ATOMIC_RELAXED, __HIP_MEMORY_SCOPE_AGENT); }
__device__ __forceinline__ unsigned xb_xcc_id() { return (unsigned)__builtin_amdgcn_s_getreg((3 << 11) | 20) & 0xFu; }
#define XB_SPIN(cond, bar) do { unsigned _sp = 0; while (cond) { __builtin_amdgcn_s_sleep(1); \
    if ((++_sp & 255u) == 0u) { if (xb_ld(&(bar)[XB_TMO])) break; if (_sp > XB_SPIN_CAP) { atomicAdd(&(bar)[XB_TMO], 1u); break; } } } } while (0)

struct XcdBarrier {
    unsigned* bar; unsigned x;
    volatile LAS unsigned* st;
};

__device__ __forceinline__ XcdBarrier xcd_barrier_post(unsigned* bar, volatile LAS unsigned* st) {
    XcdBarrier b; b.bar = bar; b.x = xb_xcc_id(); b.st = st;
    if (threadIdx.x == 0) (void)xb_add(&bar[XB_XCNT(b.x)], 1u);
    return b;
}
__device__ __forceinline__ void xcd_barrier_complete(unsigned* bar, unsigned x, unsigned& nloc, unsigned& nx) {
    const unsigned G = gridDim.x * gridDim.y * gridDim.z;
    unsigned sum, cnt, mine, sp = 0u;
    for (;;) {
        sum = 0u; cnt = 0u; mine = 0u;
#pragma unroll
        for (unsigned j = 0; j < 16; ++j) { const unsigned c = xb_ld(&bar[XB_XCNT(j)]); sum += c; cnt += (c > 0u) ? 1u : 0u; mine = (j == x) ? c : mine; }
        if (sum == G) break;
        __builtin_amdgcn_s_sleep(1);
        if ((++sp & 255u) == 0u) { if (xb_ld(&bar[XB_TMO])) break; if (sp > XB_SPIN_CAP) { atomicAdd(&bar[XB_TMO], 1u); break; } }
    }
    nloc = mine > 0u ? mine : 1u; nx = cnt > 0u ? cnt : 1u;
}
__device__ __forceinline__ void xcd_barrier(const XcdBarrier& b) {
    asm volatile("s_waitcnt vmcnt(0)" ::: "memory");
    __syncthreads();
    if (threadIdx.x == 0) {
        unsigned* bar = b.bar;
        __builtin_amdgcn_s_waitcnt(0);
        unsigned nloc = b.st[0], nx = b.st[1];
        if (nloc == 0u) { xcd_barrier_complete(bar, b.x, nloc, nx); b.st[0] = nloc; b.st[1] = nx; }
        const unsigned old = xb_add(&bar[XB_XSUB(b.x)], 1u);
        const unsigned gen = old / nloc;
        if (old + 1u == (gen + 1u) * nloc) {
            __builtin_amdgcn_fence(__ATOMIC_RELEASE, "agent");
            asm volatile("s_waitcnt vmcnt(0)" ::: "memory");
            const unsigned og = xb_add(&bar[XB_TOP], 1u);
            const unsigned tg = og / nx;
            if (og + 1u == (tg + 1u) * nx) xb_add(&bar[XB_TOPGEN], 1u);
            else XB_SPIN(xb_ld(&bar[XB_TOPGEN]) == tg, bar);
            __builtin_amdgcn_fence(__ATOMIC_ACQUIRE, "agent");
            xb_add(&bar[XB_XGEN(b.x)], 1u);
            asm volatile("s_waitcnt vmcnt(0)" ::: "memory");
        } else {
            XB_SPIN(xb_ld(&bar[XB_XGEN(b.x)]) == gen, bar);
            __builtin_amdgcn_fence(__ATOMIC_ACQUIRE, "agent");
            asm volatile("s_waitcnt vmcnt(0)" ::: "memory");
        }
    }
    __syncthreads();
}

__device__ __forceinline__ void grid_sync(unsigned* bar0, char* stw) {
  unsigned* q = bar0;
  asm volatile("" : "+s"(q));
  XcdBarrier b; b.bar = q; b.x = xb_xcc_id(); b.st = (volatile LAS unsigned*)stw;
  xcd_barrier(b);
}

typedef __attribute__((ext_vector_type(8))) __bf16 bf16x8;
typedef __attribute__((ext_vector_type(16))) float f32x16;
typedef __attribute__((ext_vector_type(4))) float f32x4;
typedef __attribute__((ext_vector_type(2))) float f32x2v;
typedef __attribute__((ext_vector_type(2))) __bf16 bf16x2v;
typedef __attribute__((ext_vector_type(4))) unsigned int u32x4;
typedef __attribute__((ext_vector_type(2))) unsigned int u32x2;

__device__ __forceinline__ unsigned pack_bf16(float a, float b) {
  f32x2v v = {a, b};
  return __builtin_bit_cast(unsigned, __builtin_convertvector(v, bf16x2v));
}
__device__ __forceinline__ f32x4 xs_load4(const bf16* p) {
  const u32x2 w = *(const u32x2*)p;
  return (f32x4){__uint_as_float(w.x << 16), __uint_as_float(w.x & 0xffff0000u), __uint_as_float(w.y << 16), __uint_as_float(w.y & 0xffff0000u)};
}
__device__ __forceinline__ void xs_store4(bf16* p, const f32x4 v) {
  u32x2 w; w.x = pack_bf16(v.x, v.y); w.y = pack_bf16(v.z, v.w);
  *(u32x2*)p = w;
}
__device__ __forceinline__ int swz(int row, int chunk) { return row * 128 + ((chunk ^ ((row >> 1) & 7)) << 4); }
__device__ __forceinline__ int rowmap(int reg, int lh) { return (reg & 3) + 8 * (reg >> 2) + 4 * lh; }

__device__ __forceinline__ int find_group(const int* __restrict__ pad_start, int m0) {
  int lo = 0, hi = NE - 1;
  while (lo < hi) {
    int mid = (lo + hi + 1) >> 1;
    if (pad_start[mid] <= m0) lo = mid; else hi = mid - 1;
  }
  return lo;
}

__device__ __forceinline__ void cvt_wave_tile(const float* __restrict__ src, bf16* __restrict__ dst, int K, int N, int kt, int ntile, int lane) {
  const int k0 = kt * 64 + (lane & 7) * 8, n0 = ntile * 32 + (lane >> 3) * 4;
  const float* s = src + (size_t)k0 * N + n0;
  const f32x4 v0 = __builtin_nontemporal_load((const f32x4*)(s)), v1 = __builtin_nontemporal_load((const f32x4*)(s + (size_t)N));
  const f32x4 v2 = __builtin_nontemporal_load((const f32x4*)(s + (size_t)2 * N)), v3 = __builtin_nontemporal_load((const f32x4*)(s + (size_t)3 * N));
  const f32x4 v4 = __builtin_nontemporal_load((const f32x4*)(s + (size_t)4 * N)), v5 = __builtin_nontemporal_load((const f32x4*)(s + (size_t)5 * N));
  const f32x4 v6 = __builtin_nontemporal_load((const f32x4*)(s + (size_t)6 * N)), v7 = __builtin_nontemporal_load((const f32x4*)(s + (size_t)7 * N));
  bf16* d = dst + (size_t)n0 * K + k0;
  *(u32x4*)(d) = (u32x4){pack_bf16(v0.x, v1.x), pack_bf16(v2.x, v3.x), pack_bf16(v4.x, v5.x), pack_bf16(v6.x, v7.x)};
  *(u32x4*)(d + (size_t)K) = (u32x4){pack_bf16(v0.y, v1.y), pack_bf16(v2.y, v3.y), pack_bf16(v4.y, v5.y), pack_bf16(v6.y, v7.y)};
  *(u32x4*)(d + (size_t)2 * K) = (u32x4){pack_bf16(v0.z, v1.z), pack_bf16(v2.z, v3.z), pack_bf16(v4.z, v5.z), pack_bf16(v6.z, v7.z)};
  *(u32x4*)(d + (size_t)3 * K) = (u32x4){pack_bf16(v0.w, v1.w), pack_bf16(v2.w, v3.w), pack_bf16(v4.w, v5.w), pack_bf16(v6.w, v7.w)};
}
typedef __attribute__((ext_vector_type(8))) int i32x8;
typedef __attribute__((ext_vector_type(4))) int i32x4;
__device__ __forceinline__ float clamp_fp8(float x) { return __builtin_amdgcn_fmed3f(x, -448.0f, 448.0f); }
__device__ __forceinline__ unsigned pk4_fp8(float a, float b, float c, float d) {
  a = clamp_fp8(a); b = clamp_fp8(b); c = clamp_fp8(c); d = clamp_fp8(d);
  int w = 0;
  w = __builtin_amdgcn_cvt_pk_fp8_f32(a, b, w, false);
  w = __builtin_amdgcn_cvt_pk_fp8_f32(c, d, w, true);
  return (unsigned)w;
}
__device__ __forceinline__ void cvt8_wave_tile(const float* __restrict__ src, unsigned char* __restrict__ dst, int K, int N, int kt, int ntile, int lane) {
  const int k0 = kt * 64 + (lane & 7) * 8, n0 = ntile * 32 + (lane >> 3) * 4;
  const float* s = src + (size_t)k0 * N + n0;
  const float sc = 16.0f;
  const f32x4 v0 = __builtin_nontemporal_load((const f32x4*)(s)) * sc, v1 = __builtin_nontemporal_load((const f32x4*)(s + (size_t)N)) * sc;
  const f32x4 v2 = __builtin_nontemporal_load((const f32x4*)(s + (size_t)2 * N)) * sc, v3 = __builtin_nontemporal_load((const f32x4*)(s + (size_t)3 * N)) * sc;
  const f32x4 v4 = __builtin_nontemporal_load((const f32x4*)(s + (size_t)4 * N)) * sc, v5 = __builtin_nontemporal_load((const f32x4*)(s + (size_t)5 * N)) * sc;
  const f32x4 v6 = __builtin_nontemporal_load((const f32x4*)(s + (size_t)6 * N)) * sc, v7 = __builtin_nontemporal_load((const f32x4*)(s + (size_t)7 * N)) * sc;
  unsigned char* d = dst + (size_t)n0 * K + k0;
  *(u32x2*)(d) = (u32x2){pk4_fp8(v0.x, v1.x, v2.x, v3.x), pk4_fp8(v4.x, v5.x, v6.x, v7.x)};
  *(u32x2*)(d + (size_t)K) = (u32x2){pk4_fp8(v0.y, v1.y, v2.y, v3.y), pk4_fp8(v4.y, v5.y, v6.y, v7.y)};
  *(u32x2*)(d + (size_t)2 * K) = (u32x2){pk4_fp8(v0.z, v1.z, v2.z, v3.z), pk4_fp8(v4.z, v5.z, v6.z, v7.z)};
  *(u32x2*)(d + (size_t)3 * K) = (u32x2){pk4_fp8(v0.w, v1.w, v2.w, v3.w), pk4_fp8(v4.w, v5.w, v6.w, v7.w)};
}
__device__ __forceinline__ void cvt8_job(const float* __restrict__ src, unsigned char* __restrict__ dst, int K, int N, int nmat, int bid, int nblk, int W = 0) {
  const int tid = tid_opaque(), lane = tid & 63, wave = tid >> 6;
  if (W == 0) W = N;
  const int tk = K >> 6, tn = W >> 5, per = tk * tn;
  const int total = per * nmat;
  for (int u = bid * 8 + wave; u < total; u += nblk * 8) {
    const int mat = u / per, r = u - mat * per;
    const int ntile = r / tk, kt = r - ntile * tk;
    cvt8_wave_tile(src + (size_t)mat * K * N, dst + (size_t)mat * K * W, K, N, kt, ntile, lane);
  }
}

__device__ __forceinline__ void cvt_job(const float* __restrict__ src, bf16* __restrict__ dst, int K, int N, int nmat, int bid, int nblk, int W = 0) {
  const int tid = tid_opaque(), lane = tid & 63, wave = tid >> 6;
  if (W == 0) W = N;
  const int tk = K >> 6, tn = W >> 5, per = tk * tn;
  const int total = per * nmat;
  for (int u = bid * 8 + wave; u < total; u += nblk * 8) {
    const int mat = u / per, r = u - mat * per;
    const int ntile = r / tk, kt = r - ntile * tk;
    cvt_wave_tile(src + (size_t)mat * K * N, dst + (size_t)mat * K * W, K, N, kt, ntile, lane);
  }
}

constexpr int G8_HT = 128 * 64;
constexpr int G8_LDS = 8 * G8_HT * 2;

__device__ __forceinline__ int g8_lds_byte(int r, int c) {
  int st = (r >> 4) * 2 + (c >> 5), rr = r & 15, cc = c & 31, ob = rr * 64 + cc * 2;
  return st * 1024 + (ob ^ (((ob >> 9) & 1) << 5));
}
__device__ __forceinline__ void g8_stage_rc(int b, int& R, int& C) {
  int st = b / 1024, sb = b % 1024, sw = sb ^ (((sb >> 9) & 1) << 5);
  R = (st >> 1) * 16 + sw / 64; C = (st & 1) * 32 + (sw % 64) / 2;
}

typedef f32x4 g8acc_t[2][2][4][2];

template <class P>
__device__ __forceinline__ void gemm8_run(const P& p, char* smem, int bid, int nblk) {
  const int ntl = __builtin_amdgcn_readfirstlane(p.ntiles());
  if (bid >= ntl) return;
  bf16* shm = (bf16*)smem;
#define SA(b, h) (shm + ((b) * 2 + (h)) * G8_HT)
#define SB(b, h) (shm + (4 + (b) * 2 + (h)) * G8_HT)
#define GLDS(SRC, DST) __builtin_amdgcn_global_load_lds((const unsigned*)(SRC), (unsigned*)(DST), 16, 0, 0)
#define STAGE_A(PP, BASE, KT) do { GLDS((BASE) + (oa + (KT) * 64), (char*)(PP) + ldsd); GLDS((BASE) + 64 * P::A_PITCH + (oa + (KT) * 64), (char*)(PP) + ldsd + 8192); } while (0)
#define STAGE_B(PP, BASE, OB, KT) do { \
    if constexpr (P::B_GATHER) { GLDS((BASE) + ((((OB) & 0xffffu) * (unsigned)P::B_PITCH + cc) + (KT) * 64), (char*)(PP) + ldsd); \
                                 GLDS((BASE) + ((((OB) >> 16) * (unsigned)P::B_PITCH + cc) + (KT) * 64), (char*)(PP) + ldsd + 8192); } \
    else { GLDS((BASE) + ((OB) + (KT) * 64), (char*)(PP) + ldsd); GLDS((BASE) + 64 * P::B_PITCH + ((OB) + (KT) * 64), (char*)(PP) + ldsd + 8192); } } while (0)
#define LDA(dst, b, h) for (int m = 0; m < 4; ++m) \
    dst[m] = __builtin_shufflevector(*reinterpret_cast<const i32x4*>((char*)SA(b, h) + aoff + m * 2048), \
                                     *reinterpret_cast<const i32x4*>((char*)SA(b, h) + aoff + m * 2048 + 1024), 0, 1, 2, 3, 4, 5, 6, 7)
#define LDB(dst, b, h) for (int n = 0; n < 2; ++n) \
    dst[n] = __builtin_shufflevector(*reinterpret_cast<const i32x4*>((char*)SB(b, h) + boff + n * 2048), \
                                     *reinterpret_cast<const i32x4*>((char*)SB(b, h) + boff + n * 2048 + 1024), 0, 1, 2, 3, 4, 5, 6, 7)
#define FRAG_LO(x) __builtin_bit_cast(bf16x8, __builtin_shufflevector(x, x, 0, 1, 2, 3))
#define FRAG_HI(x) __builtin_bit_cast(bf16x8, __builtin_shufflevector(x, x, 4, 5, 6, 7))
#define MMA(ai, bj, At_, Bt_) do { __builtin_amdgcn_s_setprio(1); \
    if constexpr (P::FP8) { \
      for (int m = 0; m < 4; ++m) for (int n = 0; n < 2; ++n) \
        asm volatile("v_mfma_f32_16x16x128_f8f6f4 %0, %1, %2, %0" \
                     : "+v"(acc[ai][bj][m][n]) : "v"(At_[m]), "v"(Bt_[n])); \
    } else { \
      for (int m = 0; m < 4; ++m) for (int n = 0; n < 2; ++n) { \
        acc[ai][bj][m][n] = __builtin_amdgcn_mfma_f32_16x16x32_bf16(FRAG_LO(At_[m]), FRAG_LO(Bt_[n]), acc[ai][bj][m][n], 0, 0, 0); \
        acc[ai][bj][m][n] = __builtin_amdgcn_mfma_f32_16x16x32_bf16(FRAG_HI(At_[m]), FRAG_HI(Bt_[n]), acc[ai][bj][m][n], 0, 0, 0); } \
    } \
    __builtin_amdgcn_s_setprio(0); } while (0)
#define WAIT_V(n) asm volatile("s_waitcnt vmcnt(" #n ")" ::: "memory")
#define WAIT_L(n) asm volatile("s_waitcnt lgkmcnt(" #n ")" ::: "memory")
#define BAR __builtin_amdgcn_s_barrier()
#define SCHED __builtin_amdgcn_sched_barrier(0)

  typename P::Ctx cur, nxt;
  p.tile(bid, cur);
  int aoff, boff, ldsd;
  unsigned oa, cc, ob0, ob1;
  bool wr1;
  {
    const int tid = tid_opaque();
    const int wid = tid >> 6, lane = tid & 63, wr = wid >> 2, wc = wid & 3, fr = lane & 15, fq = lane >> 4;
    aoff = g8_lds_byte(wr * 64 + fr, fq * 8); boff = g8_lds_byte(wc * 32 + fr, fq * 8);
    ldsd = tid * 16; wr1 = (wr == 1);
    int R0, C0;
    g8_stage_rc(tid * 16, R0, C0);
    cc = C0;
    oa = (((R0 >> 2) & 3) * 16 + (R0 >> 4) * 4 + (R0 & 3)) * P::A_PITCH + C0;
    if constexpr (P::B_GATHER) {
      ob0 = p.b_row(cur, 0, R0) | (p.b_row(cur, 0, R0 + 64) << 16);
      ob1 = p.b_row(cur, 1, R0) | (p.b_row(cur, 1, R0 + 64) << 16);
    } else { ob0 = R0 * P::B_PITCH + C0; ob1 = ob0; }
  }
  const bf16* ca0 = p.a_base(cur, 0);
  const bf16* ca1 = p.a_base(cur, 1);
  const bf16* cb0 = p.b_base(cur, 0);
  const bf16* cb1 = p.b_base(cur, 1);

  g8acc_t acc;
#pragma unroll
  for (int a0 = 0; a0 < 2; ++a0)
#pragma unroll
    for (int b0 = 0; b0 < 2; ++b0)
#pragma unroll
      for (int m = 0; m < 4; ++m)
#pragma unroll
        for (int n = 0; n < 2; ++n) acc[a0][b0][m][n] = (f32x4){0.f, 0.f, 0.f, 0.f};
  i32x8 At[4], B0[2], B1[2];
  const int mxs = 0x7F7F7F7F;
  const int nt = opq(P::NKT);
  STAGE_B(SB(0, 0), cb0, ob0, 0); STAGE_A(SA(0, 0), ca0, 0);
  STAGE_B(SB(0, 1), cb1, ob1, 0); STAGE_A(SA(0, 1), ca1, 0);
  if (wr1) BAR;
  WAIT_V(4); BAR;
  STAGE_B(SB(1, 0), cb0, ob0, 1); STAGE_A(SA(1, 0), ca0, 1); STAGE_B(SB(1, 1), cb1, ob1, 1);
  WAIT_V(6); BAR;
#pragma unroll 1
  for (int idx = bid;;) {
    const int nidx = idx + nblk;
    const bool has_next = nidx < ntl;
    if (has_next) p.tile(nidx, nxt); else nxt = cur;
    const bf16* na0 = p.a_base(nxt, 0);
    const bf16* na1 = p.a_base(nxt, 1);
    const bf16* nb0 = p.b_base(nxt, 0);
    const bf16* nb1 = p.b_base(nxt, 1);
    unsigned nob0 = ob0, nob1 = ob1;
    if constexpr (P::B_GATHER) {
      const int t2 = tid_opaque();
      int R0, C0;
      g8_stage_rc(t2 * 16, R0, C0);
      nob0 = p.b_row(nxt, 0, R0) | (p.b_row(nxt, 0, R0 + 64) << 16);
      nob1 = p.b_row(nxt, 1, R0) | (p.b_row(nxt, 1, R0 + 64) << 16);
    }
#pragma unroll 1
    for (int t = 0; t < nt; t += 2) {
      const bool last = (t == nt - 2);
      const bf16* a2h0 = last ? na0 : ca0; const bf16* a2h1 = last ? na1 : ca1;
      const bf16* b2h0 = last ? nb0 : cb0; const bf16* b2h1 = last ? nb1 : cb1;
      const int k2 = last ? 0 : t + 2;
      const unsigned q0 = last ? nob0 : ob0, q1 = last ? nob1 : ob1;
      LDB(B0, 0, 0); SCHED; LDA(At, 0, 0); STAGE_A(SA(1, 1), ca1, t + 1);
      WAIT_L(8); BAR; WAIT_L(0); MMA(0, 0, At, B0); BAR; SCHED;
      LDB(B1, 0, 1); STAGE_B(SB(0, 0), b2h0, q0, k2);
      BAR; WAIT_L(0); MMA(0, 1, At, B1); BAR;
      LDA(At, 0, 1); STAGE_A(SA(0, 0), a2h0, k2);
      BAR; WAIT_L(0); MMA(1, 0, At, B0); BAR; SCHED;
      STAGE_B(SB(0, 1), b2h1, q1, k2);
      WAIT_V(6); BAR; MMA(1, 1, At, B1); BAR;
      LDB(B0, 1, 0); SCHED; LDA(At, 1, 0); STAGE_A(SA(0, 1), a2h1, k2);
      WAIT_L(8); BAR; WAIT_L(0); MMA(0, 0, At, B0); BAR; SCHED;
      LDB(B1, 1, 1); STAGE_B(SB(1, 0), b2h0, q0, k2 + 1);
      BAR; WAIT_L(0); MMA(0, 1, At, B1); BAR;
      LDA(At, 1, 1); STAGE_A(SA(1, 0), a2h0, k2 + 1);
      BAR; WAIT_L(0); MMA(1, 0, At, B0); BAR; SCHED;
      STAGE_B(SB(1, 1), b2h1, q1, k2 + 1);
      WAIT_V(6); BAR; MMA(1, 1, At, B1); BAR;
    }
    if constexpr (P::FP8) asm volatile("s_nop 15\n\ts_nop 15" ::: "memory");
    {
      const int t3 = tid_opaque();
      const int wid = t3 >> 6, lane = t3 & 63;
      p.epi(cur, acc, wid >> 2, wid & 3, lane & 15, lane >> 4);
    }
    if (!has_next) break;
#pragma unroll
    for (int a0 = 0; a0 < 2; ++a0)
#pragma unroll
      for (int b0 = 0; b0 < 2; ++b0)
#pragma unroll
        for (int m = 0; m < 4; ++m)
#pragma unroll
          for (int n = 0; n < 2; ++n) acc[a0][b0][m][n] = (f32x4){0.f, 0.f, 0.f, 0.f};
    cur = nxt; ca0 = na0; ca1 = na1; cb0 = nb0; cb1 = nb1;
    ob0 = nob0; ob1 = nob1;
    idx = nidx;
  }
  WAIT_V(0);
  if (!wr1) BAR;
  BAR;
#undef SA
#undef SB
#undef GLDS
#undef STAGE_A
#undef STAGE_B
#undef LDA
#undef LDB
#undef MMA
#undef FRAG_LO
#undef FRAG_HI
#undef WAIT_V
#undef WAIT_L
#undef BAR
#undef SCHED
}

#define G8_FOR_BLK(AI, BJ, M, N) \
  _Pragma("unroll") for (int AI = 0; AI < 2; ++AI) _Pragma("unroll") for (int BJ = 0; BJ < 2; ++BJ) \
  _Pragma("unroll") for (int M = 0; M < 4; ++M) _Pragma("unroll") for (int N = 0; N < 2; ++N)
#define G8_AIDX(AI, M) ((AI) * 128 + wr * 64 + fq * 16 + (M) * 4)
#define G8_BIDX(BJ, N) ((BJ) * 128 + wc * 32 + (N) * 16 + fr)
__device__ __forceinline__ u32x2 pack4_bf16(const f32x4 v) { return (u32x2){pack_bf16(v.x, v.y), pack_bf16(v.z, v.w)}; }
__device__ __forceinline__ unsigned pack4_fp8(const f32x4 v) { return pk4_fp8(v.x, v.y, v.z, v.w); }
__device__ __forceinline__ u32x4 pack8_bf16(const f32x4 a, const f32x4 b) { return (u32x4){pack_bf16(a.x, a.y), pack_bf16(a.z, a.w), pack_bf16(b.x, b.y), pack_bf16(b.z, b.w)}; }
#define G8_FOR_BLK2(AI, BJ, M2, N) \
  _Pragma("unroll") for (int AI = 0; AI < 2; ++AI) _Pragma("unroll") for (int BJ = 0; BJ < 2; ++BJ) \
  _Pragma("unroll") for (int M2 = 0; M2 < 4; M2 += 2) _Pragma("unroll") for (int N = 0; N < 2; ++N)

struct G8InZT {
  static constexpr int NKT = 16; static constexpr bool B_GATHER = false; static constexpr bool FP8 = false; static constexpr int B_PITCH = D; static constexpr int A_PITCH = D;
  template <class C_> __device__ unsigned b_row(const C_&, int, int) const { return 0u; }
  struct Ctx { int t0, z0; };
  const bf16* wt; const bf16* A; bf16* zt; int ntok;
  __device__ int ntiles() const { return 6 * (ntok / 256); }
  __device__ void tile(int idx, Ctx& c) const { int tt = idx / 6; c.z0 = (idx - tt * 6) * 256; c.t0 = tt * 256; }
  __device__ const bf16* a_base(const Ctx& c, int h) const { return A + (size_t)(c.t0 + h * 128) * D; }
  __device__ unsigned a_off(const Ctx&, int, int r) const { return r * D; }
  __device__ const bf16* b_base(const Ctx& c, int h) const { return wt + (size_t)(c.z0 + h * 128) * D; }
  __device__ unsigned b_off(const Ctx&, int, int r) const { return r * D; }
  __device__ void epi(const Ctx& c, g8acc_t& acc, int wr, int wc, int fr, int fq) const {
    G8_FOR_BLK2(ai, bj, m, n) {
      const int tok = c.t0 + G8_AIDX(ai, m), z = c.z0 + G8_BIDX(bj, n);
      *(u32x4*)(zt + (size_t)z * NT + tok) = pack8_bf16(acc[ai][bj][m][n], acc[ai][bj][m + 1][n]);
    }
  }
};
struct G8InG {
  static constexpr int NKT = 8; static constexpr bool B_GATHER = false; static constexpr bool FP8 = true; static constexpr int B_PITCH = D / 2; static constexpr int A_PITCH = D / 2;
  template <class C_> __device__ unsigned b_row(const C_&, int, int) const { return 0u; }
  struct Ctx { int c0, t0; };
  const unsigned char* wt; const unsigned char* A; bf16* zg;
  __device__ int ntiles() const { return 7 * (NT / 256); }
  __device__ void tile(int idx, Ctx& c) const { int tt = idx / 7; c.t0 = tt * 256; c.c0 = (idx - tt * 7) * 256; }
  __device__ const bf16* a_base(const Ctx& c, int h) const { return (const bf16*)(wt + (size_t)(c.c0 + h * 128) * D); }
  __device__ unsigned a_off(const Ctx&, int, int r) const { return r * (D / 2); }
  __device__ const bf16* b_base(const Ctx& c, int h) const { return (const bf16*)(A + (size_t)(c.t0 + h * 128) * D); }
  __device__ unsigned b_off(const Ctx&, int, int r) const { return r * (D / 2); }
  __device__ void epi(const Ctx& c, g8acc_t& acc, int wr, int wc, int fr, int fq) const {
    const float isc = 1.0f / 16.0f;
    G8_FOR_BLK2(ai, bj, m, n) {
      const int col = c.c0 + G8_AIDX(ai, m), tok = c.t0 + G8_BIDX(bj, n);
      if (col < GLACOLS) *(u32x4*)(zg + (size_t)tok * GLACOLS + col) = pack8_bf16(acc[ai][bj][m][n] * isc, acc[ai][bj][m + 1][n] * isc);
    }
  }
};
struct G8Out {
  static constexpr int NKT = 16; static constexpr bool B_GATHER = false; static constexpr bool FP8 = false; static constexpr int B_PITCH = D; static constexpr int A_PITCH = D;
  template <class C_> __device__ unsigned b_row(const C_&, int, int) const { return 0u; }
  struct Ctx { int c0, t0; };
  int mrows; const bf16* ymix; const bf16* wt; const float* modl; bf16* xs;
  __device__ int ntiles() const { return (mrows / 256) * 4; }
  __device__ void tile(int idx, Ctx& c) const { c.t0 = (idx >> 2) * 256; c.c0 = (idx & 3) * 256; }
  __device__ const bf16* a_base(const Ctx& c, int h) const { return wt + (size_t)(c.c0 + h * 128) * D; }
  __device__ unsigned a_off(const Ctx&, int, int r) const { return r * D; }
  __device__ const bf16* b_base(const Ctx& c, int h) const { return ymix + (size_t)(c.t0 + h * 128) * D; }
  __device__ unsigned b_off(const Ctx&, int, int r) const { return r * D; }
  __device__ void epi(const Ctx& c, g8acc_t& acc, int wr, int wc, int fr, int fq) const {
    const float* g1 = modl + (size_t)row_batch(c.t0) * 6 * D + 2 * D;
    G8_FOR_BLK(ai, bj, m, n) {
      const int col = c.c0 + G8_AIDX(ai, m), tok = c.t0 + G8_BIDX(bj, n);
      bf16* xp = xs + (size_t)tok * D + col;
      xs_store4(xp, xs_load4(xp) + *(const f32x4*)(g1 + col) * acc[ai][bj][m][n]);
    }
  }
};
struct G8Router {
  static constexpr int NKT = 16; static constexpr bool B_GATHER = false; static constexpr bool FP8 = false; static constexpr int B_PITCH = D; static constexpr int A_PITCH = D;
  template <class C_> __device__ unsigned b_row(const C_&, int, int) const { return 0u; }
  struct Ctx { int t0; };
  int mrows; const bf16* A; const bf16* rwt; float* logits;
  __device__ int ntiles() const { return mrows / 256; }
  __device__ void tile(int idx, Ctx& c) const { c.t0 = idx * 256; }
  __device__ const bf16* a_base(const Ctx&, int h) const { return rwt + (size_t)(h * 128) * D; }
  __device__ unsigned a_off(const Ctx&, int, int r) const { return r * D; }
  __device__ const bf16* b_base(const Ctx& c, int h) const { return A + (size_t)(c.t0 + h * 128) * D; }
  __device__ unsigned b_off(const Ctx&, int, int r) const { return r * D; }
  __device__ void epi(const Ctx& c, g8acc_t& acc, int wr, int wc, int fr, int fq) const {
    G8_FOR_BLK(ai, bj, m, n) {
      const int e = G8_AIDX(ai, m), tok = c.t0 + G8_BIDX(bj, n);
      *(f32x4*)(logits + (size_t)tok * NE + e) = acc[ai][bj][m][n];
    }
  }
};
struct G8ShUp {
  static constexpr int NKT = 8; static constexpr bool B_GATHER = false; static constexpr bool FP8 = true; static constexpr int B_PITCH = D / 2; static constexpr int A_PITCH = D / 2;
  template <class C_> __device__ unsigned b_row(const C_&, int, int) const { return 0u; }
  struct Ctx { int t0, hb; };
  int mrows; const unsigned char* A8; const unsigned char* s1t; const unsigned char* s3t; unsigned char* hs;
  __device__ int ntiles() const { return (mrows / 256) * 2; }
  __device__ void tile(int idx, Ctx& c) const { c.t0 = (idx >> 1) * 256; c.hb = (idx & 1) * 128; }
  __device__ const bf16* a_base(const Ctx& c, int h) const { return (const bf16*)((h ? s3t : s1t) + (size_t)c.hb * D); }
  __device__ unsigned a_off(const Ctx&, int, int r) const { return r * (D / 2); }
  __device__ const bf16* b_base(const Ctx& c, int h) const { return (const bf16*)(A8 + (size_t)(c.t0 + h * 128) * D); }
  __device__ unsigned b_off(const Ctx&, int, int r) const { return r * (D / 2); }
  __device__ void epi(const Ctx& c, g8acc_t& acc, int wr, int wc, int fr, int fq) const {
    const float isc = 1.0f / 16.0f;
#pragma unroll
    for (int bj = 0; bj < 2; ++bj)
#pragma unroll
      for (int n = 0; n < 2; ++n) {
        const int hcol = c.hb + wr * 64 + fq * 16, tok = c.t0 + G8_BIDX(bj, n);
        u32x4 o;
#pragma unroll
        for (int m = 0; m < 4; ++m) {
          const f32x4 u = acc[0][bj][m][n] * isc, v = acc[1][bj][m][n] * isc;
          const unsigned w = pk4_fp8(silu_f(u.x) * v.x, silu_f(u.y) * v.y, silu_f(u.z) * v.z, silu_f(u.w) * v.w);
          if (m == 0) o.x = w; else if (m == 1) o.y = w; else if (m == 2) o.z = w; else o.w = w;
        }
        *(u32x4*)(hs + (size_t)tok * DE + hcol) = o;
      }
  }
};
struct G8Up {
  static constexpr int NKT = 8; static constexpr bool B_GATHER = true; static constexpr bool FP8 = true; static constexpr int B_PITCH = D / 2; static constexpr int A_PITCH = D / 2;
  struct Ctx { int s0, hb, grp; };
  const unsigned char* A8; const int* slot_tok; const int* pad_start; const unsigned char* w1t; const unsigned char* w3t; unsigned char* H; const unsigned short* tile_e;
  __device__ int ntiles() const { return (pad_start[NE] >> 8) * 2; }
  __device__ void tile(int idx, Ctx& c) const { c.s0 = (idx >> 1) * 256; c.hb = (idx & 1) * 128; c.grp = __builtin_amdgcn_readfirstlane((int)tile_e[idx >> 1]); }
  __device__ const bf16* a_base(const Ctx& c, int h) const { return (const bf16*)((h ? w3t : w1t) + ((size_t)c.grp * DE + c.hb) * D); }
  __device__ unsigned a_off(const Ctx&, int, int r) const { return r * (D / 2); }
  __device__ const bf16* b_base(const Ctx&, int) const { return (const bf16*)A8; }
  __device__ unsigned b_off(const Ctx&, int, int) const { return 0u; }
  __device__ unsigned b_row(const Ctx& c, int h, int r) const { int t = slot_tok[c.s0 + h * 128 + r]; t = (t < 0 || t >= NT) ? 0 : t; return (unsigned)t; }
  __device__ void epi(const Ctx& c, g8acc_t& acc, int wr, int wc, int fr, int fq) const {
    const float isc = 1.0f / 16.0f;
#pragma unroll
    for (int bj = 0; bj < 2; ++bj)
#pragma unroll
      for (int n = 0; n < 2; ++n) {
        const int hcol = c.hb + wr * 64 + fq * 16, slot = c.s0 + G8_BIDX(bj, n);
        u32x4 o;
#pragma unroll
        for (int m = 0; m < 4; ++m) {
          const f32x4 u = acc[0][bj][m][n] * isc, v = acc[1][bj][m][n] * isc;
          const unsigned w = pk4_fp8(silu_f(u.x) * v.x, silu_f(u.y) * v.y, silu_f(u.z) * v.z, silu_f(u.w) * v.w);
          if (m == 0) o.x = w; else if (m == 1) o.y = w; else if (m == 2) o.z = w; else o.w = w;
        }
        *(u32x4*)(H + (size_t)slot * DE + hcol) = o;
      }
  }
};
struct G8ShDown {
  static constexpr int NKT = 2; static constexpr bool B_GATHER = false; static constexpr bool FP8 = true; static constexpr int B_PITCH = DE / 2; static constexpr int A_PITCH = DE / 2;
  template <class C_> __device__ unsigned b_row(const C_&, int, int) const { return 0u; }
  struct Ctx { int c0, t0; };
  int mrows; const unsigned char* hs; const unsigned char* wt; const float* modl; bf16* xs;
  __device__ int ntiles() const { return (mrows / 256) * 4; }
  __device__ void tile(int idx, Ctx& c) const { c.t0 = (idx >> 2) * 256; c.c0 = (idx & 3) * 256; }
  __device__ const bf16* a_base(const Ctx& c, int h) const { return (const bf16*)(wt + (size_t)(c.c0 + h * 128) * DE); }
  __device__ unsigned a_off(const Ctx&, int, int r) const { return r * (DE / 2); }
  __device__ const bf16* b_base(const Ctx& c, int h) const { return (const bf16*)(hs + (size_t)(c.t0 + h * 128) * DE); }
  __device__ unsigned b_off(const Ctx&, int, int r) const { return r * (DE / 2); }
  __device__ void epi(const Ctx& c, g8acc_t& acc, int wr, int wc, int fr, int fq) const {
    const float* g2 = modl + (size_t)row_batch(c.t0) * 6 * D + 5 * D;
    const float isc = 1.0f / 16.0f;
    G8_FOR_BLK(ai, bj, m, n) {
      const int col = c.c0 + G8_AIDX(ai, m), tok = c.t0 + G8_BIDX(bj, n);
      bf16* xp = xs + (size_t)tok * D + col;
      xs_store4(xp, xs_load4(xp) + *(const f32x4*)(g2 + col) * (acc[ai][bj][m][n] * isc));
    }
  }
};
struct G8Down {
  static constexpr int NKT = 2; static constexpr bool B_GATHER = false; static constexpr bool FP8 = true; static constexpr int B_PITCH = DE / 2; static constexpr int A_PITCH = DE / 2;
  struct Ctx { int c0, s0, grp; };
  const unsigned char* H; const int* pad_start; const unsigned char* w2t; unsigned char* Y; const unsigned short* tile_e;
  template <class C_> __device__ unsigned b_row(const C_&, int, int) const { return 0u; }
  __device__ int ntiles() const { return (pad_start[NE] >> 8) * 4; }
  __device__ void tile(int idx, Ctx& c) const { c.s0 = (idx >> 2) * 256; c.c0 = (idx & 3) * 256; c.grp = __builtin_amdgcn_readfirstlane((int)tile_e[idx >> 2]); }
  __device__ const bf16* a_base(const Ctx& c, int h) const { return (const bf16*)(w2t + ((size_t)c.grp * D + c.c0 + h * 128) * DE); }
  __device__ unsigned a_off(const Ctx&, int, int r) const { return r * (DE / 2); }
  __device__ const bf16* b_base(const Ctx& c, int h) const { return (const bf16*)(H + (size_t)(c.s0 + h * 128) * DE); }
  __device__ unsigned b_off(const Ctx&, int, int r) const { return r * (DE / 2); }
  __device__ void epi(const Ctx& c, g8acc_t& acc, int wr, int wc, int fr, int fq) const {
    const float isc = 1.0f / 16.0f;
#pragma unroll
    for (int ai = 0; ai < 2; ++ai)
#pragma unroll
      for (int bj = 0; bj < 2; ++bj)
#pragma unroll
        for (int n = 0; n < 2; ++n) {
          const int col = c.c0 + G8_AIDX(ai, 0), slot = c.s0 + G8_BIDX(bj, n);
          u32x4 o;
          o.x = pack4_fp8(acc[ai][bj][0][n] * isc); o.y = pack4_fp8(acc[ai][bj][1][n] * isc);
          o.z = pack4_fp8(acc[ai][bj][2][n] * isc); o.w = pack4_fp8(acc[ai][bj][3][n] * isc);
          *(u32x4*)(Y + (size_t)slot * D + col) = o;
        }
  }
};

constexpr int CVT_TILES = 3 * NE * 128;
struct CvtCtx { const float* w1; const float* w3; const float* w2; unsigned char* d1; unsigned char* d3; unsigned char* d2; };
struct CvtRegs { int pend; f32x4 r0, r1, r2, r3, r4, r5, r6, r7; };
__device__ __forceinline__ void cvt_locate(const CvtCtx& js, int u, int lane, const float*& s, unsigned char*& d, int& K, int& N) {
  const int job = u >> 15, r = u & 32767, mat = r >> 7, rr = r & 127;
  int kt, ntile;
  if (job < 2) { K = D; N = DE; ntile = rr >> 4; kt = rr & 15; } else { K = DE; N = D; ntile = rr >> 2; kt = rr & 3; }
  const float* s1 = js.w1; const float* s3 = js.w3; const float* s2 = js.w2;
  unsigned char* q1 = js.d1; unsigned char* q3 = js.d3; unsigned char* q2 = js.d2;
  const float* sb = job == 0 ? s1 : (job == 1 ? s3 : s2);
  unsigned char* db = job == 0 ? q1 : (job == 1 ? q3 : q2);
  const int k0 = kt * 64 + (lane & 7) * 8, n0 = ntile * 32 + (lane >> 3) * 4;
  s = sb + (size_t)mat * D * DE + (size_t)k0 * N + n0;
  d = db + (size_t)mat * D * DE + (size_t)n0 * K + k0;
}
__device__ __forceinline__ void cvt_init(CvtRegs& st) {
  st.pend = -1;
  st.r0 = st.r1 = st.r2 = st.r3 = st.r4 = st.r5 = st.r6 = st.r7 = (f32x4){0.f, 0.f, 0.f, 0.f};
}
__device__ __forceinline__ void cvt_finish(const CvtCtx& cx, CvtRegs& st, int lane) {
  if (st.pend < 0) return;
  const float* s; unsigned char* d; int K, N;
  cvt_locate(cx, st.pend, lane, s, d, K, N);
  const float sc = 16.0f;
  const f32x4 v0 = st.r0 * sc, v1 = st.r1 * sc, v2 = st.r2 * sc, v3 = st.r3 * sc, v4 = st.r4 * sc, v5 = st.r5 * sc, v6 = st.r6 * sc, v7 = st.r7 * sc;
  *(u32x2*)(d) = (u32x2){pk4_fp8(v0.x, v1.x, v2.x, v3.x), pk4_fp8(v4.x, v5.x, v6.x, v7.x)};
  *(u32x2*)(d + (size_t)K) = (u32x2){pk4_fp8(v0.y, v1.y, v2.y, v3.y), pk4_fp8(v4.y, v5.y, v6.y, v7.y)};
  *(u32x2*)(d + (size_t)2 * K) = (u32x2){pk4_fp8(v0.z, v1.z, v2.z, v3.z), pk4_fp8(v4.z, v5.z, v6.z, v7.z)};
  *(u32x2*)(d + (size_t)3 * K) = (u32x2){pk4_fp8(v0.w, v1.w, v2.w, v3.w), pk4_fp8(v4.w, v5.w, v6.w, v7.w)};
  st.pend = -1;
}
constexpr int CVT_GLA_TILES = 128 * 36 * 2 * 8;
static_assert(CVT_GLA_TILES + 512 * 2 * 3 * 8 == CVT_TILES, "tile ownership must cover every tile exactly once");
__device__ __forceinline__ void cvt_step(const CvtCtx& cx, CvtRegs& st, int lane, int u) {
  cvt_finish(cx, st, lane);
  const float* s; unsigned char* d; int K, N;
  cvt_locate(cx, u, lane, s, d, K, N);
  st.r0 = __builtin_nontemporal_load((const f32x4*)(s));
  st.r1 = __builtin_nontemporal_load((const f32x4*)(s + (size_t)N));
  st.r2 = __builtin_nontemporal_load((const f32x4*)(s + (size_t)2 * N));
  st.r3 = __builtin_nontemporal_load((const f32x4*)(s + (size_t)3 * N));
  st.r4 = __builtin_nontemporal_load((const f32x4*)(s + (size_t)4 * N));
  st.r5 = __builtin_nontemporal_load((const f32x4*)(s + (size_t)5 * N));
  st.r6 = __builtin_nontemporal_load((const f32x4*)(s + (size_t)6 * N));
  st.r7 = __builtin_nontemporal_load((const f32x4*)(s + (size_t)7 * N));
  st.pend = u;
}

constexpr int UST = 2056;
constexpr int HY_U_BYTES = 16 * UST * 2;
constexpr int TCOPY = 2064;
constexpr int HY_T_BYTES = 4 * TCOPY * 4;
constexpr int HY_LDS = HY_U_BYTES + HY_T_BYTES;
constexpr int USTC = 264;
constexpr int TCOPYC = 264;

__device__ __forceinline__ f32x4 mfma16(bf16x8 a, bf16x8 b, f32x4 c) {
  return __builtin_amdgcn_mfma_f32_16x16x32_bf16(a, b, c, 0, 0, 0);
}
__device__ __forceinline__ float bflo(unsigned v) { return __uint_as_float(v << 16); }
__device__ __forceinline__ float bfhi(unsigned v) { return __uint_as_float(v & 0xffff0000u); }
__device__ __forceinline__ float ldbf(const bf16* p) { return bf2f(*p); }

template <int GSTR, int TCP>
__device__ __forceinline__ void hy_load_tables(const bf16* __restrict__ G, int c, unsigned* T) {
  constexpr int NCH = GSTR / 8;
  for (int q = tid_opaque(); q < 2 * NCH; q += 512) {
    int o = q / NCH, ch = q - o * NCH;
    const unsigned* s32 = (const unsigned*)(G + ((size_t)(o * 512 + c)) * GSTR);
    u32x4 a = *(const u32x4*)(s32 + 4 * ch);
    unsigned nx = (ch + 1 < NCH) ? s32[4 * ch + 4] : 0u;
    unsigned* d0 = T + o * 2 * TCP;
    unsigned* d1 = d0 + TCP;
    *(u32x4*)(d0 + 4 * ch) = a;
    u32x4 b;
    b.x = (a.x >> 16) | (a.y << 16); b.y = (a.y >> 16) | (a.z << 16); b.z = (a.z >> 16) | (a.w << 16); b.w = (a.w >> 16) | (nx << 16);
    *(u32x4*)(d1 + 4 * ch) = b;
  }
}

template <int L, int USTR>
__device__ __forceinline__ void hy_load_u(const bf16* __restrict__ z, float w0, float w1, float w2, float bb, bf16* U) {
  constexpr int CPB = L / 8;
  for (int q = tid_opaque(); q < 16 * CPB; q += 512) {
    int b = q / CPB, t8 = (q - b * CPB) * 8;
    const bf16* zr = z + (size_t)b * L + t8;
    u32x4 v = *(const u32x4*)zr;
    float zm = t8 > 0 ? ldbf(zr - 1) : 0.f;
    float zp = t8 + 8 < L ? ldbf(zr + 8) : 0.f;
    float e0 = bflo(v.x), e1 = bfhi(v.x), e2 = bflo(v.y), e3 = bfhi(v.y), e4 = bflo(v.z), e5 = bfhi(v.z), e6 = bflo(v.w), e7 = bfhi(v.w);
    u32x4 o;
    o.x = pack_bf16(w0 * zm + w1 * e0 + w2 * e1 + bb, w0 * e0 + w1 * e1 + w2 * e2 + bb);
    o.y = pack_bf16(w0 * e1 + w1 * e2 + w2 * e3 + bb, w0 * e2 + w1 * e3 + w2 * e4 + bb);
    o.z = pack_bf16(w0 * e3 + w1 * e4 + w2 * e5 + bb, w0 * e4 + w1 * e5 + w2 * e6 + bb);
    o.w = pack_bf16(w0 * e5 + w1 * e6 + w2 * e7 + bb, w0 * e6 + w1 * e7 + w2 * zp + bb);
    *(u32x4*)(U + b * USTR + t8) = o;
  }
}

template <int L>
__device__ __forceinline__ void hy_gate4(const bf16* __restrict__ zr, int t0, float w0, float w1, float w2, float bb, float (&x)[4]) {
  u32x2 v = *(const u32x2*)(zr + t0);
  float zm = t0 > 0 ? ldbf(zr + t0 - 1) : 0.f;
  float zp = t0 + 4 < L ? ldbf(zr + t0 + 4) : 0.f;
  float e0 = bflo(v.x), e1 = bfhi(v.x), e2 = bflo(v.y), e3 = bfhi(v.y);
  x[0] = w0 * zm + w1 * e0 + w2 * e1 + bb;
  x[1] = w0 * e0 + w1 * e1 + w2 * e2 + bb;
  x[2] = w0 * e1 + w1 * e2 + w2 * e3 + bb;
  x[3] = w0 * e2 + w1 * e3 + w2 * zp + bb;
}

__device__ __forceinline__ bf16x8 hy_frag(const unsigned* p) {
  u32x4 v; v.x = p[0]; v.y = p[1]; v.z = p[2]; v.w = p[3];
  return __builtin_bit_cast(bf16x8, v);
}

__device__ __forceinline__ void hyena_latent(int c, const bf16* __restrict__ zt, const float* __restrict__ cw,
                                             const float* __restrict__ cb, const bf16* __restrict__ G,
                                             bf16* __restrict__ yt, char* smem, const CvtCtx& cx) {
  const int tid = tid_opaque(), lane = tid & 63, wave = tid >> 6;
  bf16* U = (bf16*)smem;
  unsigned* T = (unsigned*)(smem + HY_U_BYTES);
  __syncthreads();
  hy_load_tables<GSTR_L, TCOPY>(G, c, T);
  hy_load_u<SEQ, UST>(zt + (size_t)c * NT, cw[c], cw[HYCOLS + c], cw[2 * HYCOLS + c], cb[c], U);
  __syncthreads();
  const int r = lane & 15, kg = lane >> 4;
  const int par = (r + 1) & 1;
  const int base_dw = 1023 - (r >> 1) + 4 * kg - 128 * wave;
  const char* ub = smem + (r * UST + 8 * kg) * 2;
  const int tw = wave * 256;
#pragma unroll 1
  for (int order = 0; order < 2; ++order) {
    const unsigned* tb = T + order * 2 * TCOPY + par * TCOPY + base_dw;
    f32x4 acc[16];
#pragma unroll
    for (int i = 0; i < 16; ++i) acc[i] = (f32x4){0.f, 0.f, 0.f, 0.f};
    bf16x8 W[16];
#pragma unroll
    for (int f = -15; f <= 0; ++f) W[f & 15] = hy_frag(tb + 8 * f);
    CvtRegs cr; cvt_init(cr);
    const int wv = __builtin_amdgcn_readfirstlane(wave);
#pragma unroll 1
    for (int J = 0; J < 8; ++J) {
      const unsigned* tj = tb + 128 * J;
      const char* uj = ub + 512 * J;
#pragma unroll
      for (int jj = 0; jj < 8; ++jj) {
        if (jj == 0 && (J == 0 || J == 3 || J == 6)) cvt_step(cx, cr, lane, CVT_GLA_TILES + ((c * 2 + order) * 3 + J / 3) * 8 + wv);
        bf16x8 uf = *(const bf16x8*)(uj + 64 * jj);
        acc[15] = mfma16(W[(2 * jj - 15) & 15], uf, acc[15]);
        acc[14] = mfma16(W[(2 * jj - 14) & 15], uf, acc[14]);
        if (J * 8 + jj < 63) {
          W[(2 * jj + 1) & 15] = hy_frag(tj + 8 * (2 * jj + 1));
          W[(2 * jj + 2) & 15] = hy_frag(tj + 8 * (2 * jj + 2));
        }
#pragma unroll
        for (int i = 13; i >= 0; --i) acc[i] = mfma16(W[(2 * jj - i) & 15], uf, acc[i]);
      }
    }
    cvt_finish(cx, cr, lane);
    __syncthreads();
    {
      const int col = (order + 1) * 512 + c;
      const float w0 = cw[col], w1 = cw[HYCOLS + col], w2 = cw[2 * HYCOLS + col], bb = cb[col];
      const bf16* zr = zt + (size_t)col * NT + (size_t)r * SEQ;
      u32x2 gv[16]; unsigned gm[16], gp[16];
#pragma unroll
      for (int i = 0; i < 16; ++i) {
        const int t0 = tw + 16 * i + 4 * kg;
        gv[i] = *(const u32x2*)(zr + t0);
        gm[i] = t0 > 0 ? (unsigned)*(const unsigned short*)(zr + t0 - 1) : 0u;
        gp[i] = t0 + 4 < SEQ ? (unsigned)*(const unsigned short*)(zr + t0 + 4) : 0u;
      }
#pragma unroll
      for (int i = 0; i < 16; ++i) {
        const int t0 = tw + 16 * i + 4 * kg;
        const float zm = __uint_as_float(gm[i] << 16), zp = __uint_as_float(gp[i] << 16);
        const float e0 = bflo(gv[i].x), e1 = bfhi(gv[i].x), e2 = bflo(gv[i].y), e3 = bfhi(gv[i].y);
        const float x0 = w0 * zm + w1 * e0 + w2 * e1 + bb, x1 = w0 * e0 + w1 * e1 + w2 * e2 + bb;
        const float x2 = w0 * e1 + w1 * e2 + w2 * e3 + bb, x3 = w0 * e2 + w1 * e3 + w2 * zp + bb;
        u32x2 o;
        o.x = pack_bf16(x0 * acc[i][0], x1 * acc[i][1]);
        o.y = pack_bf16(x2 * acc[i][2], x3 * acc[i][3]);
        *(u32x2*)(U + r * UST + t0) = o;
      }
    }
    __syncthreads();
  }
  for (int q = tid; q < 16 * 256; q += 512) {
    int b = q >> 8, t8 = (q & 255) * 8;
    *(u32x4*)(yt + (size_t)c * NT + (size_t)b * SEQ + t8) = *(const u32x4*)(U + b * UST + t8);
  }
}

__device__ __forceinline__ void hyena_ctx(int c, const bf16* __restrict__ zt, const float* __restrict__ cw,
                                          const float* __restrict__ cb, const bf16* __restrict__ G,
                                          bf16* __restrict__ yt, char* smem) {
  const int tid = tid_opaque(), lane = tid & 63, wave = tid >> 6;
  bf16* U = (bf16*)smem;
  unsigned* T = (unsigned*)(smem + HY_U_BYTES);
  __syncthreads();
  hy_load_tables<GSTR_C, TCOPYC>(G, c, T);
  hy_load_u<LC, USTC>(zt + (size_t)c * NT, cw[c], cw[HYCOLS + c], cw[2 * HYCOLS + c], cb[c], U);
  __syncthreads();
  const int r = lane & 15, kg = lane >> 4;
  const int par = (r + 1) & 1;
  const int base_dw = (8 * kg - r + 255 - par) >> 1;
  const char* ub = smem + (r * USTC + 8 * kg) * 2;
#pragma unroll 1
  for (int order = 0; order < 2; ++order) {
    const unsigned* tb = T + order * 2 * TCOPYC + par * TCOPYC + base_dw;
    f32x4 acc[2];
    acc[0] = (f32x4){0.f, 0.f, 0.f, 0.f};
    acc[1] = acc[0];
#pragma unroll
    for (int j = 0; j < 8; ++j) {
      bf16x8 uf = *(const bf16x8*)(ub + 64 * j);
#pragma unroll
      for (int ii = 0; ii < 2; ++ii) {
        const int i = wave * 2 + ii;
        acc[ii] = mfma16(hy_frag(tb + 16 * j - 8 * i), uf, acc[ii]);
      }
    }
    __syncthreads();
    {
      const int col = (order + 1) * 512 + c;
      const float w0 = cw[col], w1 = cw[HYCOLS + col], w2 = cw[2 * HYCOLS + col], bb = cb[col];
      const bf16* zr = zt + (size_t)col * NT + (size_t)r * LC;
#pragma unroll
      for (int ii = 0; ii < 2; ++ii) {
        const int t0 = (wave * 2 + ii) * 16 + 4 * kg;
        float x[4];
        hy_gate4<LC>(zr, t0, w0, w1, w2, bb, x);
        u32x2 o;
        o.x = pack_bf16(x[0] * acc[ii][0], x[1] * acc[ii][1]);
        o.y = pack_bf16(x[2] * acc[ii][2], x[3] * acc[ii][3]);
        *(u32x2*)(U + r * USTC + t0) = o;
      }
    }
    __syncthreads();
  }
  {
    int b = tid >> 5, t8 = (tid & 31) * 8;
    *(u32x4*)(yt + (size_t)c * NT + (size_t)b * LC + t8) = *(const u32x4*)(U + b * USTC + t8);
  }
}

constexpr int GL_QE = 0, GL_KE = 8192, GL_KST = 16384, GL_ATT = 24576, GL_ST = 32768, GL_VT = 49152  ;
constexpr int GL_RAW = 81920  , GL_RAWSZ = 18432, GL_SEG = 118784, GL_DEC = 120832;
constexpr int GLA_LDS = 121088;

__device__ __forceinline__ f32x16 mfma32(bf16x8 a, bf16x8 b, f32x16 c) {
  return __builtin_amdgcn_mfma_f32_32x32x16_bf16(a, b, c, 0, 0, 0);
}
__device__ __forceinline__ unsigned short bf16bits(float v) { bf16 h = f2bf(v); return *(unsigned short*)&h; }

struct GlaArgs {
  const bf16* zg; const float* wa2; const float* ba2; bf16* of; bf16* ob; int emit_ctx; int pad_;
};

__device__ __forceinline__ void gla_unit(int unit, const GlaArgs& a, char* smem, const CvtCtx& cx) {
  const int tid = tid_opaque(), lane = tid & 63, wave = tid >> 6;
  const int dir = unit & 1, h = (unit >> 1) & 3, b = unit >> 3;
  const int lr = lane & 31, lh = lane >> 5;
  const int swl = (lr >> 1) & 7;
  bf16* outp = dir ? a.ob : a.of;
  __syncthreads();
  const int d = tid & 63, sg = tid >> 6;
  float wa[16];
#pragma unroll
  for (int r = 0; r < 16; ++r) wa[r] = a.wa2[(dir * 16 + r) * 256 + h * 64 + d];
  const float ba = a.ba2[dir * 256 + h * 64 + d];
  { unsigned zz = 0u; asm volatile("" : "+v"(zz));
    for (int q = tid; q < 16384 / 16; q += 512) *(u32x4*)(smem + GL_ST + q * 16) = (u32x4){zz, zz, zz, zz}; }
  f32x16 S;
#pragma unroll
  for (int r = 0; r < 16; ++r) S[r] = 0.f;

  const int qi = tid >> 3, qc = tid & 7;
  const int ai = (tid >> 1) & 63, ac = tid & 1;
  const int vsg = (tid >> 5) & 7, vdq = tid & 31;
  u32x4 pq, pk, pa;
  u32x2 pw0, pw1, pw2, pw3, pw4, pw5, pw6, pw7;

#define GLA_ROW(N_, I_, ROW_)                                                        \
  {                                                                                  \
    const int n_ = (N_);                                                             \
    const int Ls_ = n_ < 4 ? LC : SEQ;                                               \
    const int cn_ = n_ < 4 ? n_ : n_ - 4;                                            \
    const int rb_ = n_ < 4 ? (NL + b * LC) : (b * SEQ);                              \
    const int pos_ = cn_ * 64 + (I_);                                                \
    ROW_ = rb_ + (dir ? (Ls_ - 1 - pos_) : pos_);                                    \
  }
#define GLA_LOAD_RAW(N_)                                                             \
  {                                                                                  \
    int row_;                                                                        \
    GLA_ROW(N_, qi, row_);                                                           \
    const bf16* zr_ = a.zg + (size_t)row_ * GLACOLS;                                 \
    pq = *(const u32x4*)(zr_ + h * 64 + qc * 8);                                     \
    pk = *(const u32x4*)(zr_ + 256 + h * 64 + qc * 8);                               \
    int ra_;                                                                         \
    GLA_ROW(N_, ai, ra_);                                                            \
    pa = *(const u32x4*)(a.zg + (size_t)ra_ * GLACOLS + 1536 + dir * 16 + ac * 8);   \
  }
#define GLA_LOAD_V(N_)                                                               \
  {                                                                                  \
    int rv_;                                                                         \
    GLA_ROW(N_, vsg * 8 + 0, rv_); pw0 = *(const u32x2*)(a.zg + (size_t)rv_ * GLACOLS + 512 + h * 128 + vdq * 4); \
    GLA_ROW(N_, vsg * 8 + 1, rv_); pw1 = *(const u32x2*)(a.zg + (size_t)rv_ * GLACOLS + 512 + h * 128 + vdq * 4); \
    GLA_ROW(N_, vsg * 8 + 2, rv_); pw2 = *(const u32x2*)(a.zg + (size_t)rv_ * GLACOLS + 512 + h * 128 + vdq * 4); \
    GLA_ROW(N_, vsg * 8 + 3, rv_); pw3 = *(const u32x2*)(a.zg + (size_t)rv_ * GLACOLS + 512 + h * 128 + vdq * 4); \
    GLA_ROW(N_, vsg * 8 + 4, rv_); pw4 = *(const u32x2*)(a.zg + (size_t)rv_ * GLACOLS + 512 + h * 128 + vdq * 4); \
    GLA_ROW(N_, vsg * 8 + 5, rv_); pw5 = *(const u32x2*)(a.zg + (size_t)rv_ * GLACOLS + 512 + h * 128 + vdq * 4); \
    GLA_ROW(N_, vsg * 8 + 6, rv_); pw6 = *(const u32x2*)(a.zg + (size_t)rv_ * GLACOLS + 512 + h * 128 + vdq * 4); \
    GLA_ROW(N_, vsg * 8 + 7, rv_); pw7 = *(const u32x2*)(a.zg + (size_t)rv_ * GLACOLS + 512 + h * 128 + vdq * 4); \
  }
#define GLA_STORE_RAW(RB_)                                                           \
  {                                                                                  \
    char* rw_ = smem + GL_RAW + (RB_) * GL_RAWSZ;                                    \
    *(u32x4*)(rw_ + qi * 128 + qc * 16) = pq;                                        \
    *(u32x4*)(rw_ + 8192 + qi * 128 + qc * 16) = pk;                                 \
    if (tid < 128) *(u32x4*)(rw_ + 16384 + ai * 32 + ac * 16) = pa;                  \
  }
#define GLA_STORE_V(VB_)                                                             \
  if (tid < 256) {                                                                   \
    char* vt_ = smem + GL_VT + (VB_) * 16384;                                        \
    u32x4 o;                                                                         \
    o.x = (pw0.x & 0xffffu) | (pw1.x << 16); o.y = (pw2.x & 0xffffu) | (pw3.x << 16); o.z = (pw4.x & 0xffffu) | (pw5.x << 16); o.w = (pw6.x & 0xffffu) | (pw7.x << 16); \
    *(u32x4*)(vt_ + swz(vdq * 4 + 0, vsg)) = o;                                      \
    o.x = (pw0.x >> 16) | (pw1.x & 0xffff0000u); o.y = (pw2.x >> 16) | (pw3.x & 0xffff0000u); o.z = (pw4.x >> 16) | (pw5.x & 0xffff0000u); o.w = (pw6.x >> 16) | (pw7.x & 0xffff0000u); \
    *(u32x4*)(vt_ + swz(vdq * 4 + 1, vsg)) = o;                                      \
    o.x = (pw0.y & 0xffffu) | (pw1.y << 16); o.y = (pw2.y & 0xffffu) | (pw3.y << 16); o.z = (pw4.y & 0xffffu) | (pw5.y << 16); o.w = (pw6.y & 0xffffu) | (pw7.y << 16); \
    *(u32x4*)(vt_ + swz(vdq * 4 + 2, vsg)) = o;                                      \
    o.x = (pw0.y >> 16) | (pw1.y & 0xffff0000u); o.y = (pw2.y >> 16) | (pw3.y & 0xffff0000u); o.z = (pw4.y >> 16) | (pw5.y & 0xffff0000u); o.w = (pw6.y >> 16) | (pw7.y & 0xffff0000u); \
    *(u32x4*)(vt_ + swz(vdq * 4 + 3, vsg)) = o;                                      \
  }
#define GLA_STEP3(RB_)                                                               \
  {                                                                                  \
    const char* ra_ = smem + GL_RAW + (RB_) * GL_RAWSZ + 16384;                      \
    float run = 0.f;                                                                 \
    _Pragma("unroll") for (int ii = 0; ii < 8; ++ii) {                               \
      const int i = sg * 8 + ii;                                                     \
      const u32x4 a0 = *(const u32x4*)(ra_ + i * 32);                                \
      const u32x4 a1 = *(const u32x4*)(ra_ + i * 32 + 16);                           \
      float g = ba;                                                                  \
      g += bflo(a0.x) * wa[0] + bfhi(a0.x) * wa[1] + bflo(a0.y) * wa[2] + bfhi(a0.y) * wa[3]; \
      g += bflo(a0.z) * wa[4] + bfhi(a0.z) * wa[5] + bflo(a0.w) * wa[6] + bfhi(a0.w) * wa[7]; \
      g += bflo(a1.x) * wa[8] + bfhi(a1.x) * wa[9] + bflo(a1.y) * wa[10] + bfhi(a1.y) * wa[11]; \
      g += bflo(a1.z) * wa[12] + bfhi(a1.z) * wa[13] + bflo(a1.w) * wa[14] + bfhi(a1.w) * wa[15]; \
      run += logsigmoid_f(g) * (1.0f / 16.0f);                                       \
      bl[ii] = run;                                                                  \
    }                                                                                \
    *(float*)(smem + GL_SEG + (sg * 64 + d) * 4) = run;                              \
  }
#define GLA_STEP5(RB_)                                                               \
  {                                                                                  \
    const char* rq_ = smem + GL_RAW + (RB_) * GL_RAWSZ;                              \
    float off = 0.f, tot = 0.f;                                                      \
    _Pragma("unroll") for (int s = 0; s < 8; ++s) {                                  \
      float v = *(const float*)(smem + GL_SEG + (s * 64 + d) * 4);                  \
      off += (s < sg) ? v : 0.f;                                                     \
      tot += v;                                                                      \
    }                                                                                \
    float ks[8];                                                                     \
    _Pragma("unroll") for (int ii = 0; ii < 8; ++ii) {                               \
      const int i = sg * 8 + ii;                                                     \
      const float bb = off + bl[ii];                                                 \
      const float qv = bf2f(*(const bf16*)(rq_ + i * 128 + d * 2));                 \
      const float kv = bf2f(*(const bf16*)(rq_ + 8192 + i * 128 + d * 2));          \
      const int eo = swz(i, d >> 3) + (d & 7) * 2;                                   \
      *(unsigned short*)(smem + GL_QE + eo) = bf16bits(qv * 0.125f * __expf(bb));    \
      *(unsigned short*)(smem + GL_KE + eo) = bf16bits(kv * __expf(-bb));            \
      ks[ii] = kv * __expf(tot - bb);                                                \
    }                                                                                \
    u32x4 o;                                                                         \
    o.x = pack_bf16(ks[0], ks[1]); o.y = pack_bf16(ks[2], ks[3]); o.z = pack_bf16(ks[4], ks[5]); o.w = pack_bf16(ks[6], ks[7]); \
    *(u32x4*)(smem + GL_KST + swz(d, sg)) = o;                                       \
    if (sg == 0) *(float*)(smem + GL_DEC + d * 4) = __expf(tot);                     \
  }

  const int tm = wave >> 2, tn = wave & 3;
  float bl[8];
  f32x16 oprev;
#pragma unroll
  for (int r = 0; r < 16; ++r) oprev[r] = 0.f;

#define GLA_STORE_OUT(N_)                                                                  \
  {                                                                                        \
    _Pragma("unroll") for (int r = 0; r < 16; ++r) {                                       \
      int row;                                                                             \
      GLA_ROW(N_, tm * 32 + rowmap(r, lh), row);                                           \
      *(unsigned short*)(outp + (size_t)row * 512 + h * 128 + tn * 32 + lr) = bf16bits(oprev[r]); \
    }                                                                                      \
  }
  GLA_LOAD_RAW(0); GLA_LOAD_V(0);
  GLA_STORE_RAW(0); GLA_STORE_V(0);
  GLA_LOAD_RAW(1);
  GLA_STORE_RAW(1);
  __syncthreads();
  GLA_STEP3(0);
  __syncthreads();
  GLA_STEP5(0);
  GLA_LOAD_RAW(2); GLA_LOAD_V(1);
  __syncthreads();
  CvtRegs cr; cvt_init(cr);
  const int cvt_u0 = __builtin_amdgcn_readfirstlane(unit * 36 * 16 + wave);
#pragma unroll 1
  for (int n = 0; n < 36; ++n) {
    const int vb = n & 1;
    const bool has1 = n + 1 < 36;
    cvt_step(cx, cr, lane, cvt_u0 + n * 16);
    f32x16 oacc;
#pragma unroll
    for (int r = 0; r < 16; ++r) oacc[r] = 0.f;
#pragma unroll
    for (int r = 0; r < 16; ++r) S[r] *= *(const float*)(smem + GL_DEC + (tm * 32 + rowmap(r, lh)) * 4);
#pragma unroll
    for (int ks4 = 0; ks4 < 4; ++ks4) {
      const int c = ((2 * ks4 + lh) ^ swl) << 4;
      const bf16x8 fq = *(const bf16x8*)(smem + GL_QE + (tm * 32 + lr) * 128 + c);
      const bf16x8 fs = *(const bf16x8*)(smem + GL_ST + (tn * 32 + lr) * 128 + c);
      oacc = mfma32(fq, fs, oacc);
      const bf16x8 fk = *(const bf16x8*)(smem + GL_KST + (tm * 32 + lr) * 128 + c);
      const bf16x8 fv = *(const bf16x8*)(smem + GL_VT + vb * 16384 + (tn * 32 + lr) * 128 + c);
      S = mfma32(fk, fv, S);
    }
    if (wave < 4) {
      const int am = wave >> 1, an = wave & 1;
      f32x16 att;
#pragma unroll
      for (int r = 0; r < 16; ++r) att[r] = 0.f;
#pragma unroll
      for (int ks4 = 0; ks4 < 4; ++ks4) {
        const int c = ((2 * ks4 + lh) ^ swl) << 4;
        const bf16x8 fq = *(const bf16x8*)(smem + GL_QE + (am * 32 + lr) * 128 + c);
        const bf16x8 fk = *(const bf16x8*)(smem + GL_KE + (an * 32 + lr) * 128 + c);
        att = mfma32(fq, fk, att);
      }
      const int s = an * 32 + lr;
#pragma unroll
      for (int r = 0; r < 16; ++r) {
        const int t = am * 32 + rowmap(r, lh);
        const float v = (s <= t) ? att[r] : 0.f;
        *(unsigned short*)(smem + GL_ATT + swz(t, s >> 3) + (s & 7) * 2) = bf16bits(v);
      }
    }
    if (has1) GLA_STEP3((n + 1) & 1);
    __syncthreads();
    cvt_step(cx, cr, lane, cvt_u0 + n * 16 + 8);
#pragma unroll
    for (int ks4 = 0; ks4 < 4; ++ks4) {
      const int c = ((2 * ks4 + lh) ^ swl) << 4;
      const bf16x8 fa = *(const bf16x8*)(smem + GL_ATT + (tm * 32 + lr) * 128 + c);
      const bf16x8 fv = *(const bf16x8*)(smem + GL_VT + vb * 16384 + (tn * 32 + lr) * 128 + c);
      oacc = mfma32(fa, fv, oacc);
    }
#pragma unroll
    for (int g = 0; g < 4; ++g) {
      u32x2 o;
      o.x = pack_bf16(S[4 * g + 0], S[4 * g + 1]);
      o.y = pack_bf16(S[4 * g + 2], S[4 * g + 3]);
      *(u32x2*)(smem + GL_ST + swz(tn * 32 + lr, tm * 4 + g) + 8 * lh) = o;
    }
    if (has1) {
      GLA_STEP5((n + 1) & 1);
      GLA_STORE_V((n + 1) & 1);
      if (n + 2 < 36) GLA_STORE_RAW(n & 1);
    }
    if (n > 0 && (n - 1 >= 4 || a.emit_ctx)) { GLA_STORE_OUT(n - 1); }
    { const int nr = n + 3 < 36 ? n + 3 : 35; GLA_LOAD_RAW(nr); const int nv = n + 2 < 36 ? n + 2 : 35; GLA_LOAD_V(nv); }
    oprev = oacc;
    __syncthreads();
  }
  cvt_finish(cx, cr, lane);
  { GLA_STORE_OUT(35); }
#undef GLA_STORE_OUT
#undef GLA_ROW
#undef GLA_LOAD_RAW
#undef GLA_LOAD_V
#undef GLA_STORE_RAW
#undef GLA_STORE_V
#undef GLA_STEP3
#undef GLA_STEP5
}


constexpr int CTRL_Q = 0;
constexpr int CTRL_CNT = 128;
constexpr int CTRL_CUR = 640;
constexpr int CTRL_XR = 1152;
constexpr int CTRL_WORDS = 1152 + 256;
constexpr size_t al256(size_t v) { return (v + 255) / 256 * 256; }
namespace wso {
constexpr size_t bar = 0;
constexpr size_t ctrl = al256(bar + (size_t)XCD_BAR_WORDS * 4);
constexpr size_t zero_end = al256(ctrl + (size_t)CTRL_WORDS * 4);
constexpr size_t xs = al256(ctrl + (size_t)CTRL_WORDS * 4);
constexpr size_t mod = al256(xs + (size_t)NT * D * 4);
constexpr size_t abuf = al256(mod + (size_t)DEPTH * 17 * 6 * D * 4);
constexpr size_t zt = al256(abuf + (size_t)NT * D * 2);
constexpr size_t zg = al256(zt + (size_t)HYCOLS * NT * 2);
constexpr size_t yt = al256(zg + (size_t)NT * GLACOLS * 2);
constexpr size_t of = al256(yt + (size_t)HYW * NT * 2);
constexpr size_t ob = al256(of + (size_t)NT * 512 * 4);
constexpr size_t ymix = al256(ob + (size_t)NT * 512 * 4);
constexpr size_t region_end_raw = al256(ymix + (size_t)NT * D * 2);
constexpr size_t region_end = (region_end_raw > zt + al256((size_t)NSLOT * D * 2)) ? region_end_raw : zt + al256((size_t)NSLOT * D * 2);
constexpr size_t hid = region_end;
constexpr size_t gl = al256(hid + (size_t)DEPTH * 2 * SEQ * 64 * 4);
constexpr size_t gc = al256(gl + (size_t)DEPTH * 2 * HYW * GSTR_L * 2);
constexpr size_t logits = al256(gc + (size_t)2 * HYW * GSTR_C * 2);
constexpr size_t tok_e = al256(logits + (size_t)NT * NE * 4);
constexpr size_t tok_gate = al256(tok_e + (size_t)NT * TOPK * 4);
constexpr size_t tok_slot = al256(tok_gate + (size_t)NT * TOPK * 4);
constexpr size_t pad_start = al256(tok_slot + (size_t)NT * TOPK * 4);
constexpr size_t slot_tok = al256(pad_start + (size_t)(NE + 2) * 4);
constexpr size_t blkcnt = al256(slot_tok + (size_t)NSLOT * 4);
constexpr size_t hbuf = al256(blkcnt + (size_t)512 * NE * 4);
constexpr size_t hs = al256(hbuf + (size_t)NSLOT * DE);
constexpr size_t w_in_t = al256(hs + (size_t)NT * DE);
constexpr size_t w_out_t = al256(w_in_t + (size_t)DEPTH * WIN_ROWS * D * 2);
constexpr size_t router_t = al256(w_out_t + (size_t)DEPTH * D * D * 2);
constexpr size_t sh1_t = al256(router_t + (size_t)DEPTH * NE * D * 2);
constexpr size_t sh3_t = al256(sh1_t + (size_t)DEPTH * DE * D);
constexpr size_t sh2_t = al256(sh3_t + (size_t)DEPTH * DE * D);
constexpr size_t e1_t = al256(sh2_t + (size_t)DEPTH * D * DE);
constexpr size_t e3_t = al256(e1_t + (size_t)NE * DE * D);
constexpr size_t e2_t = al256(e3_t + (size_t)NE * DE * D);
constexpr size_t abuf8 = al256(e2_t + (size_t)NE * D * DE);
constexpr size_t w_g8 = al256(abuf8 + (size_t)NT * D);
constexpr size_t total = al256(w_g8 + (size_t)DEPTH * GW_ROWS * D);
constexpr size_t ybuf = zt;
}
struct WS {
  char* b;
  __device__ __forceinline__ unsigned* bar() const { char* q = b; asm volatile("" : "+s"(q)); return (unsigned*)(q + wso::bar); }
  __device__ __forceinline__ int* ctrl() const { char* q = b; asm volatile("" : "+s"(q)); return (int*)(q + wso::ctrl); }
  __device__ __forceinline__ bf16* xs() const { char* q = b; asm volatile("" : "+s"(q)); return (bf16*)(q + wso::xs); }
  __device__ __forceinline__ float* mod() const { char* q = b; asm volatile("" : "+s"(q)); return (float*)(q + wso::mod); }
  __device__ __forceinline__ bf16* abuf() const { char* q = b; asm volatile("" : "+s"(q)); return (bf16*)(q + wso::abuf); }
  __device__ __forceinline__ bf16* zt() const { char* q = b; asm volatile("" : "+s"(q)); return (bf16*)(q + wso::zt); }
  __device__ __forceinline__ bf16* zg() const { char* q = b; asm volatile("" : "+s"(q)); return (bf16*)(q + wso::zg); }
  __device__ __forceinline__ bf16* yt() const { char* q = b; asm volatile("" : "+s"(q)); return (bf16*)(q + wso::yt); }
  __device__ __forceinline__ bf16* of() const { char* q = b; asm volatile("" : "+s"(q)); return (bf16*)(q + wso::of); }
  __device__ __forceinline__ bf16* ob() const { char* q = b; asm volatile("" : "+s"(q)); return (bf16*)(q + wso::ob); }
  __device__ __forceinline__ bf16* ymix() const { char* q = b; asm volatile("" : "+s"(q)); return (bf16*)(q + wso::ymix); }
  __device__ __forceinline__ float* hid() const { char* q = b; asm volatile("" : "+s"(q)); return (float*)(q + wso::hid); }
  __device__ __forceinline__ bf16* gl() const { char* q = b; asm volatile("" : "+s"(q)); return (bf16*)(q + wso::gl); }
  __device__ __forceinline__ bf16* gc() const { char* q = b; asm volatile("" : "+s"(q)); return (bf16*)(q + wso::gc); }
  __device__ __forceinline__ float* logits() const { char* q = b; asm volatile("" : "+s"(q)); return (float*)(q + wso::logits); }
  __device__ __forceinline__ int* tok_e() const { char* q = b; asm volatile("" : "+s"(q)); return (int*)(q + wso::tok_e); }
  __device__ __forceinline__ float* tok_gate() const { char* q = b; asm volatile("" : "+s"(q)); return (float*)(q + wso::tok_gate); }
  __device__ __forceinline__ int* tok_slot() const { char* q = b; asm volatile("" : "+s"(q)); return (int*)(q + wso::tok_slot); }
  __device__ __forceinline__ int* pad_start() const { char* q = b; asm volatile("" : "+s"(q)); return (int*)(q + wso::pad_start); }
  __device__ __forceinline__ int* slot_tok() const { char* q = b; asm volatile("" : "+s"(q)); return (int*)(q + wso::slot_tok); }
  __device__ __forceinline__ int* blkcnt() const { char* q = b; asm volatile("" : "+s"(q)); return (int*)(q + wso::blkcnt); }
  __device__ __forceinline__ unsigned char* hbuf() const { char* q = b; asm volatile("" : "+s"(q)); return (unsigned char*)(q + wso::hbuf); }
  __device__ __forceinline__ unsigned char* hs() const { char* q = b; asm volatile("" : "+s"(q)); return (unsigned char*)(q + wso::hs); }
  __device__ __forceinline__ bf16* w_in_t() const { char* q = b; asm volatile("" : "+s"(q)); return (bf16*)(q + wso::w_in_t); }
  __device__ __forceinline__ bf16* w_out_t() const { char* q = b; asm volatile("" : "+s"(q)); return (bf16*)(q + wso::w_out_t); }
  __device__ __forceinline__ bf16* router_t() const { char* q = b; asm volatile("" : "+s"(q)); return (bf16*)(q + wso::router_t); }
  __device__ __forceinline__ unsigned char* sh1_t() const { char* q = b; asm volatile("" : "+s"(q)); return (unsigned char*)(q + wso::sh1_t); }
  __device__ __forceinline__ unsigned char* sh3_t() const { char* q = b; asm volatile("" : "+s"(q)); return (unsigned char*)(q + wso::sh3_t); }
  __device__ __forceinline__ unsigned char* sh2_t() const { char* q = b; asm volatile("" : "+s"(q)); return (unsigned char*)(q + wso::sh2_t); }
  __device__ __forceinline__ unsigned char* e1_t() const { char* q = b; asm volatile("" : "+s"(q)); return (unsigned char*)(q + wso::e1_t); }
  __device__ __forceinline__ unsigned char* e3_t() const { char* q = b; asm volatile("" : "+s"(q)); return (unsigned char*)(q + wso::e3_t); }
  __device__ __forceinline__ unsigned char* e2_t() const { char* q = b; asm volatile("" : "+s"(q)); return (unsigned char*)(q + wso::e2_t); }
  __device__ __forceinline__ unsigned char* ybuf() const { char* q = b; asm volatile("" : "+s"(q)); return (unsigned char*)(q + wso::ybuf); }
  __device__ __forceinline__ unsigned char* abuf8() const { char* q = b; asm volatile("" : "+s"(q)); return (unsigned char*)(q + wso::abuf8); }
  __device__ __forceinline__ unsigned char* w_g8() const { char* q = b; asm volatile("" : "+s"(q)); return (unsigned char*)(q + wso::w_g8); }
};

constexpr int MEGA_LDS_MAIN = G8_LDS;
constexpr int LDS_TILE_E = MEGA_LDS_MAIN + 16;
constexpr int MEGA_LDS = MEGA_LDS_MAIN + 16 + 4096;

struct MP { Inputs in; WS w; float* out; };

__device__ __forceinline__ void row_load(const float* __restrict__ p, int lane, f32x4 (&v)[4]) {
#pragma unroll
  for (int j = 0; j < 4; ++j) v[j] = *(const f32x4*)(p + j * 256 + lane * 4);
}
__device__ __forceinline__ void row_load_xs(const bf16* __restrict__ p, int lane, f32x4 (&v)[4]) {
#pragma unroll
  for (int j = 0; j < 4; ++j) v[j] = xs_load4(p + j * 256 + lane * 4);
}
__device__ __forceinline__ float row_rinv(const f32x4 (&v)[4], int lane) {
  float ss = 0.f;
#pragma unroll
  for (int j = 0; j < 4; ++j) ss += v[j].x * v[j].x + v[j].y * v[j].y + v[j].z * v[j].z + v[j].w * v[j].w;
  ss = wave_sum(ss, lane);
  return rsqrtf(ss * (1.0f / D) + EPS);
}
__device__ __forceinline__ void row_norm_mod_store(const f32x4 (&v)[4], float rinv, const float* __restrict__ g,
                                                   const float* __restrict__ sh, const float* __restrict__ sc, int lane,
                                                   bf16* __restrict__ dst, unsigned char* __restrict__ dst8 = nullptr) {
#pragma unroll
  for (int j = 0; j < 4; ++j) {
    const int d = j * 256 + lane * 4;
    const f32x4 gv = *(const f32x4*)(g + d), shv = *(const f32x4*)(sh + d), scv = *(const f32x4*)(sc + d);
    const float y0 = v[j].x * rinv * gv.x * (1.f + scv.x) + shv.x, y1 = v[j].y * rinv * gv.y * (1.f + scv.y) + shv.y;
    const float y2 = v[j].z * rinv * gv.z * (1.f + scv.z) + shv.z, y3 = v[j].w * rinv * gv.w * (1.f + scv.w) + shv.w;
    u32x2 o;
    o.x = pack_bf16(y0, y1);
    o.y = pack_bf16(y2, y3);
    *(u32x2*)(dst + d) = o;
    if (dst8) *(unsigned*)(dst8 + d) = pk4_fp8(y0, y1, y2, y3);
  }
}

__device__ __forceinline__ void ph_mod_hid(const MP& p, char* smem, int bid, int nblk) {
  const int tid = tid_opaque(), lane = tid & 63, wave = tid >> 6;
  float* sc = (float*)smem;
  for (int u = bid; u < 192; u += nblk) {
    const int l = u / 96, col0 = (u - l * 96) * 64;
    __syncthreads();
    for (int i = tid; i < 17 * 1024; i += 512) {
      const int r = i >> 10, k = i & 1023;
      const float v = (r < 16) ? p.in.c[r * D + k] : p.in.c_ctx[k];
      sc[i] = silu_f(v);
    }
    __syncthreads();
    const int col = tid & 63, ks = tid >> 6;
    float acc[17];
#pragma unroll
    for (int r = 0; r < 17; ++r) acc[r] = 0.f;
    const float* wp = p.in.ada_w + ((size_t)l * D + ks * 128) * (6 * D) + col0 + col;
#pragma unroll 16
    for (int kk = 0; kk < 128; ++kk) {
      const float wv = wp[(size_t)kk * (6 * D)];
#pragma unroll
      for (int r = 0; r < 17; ++r) acc[r] += sc[r * 1024 + ks * 128 + kk] * wv;
    }
    __syncthreads();
#pragma unroll
    for (int r = 0; r < 17; ++r) sc[(ks * 17 + r) * 64 + col] = acc[r];
    __syncthreads();
    for (int i = tid; i < 17 * 64; i += 512) {
      const int r = i >> 6, cc = i & 63;
      float s = 0.f;
#pragma unroll
      for (int k8 = 0; k8 < 8; ++k8) s += sc[(k8 * 17 + r) * 64 + cc];
      p.w.mod()[((size_t)l * 17 + r) * (6 * D) + col0 + cc] = s + p.in.ada_b[l * 6 * D + col0 + cc];
    }
  }
  for (int it = bid; it * 8 < 4352; it += nblk) {
    const int rid = it * 8 + wave;
    int l, ty, t;
    if (rid < 2048) { l = 0; ty = 0; t = rid; }
    else if (rid < 2304) { l = 0; ty = 1; t = rid - 2048; }
    else { l = 1; ty = 0; t = rid - 2304; }
    const int L = ty ? LC : SEQ;
    const float* w1 = p.in.hy_f_w1 + l * 33 * 64; const float* b1 = p.in.hy_f_b1 + l * 64;
    const float* w2 = p.in.hy_f_w2 + l * 64 * 64; const float* b2 = p.in.hy_f_b2 + l * 64;
    float pv = 0.f;
    if (lane == 0) pv = (float)t / (float)(L - 1);
    else if (lane < 33) {
      const int bi = (lane - 1) & 15;
      const float wph = 2.0f * 3.14159265358979323846f * (float)t / (float)L;
      const float f = 1e-4f + (float)bi * ((15.0f - 1e-4f) / 15.0f);
      pv = (lane <= 16) ? cosf(f * wph) : -sinf(f * wph);
    }
    float a1 = b1[lane];
#pragma unroll
    for (int i = 0; i < 33; ++i) a1 += shl_f(pv, i) * w1[i * 64 + lane];
    const float h1 = sinf(a1);
    float a2 = b2[lane];
#pragma unroll 16
    for (int i = 0; i < 64; ++i) a2 += shl_f(h1, i) * w2[i * 64 + lane];
    p.w.hid()[((size_t)(l * 2 + ty) * SEQ + t) * 64 + lane] = sinf(a2);
  }
}

__device__ __forceinline__ void ph_gtab(const MP& p, char* smem, int bid, int nblk) {
  const int tid = tid_opaque();
  float* wl = (float*)smem;
  for (int u = bid; u < 544; u += nblk) {
    int l, ty, ib, cg;
    if (u < 512) { l = u >> 8; ty = 0; ib = (u >> 5) & 7; cg = u & 31; }
    else { l = 0; ty = 1; ib = 0; cg = u - 512; }
    const int L = ty ? LC : SEQ, gstr = ty ? GSTR_C : GSTR_L;
    const float* hid = p.w.hid() + (size_t)(l * 2 + ty) * SEQ * 64;
    const float* w3 = p.in.hy_f_w3 + (size_t)l * 64 * 2048;
    const float* skip = p.in.hy_skip + l * 2 * 512;
    bf16* G = ty ? p.w.gc() : (p.w.gl() + (size_t)l * 2 * HYW * GSTR_L);
    __syncthreads();
    for (int i = tid; i < 2 * 32 * 64; i += 512) {
      const int dir = i >> 11, cc = (i >> 6) & 31, j = i & 63;
      const int oc = cg * 32 + cc, o = oc >> 9, c = oc & 511;
      wl[i] = w3[(size_t)j * 2048 + o * 1024 + dir * 512 + c];
    }
    __syncthreads();
    const int i = ib * 512 + tid;
    const int dd = i - (L - 1);
    const int t = dd < 0 ? -dd : dd;
    const bool inr = i < 2 * L - 1;
    const int dir = dd > 0 ? 1 : 0;
    float hr[64];
    {
      const float* hp = hid + (size_t)(inr ? t : 0) * 64;
#pragma unroll
      for (int j = 0; j < 16; ++j) { const f32x4 v = *(const f32x4*)(hp + 4 * j); hr[4 * j] = v.x; hr[4 * j + 1] = v.y; hr[4 * j + 2] = v.z; hr[4 * j + 3] = v.w; }
    }
    const float tn = (float)t / (float)(L - 1);
#pragma unroll 1
    for (int cc = 0; cc < 32; ++cc) {
      const int oc = cg * 32 + cc, o = oc >> 9, c = oc & 511;
      const float* wc = wl + (dir * 32 + cc) * 64;
      float s = 0.f;
#pragma unroll
      for (int j = 0; j < 16; ++j) { const f32x4 wv = *(const f32x4*)(wc + 4 * j); s += hr[4 * j] * wv.x + hr[4 * j + 1] * wv.y + hr[4 * j + 2] * wv.z + hr[4 * j + 3] * wv.w; }
      if (dd == 0) {
        const float* wc1 = wl + (32 + cc) * 64;
        float s1 = 0.f;
#pragma unroll
        for (int j = 0; j < 16; ++j) { const f32x4 wv = *(const f32x4*)(wc1 + 4 * j); s1 += hr[4 * j] * wv.x + hr[4 * j + 1] * wv.y + hr[4 * j + 2] * wv.z + hr[4 * j + 3] * wv.w; }
        s += s1;
      }
      const float delta = HY_MIN_DECAY + (float)c * ((HY_MAX_DECAY - HY_MIN_DECAY) / 511.0f);
      float val = s * __expf(-tn * delta);
      if (dd == 0) val += skip[o * 512 + c];
      if (!inr) val = 0.f;
      G[(size_t)oc * gstr + i] = f2bf(val);
    }
  }
}

__device__ __forceinline__ void ph_init_norm1(const MP& p, int bid, int nblk) {
  const int lane = tid_opaque() & 63, wave = tid_opaque() >> 6;
  const float* g = p.in.norm1_g;
  for (int it = bid; it * 8 < SEQ; it += nblk) {
    const int t = it * 8 + wave;
    const float rr = (float)(t >> 6), colp = (float)(t & 63);
    f32x4 e[4];
#pragma unroll
    for (int j = 0; j < 4; ++j) {
      float ev[4];
#pragma unroll
      for (int q = 0; q < 4; ++q) {
        const int i = lane * 4 + q;
        const float omega = 1.0f / powf(10000.0f, (float)i / 256.0f);
        const float a = ((j < 2) ? rr : colp) * omega;
        ev[q] = (j & 1) ? cosf(a) : sinf(a);
      }
      e[j] = (f32x4){ev[0], ev[1], ev[2], ev[3]};
    }
    for (int b = 0; b < NB; ++b) {
      const int row = b * SEQ + t;
      f32x4 v[4];
      row_load(p.in.x + (size_t)row * D, lane, v);
#pragma unroll
      for (int j = 0; j < 4; ++j) { v[j] += e[j]; xs_store4(p.w.xs() + (size_t)row * D + j * 256 + lane * 4, v[j]); }
      const float rinv = row_rinv(v, lane);
      const float* mb = p.w.mod() + (size_t)b * 6 * D;
      row_norm_mod_store(v, rinv, g, mb, mb + D, lane, p.w.abuf() + (size_t)row * D, p.w.abuf8() + (size_t)row * D);
    }
  }
  for (int it = bid; it * 8 < NC; it += nblk) {
    const int rc = it * 8 + wave, row = NL + rc;
    f32x4 v[4];
    row_load(p.in.ctx + (size_t)rc * D, lane, v);
#pragma unroll
    for (int j = 0; j < 4; ++j) xs_store4(p.w.xs() + (size_t)row * D + j * 256 + lane * 4, v[j]);
    const float rinv = row_rinv(v, lane);
    const float* mb = p.w.mod() + (size_t)16 * 6 * D;
    row_norm_mod_store(v, rinv, g, mb, mb + D, lane, p.w.abuf() + (size_t)row * D, p.w.abuf8() + (size_t)row * D);
  }
}

__device__ __forceinline__ void ph_mixer(const MP& p, char* smem, int l, bool last, int bid, int nblk) {
  int* qctr = p.w.ctrl() + CTRL_Q + 64 * l;
  int* slot = (int*)(smem + MEGA_LDS_MAIN + 8);
  GlaArgs ga;
  ga.zg = p.w.zg(); ga.wa2 = p.in.gla_wa2 + (size_t)l * 2 * 16 * 256; ga.ba2 = p.in.gla_ba2 + (size_t)l * 2 * 256;
  ga.of = p.w.of(); ga.ob = p.w.ob(); ga.emit_ctx = last ? 0 : 1; ga.pad_ = 0;
  const float* cw = p.in.hy_conv_w + (size_t)l * 3 * HYCOLS;
  const float* cb = p.in.hy_conv_b + (size_t)l * HYCOLS;
  const bf16* gl = p.w.gl() + (size_t)l * 2 * HYW * GSTR_L;
  CvtCtx cx;
  cx.w1 = p.in.exp_w1 + (size_t)l * NE * D * DE; cx.w3 = p.in.exp_w3 + (size_t)l * NE * D * DE; cx.w2 = p.in.exp_w2 + (size_t)l * NE * DE * D;
  cx.d1 = p.w.e1_t(); cx.d3 = p.w.e3_t(); cx.d2 = p.w.e2_t();
  for (;;) {
    __syncthreads();
    if (tid_opaque() == 0) *slot = atomicAdd(qctr, 1);
    __syncthreads();
    const int u = *slot;
    const int nunits = last ? 640 : 1152;
    if (u >= nunits) break;
    if (u < 128) gla_unit(u, ga, smem, cx);
    else if (u < 640) hyena_latent(u - 128, p.w.zt(), cw, cb, gl, p.w.yt(), smem, cx);
    else hyena_ctx(u - 640, p.w.zt() + NL, cw, cb, p.w.gc(), p.w.yt() + NL, smem);
  }
}

__device__ __forceinline__ void ph_gla_out(const MP& p, char* smem, int l, int mrows, int bid, int nblk) {
  const int tid = tid_opaque();
  const int lane = tid & 63, wave = tid >> 6;
  {
    const float* gn = p.in.gla_norm_g + l * 128 + (lane & 15) * 8;
    const f32x4 ga = *(const f32x4*)gn, gb = *(const f32x4*)(gn + 4);
    const bf16* of = p.w.of(); const bf16* ob = p.w.ob(); const bf16* zg = p.w.zg(); bf16* ymix = p.w.ymix();
#pragma unroll 2
    for (int it = bid; it * 8 < mrows; it += nblk) {
      const int row = it * 8 + wave;
      const size_t base = (size_t)row * 512 + lane * 8;
      const u32x4 av = *(const u32x4*)(of + base), bv = *(const u32x4*)(ob + base);
      const f32x4 a0 = {bflo(av.x), bfhi(av.x), bflo(av.y), bfhi(av.y)}, a1 = {bflo(av.z), bfhi(av.z), bflo(av.w), bfhi(av.w)};
      const f32x4 b0 = {bflo(bv.x), bfhi(bv.x), bflo(bv.y), bfhi(bv.y)}, b1 = {bflo(bv.z), bfhi(bv.z), bflo(bv.w), bfhi(bv.w)};
      const u32x4 rv = *(const u32x4*)(zg + (size_t)row * GLACOLS + 1024 + lane * 8);
      const f32x4 o0 = a0 + b0, o1 = a1 + b1;
      float ss = o0.x * o0.x + o0.y * o0.y + o0.z * o0.z + o0.w * o0.w + o1.x * o1.x + o1.y * o1.y + o1.z * o1.z + o1.w * o1.w;
      ss += shx_f(ss, 1, lane); ss += shx_f(ss, 2, lane); ss += shx_f(ss, 4, lane); ss += shx_f(ss, 8, lane);
      const float rinv = rsqrtf(ss * (1.0f / 128.0f) + EPS);
      u32x4 o;
      o.x = pack_bf16(o0.x * rinv * ga.x * silu_f(bflo(rv.x)), o0.y * rinv * ga.y * silu_f(bfhi(rv.x)));
      o.y = pack_bf16(o0.z * rinv * ga.z * silu_f(bflo(rv.y)), o0.w * rinv * ga.w * silu_f(bfhi(rv.y)));
      o.z = pack_bf16(o1.x * rinv * gb.x * silu_f(bflo(rv.z)), o1.y * rinv * gb.y * silu_f(bfhi(rv.z)));
      o.w = pack_bf16(o1.z * rinv * gb.z * silu_f(bflo(rv.w)), o1.w * rinv * gb.w * silu_f(bfhi(rv.w)));
      *(u32x4*)(ymix + (size_t)row * D + 512 + lane * 8) = o;
    }
  }
  {
    const bf16* yt = p.w.yt(); bf16* ymix = p.w.ymix();
    for (int tt = bid; tt * 64 < mrows; tt += nblk) {
      const int tok0 = tt * 64;
      __syncthreads();
#pragma unroll
      for (int i = 0; i < 8; ++i) {
        const int q = tid + i * 512, c = q >> 3, ch = q & 7;
        const u32x4 v = *(const u32x4*)(yt + (size_t)c * NT + tok0 + ch * 8);
        unsigned* d = (unsigned*)(smem + c * 132 + ch * 16);
        d[0] = v.x; d[1] = v.y; d[2] = v.z; d[3] = v.w;
      }
      __syncthreads();
#pragma unroll
      for (int i = 0; i < 8; ++i) {
        const int c8 = wave * 8 + (lane & 7), t = i * 8 + (lane >> 3);
        const unsigned short* s = (const unsigned short*)(smem + (c8 * 8) * 132 + t * 2);
        const unsigned e0 = s[0], e1 = s[66], e2 = s[132], e3 = s[198], e4 = s[264], e5 = s[330], e6 = s[396], e7 = s[462];
        *(u32x4*)(ymix + (size_t)(tok0 + t) * D + c8 * 8) = (u32x4){e0 | (e1 << 16), e2 | (e3 << 16), e4 | (e5 << 16), e6 | (e7 << 16)};
      }
    }
  }
}

__device__ __forceinline__ void ph_norm2(const MP& p, int l, int mrows, int bid, int nblk) {
  const int lane = tid_opaque() & 63, wave = tid_opaque() >> 6;
  const float* g = p.in.norm2_g + l * D;
  const float* modl = p.w.mod() + (size_t)l * 17 * 6 * D;
  for (int it = bid; it * 8 < mrows; it += nblk) {
    const int row = it * 8 + wave;
    f32x4 v[4];
    row_load_xs(p.w.xs() + (size_t)row * D, lane, v);
    const float rinv = row_rinv(v, lane);
    const float* mb = modl + (size_t)row_batch(row) * 6 * D;
    row_norm_mod_store(v, rinv, g, mb + 3 * D, mb + 4 * D, lane, p.w.abuf() + (size_t)row * D, p.w.abuf8() + (size_t)row * D);
  }
}

__device__ __forceinline__ void ph_route(const MP& p, char* smem, int l, int ntok, int bid, int nblk) {
  const int tid = tid_opaque();
  const int lane = tid & 63, wave = tid >> 6;
  const float* rb = p.in.router_b + l * NE;
  int* lcnt = (int*)smem;
  __syncthreads();
  if (tid < NE) lcnt[tid] = 0;
  __syncthreads();
  const f32x4 bb = *(const f32x4*)(rb + lane * 4);
  const int tpb = (ntok + nblk - 1) / nblk;
  for (int it = wave; it < tpb; it += 8) {
    const int tok = bid * tpb + it;
    if (tok >= ntok) break;
    const f32x4 lg = *(const f32x4*)(p.w.logits() + (size_t)tok * NE + lane * 4);
    const float s0 = sigmoid_f(lg.x), s1 = sigmoid_f(lg.y), s2 = sigmoid_f(lg.z), s3 = sigmoid_f(lg.w);
    const float v0 = s0 + bb.x, v1 = s1 + bb.y, v2 = s2 + bb.z, v3 = s3 + bb.w;
    float m1 = fmaxf(v0, v1), m2 = fminf(v0, v1);
    { float n1 = fmaxf(m1, v2); float n2 = fmaxf(fminf(m1, v2), m2); m1 = n1; m2 = n2; }
    { float n1 = fmaxf(m1, v3); float n2 = fmaxf(fminf(m1, v3), m2); m1 = n1; m2 = n2; }
#pragma unroll
    for (int o = 1; o <= 4; o <<= 1) {
      float a1 = shx_f(m1, o, lane), a2 = shx_f(m2, o, lane);
      float n1 = fmaxf(m1, a1);
      float n2 = fmaxf(fminf(m1, a1), fmaxf(m2, a2));
      m1 = n1; m2 = n2;
    }
    const float gs = m1 + m2;
    const int g = lane >> 3;
    int rank = 0;
#pragma unroll
    for (int gg = 0; gg < 8; ++gg) {
      const float og = __int_as_float(__builtin_amdgcn_readlane(__float_as_int(gs), gg * 8));
      rank += (og > gs || (og == gs && gg < g)) ? 1 : 0;
    }
    unsigned k0, k1, k2, k3;
    {
      const bool sel = rank < 4;
      unsigned u;
      u = __float_as_uint(v0); u = (u & 0x80000000u) ? ~u : (u | 0x80000000u); k0 = sel ? ((u & 0xffffff00u) | (unsigned)(255 - (lane * 4 + 0))) : 0u;
      u = __float_as_uint(v1); u = (u & 0x80000000u) ? ~u : (u | 0x80000000u); k1 = sel ? ((u & 0xffffff00u) | (unsigned)(255 - (lane * 4 + 1))) : 0u;
      u = __float_as_uint(v2); u = (u & 0x80000000u) ? ~u : (u | 0x80000000u); k2 = sel ? ((u & 0xffffff00u) | (unsigned)(255 - (lane * 4 + 2))) : 0u;
      u = __float_as_uint(v3); u = (u & 0x80000000u) ? ~u : (u | 0x80000000u); k3 = sel ? ((u & 0xffffff00u) | (unsigned)(255 - (lane * 4 + 3))) : 0u;
    }
    float gsum = 0.f, myg = 0.f; int mye = 0;
#pragma unroll
    for (int k = 0; k < TOPK; ++k) {
      unsigned m = max(max(k0, k1), max(k2, k3));
      m = max(m, (unsigned)__builtin_amdgcn_update_dpp(0, (int)m, 0x111, 0xf, 0xf, false));
      m = max(m, (unsigned)__builtin_amdgcn_update_dpp(0, (int)m, 0x112, 0xf, 0xf, false));
      m = max(m, (unsigned)__builtin_amdgcn_update_dpp(0, (int)m, 0x114, 0xf, 0xf, false));
      m = max(m, (unsigned)__builtin_amdgcn_update_dpp(0, (int)m, 0x118, 0xf, 0xf, false));
      m = max(m, (unsigned)__builtin_amdgcn_update_dpp(0, (int)m, 0x142, 0xa, 0xf, false));
      m = max(m, (unsigned)__builtin_amdgcn_update_dpp(0, (int)m, 0x143, 0xc, 0xf, false));
      const unsigned wk = (unsigned)__builtin_amdgcn_readlane((int)m, 63);
      const int we = 255 - (int)(wk & 255u);
      const int wl = we >> 2, wi = we & 3;
      const float sv = __int_as_float(__builtin_amdgcn_readlane(__float_as_int(wi == 0 ? s0 : wi == 1 ? s1 : wi == 2 ? s2 : s3), wl));
      if (lane == wl) { if (wi == 0) k0 = 0u; else if (wi == 1) k1 = 0u; else if (wi == 2) k2 = 0u; else k3 = 0u; }
      gsum += sv;
      if (lane == k) { myg = sv; mye = we; }
    }
    if (lane < TOPK) {
      p.w.tok_e()[tok * TOPK + lane] = mye;
      p.w.tok_gate()[tok * TOPK + lane] = myg / gsum * 2.5f;
      atomicAdd(&lcnt[mye], 1);
    }
  }
  __syncthreads();
  if (tid < NE) p.w.blkcnt()[bid * NE + tid] = lcnt[tid];
}

__device__ __forceinline__ void ph_assign(const MP& p, char* smem, int l, int ntok, int bid, int nblk) {
  const int tid = tid_opaque();
  int* ps = (int*)smem;
  int* cur = (int*)smem + 512;
  __syncthreads();
  int* part = (int*)smem + 1024;
  {
    const int eg = tid & 63, bg = tid >> 6;
    const int per = (nblk + 7) >> 3;
    int t0 = 0, t1 = 0, t2 = 0, t3 = 0, b0 = 0, b1 = 0, b2 = 0, b3 = 0;
    const int* src = p.w.blkcnt() + eg * 4;
#pragma unroll 8
    for (int i = 0; i < per; ++i) {
      const int b = bg * per + i;
      if (b < nblk) {
        const u32x4 v = *(const u32x4*)(src + (size_t)b * NE);
        t0 += (int)v.x; t1 += (int)v.y; t2 += (int)v.z; t3 += (int)v.w;
        if (b < bid) { b0 += (int)v.x; b1 += (int)v.y; b2 += (int)v.z; b3 += (int)v.w; }
      }
    }
    int* pt = part + bg * 512 + eg * 4;
    pt[0] = t0; pt[1] = t1; pt[2] = t2; pt[3] = t3;
    pt[256] = b0; pt[257] = b1; pt[258] = b2; pt[259] = b3;
  }
  __syncthreads();
  int before = 0;
  if (tid < NE) {
    int tot = 0;
#pragma unroll
    for (int g = 0; g < 8; ++g) { tot += part[g * 512 + tid]; before += part[g * 512 + 256 + tid]; }
    const int pc = (tot + 255) & ~255;
    const int lane = tid & 63;
    int inc = pc;
#pragma unroll
    for (int o = 1; o < 64; o <<= 1) { const int n = shl_i(inc, lane - o); if (lane >= o) inc += n; }
    ps[tid + 1] = inc;
    if (lane == 63) cur[tid >> 6] = inc;
  }
  __syncthreads();
  if (tid < NE) {
    const int w = tid >> 6;
    int offs = 0;
#pragma unroll
    for (int k = 0; k < 3; ++k) offs += (k < w) ? cur[k] : 0;
    ps[tid + 1] += offs;
    if (tid == 0) ps[0] = 0;
  }
  __syncthreads();
  if (tid < NE) {
    unsigned short* te = (unsigned short*)(smem + LDS_TILE_E);
    for (int t = ps[tid] >> 8; t < (ps[tid + 1] >> 8); ++t) te[t] = (unsigned short)tid;
  }
  if (tid < NE) cur[tid] = ps[tid] + before;
  if (bid == 0 && tid <= NE) p.w.pad_start()[tid] = ps[tid];
  __syncthreads();
  const int tpb = (ntok + nblk - 1) / nblk;
  for (int i = tid; i < tpb * TOPK; i += 512) {
    const int gi = bid * tpb * TOPK + i;
    if (gi >= ntok * TOPK) break;
    const int e = p.w.tok_e()[gi];
    const int slot = atomicAdd(&cur[e], 1);
    p.w.slot_tok()[slot] = gi >> 3;
    p.w.tok_slot()[gi] = slot;
  }
}

__device__ __forceinline__ void ph_combine(const MP& p, int l, int mrows, bool last, int bid, int nblk) {
  const int lane = tid_opaque() & 63, wave = tid_opaque() >> 6;
  const float* modl = p.w.mod() + (size_t)l * 17 * 6 * D;
  for (int it = bid; it * 8 < mrows; it += nblk) {
    const int row = it * 8 + wave;
    const int b = row_batch(row);
    f32x4 v[4], acc[4];
    row_load_xs(p.w.xs() + (size_t)row * D, lane, v);
#pragma unroll
    for (int j = 0; j < 4; ++j) acc[j] = (f32x4){0.f, 0.f, 0.f, 0.f};
    int sl = 0; float gt = 0.f;
    if (lane < TOPK) { sl = p.w.tok_slot()[row * TOPK + lane]; gt = p.w.tok_gate()[row * TOPK + lane]; }
#pragma unroll
    for (int k = 0; k < TOPK; ++k) {
      const int s = shl_i(sl, k);
      const float gk = shl_f(gt, k);
      const unsigned char* yr = p.w.ybuf() + (size_t)s * D + lane * 4;
#pragma unroll
      for (int j = 0; j < 4; ++j) {
        const int y = *(const int*)(yr + j * 256);
        const f32x2v lo = __builtin_amdgcn_cvt_pk_f32_fp8(y, false), hi = __builtin_amdgcn_cvt_pk_f32_fp8(y, true);
        acc[j].x += gk * lo.x; acc[j].y += gk * lo.y; acc[j].z += gk * hi.x; acc[j].w += gk * hi.y;
      }
    }
    const float* g2 = modl + (size_t)b * 6 * D + 5 * D;
#pragma unroll
    for (int j = 0; j < 4; ++j) {
      const f32x4 gv = *(const f32x4*)(g2 + j * 256 + lane * 4);
      v[j] += gv * acc[j];
    }
    const float rinv = row_rinv(v, lane);
    if (last) {
#pragma unroll
      for (int j = 0; j < 4; ++j) {
        const f32x4 fg = *(const f32x4*)(p.in.final_g + j * 256 + lane * 4);
        *(f32x4*)(p.out + (size_t)row * D + j * 256 + lane * 4) = v[j] * rinv * fg;
      }
    } else {
#pragma unroll
      for (int j = 0; j < 4; ++j) xs_store4(p.w.xs() + (size_t)row * D + j * 256 + lane * 4, v[j]);
      const float* mb = p.w.mod() + ((size_t)(l + 1) * 17 + b) * 6 * D;
      row_norm_mod_store(v, rinv, p.in.norm1_g + (l + 1) * D, mb, mb + D, lane, p.w.abuf() + (size_t)row * D, p.w.abuf8() + (size_t)row * D);
    }
  }
}

__global__ void __launch_bounds__(512, 2) k_mega(MP p) {
  extern __shared__ __attribute__((aligned(16))) char smem[];
  const int bid = blockIdx.x, nblk = gridDim.x;
  if (tid_opaque() == 0) *(u32x4*)(smem + MEGA_LDS_MAIN) = (u32x4){0u, 0u, 0u, 0u};
  __syncthreads();
  (void)xcd_barrier_post(p.w.bar(), (volatile LAS unsigned*)(smem + MEGA_LDS_MAIN));

  if (threadIdx.x == 0) {
    const unsigned xcc = xb_xcc_id();
    const int rank = atomicAdd(&p.w.ctrl()[CTRL_XR + 16 * xcc], 1);
    *(int*)(smem + MEGA_LDS_MAIN + 12) = rank;
  }
  ph_mod_hid(p, smem, bid, nblk);
  cvt_job(p.in.w_in, p.w.w_in_t(), D, INCOLS, 1, bid, nblk, HYCOLS);
  cvt_job(p.in.w_in + (size_t)D * INCOLS, p.w.w_in_t() + (size_t)WIN_ROWS * D, D, INCOLS, 1, bid, nblk, HYCOLS);
  cvt8_job(p.in.w_in + HYCOLS, p.w.w_g8(), D, INCOLS, 1, bid, nblk, GLACOLS);
  cvt8_job(p.in.w_in + (size_t)D * INCOLS + HYCOLS, p.w.w_g8() + (size_t)GW_ROWS * D, D, INCOLS, 1, bid, nblk, GLACOLS);
  cvt_job(p.in.w_out, p.w.w_out_t(), D, D, DEPTH, bid, nblk);
  cvt_job(p.in.router_w, p.w.router_t(), D, NE, DEPTH, bid, nblk);
  cvt8_job(p.in.sh_w1, p.w.sh1_t(), D, DE, DEPTH, bid, nblk);
  cvt8_job(p.in.sh_w3, p.w.sh3_t(), D, DE, DEPTH, bid, nblk);
  cvt8_job(p.in.sh_w2, p.w.sh2_t(), DE, D, DEPTH, bid, nblk);
  grid_sync(p.w.bar(), smem + MEGA_LDS_MAIN);
  int vb = bid;
  {
    const int rank = *(const int*)(smem + MEGA_LDS_MAIN + 12);
    const unsigned xcc = xb_xcc_id();
    int npop = 0, xidx = 0, cnt0 = -1; bool equal = true;
    for (int j = 0; j < 16; ++j) {
      const int c = p.w.ctrl()[CTRL_XR + 16 * j];
      if (c > 0) {
        if (cnt0 < 0) cnt0 = c; else if (c != cnt0) equal = false;
        if (j < (int)xcc) ++xidx;
        ++npop;
      }
    }
    if (equal && cnt0 > 0 && npop * cnt0 == nblk && rank < cnt0) vb = xidx * cnt0 + rank;
  }
  ph_gtab(p, smem, bid, nblk);
  ph_init_norm1(p, bid, nblk);
  grid_sync(p.w.bar(), smem + MEGA_LDS_MAIN);

  const int vbu = __builtin_amdgcn_readfirstlane(vb);
#pragma unroll 1
  for (int l0 = 0; l0 < DEPTH; ++l0) {
#define LL opq(l0)
    const bool last = (l0 == DEPTH - 1);
    const int mrows = last ? NL : NT;
#define MODL (p.w.mod() + (size_t)LL * 17 * 6 * D)
    {
      G8InZT g; g.wt = p.w.w_in_t() + (size_t)LL * WIN_ROWS * D; g.A = p.w.abuf(); g.zt = p.w.zt(); g.ntok = last ? NL : NT;
      gemm8_run(g, smem, opq(vbu), nblk);
    }
    {
      G8InG g; g.wt = p.w.w_g8() + (size_t)LL * GW_ROWS * D; g.A = p.w.abuf8(); g.zg = p.w.zg();
      gemm8_run(g, smem, opq(vbu), nblk);
    }
    grid_sync(p.w.bar(), smem + MEGA_LDS_MAIN);
    ph_mixer(p, smem, LL, last, opq(bid), nblk);
    grid_sync(p.w.bar(), smem + MEGA_LDS_MAIN);
    ph_gla_out(p, smem, LL, mrows, opq(bid), nblk);
    grid_sync(p.w.bar(), smem + MEGA_LDS_MAIN);
    {
      G8Out g; g.mrows = mrows; g.ymix = p.w.ymix(); g.wt = p.w.w_out_t() + (size_t)LL * D * D; g.modl = MODL; g.xs = p.w.xs();
      gemm8_run(g, smem, opq(vbu), nblk);
    }
    grid_sync(p.w.bar(), smem + MEGA_LDS_MAIN);
    ph_norm2(p, LL, mrows, opq(bid), nblk);
    grid_sync(p.w.bar(), smem + MEGA_LDS_MAIN);
    {
      G8Router g; g.mrows = mrows; g.A = p.w.abuf(); g.rwt = p.w.router_t() + (size_t)LL * NE * D; g.logits = p.w.logits();
      gemm8_run(g, smem, opq(vbu), nblk);
    }
    {
      G8ShUp g; g.mrows = mrows; g.A8 = p.w.abuf8(); g.s1t = p.w.sh1_t() + (size_t)LL * DE * D; g.s3t = p.w.sh3_t() + (size_t)LL * DE * D; g.hs = p.w.hs();
      gemm8_run(g, smem, opq(vbu), nblk);
    }
    grid_sync(p.w.bar(), smem + MEGA_LDS_MAIN);
    ph_route(p, smem, LL, mrows, opq(bid), nblk);
    grid_sync(p.w.bar(), smem + MEGA_LDS_MAIN);
    ph_assign(p, smem, LL, mrows, opq(bid), nblk);
    grid_sync(p.w.bar(), smem + MEGA_LDS_MAIN);
    {
      G8Up g; g.A8 = p.w.abuf8(); g.slot_tok = p.w.slot_tok(); g.pad_start = p.w.pad_start(); g.w1t = p.w.e1_t(); g.w3t = p.w.e3_t(); g.H = p.w.hbuf(); g.tile_e = (const unsigned short*)(smem + LDS_TILE_E);
      gemm8_run(g, smem, opq(vbu), nblk);
    }
    {
      G8ShDown g; g.mrows = mrows; g.hs = p.w.hs(); g.wt = p.w.sh2_t() + (size_t)LL * D * DE; g.modl = MODL; g.xs = p.w.xs();
      gemm8_run(g, smem, opq(vbu), nblk);
    }
    grid_sync(p.w.bar(), smem + MEGA_LDS_MAIN);
    {
      G8Down g; g.H = p.w.hbuf(); g.pad_start = p.w.pad_start(); g.w2t = p.w.e2_t(); g.Y = p.w.ybuf(); g.tile_e = (const unsigned short*)(smem + LDS_TILE_E);
      gemm8_run(g, smem, opq(vbu), nblk);
    }
    grid_sync(p.w.bar(), smem + MEGA_LDS_MAIN);
    ph_combine(p, LL, mrows, last, opq(bid), nblk);
    if (!last) grid_sync(p.w.bar(), smem + MEGA_LDS_MAIN);
  }
#undef LL
#undef MODL
}

static inline size_t align_up(size_t v, size_t a) { return (v + a - 1) / a * a; }

extern "C" void kernel_launch(void* const* d_in, const int* in_sizes, int n_in, void* d_out, int out_size, void* d_ws,
                              size_t ws_size, hipStream_t stream) {
  MP p;
  memset(&p, 0, sizeof(p));
  const float** ip = (const float**)&p.in;
  for (int i = 0; i < 30; ++i) ip[i] = (const float*)d_in[i];
  p.out = (float*)d_out;

  p.w.b = (char*)d_ws;
  const size_t zero_bytes = wso::zero_end;
  (void)ws_size; (void)n_in; (void)in_sizes; (void)out_size;

  static int grid = 0;
  if (!grid) {
    hipFuncSetAttribute((const void*)k_mega, hipFuncAttributeMaxDynamicSharedMemorySize, MEGA_LDS);
    int dev = 0, cus = 0, per_cu = 0;
    hipGetDevice(&dev);
    hipDeviceGetAttribute(&cus, hipDeviceAttributeMultiprocessorCount, dev);
    hipOccupancyMaxActiveBlocksPerMultiprocessor(&per_cu, k_mega, 512, MEGA_LDS);
    if (cus <= 0) cus = 256;
    grid = per_cu >= 1 ? cus : 0;
    if (grid <= 0) grid = 256;
  }
  hipMemsetAsync(d_ws, 0, zero_bytes, stream);
  hipLaunchKernelGGL(k_mega, dim3(grid), dim3(512), MEGA_LDS, stream, p);
}
```

```cpp
#include <hip/hip_runtime.h>
#include <hip/hip_bf16.h>
#include <stdint.h>
#include <string.h>

typedef __hip_bfloat16 bf16;

constexpr int D = 1024, NB = 16, SEQ = 2048, LC = 256, DEPTH = 2;
constexpr int NL = NB * SEQ, NC = NB * LC, NT = NL + NC;
constexpr int HYW = 512, HYCOLS = 1536, GLACOLS = 1568, INCOLS = 3104;
constexpr int NE = 256, TOPK = 8, DE = 256;
constexpr int NSLOT = NT * TOPK + NE * 256;
constexpr float EPS = 1e-6f;
constexpr float HY_MIN_DECAY = 3.0701134573253945f;
constexpr float HY_MAX_DECAY = 15.350567286626973f;
constexpr int GSTR_L = 4096, GSTR_C = 512;
constexpr int WIN_ROWS = HYCOLS;
constexpr int GW_ROWS = 7 * 256;

__device__ __forceinline__ float bf2f(bf16 v) { return __bfloat162float(v); }
__device__ __forceinline__ bf16 f2bf(float v) { return __float2bfloat16(v); }
__device__ __forceinline__ float silu_f(float x) { return x / (1.f + __expf(-x)); }
__device__ __forceinline__ float sigmoid_f(float x) { return 1.f / (1.f + __expf(-x)); }
__device__ __forceinline__ float logsigmoid_f(float x) { return fminf(x, 0.f) - __logf(1.f + __expf(-fabsf(x))); }

__device__ __forceinline__ float shx_f(float v, int mask, int lane) { return __int_as_float(__builtin_amdgcn_ds_bpermute((lane ^ mask) << 2, __float_as_int(v))); }
__device__ __forceinline__ int shx_i(int v, int mask, int lane) { return __builtin_amdgcn_ds_bpermute((lane ^ mask) << 2, v); }
__device__ __forceinline__ float shl_f(float v, int src) { return __int_as_float(__builtin_amdgcn_ds_bpermute(src << 2, __float_as_int(v))); }
__device__ __forceinline__ int shl_i(int v, int src) { return __builtin_amdgcn_ds_bpermute(src << 2, v); }
__device__ __forceinline__ float wave_sum(float v, int lane) {
#pragma unroll
  for (int o = 32; o > 0; o >>= 1) v += shx_f(v, o, lane);
  return v;
}

struct Inputs {
  const float *x, *c, *ctx, *c_ctx, *ada_w, *ada_b, *norm1_g, *norm2_g, *w_in, *w_out, *hy_conv_w, *hy_conv_b,
      *hy_f_w1, *hy_f_b1, *hy_f_w2, *hy_f_b2, *hy_f_w3, *hy_skip, *gla_wa2, *gla_ba2, *gla_norm_g, *router_w,
      *router_b, *exp_w1, *exp_w3, *exp_w2, *sh_w1, *sh_w3, *sh_w2, *final_g;
};

__device__ __forceinline__ int opq(int v) { asm volatile("" : "+s"(v)); return v; }
__device__ __forceinline__ int tid_opaque() { int t = threadIdx.x; asm volatile("" : "+v"(t)); return t; }
__device__ __forceinline__ int row_batch(int row) { return row < NL ? (row >> 11) : 16; }

#define XB_TMO      128
#define XB_XCNT(j)  (256  + 64 * (j))
#define XB_XSUB(j)  (1280 + 64 * (j))
#define XB_XGEN(j)  (2304 + 64 * (j))
#define XB_TOP      3328
#define XB_TOPGEN   3392
#define XCD_BAR_WORDS 3456
#define XB_SPIN_CAP (1u << 18)
#define LAS __attribute__((address_space(3)))

__device__ __forceinline__ unsigned xb_ld(unsigned* p)              { return __hip_atomic_load(p, __ATOMIC_RELAXED, __HIP_MEMORY_SCOPE_AGENT); }
__device__ __forceinline__ unsigned xb_add(unsigned* p, unsigned v) { return __hip_atomic_fetch_add(p, v, __ATOMIC_RELAXED, __HIP_MEMORY_SCOPE_AGENT); }
__device__ __forceinline__ unsigned xb_xcc_id() { return (unsigned)__builtin_amdgcn_s_getreg((3 << 11) | 20) & 0xFu; }
#define XB_SPIN(cond, bar) do { unsigned _sp = 0; while (cond) { __builtin_amdgcn_s_sleep(1); \
    if ((++_sp & 255u) == 0u) { if (xb_ld(&(bar)[XB_TMO])) break; if (_sp > XB_SPIN_CAP) { atomicAdd(&(bar)[XB_TMO], 1u); break; } } } } while (0)

struct XcdBarrier {
    unsigned* bar; unsigned x;
    volatile LAS unsigned* st;
};

__device__ __forceinline__ XcdBarrier xcd_barrier_post(unsigned* bar, volatile LAS unsigned* st) {
    XcdBarrier b; b.bar = bar; b.x = xb_xcc_id(); b.st = st;
    if (threadIdx.x == 0) (void)xb_add(&bar[XB_XCNT(b.x)], 1u);
    return b;
}
__device__ __forceinline__ void xcd_barrier_complete(unsigned* bar, unsigned x, unsigned& nloc, unsigned& nx) {
    const unsigned G = gridDim.x * gridDim.y * gridDim.z;
    unsigned sum, cnt, mine, sp = 0u;
    for (;;) {
        sum = 0u; cnt = 0u; mine = 0u;
#pragma unroll
        for (unsigned j = 0; j < 16; ++j) { const unsigned c = xb_ld(&bar[XB_XCNT(j)]); sum += c; cnt += (c > 0u) ? 1u : 0u; mine = (j == x) ? c : mine; }
        if (sum == G) break;
        __builtin_amdgcn_s_sleep(1);
        if ((++sp & 255u) == 0u) { if (xb_ld(&bar[XB_TMO])) break; if (sp > XB_SPIN_CAP) { atomicAdd(&bar[XB_TMO], 1u); break; } }
    }
    nloc = mine > 0u ? mine : 1u; nx = cnt > 0u ? cnt : 1u;
}
__device__ __forceinline__ void xcd_barrier(const XcdBarrier& b) {
    asm volatile("s_waitcnt vmcnt(0)" ::: "memory");
    __syncthreads();
    if (threadIdx.x == 0) {
        unsigned* bar = b.bar;
        __builtin_amdgcn_s_waitcnt(0);
        unsigned nloc = b.st[0], nx = b.st[1];
        if (nloc == 0u) { xcd_barrier_complete(bar, b.x, nloc, nx); b.st[0] = nloc; b.st[1] = nx; }
        const unsigned old = xb_add(&bar[XB_XSUB(b.x)], 1u);
        const unsigned gen = old / nloc;
        if (old + 1u == (gen + 1u) * nloc) {
            __builtin_amdgcn_fence(__ATOMIC_RELEASE, "agent");
            asm volatile("s_waitcnt vmcnt(0)" ::: "memory");
            const unsigned og = xb_add(&bar[XB_TOP], 1u);
            const unsigned tg = og / nx;
            if (og + 1u == (tg + 1u) * nx) xb_add(&bar[XB_TOPGEN], 1u);
            else XB_SPIN(xb_ld(&bar[XB_TOPGEN]) == tg, bar);
            __builtin_amdgcn_fence(__ATOMIC_ACQUIRE, "agent");
            xb_add(&bar[XB_XGEN(b.x)], 1u);
            asm volatile("s_waitcnt vmcnt(0)" ::: "memory");
        } else {
            XB_SPIN(xb_ld(&bar[XB_XGEN(b.x)]) == gen, bar);
            __builtin_amdgcn_fence(__ATOMIC_ACQUIRE, "agent");
            asm volatile("s_waitcnt vmcnt(0)" ::: "memory");
        }
    }
    __syncthreads();
}

__device__ __forceinline__ void grid_sync(unsigned* bar0, char* stw) {
  unsigned* q = bar0;
  asm volatile("" : "+s"(q));
  XcdBarrier b; b.bar = q; b.x = xb_xcc_id(); b.st = (volatile LAS unsigned*)stw;
  xcd_barrier(b);
}

typedef __attribute__((ext_vector_type(8))) __bf16 bf16x8;
typedef __attribute__((ext_vector_type(16))) float f32x16;
typedef __attribute__((ext_vector_type(4))) float f32x4;
typedef __attribute__((ext_vector_type(2))) float f32x2v;
typedef __attribute__((ext_vector_type(2))) __bf16 bf16x2v;
typedef __attribute__((ext_vector_type(4))) unsigned int u32x4;
typedef __attribute__((ext_vector_type(2))) unsigned int u32x2;

__device__ __forceinline__ unsigned pack_bf16(float a, float b) {
  f32x2v v = {a, b};
  return __builtin_bit_cast(unsigned, __builtin_convertvector(v, bf16x2v));
}
__device__ __forceinline__ f32x4 xs_load4(const bf16* p) {
  const u32x2 w = *(const u32x2*)p;
  return (f32x4){__uint_as_float(w.x << 16), __uint_as_float(w.x & 0xffff0000u), __uint_as_float(w.y << 16), __uint_as_float(w.y & 0xffff0000u)};
}
__device__ __forceinline__ void xs_store4(bf16* p, const f32x4 v) {
  u32x2 w; w.x = pack_bf16(v.x, v.y); w.y = pack_bf16(v.z, v.w);
  *(u32x2*)p = w;
}
__device__ __forceinline__ int swz(int row, int chunk) { return row * 128 + ((chunk ^ ((row >> 1) & 7)) << 4); }
__device__ __forceinline__ int rowmap(int reg, int lh) { return (reg & 3) + 8 * (reg >> 2) + 4 * lh; }

__device__ __forceinline__ int find_group(const int* __restrict__ pad_start, int m0) {
  int lo = 0, hi = NE - 1;
  while (lo < hi) {
    int mid = (lo + hi + 1) >> 1;
    if (pad_start[mid] <= m0) lo = mid; else hi = mid - 1;
  }
  return lo;
}

__device__ __forceinline__ void cvt_wave_tile(const float* __restrict__ src, bf16* __restrict__ dst, int K, int N, int kt, int ntile, int lane) {
  const int k0 = kt * 64 + (lane & 7) * 8, n0 = ntile * 32 + (lane >> 3) * 4;
  const float* s = src + (size_t)k0 * N + n0;
  const f32x4 v0 = __builtin_nontemporal_load((const f32x4*)(s)), v1 = __builtin_nontemporal_load((const f32x4*)(s + (size_t)N));
  const f32x4 v2 = __builtin_nontemporal_load((const f32x4*)(s + (size_t)2 * N)), v3 = __builtin_nontemporal_load((const f32x4*)(s + (size_t)3 * N));
  const f32x4 v4 = __builtin_nontemporal_load((const f32x4*)(s + (size_t)4 * N)), v5 = __builtin_nontemporal_load((const f32x4*)(s + (size_t)5 * N));
  const f32x4 v6 = __builtin_nontemporal_load((const f32x4*)(s + (size_t)6 * N)), v7 = __builtin_nontemporal_load((const f32x4*)(s + (size_t)7 * N));
  bf16* d = dst + (size_t)n0 * K + k0;
  *(u32x4*)(d) = (u32x4){pack_bf16(v0.x, v1.x), pack_bf16(v2.x, v3.x), pack_bf16(v4.x, v5.x), pack_bf16(v6.x, v7.x)};
  *(u32x4*)(d + (size_t)K) = (u32x4){pack_bf16(v0.y, v1.y), pack_bf16(v2.y, v3.y), pack_bf16(v4.y, v5.y), pack_bf16(v6.y, v7.y)};
  *(u32x4*)(d + (size_t)2 * K) = (u32x4){pack_bf16(v0.z, v1.z), pack_bf16(v2.z, v3.z), pack_bf16(v4.z, v5.z), pack_bf16(v6.z, v7.z)};
  *(u32x4*)(d + (size_t)3 * K) = (u32x4){pack_bf16(v0.w, v1.w), pack_bf16(v2.w, v3.w), pack_bf16(v4.w, v5.w), pack_bf16(v6.w, v7.w)};
}
typedef __attribute__((ext_vector_type(8))) int i32x8;
typedef __attribute__((ext_vector_type(4))) int i32x4;
__device__ __forceinline__ float clamp_fp8(float x) { return __builtin_amdgcn_fmed3f(x, -448.0f, 448.0f); }
__device__ __forceinline__ unsigned pk4_fp8(float a, float b, float c, float d) {
  a = clamp_fp8(a); b = clamp_fp8(b); c = clamp_fp8(c); d = clamp_fp8(d);
  int w = 0;
  w = __builtin_amdgcn_cvt_pk_fp8_f32(a, b, w, false);
  w = __builtin_amdgcn_cvt_pk_fp8_f32(c, d, w, true);
  return (unsigned)w;
}
__device__ __forceinline__ void cvt8_wave_tile(const float* __restrict__ src, unsigned char* __restrict__ dst, int K, int N, int kt, int ntile, int lane) {
  const int k0 = kt * 64 + (lane & 7) * 8, n0 = ntile * 32 + (lane >> 3) * 4;
  const float* s = src + (size_t)k0 * N + n0;
  const float sc = 16.0f;
  const f32x4 v0 = __builtin_nontemporal_load((const f32x4*)(s)) * sc, v1 = __builtin_nontemporal_load((const f32x4*)(s + (size_t)N)) * sc;
  const f32x4 v2 = __builtin_nontemporal_load((const f32x4*)(s + (size_t)2 * N)) * sc, v3 = __builtin_nontemporal_load((const f32x4*)(s + (size_t)3 * N)) * sc;
  const f32x4 v4 = __builtin_nontemporal_load((const f32x4*)(s + (size_t)4 * N)) * sc, v5 = __builtin_nontemporal_load((const f32x4*)(s + (size_t)5 * N)) * sc;
  const f32x4 v6 = __builtin_nontemporal_load((const f32x4*)(s + (size_t)6 * N)) * sc, v7 = __builtin_nontemporal_load((const f32x4*)(s + (size_t)7 * N)) * sc;
  unsigned char* d = dst + (size_t)n0 * K + k0;
  *(u32x2*)(d) = (u32x2){pk4_fp8(v0.x, v1.x, v2.x, v3.x), pk4_fp8(v4.x, v5.x, v6.x, v7.x)};
  *(u32x2*)(d + (size_t)K) = (u32x2){pk4_fp8(v0.y, v1.y, v2.y, v3.y), pk4_fp8(v4.y, v5.y, v6.y, v7.y)};
  *(u32x2*)(d + (size_t)2 * K) = (u32x2){pk4_fp8(v0.z, v1.z, v2.z, v3.z), pk4_fp8(v4.z, v5.z, v6.z, v7.z)};
  *(u32x2*)(d + (size_t)3 * K) = (u32x2){pk4_fp8(v0.w, v1.w, v2.w, v3.w), pk4_fp8(v4.w, v5.w, v6.w, v7.w)};
}
__device__ __forceinline__ void cvt8_job(const float* __restrict__ src, unsigned char* __restrict__ dst, int K, int N, int nmat, int bid, int nblk, int W = 0) {
  const int tid = tid_opaque(), lane = tid & 63, wave = tid >> 6;
  if (W == 0) W = N;
  const int tk = K >> 6, tn = W >> 5, per = tk * tn;
  const int total = per * nmat;
  for (int u = bid * 8 + wave; u < total; u += nblk * 8) {
    const int mat = u / per, r = u - mat * per;
    const int ntile = r / tk, kt = r - ntile * tk;
    cvt8_wave_tile(src + (size_t)mat * K * N, dst + (size_t)mat * K * W, K, N, kt, ntile, lane);
  }
}

__device__ __forceinline__ void cvt_job(const float* __restrict__ src, bf16* __restrict__ dst, int K, int N, int nmat, int bid, int nblk, int W = 0) {
  const int tid = tid_opaque(), lane = tid & 63, wave = tid >> 6;
  if (W == 0) W = N;
  const int tk = K >> 6, tn = W >> 5, per = tk * tn;
  const int total = per * nmat;
  for (int u = bid * 8 + wave; u < total; u += nblk * 8) {
    const int mat = u / per, r = u - mat * per;
    const int ntile = r / tk, kt = r - ntile * tk;
    cvt_wave_tile(src + (size_t)mat * K * N, dst + (size_t)mat * K * W, K, N, kt, ntile, lane);
  }
}

constexpr int G8_HT = 128 * 64;
constexpr int G8_LDS = 8 * G8_HT * 2;

__device__ __forceinline__ int g8_lds_byte(int r, int c) {
  int st = (r >> 4) * 2 + (c >> 5), rr = r & 15, cc = c & 31, ob = rr * 64 + cc * 2;
  return st * 1024 + (ob ^ (((ob >> 9) & 1) << 5));
}
__device__ __forceinline__ void g8_stage_rc(int b, int& R, int& C) {
  int st = b / 1024, sb = b % 1024, sw = sb ^ (((sb >> 9) & 1) << 5);
  R = (st >> 1) * 16 + sw / 64; C = (st & 1) * 32 + (sw % 64) / 2;
}

typedef f32x4 g8acc_t[2][2][4][2];

template <class P>
__device__ __forceinline__ void gemm8_run(const P& p, char* smem, int bid, int nblk) {
  const int ntl = __builtin_amdgcn_readfirstlane(p.ntiles());
  if (bid >= ntl) return;
  bf16* shm = (bf16*)smem;
#define SA(b, h) (shm + ((b) * 2 + (h)) * G8_HT)
#define SB(b, h) (shm + (4 + (b) * 2 + (h)) * G8_HT)
#define GLDS(SRC, DST) __builtin_amdgcn_global_load_lds((const unsigned*)(SRC), (unsigned*)(DST), 16, 0, 0)
#define STAGE_A(PP, BASE, KT) do { GLDS((BASE) + (oa + (KT) * 64), (char*)(PP) + ldsd); GLDS((BASE) + 64 * P::A_PITCH + (oa + (KT) * 64), (char*)(PP) + ldsd + 8192); } while (0)
#define STAGE_B(PP, BASE, OB, KT) do { \
    if constexpr (P::B_GATHER) { GLDS((BASE) + ((((OB) & 0xffffu) * (unsigned)P::B_PITCH + cc) + (KT) * 64), (char*)(PP) + ldsd); \
                                 GLDS((BASE) + ((((OB) >> 16) * (unsigned)P::B_PITCH + cc) + (KT) * 64), (char*)(PP) + ldsd + 8192); } \
    else { GLDS((BASE) + ((OB) + (KT) * 64), (char*)(PP) + ldsd); GLDS((BASE) + 64 * P::B_PITCH + ((OB) + (KT) * 64), (char*)(PP) + ldsd + 8192); } } while (0)
#define LDA(dst, b, h) for (int m = 0; m < 4; ++m) \
    dst[m] = __builtin_shufflevector(*reinterpret_cast<const i32x4*>((char*)SA(b, h) + aoff + m * 2048), \
                                     *reinterpret_cast<const i32x4*>((char*)SA(b, h) + aoff + m * 2048 + 1024), 0, 1, 2, 3, 4, 5, 6, 7)
#define LDB(dst, b, h) for (int n = 0; n < 2; ++n) \
    dst[n] = __builtin_shufflevector(*reinterpret_cast<const i32x4*>((char*)SB(b, h) + boff + n * 2048), \
                                     *reinterpret_cast<const i32x4*>((char*)SB(b, h) + boff + n * 2048 + 1024), 0, 1, 2, 3, 4, 5, 6, 7)
#define FRAG_LO(x) __builtin_bit_cast(bf16x8, __builtin_shufflevector(x, x, 0, 1, 2, 3))
#define FRAG_HI(x) __builtin_bit_cast(bf16x8, __builtin_shufflevector(x, x, 4, 5, 6, 7))
#define MMA(ai, bj, At_, Bt_) do { __builtin_amdgcn_s_setprio(1); \
    if constexpr (P::FP8) { \
      for (int m = 0; m < 4; ++m) for (int n = 0; n < 2; ++n) \
        asm volatile("v_mfma_f32_16x16x128_f8f6f4 %0, %1, %2, %0" \
                     : "+v"(acc[ai][bj][m][n]) : "v"(At_[m]), "v"(Bt_[n])); \
    } else { \
      for (int m = 0; m < 4; ++m) for (int n = 0; n < 2; ++n) { \
        acc[ai][bj][m][n] = __builtin_amdgcn_mfma_f32_16x16x32_bf16(FRAG_LO(At_[m]), FRAG_LO(Bt_[n]), acc[ai][bj][m][n], 0, 0, 0); \
        acc[ai][bj][m][n] = __builtin_amdgcn_mfma_f32_16x16x32_bf16(FRAG_HI(At_[m]), FRAG_HI(Bt_[n]), acc[ai][bj][m][n], 0, 0, 0); } \
    } \
    __builtin_amdgcn_s_setprio(0); } while (0)
#define WAIT_V(n) asm volatile("s_waitcnt vmcnt(" #n ")" ::: "memory")
#define WAIT_L(n) asm volatile("s_waitcnt lgkmcnt(" #n ")" ::: "memory")
#define BAR __builtin_amdgcn_s_barrier()
#define SCHED __builtin_amdgcn_sched_barrier(0)

  typename P::Ctx cur, nxt;
  p.tile(bid, cur);
  int aoff, boff, ldsd;
  unsigned oa, cc, ob0, ob1;
  bool wr1;
  {
    const int tid = tid_opaque();
    const int wid = tid >> 6, lane = tid & 63, wr = wid >> 2, wc = wid & 3, fr = lane & 15, fq = lane >> 4;
    aoff = g8_lds_byte(wr * 64 + fr, fq * 8); boff = g8_lds_byte(wc * 32 + fr, fq * 8);
    ldsd = tid * 16; wr1 = (wr == 1);
    int R0, C0;
    g8_stage_rc(tid * 16, R0, C0);
    cc = C0;
    oa = (((R0 >> 2) & 3) * 16 + (R0 >> 4) * 4 + (R0 & 3)) * P::A_PITCH + C0;
    if constexpr (P::B_GATHER) {
      ob0 = p.b_row(cur, 0, R0) | (p.b_row(cur, 0, R0 + 64) << 16);
      ob1 = p.b_row(cur, 1, R0) | (p.b_row(cur, 1, R0 + 64) << 16);
    } else { ob0 = R0 * P::B_PITCH + C0; ob1 = ob0; }
  }
  const bf16* ca0 = p.a_base(cur, 0);
  const bf16* ca1 = p.a_base(cur, 1);
  const bf16* cb0 = p.b_base(cur, 0);
  const bf16* cb1 = p.b_base(cur, 1);

  g8acc_t acc;
#pragma unroll
  for (int a0 = 0; a0 < 2; ++a0)
#pragma unroll
    for (int b0 = 0; b0 < 2; ++b0)
#pragma unroll
      for (int m = 0; m < 4; ++m)
#pragma unroll
        for (int n = 0; n < 2; ++n) acc[a0][b0][m][n] = (f32x4){0.f, 0.f, 0.f, 0.f};
  i32x8 At[4], B0[2], B1[2];
  const int mxs = 0x7F7F7F7F;
  const int nt = opq(P::NKT);
  STAGE_B(SB(0, 0), cb0, ob0, 0); STAGE_A(SA(0, 0), ca0, 0);
  STAGE_B(SB(0, 1), cb1, ob1, 0); STAGE_A(SA(0, 1), ca1, 0);
  if (wr1) BAR;
  WAIT_V(4); BAR;
  STAGE_B(SB(1, 0), cb0, ob0, 1); STAGE_A(SA(1, 0), ca0, 1); STAGE_B(SB(1, 1), cb1, ob1, 1);
  WAIT_V(6); BAR;
#pragma unroll 1
  for (int idx = bid;;) {
    const int nidx = idx + nblk;
    const bool has_next = nidx < ntl;
    if (has_next) p.tile(nidx, nxt); else nxt = cur;
    const bf16* na0 = p.a_base(nxt, 0);
    const bf16* na1 = p.a_base(nxt, 1);
    const bf16* nb0 = p.b_base(nxt, 0);
    const bf16* nb1 = p.b_base(nxt, 1);
    unsigned nob0 = ob0, nob1 = ob1;
    if constexpr (P::B_GATHER) {
      const int t2 = tid_opaque();
      int R0, C0;
      g8_stage_rc(t2 * 16, R0, C0);
      nob0 = p.b_row(nxt, 0, R0) | (p.b_row(nxt, 0, R0 + 64) << 16);
      nob1 = p.b_row(nxt, 1, R0) | (p.b_row(nxt, 1, R0 + 64) << 16);
    }
#pragma unroll 1
    for (int t = 0; t < nt; t += 2) {
      const bool last = (t == nt - 2);
      const bf16* a2h0 = last ? na0 : ca0; const bf16* a2h1 = last ? na1 : ca1;
      const bf16* b2h0 = last ? nb0 : cb0; const bf16* b2h1 = last ? nb1 : cb1;
      const int k2 = last ? 0 : t + 2;
      const unsigned q0 = last ? nob0 : ob0, q1 = last ? nob1 : ob1;
      LDB(B0, 0, 0); SCHED; LDA(At, 0, 0); STAGE_A(SA(1, 1), ca1, t + 1);
      WAIT_L(8); BAR; WAIT_L(0); MMA(0, 0, At, B0); BAR; SCHED;
      LDB(B1, 0, 1); STAGE_B(SB(0, 0), b2h0, q0, k2);
      BAR; WAIT_L(0); MMA(0, 1, At, B1); BAR;
      LDA(At, 0, 1); STAGE_A(SA(0, 0), a2h0, k2);
      BAR; WAIT_L(0); MMA(1, 0, At, B0); BAR; SCHED;
      STAGE_B(SB(0, 1), b2h1, q1, k2);
      WAIT_V(6); BAR; MMA(1, 1, At, B1); BAR;
      LDB(B0, 1, 0); SCHED; LDA(At, 1, 0); STAGE_A(SA(0, 1), a2h1, k2);
      WAIT_L(8); BAR; WAIT_L(0); MMA(0, 0, At, B0); BAR; SCHED;
      LDB(B1, 1, 1); STAGE_B(SB(1, 0), b2h0, q0, k2 + 1);
      BAR; WAIT_L(0); MMA(0, 1, At, B1); BAR;
      LDA(At, 1, 1); STAGE_A(SA(1, 0), a2h0, k2 + 1);
      BAR; WAIT_L(0); MMA(1, 0, At, B0); BAR; SCHED;
      STAGE_B(SB(1, 1), b2h1, q1, k2 + 1);
      WAIT_V(6); BAR; MMA(1, 1, At, B1); BAR;
    }
    if constexpr (P::FP8) asm volatile("s_nop 15\n\ts_nop 15" ::: "memory");
    {
      const int t3 = tid_opaque();
      const int wid = t3 >> 6, lane = t3 & 63;
      p.epi(cur, acc, wid >> 2, wid & 3, lane & 15, lane >> 4);
    }
    if (!has_next) break;
#pragma unroll
    for (int a0 = 0; a0 < 2; ++a0)
#pragma unroll
      for (int b0 = 0; b0 < 2; ++b0)
#pragma unroll
        for (int m = 0; m < 4; ++m)
#pragma unroll
          for (int n = 0; n < 2; ++n) acc[a0][b0][m][n] = (f32x4){0.f, 0.f, 0.f, 0.f};
    cur = nxt; ca0 = na0; ca1 = na1; cb0 = nb0; cb1 = nb1;
    ob0 = nob0; ob1 = nob1;
    idx = nidx;
  }
  WAIT_V(0);
  if (!wr1) BAR;
  BAR;
#undef SA
#undef SB
#undef GLDS
#undef STAGE_A
#undef STAGE_B
#undef LDA
#undef LDB
#undef MMA
#undef FRAG_LO
#undef FRAG_HI
#undef WAIT_V
#undef WAIT_L
#undef BAR
#undef SCHED
}

#define G8_FOR_BLK(AI, BJ, M, N) \
  _Pragma("unroll") for (int AI = 0; AI < 2; ++AI) _Pragma("unroll") for (int BJ = 0; BJ < 2; ++BJ) \
  _Pragma("unroll") for (int M = 0; M < 4; ++M) _Pragma("unroll") for (int N = 0; N < 2; ++N)
#define G8_AIDX(AI, M) ((AI) * 128 + wr * 64 + fq * 16 + (M) * 4)
#define G8_BIDX(BJ, N) ((BJ) * 128 + wc * 32 + (N) * 16 + fr)
__device__ __forceinline__ u32x2 pack4_bf16(const f32x4 v) { return (u32x2){pack_bf16(v.x, v.y), pack_bf16(v.z, v.w)}; }
__device__ __forceinline__ unsigned pack4_fp8(const f32x4 v) { return pk4_fp8(v.x, v.y, v.z, v.w); }
__device__ __forceinline__ u32x4 pack8_bf16(const f32x4 a, const f32x4 b) { return (u32x4){pack_bf16(a.x, a.y), pack_bf16(a.z, a.w), pack_bf16(b.x, b.y), pack_bf16(b.z, b.w)}; }
#define G8_FOR_BLK2(AI, BJ, M2, N) \
  _Pragma("unroll") for (int AI = 0; AI < 2; ++AI) _Pragma("unroll") for (int BJ = 0; BJ < 2; ++BJ) \
  _Pragma("unroll") for (int M2 = 0; M2 < 4; M2 += 2) _Pragma("unroll") for (int N = 0; N < 2; ++N)

struct G8InZT {
  static constexpr int NKT = 16; static constexpr bool B_GATHER = false; static constexpr bool FP8 = false; static constexpr int B_PITCH = D; static constexpr int A_PITCH = D;
  template <class C_> __device__ unsigned b_row(const C_&, int, int) const { return 0u; }
  struct Ctx { int t0, z0; };
  const bf16* wt; const bf16* A; bf16* zt; int ntok;
  __device__ int ntiles() const { return 6 * (ntok / 256); }
  __device__ void tile(int idx, Ctx& c) const { int tt = idx / 6; c.z0 = (idx - tt * 6) * 256; c.t0 = tt * 256; }
  __device__ const bf16* a_base(const Ctx& c, int h) const { return A + (size_t)(c.t0 + h * 128) * D; }
  __device__ unsigned a_off(const Ctx&, int, int r) const { return r * D; }
  __device__ const bf16* b_base(const Ctx& c, int h) const { return wt + (size_t)(c.z0 + h * 128) * D; }
  __device__ unsigned b_off(const Ctx&, int, int r) const { return r * D; }
  __device__ void epi(const Ctx& c, g8acc_t& acc, int wr, int wc, int fr, int fq) const {
    G8_FOR_BLK2(ai, bj, m, n) {
      const int tok = c.t0 + G8_AIDX(ai, m), z = c.z0 + G8_BIDX(bj, n);
      *(u32x4*)(zt + (size_t)z * NT + tok) = pack8_bf16(acc[ai][bj][m][n], acc[ai][bj][m + 1][n]);
    }
  }
};
struct G8InG {
  static constexpr int NKT = 8; static constexpr bool B_GATHER = false; static constexpr bool FP8 = true; static constexpr int B_PITCH = D / 2; static constexpr int A_PITCH = D / 2;
  template <class C_> __device__ unsigned b_row(const C_&, int, int) const { return 0u; }
  struct Ctx { int c0, t0; };
  const unsigned char* wt; const unsigned char* A; bf16* zg;
  __device__ int ntiles() const { return 7 * (NT / 256); }
  __device__ void tile(int idx, Ctx& c) const { int tt = idx / 7; c.t0 = tt * 256; c.c0 = (idx - tt * 7) * 256; }
  __device__ const bf16* a_base(const Ctx& c, int h) const { return (const bf16*)(wt + (size_t)(c.c0 + h * 128) * D); }
  __device__ unsigned a_off(const Ctx&, int, int r) const { return r * (D / 2); }
  __device__ const bf16* b_base(const Ctx& c, int h) const { return (const bf16*)(A + (size_t)(c.t0 + h * 128) * D); }
  __device__ unsigned b_off(const Ctx&, int, int r) const { return r * (D / 2); }
  __device__ void epi(const Ctx& c, g8acc_t& acc, int wr, int wc, int fr, int fq) const {
    const float isc = 1.0f / 16.0f;
    G8_FOR_BLK2(ai, bj, m, n) {
      const int col = c.c0 + G8_AIDX(ai, m), tok = c.t0 + G8_BIDX(bj, n);
      if (col < GLACOLS) *(u32x4*)(zg + (size_t)tok * GLACOLS + col) = pack8_bf16(acc[ai][bj][m][n] * isc, acc[ai][bj][m + 1][n] * isc);
    }
  }
};
struct G8Out {
  static constexpr int NKT = 16; static constexpr bool B_GATHER = false; static constexpr bool FP8 = false; static constexpr int B_PITCH = D; static constexpr int A_PITCH = D;
  template <class C_> __device__ unsigned b_row(const C_&, int, int) const { return 0u; }
  struct Ctx { int c0, t0; };
  int mrows; const bf16* ymix; const bf16* wt; const float* modl; bf16* xs;
  __device__ int ntiles() const { return (mrows / 256) * 4; }
  __device__ void tile(int idx, Ctx& c) const { c.t0 = (idx >> 2) * 256; c.c0 = (idx & 3) * 256; }
  __device__ const bf16* a_base(const Ctx& c, int h) const { return wt + (size_t)(c.c0 + h * 128) * D; }
  __device__ unsigned a_off(const Ctx&, int, int r) const { return r * D; }
  __device__ const bf16* b_base(const Ctx& c, int h) const { return ymix + (size_t)(c.t0 + h * 128) * D; }
  __device__ unsigned b_off(const Ctx&, int, int r) const { return r * D; }
  __device__ void epi(const Ctx& c, g8acc_t& acc, int wr, int wc, int fr, int fq) const {
    const float* g1 = modl + (size_t)row_batch(c.t0) * 6 * D + 2 * D;
    G8_FOR_BLK(ai, bj, m, n) {
      const int col = c.c0 + G8_AIDX(ai, m), tok = c.t0 + G8_BIDX(bj, n);
      bf16* xp = xs + (size_t)tok * D + col;
      xs_store4(xp, xs_load4(xp) + *(const f32x4*)(g1 + col) * acc[ai][bj][m][n]);
    }
  }
};
struct G8Router {
  static constexpr int NKT = 16; static constexpr bool B_GATHER = false; static constexpr bool FP8 = false; static constexpr int B_PITCH = D; static constexpr int A_PITCH = D;
  template <class C_> __device__ unsigned b_row(const C_&, int, int) const { return 0u; }
  struct Ctx { int t0; };
  int mrows; const bf16* A; const bf16* rwt; float* logits;
  __device__ int ntiles() const { return mrows / 256; }
  __device__ void tile(int idx, Ctx& c) const { c.t0 = idx * 256; }
  __device__ const bf16* a_base(const Ctx&, int h) const { return rwt + (size_t)(h * 128) * D; }
  __device__ unsigned a_off(const Ctx&, int, int r) const { return r * D; }
  __device__ const bf16* b_base(const Ctx& c, int h) const { return A + (size_t)(c.t0 + h * 128) * D; }
  __device__ unsigned b_off(const Ctx&, int, int r) const { return r * D; }
  __device__ void epi(const Ctx& c, g8acc_t& acc, int wr, int wc, int fr, int fq) const {
    G8_FOR_BLK(ai, bj, m, n) {
      const int e = G8_AIDX(ai, m), tok = c.t0 + G8_BIDX(bj, n);
      *(f32x4*)(logits + (size_t)tok * NE + e) = acc[ai][bj][m][n];
    }
  }
};
struct G8ShUp {
  static constexpr int NKT = 8; static constexpr bool B_GATHER = false; static constexpr bool FP8 = true; static constexpr int B_PITCH = D / 2; static constexpr int A_PITCH = D / 2;
  template <class C_> __device__ unsigned b_row(const C_&, int, int) const { return 0u; }
  struct Ctx { int t0, hb; };
  int mrows; const unsigned char* A8; const unsigned char* s1t; const unsigned char* s3t; unsigned char* hs;
  __device__ int ntiles() const { return (mrows / 256) * 2; }
  __device__ void tile(int idx, Ctx& c) const { c.t0 = (idx >> 1) * 256; c.hb = (idx & 1) * 128; }
  __device__ const bf16* a_base(const Ctx& c, int h) const { return (const bf16*)((h ? s3t : s1t) + (size_t)c.hb * D); }
  __device__ unsigned a_off(const Ctx&, int, int r) const { return r * (D / 2); }
  __device__ const bf16* b_base(const Ctx& c, int h) const { return (const bf16*)(A8 + (size_t)(c.t0 + h * 128) * D); }
  __device__ unsigned b_off(const Ctx&, int, int r) const { return r * (D / 2); }
  __device__ void epi(const Ctx& c, g8acc_t& acc, int wr, int wc, int fr, int fq) const {
    const float isc = 1.0f / 16.0f;
#pragma unroll
    for (int bj = 0; bj < 2; ++bj)
#pragma unroll
      for (int n = 0; n < 2; ++n) {
        const int hcol = c.hb + wr * 64 + fq * 16, tok = c.t0 + G8_BIDX(bj, n);
        u32x4 o;
#pragma unroll
        for (int m = 0; m < 4; ++m) {
          const f32x4 u = acc[0][bj][m][n] * isc, v = acc[1][bj][m][n] * isc;
          const unsigned w = pk4_fp8(silu_f(u.x) * v.x, silu_f(u.y) * v.y, silu_f(u.z) * v.z, silu_f(u.w) * v.w);
          if (m == 0) o.x = w; else if (m == 1) o.y = w; else if (m == 2) o.z = w; else o.w = w;
        }
        *(u32x4*)(hs + (size_t)tok * DE + hcol) = o;
      }
  }
};
struct G8Up {
  static constexpr int NKT = 8; static constexpr bool B_GATHER = true; static constexpr bool FP8 = true; static constexpr int B_PITCH = D / 2; static constexpr int A_PITCH = D / 2;
  struct Ctx { int s0, hb, grp; };
  const unsigned char* A8; const int* slot_tok; const int* pad_start; const unsigned char* w1t; const unsigned char* w3t; unsigned char* H; const unsigned short* tile_e;
  __device__ int ntiles() const { return (pad_start[NE] >> 8) * 2; }
  __device__ void tile(int idx, Ctx& c) const { c.s0 = (idx >> 1) * 256; c.hb = (idx & 1) * 128; c.grp = __builtin_amdgcn_readfirstlane((int)tile_e[idx >> 1]); }
  __device__ const bf16* a_base(const Ctx& c, int h) const { return (const bf16*)((h ? w3t : w1t) + ((size_t)c.grp * DE + c.hb) * D); }
  __device__ unsigned a_off(const Ctx&, int, int r) const { return r * (D / 2); }
  __device__ const bf16* b_base(const Ctx&, int) const { return (const bf16*)A8; }
  __device__ unsigned b_off(const Ctx&, int, int) const { return 0u; }
  __device__ unsigned b_row(const Ctx& c, int h, int r) const { int t = slot_tok[c.s0 + h * 128 + r]; t = (t < 0 || t >= NT) ? 0 : t; return (unsigned)t; }
  __device__ void epi(const Ctx& c, g8acc_t& acc, int wr, int wc, int fr, int fq) const {
    const float isc = 1.0f / 16.0f;
#pragma unroll
    for (int bj = 0; bj < 2; ++bj)
#pragma unroll
      for (int n = 0; n < 2; ++n) {
        const int hcol = c.hb + wr * 64 + fq * 16, slot = c.s0 + G8_BIDX(bj, n);
        u32x4 o;
#pragma unroll
        for (int m = 0; m < 4; ++m) {
          const f32x4 u = acc[0][bj][m][n] * isc, v = acc[1][bj][m][n] * isc;
          const unsigned w = pk4_fp8(silu_f(u.x) * v.x, silu_f(u.y) * v.y, silu_f(u.z) * v.z, silu_f(u.w) * v.w);
          if (m == 0) o.x = w; else if (m == 1) o.y = w; else if (m == 2) o.z = w; else o.w = w;
        }
        *(u32x4*)(H + (size_t)slot * DE + hcol) = o;
      }
  }
};
struct G8ShDown {
  static constexpr int NKT = 2; static constexpr bool B_GATHER = false; static constexpr bool FP8 = true; static constexpr int B_PITCH = DE / 2; static constexpr int A_PITCH = DE / 2;
  template <class C_> __device__ unsigned b_row(const C_&, int, int) const { return 0u; }
  struct Ctx { int c0, t0; };
  int mrows; const unsigned char* hs; const unsigned char* wt; const float* modl; bf16* xs;
  __device__ int ntiles() const { return (mrows / 256) * 4; }
  __device__ void tile(int idx, Ctx& c) const { c.t0 = (idx >> 2) * 256; c.c0 = (idx & 3) * 256; }
  __device__ const bf16* a_base(const Ctx& c, int h) const { return (const bf16*)(wt + (size_t)(c.c0 + h * 128) * DE); }
  __device__ unsigned a_off(const Ctx&, int, int r) const { return r * (DE / 2); }
  __device__ const bf16* b_base(const Ctx& c, int h) const { return (const bf16*)(hs + (size_t)(c.t0 + h * 128) * DE); }
  __device__ unsigned b_off(const Ctx&, int, int r) const { return r * (DE / 2); }
  __device__ void epi(const Ctx& c, g8acc_t& acc, int wr, int wc, int fr, int fq) const {
    const float* g2 = modl + (size_t)row_batch(c.t0) * 6 * D + 5 * D;
    const float isc = 1.0f / 16.0f;
    G8_FOR_BLK(ai, bj, m, n) {
      const int col = c.c0 + G8_AIDX(ai, m), tok = c.t0 + G8_BIDX(bj, n);
      bf16* xp = xs + (size_t)tok * D + col;
      xs_store4(xp, xs_load4(xp) + *(const f32x4*)(g2 + col) * (acc[ai][bj][m][n] * isc));
    }
  }
};
struct G8Down {
  static constexpr int NKT = 2; static constexpr bool B_GATHER = false; static constexpr bool FP8 = true; static constexpr int B_PITCH = DE / 2; static constexpr int A_PITCH = DE / 2;
  struct Ctx { int c0, s0, grp; };
  const unsigned char* H; const int* pad_start; const unsigned char* w2t; unsigned char* Y; const unsigned short* tile_e;
  template <class C_> __device__ unsigned b_row(const C_&, int, int) const { return 0u; }
  __device__ int ntiles() const { return (pad_start[NE] >> 8) * 4; }
  __device__ void tile(int idx, Ctx& c) const { c.s0 = (idx >> 2) * 256; c.c0 = (idx & 3) * 256; c.grp = __builtin_amdgcn_readfirstlane((int)tile_e[idx >> 2]); }
  __device__ const bf16* a_base(const Ctx& c, int h) const { return (const bf16*)(w2t + ((size_t)c.grp * D + c.c0 + h * 128) * DE); }
  __device__ unsigned a_off(const Ctx&, int, int r) const { return r * (DE / 2); }
  __device__ const bf16* b_base(const Ctx& c, int h) const { return (const bf16*)(H + (size_t)(c.s0 + h * 128) * DE); }
  __device__ unsigned b_off(const Ctx&, int, int r) const { return r * (DE / 2); }
  __device__ void epi(const Ctx& c, g8acc_t& acc, int wr, int wc, int fr, int fq) const {
    const float isc = 1.0f / 16.0f;
#pragma unroll
    for (int ai = 0; ai < 2; ++ai)
#pragma unroll
      for (int bj = 0; bj < 2; ++bj)
#pragma unroll
        for (int n = 0; n < 2; ++n) {
          const int col = c.c0 + G8_AIDX(ai, 0), slot = c.s0 + G8_BIDX(bj, n);
          u32x4 o;
          o.x = pack4_fp8(acc[ai][bj][0][n] * isc); o.y = pack4_fp8(acc[ai][bj][1][n] * isc);
          o.z = pack4_fp8(acc[ai][bj][2][n] * isc); o.w = pack4_fp8(acc[ai][bj][3][n] * isc);
          *(u32x4*)(Y + (size_t)slot * D + col) = o;
        }
  }
};

constexpr int CVT_TILES = 3 * NE * 128;
struct CvtCtx { const float* w1; const float* w3; const float* w2; unsigned char* d1; unsigned char* d3; unsigned char* d2; };
struct CvtRegs { int pend; f32x4 r0, r1, r2, r3, r4, r5, r6, r7; };
__device__ __forceinline__ void cvt_locate(const CvtCtx& js, int u, int lane, const float*& s, unsigned char*& d, int& K, int& N) {
  const int job = u >> 15, r = u & 32767, mat = r >> 7, rr = r & 127;
  int kt, ntile;
  if (job < 2) { K = D; N = DE; ntile = rr >> 4; kt = rr & 15; } else { K = DE; N = D; ntile = rr >> 2; kt = rr & 3; }
  const float* s1 = js.w1; const float* s3 = js.w3; const float* s2 = js.w2;
  unsigned char* q1 = js.d1; unsigned char* q3 = js.d3; unsigned char* q2 = js.d2;
  const float* sb = job == 0 ? s1 : (job == 1 ? s3 : s2);
  unsigned char* db = job == 0 ? q1 : (job == 1 ? q3 : q2);
  const int k0 = kt * 64 + (lane & 7) * 8, n0 = ntile * 32 + (lane >> 3) * 4;
  s = sb + (size_t)mat * D * DE + (size_t)k0 * N + n0;
  d = db + (size_t)mat * D * DE + (size_t)n0 * K + k0;
}
__device__ __forceinline__ void cvt_init(CvtRegs& st) {
  st.pend = -1;
  st.r0 = st.r1 = st.r2 = st.r3 = st.r4 = st.r5 = st.r6 = st.r7 = (f32x4){0.f, 0.f, 0.f, 0.f};
}
__device__ __forceinline__ void cvt_finish(const CvtCtx& cx, CvtRegs& st, int lane) {
  if (st.pend < 0) return;
  const float* s; unsigned char* d; int K, N;
  cvt_locate(cx, st.pend, lane, s, d, K, N);
  const float sc = 16.0f;
  const f32x4 v0 = st.r0 * sc, v1 = st.r1 * sc, v2 = st.r2 * sc, v3 = st.r3 * sc, v4 = st.r4 * sc, v5 = st.r5 * sc, v6 = st.r6 * sc, v7 = st.r7 * sc;
  *(u32x2*)(d) = (u32x2){pk4_fp8(v0.x, v1.x, v2.x, v3.x), pk4_fp8(v4.x, v5.x, v6.x, v7.x)};
  *(u32x2*)(d + (size_t)K) = (u32x2){pk4_fp8(v0.y, v1.y, v2.y, v3.y), pk4_fp8(v4.y, v5.y, v6.y, v7.y)};
  *(u32x2*)(d + (size_t)2 * K) = (u32x2){pk4_fp8(v0.z, v1.z, v2.z, v3.z), pk4_fp8(v4.z, v5.z, v6.z, v7.z)};
  *(u32x2*)(d + (size_t)3 * K) = (u32x2){pk4_fp8(v0.w, v1.w, v2.w, v3.w), pk4_fp8(v4.w, v5.w, v6.w, v7.w)};
  st.pend = -1;
}
constexpr int CVT_GLA_TILES = 128 * 36 * 2 * 8;
static_assert(CVT_GLA_TILES + 512 * 2 * 3 * 8 == CVT_TILES, "tile ownership must cover every tile exactly once");
__device__ __forceinline__ void cvt_step(const CvtCtx& cx, CvtRegs& st, int lane, int u) {
  cvt_finish(cx, st, lane);
  const float* s; unsigned char* d; int K, N;
  cvt_locate(cx, u, lane, s, d, K, N);
  st.r0 = __builtin_nontemporal_load((const f32x4*)(s));
  st.r1 = __builtin_nontemporal_load((const f32x4*)(s + (size_t)N));
  st.r2 = __builtin_nontemporal_load((const f32x4*)(s + (size_t)2 * N));
  st.r3 = __builtin_nontemporal_load((const f32x4*)(s + (size_t)3 * N));
  st.r4 = __builtin_nontemporal_load((const f32x4*)(s + (size_t)4 * N));
  st.r5 = __builtin_nontemporal_load((const f32x4*)(s + (size_t)5 * N));
  st.r6 = __builtin_nontemporal_load((const f32x4*)(s + (size_t)6 * N));
  st.r7 = __builtin_nontemporal_load((const f32x4*)(s + (size_t)7 * N));
  st.pend = u;
}

constexpr int UST = 2056;
constexpr int HY_U_BYTES = 16 * UST * 2;
constexpr int TCOPY = 2064;
constexpr int HY_T_BYTES = 4 * TCOPY * 4;
constexpr int HY_LDS = HY_U_BYTES + HY_T_BYTES;
constexpr int USTC = 264;
constexpr int TCOPYC = 264;

__device__ __forceinline__ f32x4 mfma16(bf16x8 a, bf16x8 b, f32x4 c) {
  return __builtin_amdgcn_mfma_f32_16x16x32_bf16(a, b, c, 0, 0, 0);
}
__device__ __forceinline__ float bflo(unsigned v) { return __uint_as_float(v << 16); }
__device__ __forceinline__ float bfhi(unsigned v) { return __uint_as_float(v & 0xffff0000u); }
__device__ __forceinline__ float ldbf(const bf16* p) { return bf2f(*p); }

template <int GSTR, int TCP>
__device__ __forceinline__ void hy_load_tables(const bf16* __restrict__ G, int c, unsigned* T) {
  constexpr int NCH = GSTR / 8;
  for (int q = tid_opaque(); q < 2 * NCH; q += 512) {
    int o = q / NCH, ch = q - o * NCH;
    const unsigned* s32 = (const unsigned*)(G + ((size_t)(o * 512 + c)) * GSTR);
    u32x4 a = *(const u32x4*)(s32 + 4 * ch);
    unsigned nx = (ch + 1 < NCH) ? s32[4 * ch + 4] : 0u;
    unsigned* d0 = T + o * 2 * TCP;
    unsigned* d1 = d0 + TCP;
    *(u32x4*)(d0 + 4 * ch) = a;
    u32x4 b;
    b.x = (a.x >> 16) | (a.y << 16); b.y = (a.y >> 16) | (a.z << 16); b.z = (a.z >> 16) | (a.w << 16); b.w = (a.w >> 16) | (nx << 16);
    *(u32x4*)(d1 + 4 * ch) = b;
  }
}

template <int L, int USTR>
__device__ __forceinline__ void hy_load_u(const bf16* __restrict__ z, float w0, float w1, float w2, float bb, bf16* U) {
  constexpr int CPB = L / 8;
  for (int q = tid_opaque(); q < 16 * CPB; q += 512) {
    int b = q / CPB, t8 = (q - b * CPB) * 8;
    const bf16* zr = z + (size_t)b * L + t8;
    u32x4 v = *(const u32x4*)zr;
    float zm = t8 > 0 ? ldbf(zr - 1) : 0.f;
    float zp = t8 + 8 < L ? ldbf(zr + 8) : 0.f;
    float e0 = bflo(v.x), e1 = bfhi(v.x), e2 = bflo(v.y), e3 = bfhi(v.y), e4 = bflo(v.z), e5 = bfhi(v.z), e6 = bflo(v.w), e7 = bfhi(v.w);
    u32x4 o;
    o.x = pack_bf16(w0 * zm + w1 * e0 + w2 * e1 + bb, w0 * e0 + w1 * e1 + w2 * e2 + bb);
    o.y = pack_bf16(w0 * e1 + w1 * e2 + w2 * e3 + bb, w0 * e2 + w1 * e3 + w2 * e4 + bb);
    o.z = pack_bf16(w0 * e3 + w1 * e4 + w2 * e5 + bb, w0 * e4 + w1 * e5 + w2 * e6 + bb);
    o.w = pack_bf16(w0 * e5 + w1 * e6 + w2 * e7 + bb, w0 * e6 + w1 * e7 + w2 * zp + bb);
    *(u32x4*)(U + b * USTR + t8) = o;
  }
}

template <int L>
__device__ __forceinline__ void hy_gate4(const bf16* __restrict__ zr, int t0, float w0, float w1, float w2, float bb, float (&x)[4]) {
  u32x2 v = *(const u32x2*)(zr + t0);
  float zm = t0 > 0 ? ldbf(zr + t0 - 1) : 0.f;
  float zp = t0 + 4 < L ? ldbf(zr + t0 + 4) : 0.f;
  float e0 = bflo(v.x), e1 = bfhi(v.x), e2 = bflo(v.y), e3 = bfhi(v.y);
  x[0] = w0 * zm + w1 * e0 + w2 * e1 + bb;
  x[1] = w0 * e0 + w1 * e1 + w2 * e2 + bb;
  x[2] = w0 * e1 + w1 * e2 + w2 * e3 + bb;
  x[3] = w0 * e2 + w1 * e3 + w2 * zp + bb;
}

__device__ __forceinline__ bf16x8 hy_frag(const unsigned* p) {
  u32x4 v; v.x = p[0]; v.y = p[1]; v.z = p[2]; v.w = p[3];
  return __builtin_bit_cast(bf16x8, v);
}

__device__ __forceinline__ void hyena_latent(int c, const bf16* __restrict__ zt, const float* __restrict__ cw,
                                             const float* __restrict__ cb, const bf16* __restrict__ G,
                                             bf16* __restrict__ yt, char* smem, const CvtCtx& cx) {
  const int tid = tid_opaque(), lane = tid & 63, wave = tid >> 6;
  bf16* U = (bf16*)smem;
  unsigned* T = (unsigned*)(smem + HY_U_BYTES);
  __syncthreads();
  hy_load_tables<GSTR_L, TCOPY>(G, c, T);
  hy_load_u<SEQ, UST>(zt + (size_t)c * NT, cw[c], cw[HYCOLS + c], cw[2 * HYCOLS + c], cb[c], U);
  __syncthreads();
  const int r = lane & 15, kg = lane >> 4;
  const int par = (r + 1) & 1;
  const int base_dw = 1023 - (r >> 1) + 4 * kg - 128 * wave;
  const char* ub = smem + (r * UST + 8 * kg) * 2;
  const int tw = wave * 256;
#pragma unroll 1
  for (int order = 0; order < 2; ++order) {
    const unsigned* tb = T + order * 2 * TCOPY + par * TCOPY + base_dw;
    f32x4 acc[16];
#pragma unroll
    for (int i = 0; i < 16; ++i) acc[i] = (f32x4){0.f, 0.f, 0.f, 0.f};
    bf16x8 W[16];
#pragma unroll
    for (int f = -15; f <= 0; ++f) W[f & 15] = hy_frag(tb + 8 * f);
    CvtRegs cr; cvt_init(cr);
    const int wv = __builtin_amdgcn_readfirstlane(wave);
#pragma unroll 1
    for (int J = 0; J < 8; ++J) {
      const unsigned* tj = tb + 128 * J;
      const char* uj = ub + 512 * J;
#pragma unroll
      for (int jj = 0; jj < 8; ++jj) {
        if (jj == 0 && (J == 0 || J == 3 || J == 6)) cvt_step(cx, cr, lane, CVT_GLA_TILES + ((c * 2 + order) * 3 + J / 3) * 8 + wv);
        bf16x8 uf = *(const bf16x8*)(uj + 64 * jj);
        acc[15] = mfma16(W[(2 * jj - 15) & 15], uf, acc[15]);
        acc[14] = mfma16(W[(2 * jj - 14) & 15], uf, acc[14]);
        if (J * 8 + jj < 63) {
          W[(2 * jj + 1) & 15] = hy_frag(tj + 8 * (2 * jj + 1));
          W[(2 * jj + 2) & 15] = hy_frag(tj + 8 * (2 * jj + 2));
        }
#pragma unroll
        for (int i = 13; i >= 0; --i) acc[i] = mfma16(W[(2 * jj - i) & 15], uf, acc[i]);
      }
    }
    cvt_finish(cx, cr, lane);
    __syncthreads();
    {
      const int col = (order + 1) * 512 + c;
      const float w0 = cw[col], w1 = cw[HYCOLS + col], w2 = cw[2 * HYCOLS + col], bb = cb[col];
      const bf16* zr = zt + (size_t)col * NT + (size_t)r * SEQ;
      u32x2 gv[16]; unsigned gm[16], gp[16];
#pragma unroll
      for (int i = 0; i < 16; ++i) {
        const int t0 = tw + 16 * i + 4 * kg;
        gv[i] = *(const u32x2*)(zr + t0);
        gm[i] = t0 > 0 ? (unsigned)*(const unsigned short*)(zr + t0 - 1) : 0u;
        gp[i] = t0 + 4 < SEQ ? (unsigned)*(const unsigned short*)(zr + t0 + 4) : 0u;
      }
#pragma unroll
      for (int i = 0; i < 16; ++i) {
        const int t0 = tw + 16 * i + 4 * kg;
        const float zm = __uint_as_float(gm[i] << 16), zp = __uint_as_float(gp[i] << 16);
        const float e0 = bflo(gv[i].x), e1 = bfhi(gv[i].x), e2 = bflo(gv[i].y), e3 = bfhi(gv[i].y);
        const float x0 = w0 * zm + w1 * e0 + w2 * e1 + bb, x1 = w0 * e0 + w1 * e1 + w2 * e2 + bb;
        const float x2 = w0 * e1 + w1 * e2 + w2 * e3 + bb, x3 = w0 * e2 + w1 * e3 + w2 * zp + bb;
        u32x2 o;
        o.x = pack_bf16(x0 * acc[i][0], x1 * acc[i][1]);
        o.y = pack_bf16(x2 * acc[i][2], x3 * acc[i][3]);
        *(u32x2*)(U + r * UST + t0) = o;
      }
    }
    __syncthreads();
  }
  for (int q = tid; q < 16 * 256; q += 512) {
    int b = q >> 8, t8 = (q & 255) * 8;
    *(u32x4*)(yt + (size_t)c * NT + (size_t)b * SEQ + t8) = *(const u32x4*)(U + b * UST + t8);
  }
}

__device__ __forceinline__ void hyena_ctx(int c, const bf16* __restrict__ zt, const float* __restrict__ cw,
                                          const float* __restrict__ cb, const bf16* __restrict__ G,
                                          bf16* __restrict__ yt, char* smem) {
  const int tid = tid_opaque(), lane = tid & 63, wave = tid >> 6;
  bf16* U = (bf16*)smem;
  unsigned* T = (unsigned*)(smem + HY_U_BYTES);
  __syncthreads();
  hy_load_tables<GSTR_C, TCOPYC>(G, c, T);
  hy_load_u<LC, USTC>(zt + (size_t)c * NT, cw[c], cw[HYCOLS + c], cw[2 * HYCOLS + c], cb[c], U);
  __syncthreads();
  const int r = lane & 15, kg = lane >> 4;
  const int par = (r + 1) & 1;
  const int base_dw = (8 * kg - r + 255 - par) >> 1;
  const char* ub = smem + (r * USTC + 8 * kg) * 2;
#pragma unroll 1
  for (int order = 0; order < 2; ++order) {
    const unsigned* tb = T + order * 2 * TCOPYC + par * TCOPYC + base_dw;
    f32x4 acc[2];
    acc[0] = (f32x4){0.f, 0.f, 0.f, 0.f};
    acc[1] = acc[0];
#pragma unroll
    for (int j = 0; j < 8; ++j) {
      bf16x8 uf = *(const bf16x8*)(ub + 64 * j);
#pragma unroll
      for (int ii = 0; ii < 2; ++ii) {
        const int i = wave * 2 + ii;
        acc[ii] = mfma16(hy_frag(tb + 16 * j - 8 * i), uf, acc[ii]);
      }
    }
    __syncthreads();
    {
      const int col = (order + 1) * 512 + c;
      const float w0 = cw[col], w1 = cw[HYCOLS + col], w2 = cw[2 * HYCOLS + col], bb = cb[col];
      const bf16* zr = zt + (size_t)col * NT + (size_t)r * LC;
#pragma unroll
      for (int ii = 0; ii < 2; ++ii) {
        const int t0 = (wave * 2 + ii) * 16 + 4 * kg;
        float x[4];
        hy_gate4<LC>(zr, t0, w0, w1, w2, bb, x);
        u32x2 o;
        o.x = pack_bf16(x[0] * acc[ii][0], x[1] * acc[ii][1]);
        o.y = pack_bf16(x[2] * acc[ii][2], x[3] * acc[ii][3]);
        *(u32x2*)(U + r * USTC + t0) = o;
      }
    }
    __syncthreads();
  }
  {
    int b = tid >> 5, t8 = (tid & 31) * 8;
    *(u32x4*)(yt + (size_t)c * NT + (size_t)b * LC + t8) = *(const u32x4*)(U + b * USTC + t8);
  }
}

constexpr int GL_QE = 0, GL_KE = 8192, GL_KST = 16384, GL_ATT = 24576, GL_ST = 32768, GL_VT = 49152  ;
constexpr int GL_RAW = 81920  , GL_RAWSZ = 18432, GL_SEG = 118784, GL_DEC = 120832;
constexpr int GLA_LDS = 121088;

__device__ __forceinline__ f32x16 mfma32(bf16x8 a, bf16x8 b, f32x16 c) {
  return __builtin_amdgcn_mfma_f32_32x32x16_bf16(a, b, c, 0, 0, 0);
}
__device__ __forceinline__ unsigned short bf16bits(float v) { bf16 h = f2bf(v); return *(unsigned short*)&h; }

struct GlaArgs {
  const bf16* zg; const float* wa2; const float* ba2; bf16* of; bf16* ob; int emit_ctx; int pad_;
};

__device__ __forceinline__ void gla_unit(int unit, const GlaArgs& a, char* smem, const CvtCtx& cx) {
  const int tid = tid_opaque(), lane = tid & 63, wave = tid >> 6;
  const int dir = unit & 1, h = (unit >> 1) & 3, b = unit >> 3;
  const int lr = lane & 31, lh = lane >> 5;
  const int swl = (lr >> 1) & 7;
  bf16* outp = dir ? a.ob : a.of;
  __syncthreads();
  const int d = tid & 63, sg = tid >> 6;
  float wa[16];
#pragma unroll
  for (int r = 0; r < 16; ++r) wa[r] = a.wa2[(dir * 16 + r) * 256 + h * 64 + d];
  const float ba = a.ba2[dir * 256 + h * 64 + d];
  { unsigned zz = 0u; asm volatile("" : "+v"(zz));
    for (int q = tid; q < 16384 / 16; q += 512) *(u32x4*)(smem + GL_ST + q * 16) = (u32x4){zz, zz, zz, zz}; }
  f32x16 S;
#pragma unroll
  for (int r = 0; r < 16; ++r) S[r] = 0.f;

  const int qi = tid >> 3, qc = tid & 7;
  const int ai = (tid >> 1) & 63, ac = tid & 1;
  const int vsg = (tid >> 5) & 7, vdq = tid & 31;
  u32x4 pq, pk, pa;
  u32x2 pw0, pw1, pw2, pw3, pw4, pw5, pw6, pw7;

#define GLA_ROW(N_, I_, ROW_)                                                        \
  {                                                                                  \
    const int n_ = (N_);                                                             \
    const int Ls_ = n_ < 4 ? LC : SEQ;                                               \
    const int cn_ = n_ < 4 ? n_ : n_ - 4;                                            \
    const int rb_ = n_ < 4 ? (NL + b * LC) : (b * SEQ);                              \
    const int pos_ = cn_ * 64 + (I_);                                                \
    ROW_ = rb_ + (dir ? (Ls_ - 1 - pos_) : pos_);                                    \
  }
#define GLA_LOAD_RAW(N_)                                                             \
  {                                                                                  \
    int row_;                                                                        \
    GLA_ROW(N_, qi, row_);                                                           \
    const bf16* zr_ = a.zg + (size_t)row_ * GLACOLS;                                 \
    pq = *(const u32x4*)(zr_ + h * 64 + qc * 8);                                     \
    pk = *(const u32x4*)(zr_ + 256 + h * 64 + qc * 8);                               \
    int ra_;                                                                         \
    GLA_ROW(N_, ai, ra_);                                                            \
    pa = *(const u32x4*)(a.zg + (size_t)ra_ * GLACOLS + 1536 + dir * 16 + ac * 8);   \
  }
#define GLA_LOAD_V(N_)                                                               \
  {                                                                                  \
    int rv_;                                                                         \
    GLA_ROW(N_, vsg * 8 + 0, rv_); pw0 = *(const u32x2*)(a.zg + (size_t)rv_ * GLACOLS + 512 + h * 128 + vdq * 4); \
    GLA_ROW(N_, vsg * 8 + 1, rv_); pw1 = *(const u32x2*)(a.zg + (size_t)rv_ * GLACOLS + 512 + h * 128 + vdq * 4); \
    GLA_ROW(N_, vsg * 8 + 2, rv_); pw2 = *(const u32x2*)(a.zg + (size_t)rv_ * GLACOLS + 512 + h * 128 + vdq * 4); \
    GLA_ROW(N_, vsg * 8 + 3, rv_); pw3 = *(const u32x2*)(a.zg + (size_t)rv_ * GLACOLS + 512 + h * 128 + vdq * 4); \
    GLA_ROW(N_, vsg * 8 + 4, rv_); pw4 = *(const u32x2*)(a.zg + (size_t)rv_ * GLACOLS + 512 + h * 128 + vdq * 4); \
    GLA_ROW(N_, vsg * 8 + 5, rv_); pw5 = *(const u32x2*)(a.zg + (size_t)rv_ * GLACOLS + 512 + h * 128 + vdq * 4); \
    GLA_ROW(N_, vsg * 8 + 6, rv_); pw6 = *(const u32x2*)(a.zg + (size_t)rv_ * GLACOLS + 512 + h * 128 + vdq * 4); \
    GLA_ROW(N_, vsg * 8 + 7, rv_); pw7 = *(const u32x2*)(a.zg + (size_t)rv_ * GLACOLS + 512 + h * 128 + vdq * 4); \
  }
#define GLA_STORE_RAW(RB_)                                                           \
  {                                                                                  \
    char* rw_ = smem + GL_RAW + (RB_) * GL_RAWSZ;                                    \
    *(u32x4*)(rw_ + qi * 128 + qc * 16) = pq;                                        \
    *(u32x4*)(rw_ + 8192 + qi * 128 + qc * 16) = pk;                                 \
    if (tid < 128) *(u32x4*)(rw_ + 16384 + ai * 32 + ac * 16) = pa;                  \
  }
#define GLA_STORE_V(VB_)                                                             \
  if (tid < 256) {                                                                   \
    char* vt_ = smem + GL_VT + (VB_) * 16384;                                        \
    u32x4 o;                                                                         \
    o.x = (pw0.x & 0xffffu) | (pw1.x << 16); o.y = (pw2.x & 0xffffu) | (pw3.x << 16); o.z = (pw4.x & 0xffffu) | (pw5.x << 16); o.w = (pw6.x & 0xffffu) | (pw7.x << 16); \
    *(u32x4*)(vt_ + swz(vdq * 4 + 0, vsg)) = o;                                      \
    o.x = (pw0.x >> 16) | (pw1.x & 0xffff0000u); o.y = (pw2.x >> 16) | (pw3.x & 0xffff0000u); o.z = (pw4.x >> 16) | (pw5.x & 0xffff0000u); o.w = (pw6.x >> 16) | (pw7.x & 0xffff0000u); \
    *(u32x4*)(vt_ + swz(vdq * 4 + 1, vsg)) = o;                                      \
    o.x = (pw0.y & 0xffffu) | (pw1.y << 16); o.y = (pw2.y & 0xffffu) | (pw3.y << 16); o.z = (pw4.y & 0xffffu) | (pw5.y << 16); o.w = (pw6.y & 0xffffu) | (pw7.y << 16); \
    *(u32x4*)(vt_ + swz(vdq * 4 + 2, vsg)) = o;                                      \
    o.x = (pw0.y >> 16) | (pw1.y & 0xffff0000u); o.y = (pw2.y >> 16) | (pw3.y & 0xffff0000u); o.z = (pw4.y >> 16) | (pw5.y & 0xffff0000u); o.w = (pw6.y >> 16) | (pw7.y & 0xffff0000u); \
    *(u32x4*)(vt_ + swz(vdq * 4 + 3, vsg)) = o;                                      \
  }
#define GLA_STEP3(RB_)                                                               \
  {                                                                                  \
    const char* ra_ = smem + GL_RAW + (RB_) * GL_RAWSZ + 16384;                      \
    float run = 0.f;                                                                 \
    _Pragma("unroll") for (int ii = 0; ii < 8; ++ii) {                               \
      const int i = sg * 8 + ii;                                                     \
      const u32x4 a0 = *(const u32x4*)(ra_ + i * 32);                                \
      const u32x4 a1 = *(const u32x4*)(ra_ + i * 32 + 16);                           \
      float g = ba;                                                                  \
      g += bflo(a0.x) * wa[0] + bfhi(a0.x) * wa[1] + bflo(a0.y) * wa[2] + bfhi(a0.y) * wa[3]; \
      g += bflo(a0.z) * wa[4] + bfhi(a0.z) * wa[5] + bflo(a0.w) * wa[6] + bfhi(a0.w) * wa[7]; \
      g += bflo(a1.x) * wa[8] + bfhi(a1.x) * wa[9] + bflo(a1.y) * wa[10] + bfhi(a1.y) * wa[11]; \
      g += bflo(a1.z) * wa[12] + bfhi(a1.z) * wa[13] + bflo(a1.w) * wa[14] + bfhi(a1.w) * wa[15]; \
      run += logsigmoid_f(g) * (1.0f / 16.0f);                                       \
      bl[ii] = run;                                                                  \
    }                                                                                \
    *(float*)(smem + GL_SEG + (sg * 64 + d) * 4) = run;                              \
  }
#define GLA_STEP5(RB_)                                                               \
  {                                                                                  \
    const char* rq_ = smem + GL_RAW + (RB_) * GL_RAWSZ;                              \
    float off = 0.f, tot = 0.f;                                                      \
    _Pragma("unroll") for (int s = 0; s < 8; ++s) {                                  \
      float v = *(const float*)(smem + GL_SEG + (s * 64 + d) * 4);                  \
      off += (s < sg) ? v : 0.f;                                                     \
      tot += v;                                                                      \
    }                                                                                \
    float ks[8];                                                                     \
    _Pragma("unroll") for (int ii = 0; ii < 8; ++ii) {                               \
      const int i = sg * 8 + ii;                                                     \
      const float bb = off + bl[ii];                                                 \
      const float qv = bf2f(*(const bf16*)(rq_ + i * 128 + d * 2));                 \
      const float kv = bf2f(*(const bf16*)(rq_ + 8192 + i * 128 + d * 2));          \
      const int eo = swz(i, d >> 3) + (d & 7) * 2;                                   \
      *(unsigned short*)(smem + GL_QE + eo) = bf16bits(qv * 0.125f * __expf(bb));    \
      *(unsigned short*)(smem + GL_KE + eo) = bf16bits(kv * __expf(-bb));            \
      ks[ii] = kv * __expf(tot - bb);                                                \
    }                                                                                \
    u32x4 o;                                                                         \
    o.x = pack_bf16(ks[0], ks[1]); o.y = pack_bf16(ks[2], ks[3]); o.z = pack_bf16(ks[4], ks[5]); o.w = pack_bf16(ks[6], ks[7]); \
    *(u32x4*)(smem + GL_KST + swz(d, sg)) = o;                                       \
    if (sg == 0) *(float*)(smem + GL_DEC + d * 4) = __expf(tot);                     \
  }

  const int tm = wave >> 2, tn = wave & 3;
  float bl[8];
  f32x16 oprev;
#pragma unroll
  for (int r = 0; r < 16; ++r) oprev[r] = 0.f;

#define GLA_STORE_OUT(N_)                                                                  \
  {                                                                                        \
    _Pragma("unroll") for (int r = 0; r < 16; ++r) {                                       \
      int row;                                                                             \
      GLA_ROW(N_, tm * 32 + rowmap(r, lh), row);                                           \
      *(unsigned short*)(outp + (size_t)row * 512 + h * 128 + tn * 32 + lr) = bf16bits(oprev[r]); \
    }                                                                                      \
  }
  GLA_LOAD_RAW(0); GLA_LOAD_V(0);
  GLA_STORE_RAW(0); GLA_STORE_V(0);
  GLA_LOAD_RAW(1);
  GLA_STORE_RAW(1);
  __syncthreads();
  GLA_STEP3(0);
  __syncthreads();
  GLA_STEP5(0);
  GLA_LOAD_RAW(2); GLA_LOAD_V(1);
  __syncthreads();
  CvtRegs cr; cvt_init(cr);
  const int cvt_u0 = __builtin_amdgcn_readfirstlane(unit * 36 * 16 + wave);
#pragma unroll 1
  for (int n = 0; n < 36; ++n) {
    const int vb = n & 1;
    const bool has1 = n + 1 < 36;
    cvt_step(cx, cr, lane, cvt_u0 + n * 16);
    f32x16 oacc;
#pragma unroll
    for (int r = 0; r < 16; ++r) oacc[r] = 0.f;
#pragma unroll
    for (int r = 0; r < 16; ++r) S[r] *= *(const float*)(smem + GL_DEC + (tm * 32 + rowmap(r, lh)) * 4);
#pragma unroll
    for (int ks4 = 0; ks4 < 4; ++ks4) {
      const int c = ((2 * ks4 + lh) ^ swl) << 4;
      const bf16x8 fq = *(const bf16x8*)(smem + GL_QE + (tm * 32 + lr) * 128 + c);
      const bf16x8 fs = *(const bf16x8*)(smem + GL_ST + (tn * 32 + lr) * 128 + c);
      oacc = mfma32(fq, fs, oacc);
      const bf16x8 fk = *(const bf16x8*)(smem + GL_KST + (tm * 32 + lr) * 128 + c);
      const bf16x8 fv = *(const bf16x8*)(smem + GL_VT + vb * 16384 + (tn * 32 + lr) * 128 + c);
      S = mfma32(fk, fv, S);
    }
    if (wave < 4) {
      const int am = wave >> 1, an = wave & 1;
      f32x16 att;
#pragma unroll
      for (int r = 0; r < 16; ++r) att[r] = 0.f;
#pragma unroll
      for (int ks4 = 0; ks4 < 4; ++ks4) {
        const int c = ((2 * ks4 + lh) ^ swl) << 4;
        const bf16x8 fq = *(const bf16x8*)(smem + GL_QE + (am * 32 + lr) * 128 + c);
        const bf16x8 fk = *(const bf16x8*)(smem + GL_KE + (an * 32 + lr) * 128 + c);
        att = mfma32(fq, fk, att);
      }
      const int s = an * 32 + lr;
#pragma unroll
      for (int r = 0; r < 16; ++r) {
        const int t = am * 32 + rowmap(r, lh);
        const float v = (s <= t) ? att[r] : 0.f;
        *(unsigned short*)(smem + GL_ATT + swz(t, s >> 3) + (s & 7) * 2) = bf16bits(v);
      }
    }
    if (has1) GLA_STEP3((n + 1) & 1);
    __syncthreads();
    cvt_step(cx, cr, lane, cvt_u0 + n * 16 + 8);
#pragma unroll
    for (int ks4 = 0; ks4 < 4; ++ks4) {
      const int c = ((2 * ks4 + lh) ^ swl) << 4;
      const bf16x8 fa = *(const bf16x8*)(smem + GL_ATT + (tm * 32 + lr) * 128 + c);
      const bf16x8 fv = *(const bf16x8*)(smem + GL_VT + vb * 16384 + (tn * 32 + lr) * 128 + c);
      oacc = mfma32(fa, fv, oacc);
    }
#pragma unroll
    for (int g = 0; g < 4; ++g) {
      u32x2 o;
      o.x = pack_bf16(S[4 * g + 0], S[4 * g + 1]);
      o.y = pack_bf16(S[4 * g + 2], S[4 * g + 3]);
      *(u32x2*)(smem + GL_ST + swz(tn * 32 + lr, tm * 4 + g) + 8 * lh) = o;
    }
    if (has1) {
      GLA_STEP5((n + 1) & 1);
      GLA_STORE_V((n + 1) & 1);
      if (n + 2 < 36) GLA_STORE_RAW(n & 1);
    }
    if (n > 0 && (n - 1 >= 4 || a.emit_ctx)) { GLA_STORE_OUT(n - 1); }
    { const int nr = n + 3 < 36 ? n + 3 : 35; GLA_LOAD_RAW(nr); const int nv = n + 2 < 36 ? n + 2 : 35; GLA_LOAD_V(nv); }
    oprev = oacc;
    __syncthreads();
  }
  cvt_finish(cx, cr, lane);
  { GLA_STORE_OUT(35); }
#undef GLA_STORE_OUT
#undef GLA_ROW
#undef GLA_LOAD_RAW
#undef GLA_LOAD_V
#undef GLA_STORE_RAW
#undef GLA_STORE_V
#undef GLA_STEP3
#undef GLA_STEP5
}


constexpr int CTRL_Q = 0;
constexpr int CTRL_CNT = 128;
constexpr int CTRL_CUR = 640;
constexpr int CTRL_XR = 1152;
constexpr int CTRL_WORDS = 1152 + 256;
constexpr size_t al256(size_t v) { return (v + 255) / 256 * 256; }
namespace wso {
constexpr size_t bar = 0;
constexpr size_t ctrl = al256(bar + (size_t)XCD_BAR_WORDS * 4);
constexpr size_t zero_end = al256(ctrl + (size_t)CTRL_WORDS * 4);
constexpr size_t xs = al256(ctrl + (size_t)CTRL_WORDS * 4);
constexpr size_t mod = al256(xs + (size_t)NT * D * 4);
constexpr size_t abuf = al256(mod + (size_t)DEPTH * 17 * 6 * D * 4);
constexpr size_t zt = al256(abuf + (size_t)NT * D * 2);
constexpr size_t zg = al256(zt + (size_t)HYCOLS * NT * 2);
constexpr size_t yt = al256(zg + (size_t)NT * GLACOLS * 2);
constexpr size_t of = al256(yt + (size_t)HYW * NT * 2);
constexpr size_t ob = al256(of + (size_t)NT * 512 * 4);
constexpr size_t ymix = al256(ob + (size_t)NT * 512 * 4);
constexpr size_t region_end_raw = al256(ymix + (size_t)NT * D * 2);
constexpr size_t region_end = (region_end_raw > zt + al256((size_t)NSLOT * D * 2)) ? region_end_raw : zt + al256((size_t)NSLOT * D * 2);
constexpr size_t hid = region_end;
constexpr size_t gl = al256(hid + (size_t)DEPTH * 2 * SEQ * 64 * 4);
constexpr size_t gc = al256(gl + (size_t)DEPTH * 2 * HYW * GSTR_L * 2);
constexpr size_t logits = al256(gc + (size_t)2 * HYW * GSTR_C * 2);
constexpr size_t tok_e = al256(logits + (size_t)NT * NE * 4);
constexpr size_t tok_gate = al256(tok_e + (size_t)NT * TOPK * 4);
constexpr size_t tok_slot = al256(tok_gate + (size_t)NT * TOPK * 4);
constexpr size_t pad_start = al256(tok_slot + (size_t)NT * TOPK * 4);
constexpr size_t slot_tok = al256(pad_start + (size_t)(NE + 2) * 4);
constexpr size_t blkcnt = al256(slot_tok + (size_t)NSLOT * 4);
constexpr size_t hbuf = al256(blkcnt + (size_t)512 * NE * 4);
constexpr size_t hs = al256(hbuf + (size_t)NSLOT * DE);
constexpr size_t w_in_t = al256(hs + (size_t)NT * DE);
constexpr size_t w_out_t = al256(w_in_t + (size_t)DEPTH * WIN_ROWS * D * 2);
constexpr size_t router_t = al256(w_out_t + (size_t)DEPTH * D * D * 2);
constexpr size_t sh1_t = al256(router_t + (size_t)DEPTH * NE * D * 2);
constexpr size_t sh3_t = al256(sh1_t + (size_t)DEPTH * DE * D);
constexpr size_t sh2_t = al256(sh3_t + (size_t)DEPTH * DE * D);
constexpr size_t e1_t = al256(sh2_t + (size_t)DEPTH * D * DE);
constexpr size_t e3_t = al256(e1_t + (size_t)NE * DE * D);
constexpr size_t e2_t = al256(e3_t + (size_t)NE * DE * D);
constexpr size_t abuf8 = al256(e2_t + (size_t)NE * D * DE);
constexpr size_t w_g8 = al256(abuf8 + (size_t)NT * D);
constexpr size_t total = al256(w_g8 + (size_t)DEPTH * GW_ROWS * D);
constexpr size_t ybuf = zt;
}
struct WS {
  char* b;
  __device__ __forceinline__ unsigned* bar() const { char* q = b; asm volatile("" : "+s"(q)); return (unsigned*)(q + wso::bar); }
  __device__ __forceinline__ int* ctrl() const { char* q = b; asm volatile("" : "+s"(q)); return (int*)(q + wso::ctrl); }
  __device__ __forceinline__ bf16* xs() const { char* q = b; asm volatile("" : "+s"(q)); return (bf16*)(q + wso::xs); }
  __device__ __forceinline__ float* mod() const { char* q = b; asm volatile("" : "+s"(q)); return (float*)(q + wso::mod); }
  __device__ __forceinline__ bf16* abuf() const { char* q = b; asm volatile("" : "+s"(q)); return (bf16*)(q + wso::abuf); }
  __device__ __forceinline__ bf16* zt() const { char* q = b; asm volatile("" : "+s"(q)); return (bf16*)(q + wso::zt); }
  __device__ __forceinline__ bf16* zg() const { char* q = b; asm volatile("" : "+s"(q)); return (bf16*)(q + wso::zg); }
  __device__ __forceinline__ bf16* yt() const { char* q = b; asm volatile("" : "+s"(q)); return (bf16*)(q + wso::yt); }
  __device__ __forceinline__ bf16* of() const { char* q = b; asm volatile("" : "+s"(q)); return (bf16*)(q + wso::of); }
  __device__ __forceinline__ bf16* ob() const { char* q = b; asm volatile("" : "+s"(q)); return (bf16*)(q + wso::ob); }
  __device__ __forceinline__ bf16* ymix() const { char* q = b; asm volatile("" : "+s"(q)); return (bf16*)(q + wso::ymix); }
  __device__ __forceinline__ float* hid() const { char* q = b; asm volatile("" : "+s"(q)); return (float*)(q + wso::hid); }
  __device__ __forceinline__ bf16* gl() const { char* q = b; asm volatile("" : "+s"(q)); return (bf16*)(q + wso::gl); }
  __device__ __forceinline__ bf16* gc() const { char* q = b; asm volatile("" : "+s"(q)); return (bf16*)(q + wso::gc); }
  __device__ __forceinline__ float* logits() const { char* q = b; asm volatile("" : "+s"(q)); return (float*)(q + wso::logits); }
  __device__ __forceinline__ int* tok_e() const { char* q = b; asm volatile("" : "+s"(q)); return (int*)(q + wso::tok_e); }
  __device__ __forceinline__ float* tok_gate() const { char* q = b; asm volatile("" : "+s"(q)); return (float*)(q + wso::tok_gate); }
  __device__ __forceinline__ int* tok_slot() const { char* q = b; asm volatile("" : "+s"(q)); return (int*)(q + wso::tok_slot); }
  __device__ __forceinline__ int* pad_start() const { char* q = b; asm volatile("" : "+s"(q)); return (int*)(q + wso::pad_start); }
  __device__ __forceinline__ int* slot_tok() const { char* q = b; asm volatile("" : "+s"(q)); return (int*)(q + wso::slot_tok); }
  __device__ __forceinline__ int* blkcnt() const { char* q = b; asm volatile("" : "+s"(q)); return (int*)(q + wso::blkcnt); }
  __device__ __forceinline__ unsigned char* hbuf() const { char* q = b; asm volatile("" : "+s"(q)); return (unsigned char*)(q + wso::hbuf); }
  __device__ __forceinline__ unsigned char* hs() const { char* q = b; asm volatile("" : "+s"(q)); return (unsigned char*)(q + wso::hs); }
  __device__ __forceinline__ bf16* w_in_t() const { char* q = b; asm volatile("" : "+s"(q)); return (bf16*)(q + wso::w_in_t); }
  __device__ __forceinline__ bf16* w_out_t() const { char* q = b; asm volatile("" : "+s"(q)); return (bf16*)(q + wso::w_out_t); }
  __device__ __forceinline__ bf16* router_t() const { char* q = b; asm volatile("" : "+s"(q)); return (bf16*)(q + wso::router_t); }
  __device__ __forceinline__ unsigned char* sh1_t() const { char* q = b; asm volatile("" : "+s"(q)); return (unsigned char*)(q + wso::sh1_t); }
  __device__ __forceinline__ unsigned char* sh3_t() const { char* q = b; asm volatile("" : "+s"(q)); return (unsigned char*)(q + wso::sh3_t); }
  __device__ __forceinline__ unsigned char* sh2_t() const { char* q = b; asm volatile("" : "+s"(q)); return (unsigned char*)(q + wso::sh2_t); }
  __device__ __forceinline__ unsigned char* e1_t() const { char* q = b; asm volatile("" : "+s"(q)); return (unsigned char*)(q + wso::e1_t); }
  __device__ __forceinline__ unsigned char* e3_t() const { char* q = b; asm volatile("" : "+s"(q)); return (unsigned char*)(q + wso::e3_t); }
  __device__ __forceinline__ unsigned char* e2_t() const { char* q = b; asm volatile("" : "+s"(q)); return (unsigned char*)(q + wso::e2_t); }
  __device__ __forceinline__ unsigned char* ybuf() const { char* q = b; asm volatile("" : "+s"(q)); return (unsigned char*)(q + wso::ybuf); }
  __device__ __forceinline__ unsigned char* abuf8() const { char* q = b; asm volatile("" : "+s"(q)); return (unsigned char*)(q + wso::abuf8); }
  __device__ __forceinline__ unsigned char* w_g8() const { char* q = b; asm volatile("" : "+s"(q)); return (unsigned char*)(q + wso::w_g8); }
};

constexpr int MEGA_LDS_MAIN = G8_LDS;
constexpr int LDS_TILE_E = MEGA_LDS_MAIN + 16;
constexpr int MEGA_LDS = MEGA_LDS_MAIN + 16 + 4096;

struct MP { Inputs in; WS w; float* out; };

__device__ __forceinline__ void row_load(const float* __restrict__ p, int lane, f32x4 (&v)[4]) {
#pragma unroll
  for (int j = 0; j < 4; ++j) v[j] = *(const f32x4*)(p + j * 256 + lane * 4);
}
__device__ __forceinline__ void row_load_xs(const bf16* __restrict__ p, int lane, f32x4 (&v)[4]) {
#pragma unroll
  for (int j = 0; j < 4; ++j) v[j] = xs_load4(p + j * 256 + lane * 4);
}
__device__ __forceinline__ float row_rinv(const f32x4 (&v)[4], int lane) {
  float ss = 0.f;
#pragma unroll
  for (int j = 0; j < 4; ++j) ss += v[j].x * v[j].x + v[j].y * v[j].y + v[j].z * v[j].z + v[j].w * v[j].w;
  ss = wave_sum(ss, lane);
  return rsqrtf(ss * (1.0f / D) + EPS);
}
__device__ __forceinline__ void row_norm_mod_store(const f32x4 (&v)[4], float rinv, const float* __restrict__ g,
                                                   const float* __restrict__ sh, const float* __restrict__ sc, int lane,
                                                   bf16* __restrict__ dst, unsigned char* __restrict__ dst8 = nullptr) {
#pragma unroll
  for (int j = 0; j < 4; ++j) {
    const int d = j * 256 + lane * 4;
    const f32x4 gv = *(const f32x4*)(g + d), shv = *(const f32x4*)(sh + d), scv = *(const f32x4*)(sc + d);
    const float y0 = v[j].x * rinv * gv.x * (1.f + scv.x) + shv.x, y1 = v[j].y * rinv * gv.y * (1.f + scv.y) + shv.y;
    const float y2 = v[j].z * rinv * gv.z * (1.f + scv.z) + shv.z, y3 = v[j].w * rinv * gv.w * (1.f + scv.w) + shv.w;
    u32x2 o;
    o.x = pack_bf16(y0, y1);
    o.y = pack_bf16(y2, y3);
    *(u32x2*)(dst + d) = o;
    if (dst8) *(unsigned*)(dst8 + d) = pk4_fp8(y0, y1, y2, y3);
  }
}

__device__ __forceinline__ void ph_mod_hid(const MP& p, char* smem, int bid, int nblk) {
  const int tid = tid_opaque(), lane = tid & 63, wave = tid >> 6;
  float* sc = (float*)smem;
  for (int u = bid; u < 192; u += nblk) {
    const int l = u / 96, col0 = (u - l * 96) * 64;
    __syncthreads();
    for (int i = tid; i < 17 * 1024; i += 512) {
      const int r = i >> 10, k = i & 1023;
      const float v = (r < 16) ? p.in.c[r * D + k] : p.in.c_ctx[k];
      sc[i] = silu_f(v);
    }
    __syncthreads();
    const int col = tid & 63, ks = tid >> 6;
    float acc[17];
#pragma unroll
    for (int r = 0; r < 17; ++r) acc[r] = 0.f;
    const float* wp = p.in.ada_w + ((size_t)l * D + ks * 128) * (6 * D) + col0 + col;
#pragma unroll 16
    for (int kk = 0; kk < 128; ++kk) {
      const float wv = wp[(size_t)kk * (6 * D)];
#pragma unroll
      for (int r = 0; r < 17; ++r) acc[r] += sc[r * 1024 + ks * 128 + kk] * wv;
    }
    __syncthreads();
#pragma unroll
    for (int r = 0; r < 17; ++r) sc[(ks * 17 + r) * 64 + col] = acc[r];
    __syncthreads();
    for (int i = tid; i < 17 * 64; i += 512) {
      const int r = i >> 6, cc = i & 63;
      float s = 0.f;
#pragma unroll
      for (int k8 = 0; k8 < 8; ++k8) s += sc[(k8 * 17 + r) * 64 + cc];
      p.w.mod()[((size_t)l * 17 + r) * (6 * D) + col0 + cc] = s + p.in.ada_b[l * 6 * D + col0 + cc];
    }
  }
  for (int it = bid; it * 8 < 4352; it += nblk) {
    const int rid = it * 8 + wave;
    int l, ty, t;
    if (rid < 2048) { l = 0; ty = 0; t = rid; }
    else if (rid < 2304) { l = 0; ty = 1; t = rid - 2048; }
    else { l = 1; ty = 0; t = rid - 2304; }
    const int L = ty ? LC : SEQ;
    const float* w1 = p.in.hy_f_w1 + l * 33 * 64; const float* b1 = p.in.hy_f_b1 + l * 64;
    const float* w2 = p.in.hy_f_w2 + l * 64 * 64; const float* b2 = p.in.hy_f_b2 + l * 64;
    float pv = 0.f;
    if (lane == 0) pv = (float)t / (float)(L - 1);
    else if (lane < 33) {
      const int bi = (lane - 1) & 15;
      const float wph = 2.0f * 3.14159265358979323846f * (float)t / (float)L;
      const float f = 1e-4f + (float)bi * ((15.0f - 1e-4f) / 15.0f);
      pv = (lane <= 16) ? cosf(f * wph) : -sinf(f * wph);
    }
    float a1 = b1[lane];
#pragma unroll
    for (int i = 0; i < 33; ++i) a1 += shl_f(pv, i) * w1[i * 64 + lane];
    const float h1 = sinf(a1);
    float a2 = b2[lane];
#pragma unroll 16
    for (int i = 0; i < 64; ++i) a2 += shl_f(h1, i) * w2[i * 64 + lane];
    p.w.hid()[((size_t)(l * 2 + ty) * SEQ + t) * 64 + lane] = sinf(a2);
  }
}

__device__ __forceinline__ void ph_gtab(const MP& p, char* smem, int bid, int nblk) {
  const int tid = tid_opaque();
  float* wl = (float*)smem;
  for (int u = bid; u < 544; u += nblk) {
    int l, ty, ib, cg;
    if (u < 512) { l = u >> 8; ty = 0; ib = (u >> 5) & 7; cg = u & 31; }
    else { l = 0; ty = 1; ib = 0; cg = u - 512; }
    const int L = ty ? LC : SEQ, gstr = ty ? GSTR_C : GSTR_L;
    const float* hid = p.w.hid() + (size_t)(l * 2 + ty) * SEQ * 64;
    const float* w3 = p.in.hy_f_w3 + (size_t)l * 64 * 2048;
    const float* skip = p.in.hy_skip + l * 2 * 512;
    bf16* G = ty ? p.w.gc() : (p.w.gl() + (size_t)l * 2 * HYW * GSTR_L);
    __syncthreads();
    for (int i = tid; i < 2 * 32 * 64; i += 512) {
      const int dir = i >> 11, cc = (i >> 6) & 31, j = i & 63;
      const int oc = cg * 32 + cc, o = oc >> 9, c = oc & 511;
      wl[i] = w3[(size_t)j * 2048 + o * 1024 + dir * 512 + c];
    }
    __syncthreads();
    const int i = ib * 512 + tid;
    const int dd = i - (L - 1);
    const int t = dd < 0 ? -dd : dd;
    const bool inr = i < 2 * L - 1;
    const int dir = dd > 0 ? 1 : 0;
    float hr[64];
    {
      const float* hp = hid + (size_t)(inr ? t : 0) * 64;
#pragma unroll
      for (int j = 0; j < 16; ++j) { const f32x4 v = *(const f32x4*)(hp + 4 * j); hr[4 * j] = v.x; hr[4 * j + 1] = v.y; hr[4 * j + 2] = v.z; hr[4 * j + 3] = v.w; }
    }
    const float tn = (float)t / (float)(L - 1);
#pragma unroll 1
    for (int cc = 0; cc < 32; ++cc) {
      const int oc = cg * 32 + cc, o = oc >> 9, c = oc & 511;
      const float* wc = wl + (dir * 32 + cc) * 64;
      float s = 0.f;
#pragma unroll
      for (int j = 0; j < 16; ++j) { const f32x4 wv = *(const f32x4*)(wc + 4 * j); s += hr[4 * j] * wv.x + hr[4 * j + 1] * wv.y + hr[4 * j + 2] * wv.z + hr[4 * j + 3] * wv.w; }
      if (dd == 0) {
        const float* wc1 = wl + (32 + cc) * 64;
        float s1 = 0.f;
#pragma unroll
        for (int j = 0; j < 16; ++j) { const f32x4 wv = *(const f32x4*)(wc1 + 4 * j); s1 += hr[4 * j] * wv.x + hr[4 * j + 1] * wv.y + hr[4 * j + 2] * wv.z + hr[4 * j + 3] * wv.w; }
        s += s1;
      }
      const float delta = HY_MIN_DECAY + (float)c * ((HY_MAX_DECAY - HY_MIN_DECAY) / 511.0f);
      float val = s * __expf(-tn * delta);
      if (dd == 0) val += skip[o * 512 + c];
      if (!inr) val = 0.f;
      G[(size_t)oc * gstr + i] = f2bf(val);
    }
  }
}

__device__ __forceinline__ void ph_init_norm1(const MP& p, int bid, int nblk) {
  const int lane = tid_opaque() & 63, wave = tid_opaque() >> 6;
  const float* g = p.in.norm1_g;
  for (int it = bid; it * 8 < SEQ; it += nblk) {
    const int t = it * 8 + wave;
    const float rr = (float)(t >> 6), colp = (float)(t & 63);
    f32x4 e[4];
#pragma unroll
    for (int j = 0; j < 4; ++j) {
      float ev[4];
#pragma unroll
      for (int q = 0; q < 4; ++q) {
        const int i = lane * 4 + q;
        const float omega = 1.0f / powf(10000.0f, (float)i / 256.0f);
        const float a = ((j < 2) ? rr : colp) * omega;
        ev[q] = (j & 1) ? cosf(a) : sinf(a);
      }
      e[j] = (f32x4){ev[0], ev[1], ev[2], ev[3]};
    }
    for (int b = 0; b < NB; ++b) {
      const int row = b * SEQ + t;
      f32x4 v[4];
      row_load(p.in.x + (size_t)row * D, lane, v);
#pragma unroll
      for (int j = 0; j < 4; ++j) { v[j] += e[j]; xs_store4(p.w.xs() + (size_t)row * D + j * 256 + lane * 4, v[j]); }
      const float rinv = row_rinv(v, lane);
      const float* mb = p.w.mod() + (size_t)b * 6 * D;
      row_norm_mod_store(v, rinv, g, mb, mb + D, lane, p.w.abuf() + (size_t)row * D, p.w.abuf8() + (size_t)row * D);
    }
  }
  for (int it = bid; it * 8 < NC; it += nblk) {
    const int rc = it * 8 + wave, row = NL + rc;
    f32x4 v[4];
    row_load(p.in.ctx + (size_t)rc * D, lane, v);
#pragma unroll
    for (int j = 0; j < 4; ++j) xs_store4(p.w.xs() + (size_t)row * D + j * 256 + lane * 4, v[j]);
    const float rinv = row_rinv(v, lane);
    const float* mb = p.w.mod() + (size_t)16 * 6 * D;
    row_norm_mod_store(v, rinv, g, mb, mb + D, lane, p.w.abuf() + (size_t)row * D, p.w.abuf8() + (size_t)row * D);
  }
}

__device__ __forceinline__ void ph_mixer(const MP& p, char* smem, int l, bool last, int bid, int nblk) {
  int* qctr = p.w.ctrl() + CTRL_Q + 64 * l;
  int* slot = (int*)(smem + MEGA_LDS_MAIN + 8);
  GlaArgs ga;
  ga.zg = p.w.zg(); ga.wa2 = p.in.gla_wa2 + (size_t)l * 2 * 16 * 256; ga.ba2 = p.in.gla_ba2 + (size_t)l * 2 * 256;
  ga.of = p.w.of(); ga.ob = p.w.ob(); ga.emit_ctx = last ? 0 : 1; ga.pad_ = 0;
  const float* cw = p.in.hy_conv_w + (size_t)l * 3 * HYCOLS;
  const float* cb = p.in.hy_conv_b + (size_t)l * HYCOLS;
  const bf16* gl = p.w.gl() + (size_t)l * 2 * HYW * GSTR_L;
  CvtCtx cx;
  cx.w1 = p.in.exp_w1 + (size_t)l * NE * D * DE; cx.w3 = p.in.exp_w3 + (size_t)l * NE * D * DE; cx.w2 = p.in.exp_w2 + (size_t)l * NE * DE * D;
  cx.d1 = p.w.e1_t(); cx.d3 = p.w.e3_t(); cx.d2 = p.w.e2_t();
  for (;;) {
    __syncthreads();
    if (tid_opaque() == 0) *slot = atomicAdd(qctr, 1);
    __syncthreads();
    const int u = *slot;
    const int nunits = last ? 640 : 1152;
    if (u >= nunits) break;
    if (u < 128) gla_unit(u, ga, smem, cx);
    else if (u < 640) hyena_latent(u - 128, p.w.zt(), cw, cb, gl, p.w.yt(), smem, cx);
    else hyena_ctx(u - 640, p.w.zt() + NL, cw, cb, p.w.gc(), p.w.yt() + NL, smem);
  }
}

__device__ __forceinline__ void ph_gla_out(const MP& p, char* smem, int l, int mrows, int bid, int nblk) {
  const int tid = tid_opaque();
  const int lane = tid & 63, wave = tid >> 6;
  {
    const float* gn = p.in.gla_norm_g + l * 128 + (lane & 15) * 8;
    const f32x4 ga = *(const f32x4*)gn, gb = *(const f32x4*)(gn + 4);
    const bf16* of = p.w.of(); const bf16* ob = p.w.ob(); const bf16* zg = p.w.zg(); bf16* ymix = p.w.ymix();
#pragma unroll 2
    for (int it = bid; it * 8 < mrows; it += nblk) {
      const int row = it * 8 + wave;
      const size_t base = (size_t)row * 512 + lane * 8;
      const u32x4 av = *(const u32x4*)(of + base), bv = *(const u32x4*)(ob + base);
      const f32x4 a0 = {bflo(av.x), bfhi(av.x), bflo(av.y), bfhi(av.y)}, a1 = {bflo(av.z), bfhi(av.z), bflo(av.w), bfhi(av.w)};
      const f32x4 b0 = {bflo(bv.x), bfhi(bv.x), bflo(bv.y), bfhi(bv.y)}, b1 = {bflo(bv.z), bfhi(bv.z), bflo(bv.w), bfhi(bv.w)};
      const u32x4 rv = *(const u32x4*)(zg + (size_t)row * GLACOLS + 1024 + lane * 8);
      const f32x4 o0 = a0 + b0, o1 = a1 + b1;
      float ss = o0.x * o0.x + o0.y * o0.y + o0.z * o0.z + o0.w * o0.w + o1.x * o1.x + o1.y * o1.y + o1.z * o1.z + o1.w * o1.w;
      ss += shx_f(ss, 1, lane); ss += shx_f(ss, 2, lane); ss += shx_f(ss, 4, lane); ss += shx_f(ss, 8, lane);
      const float rinv = rsqrtf(ss * (1.0f / 128.0f) + EPS);
      u32x4 o;
      o.x = pack_bf16(o0.x * rinv * ga.x * silu_f(bflo(rv.x)), o0.y * rinv * ga.y * silu_f(bfhi(rv.x)));
      o.y = pack_bf16(o0.z * rinv * ga.z * silu_f(bflo(rv.y)), o0.w * rinv * ga.w * silu_f(bfhi(rv.y)));
      o.z = pack_bf16(o1.x * rinv * gb.x * silu_f(bflo(rv.z)), o1.y * rinv * gb.y * silu_f(bfhi(rv.z)));
      o.w = pack_bf16(o1.z * rinv * gb.z * silu_f(bflo(rv.w)), o1.w * rinv * gb.w * silu_f(bfhi(rv.w)));
      *(u32x4*)(ymix + (size_t)row * D + 512 + lane * 8) = o;
    }
  }
  {
    const bf16* yt = p.w.yt(); bf16* ymix = p.w.ymix();
    for (int tt = bid; tt * 64 < mrows; tt += nblk) {
      const int tok0 = tt * 64;
      __syncthreads();
#pragma unroll
      for (int i = 0; i < 8; ++i) {
        const int q = tid + i * 512, c = q >> 3, ch = q & 7;
        const u32x4 v = *(const u32x4*)(yt + (size_t)c * NT + tok0 + ch * 8);
        unsigned* d = (unsigned*)(smem + c * 132 + ch * 16);
        d[0] = v.x; d[1] = v.y; d[2] = v.z; d[3] = v.w;
      }
      __syncthreads();
#pragma unroll
      for (int i = 0; i < 8; ++i) {
        const int c8 = wave * 8 + (lane & 7), t = i * 8 + (lane >> 3);
        const unsigned short* s = (const unsigned short*)(smem + (c8 * 8) * 132 + t * 2);
        const unsigned e0 = s[0], e1 = s[66], e2 = s[132], e3 = s[198], e4 = s[264], e5 = s[330], e6 = s[396], e7 = s[462];
        *(u32x4*)(ymix + (size_t)(tok0 + t) * D + c8 * 8) = (u32x4){e0 | (e1 << 16), e2 | (e3 << 16), e4 | (e5 << 16), e6 | (e7 << 16)};
      }
    }
  }
}

__device__ __forceinline__ void ph_norm2(const MP& p, int l, int mrows, int bid, int nblk) {
  const int lane = tid_opaque() & 63, wave = tid_opaque() >> 6;
  const float* g = p.in.norm2_g + l * D;
  const float* modl = p.w.mod() + (size_t)l * 17 * 6 * D;
  for (int it = bid; it * 8 < mrows; it += nblk) {
    const int row = it * 8 + wave;
    f32x4 v[4];
    row_load_xs(p.w.xs() + (size_t)row * D, lane, v);
    const float rinv = row_rinv(v, lane);
    const float* mb = modl + (size_t)row_batch(row) * 6 * D;
    row_norm_mod_store(v, rinv, g, mb + 3 * D, mb + 4 * D, lane, p.w.abuf() + (size_t)row * D, p.w.abuf8() + (size_t)row * D);
  }
}

__device__ __forceinline__ void ph_route(const MP& p, char* smem, int l, int ntok, int bid, int nblk) {
  const int tid = tid_opaque();
  const int lane = tid & 63, wave = tid >> 6;
  const float* rb = p.in.router_b + l * NE;
  int* lcnt = (int*)smem;
  __syncthreads();
  if (tid < NE) lcnt[tid] = 0;
  __syncthreads();
  const f32x4 bb = *(const f32x4*)(rb + lane * 4);
  const int tpb = (ntok + nblk - 1) / nblk;
  for (int it = wave; it < tpb; it += 8) {
    const int tok = bid * tpb + it;
    if (tok >= ntok) break;
    const f32x4 lg = *(const f32x4*)(p.w.logits() + (size_t)tok * NE + lane * 4);
    const float s0 = sigmoid_f(lg.x), s1 = sigmoid_f(lg.y), s2 = sigmoid_f(lg.z), s3 = sigmoid_f(lg.w);
    const float v0 = s0 + bb.x, v1 = s1 + bb.y, v2 = s2 + bb.z, v3 = s3 + bb.w;
    float m1 = fmaxf(v0, v1), m2 = fminf(v0, v1);
    { float n1 = fmaxf(m1, v2); float n2 = fmaxf(fminf(m1, v2), m2); m1 = n1; m2 = n2; }
    { float n1 = fmaxf(m1, v3); float n2 = fmaxf(fminf(m1, v3), m2); m1 = n1; m2 = n2; }
#pragma unroll
    for (int o = 1; o <= 4; o <<= 1) {
      float a1 = shx_f(m1, o, lane), a2 = shx_f(m2, o, lane);
      float n1 = fmaxf(m1, a1);
      float n2 = fmaxf(fminf(m1, a1), fmaxf(m2, a2));
      m1 = n1; m2 = n2;
    }
    const float gs = m1 + m2;
    const int g = lane >> 3;
    int rank = 0;
#pragma unroll
    for (int gg = 0; gg < 8; ++gg) {
      const float og = __int_as_float(__builtin_amdgcn_readlane(__float_as_int(gs), gg * 8));
      rank += (og > gs || (og == gs && gg < g)) ? 1 : 0;
    }
    unsigned k0, k1, k2, k3;
    {
      const bool sel = rank < 4;
      unsigned u;
      u = __float_as_uint(v0); u = (u & 0x80000000u) ? ~u : (u | 0x80000000u); k0 = sel ? ((u & 0xffffff00u) | (unsigned)(255 - (lane * 4 + 0))) : 0u;
      u = __float_as_uint(v1); u = (u & 0x80000000u) ? ~u : (u | 0x80000000u); k1 = sel ? ((u & 0xffffff00u) | (unsigned)(255 - (lane * 4 + 1))) : 0u;
      u = __float_as_uint(v2); u = (u & 0x80000000u) ? ~u : (u | 0x80000000u); k2 = sel ? ((u & 0xffffff00u) | (unsigned)(255 - (lane * 4 + 2))) : 0u;
      u = __float_as_uint(v3); u = (u & 0x80000000u) ? ~u : (u | 0x80000000u); k3 = sel ? ((u & 0xffffff00u) | (unsigned)(255 - (lane * 4 + 3))) : 0u;
    }
    float gsum = 0.f, myg = 0.f; int mye = 0;
#pragma unroll
    for (int k = 0; k < TOPK; ++k) {
      unsigned m = max(max(k0, k1), max(k2, k3));
      m = max(m, (unsigned)__builtin_amdgcn_update_dpp(0, (int)m, 0x111, 0xf, 0xf, false));
      m = max(m, (unsigned)__builtin_amdgcn_update_dpp(0, (int)m, 0x112, 0xf, 0xf, false));
      m = max(m, (unsigned)__builtin_amdgcn_update_dpp(0, (int)m, 0x114, 0xf, 0xf, false));
      m = max(m, (unsigned)__builtin_amdgcn_update_dpp(0, (int)m, 0x118, 0xf, 0xf, false));
      m = max(m, (unsigned)__builtin_amdgcn_update_dpp(0, (int)m, 0x142, 0xa, 0xf, false));
      m = max(m, (unsigned)__builtin_amdgcn_update_dpp(0, (int)m, 0x143, 0xc, 0xf, false));
      const unsigned wk = (unsigned)__builtin_amdgcn_readlane((int)m, 63);
      const int we = 255 - (int)(wk & 255u);
      const int wl = we >> 2, wi = we & 3;
      const float sv = __int_as_float(__builtin_amdgcn_readlane(__float_as_int(wi == 0 ? s0 : wi == 1 ? s1 : wi == 2 ? s2 : s3), wl));
      if (lane == wl) { if (wi == 0) k0 = 0u; else if (wi == 1) k1 = 0u; else if (wi == 2) k2 = 0u; else k3 = 0u; }
      gsum += sv;
      if (lane == k) { myg = sv; mye = we; }
    }
    if (lane < TOPK) {
      p.w.tok_e()[tok * TOPK + lane] = mye;
      p.w.tok_gate()[tok * TOPK + lane] = myg / gsum * 2.5f;
      atomicAdd(&lcnt[mye], 1);
    }
  }
  __syncthreads();
  if (tid < NE) p.w.blkcnt()[bid * NE + tid] = lcnt[tid];
}

__device__ __forceinline__ void ph_assign(const MP& p, char* smem, int l, int ntok, int bid, int nblk) {
  const int tid = tid_opaque();
  int* ps = (int*)smem;
  int* cur = (int*)smem + 512;
  __syncthreads();
  int* part = (int*)smem + 1024;
  {
    const int eg = tid & 63, bg = tid >> 6;
    const int per = (nblk + 7) >> 3;
    int t0 = 0, t1 = 0, t2 = 0, t3 = 0, b0 = 0, b1 = 0, b2 = 0, b3 = 0;
    const int* src = p.w.blkcnt() + eg * 4;
#pragma unroll 8
    for (int i = 0; i < per; ++i) {
      const int b = bg * per + i;
      if (b < nblk) {
        const u32x4 v = *(const u32x4*)(src + (size_t)b * NE);
        t0 += (int)v.x; t1 += (int)v.y; t2 += (int)v.z; t3 += (int)v.w;
        if (b < bid) { b0 += (int)v.x; b1 += (int)v.y; b2 += (int)v.z; b3 += (int)v.w; }
      }
    }
    int* pt = part + bg * 512 + eg * 4;
    pt[0] = t0; pt[1] = t1; pt[2] = t2; pt[3] = t3;
    pt[256] = b0; pt[257] = b1; pt[258] = b2; pt[259] = b3;
  }
  __syncthreads();
  int before = 0;
  if (tid < NE) {
    int tot = 0;
#pragma unroll
    for (int g = 0; g < 8; ++g) { tot += part[g * 512 + tid]; before += part[g * 512 + 256 + tid]; }
    const int pc = (tot + 255) & ~255;
    const int lane = tid & 63;
    int inc = pc;
#pragma unroll
    for (int o = 1; o < 64; o <<= 1) { const int n = shl_i(inc, lane - o); if (lane >= o) inc += n; }
    ps[tid + 1] = inc;
    if (lane == 63) cur[tid >> 6] = inc;
  }
  __syncthreads();
  if (tid < NE) {
    const int w = tid >> 6;
    int offs = 0;
#pragma unroll
    for (int k = 0; k < 3; ++k) offs += (k < w) ? cur[k] : 0;
    ps[tid + 1] += offs;
    if (tid == 0) ps[0] = 0;
  }
  __syncthreads();
  if (tid < NE) {
    unsigned short* te = (unsigned short*)(smem + LDS_TILE_E);
    for (int t = ps[tid] >> 8; t < (ps[tid + 1] >> 8); ++t) te[t] = (unsigned short)tid;
  }
  if (tid < NE) cur[tid] = ps[tid] + before;
  if (bid == 0 && tid <= NE) p.w.pad_start()[tid] = ps[tid];
  __syncthreads();
  const int tpb = (ntok + nblk - 1) / nblk;
  for (int i = tid; i < tpb * TOPK; i += 512) {
    const int gi = bid * tpb * TOPK + i;
    if (gi >= ntok * TOPK) break;
    const int e = p.w.tok_e()[gi];
    const int slot = atomicAdd(&cur[e], 1);
    p.w.slot_tok()[slot] = gi >> 3;
    p.w.tok_slot()[gi] = slot;
  }
}

__device__ __forceinline__ void ph_combine(const MP& p, int l, int mrows, bool last, int bid, int nblk) {
  const int lane = tid_opaque() & 63, wave = tid_opaque() >> 6;
  const float* modl = p.w.mod() + (size_t)l * 17 * 6 * D;
  for (int it = bid; it * 8 < mrows; it += nblk) {
    const int row = it * 8 + wave;
    const int b = row_batch(row);
    f32x4 v[4], acc[4];
    row_load_xs(p.w.xs() + (size_t)row * D, lane, v);
#pragma unroll
    for (int j = 0; j < 4; ++j) acc[j] = (f32x4){0.f, 0.f, 0.f, 0.f};
    int sl = 0; float gt = 0.f;
    if (lane < TOPK) { sl = p.w.tok_slot()[row * TOPK + lane]; gt = p.w.tok_gate()[row * TOPK + lane]; }
#pragma unroll
    for (int k = 0; k < TOPK; ++k) {
      const int s = shl_i(sl, k);
      const float gk = shl_f(gt, k);
      const unsigned char* yr = p.w.ybuf() + (size_t)s * D + lane * 4;
#pragma unroll
      for (int j = 0; j < 4; ++j) {
        const int y = *(const int*)(yr + j * 256);
        const f32x2v lo = __builtin_amdgcn_cvt_pk_f32_fp8(y, false), hi = __builtin_amdgcn_cvt_pk_f32_fp8(y, true);
        acc[j].x += gk * lo.x; acc[j].y += gk * lo.y; acc[j].z += gk * hi.x; acc[j].w += gk * hi.y;
      }
    }
    const float* g2 = modl + (size_t)b * 6 * D + 5 * D;
#pragma unroll
    for (int j = 0; j < 4; ++j) {
      const f32x4 gv = *(const f32x4*)(g2 + j * 256 + lane * 4);
      v[j] += gv * acc[j];
    }
    const float rinv = row_rinv(v, lane);
    if (last) {
#pragma unroll
      for (int j = 0; j < 4; ++j) {
        const f32x4 fg = *(const f32x4*)(p.in.final_g + j * 256 + lane * 4);
        *(f32x4*)(p.out + (size_t)row * D + j * 256 + lane * 4) = v[j] * rinv * fg;
      }
    } else {
#pragma unroll
      for (int j = 0; j < 4; ++j) xs_store4(p.w.xs() + (size_t)row * D + j * 256 + lane * 4, v[j]);
      const float* mb = p.w.mod() + ((size_t)(l + 1) * 17 + b) * 6 * D;
      row_norm_mod_store(v, rinv, p.in.norm1_g + (l + 1) * D, mb, mb + D, lane, p.w.abuf() + (size_t)row * D, p.w.abuf8() + (size_t)row * D);
    }
  }
}

__global__ void __launch_bounds__(512, 2) k_mega(MP p) {
  extern __shared__ __attribute__((aligned(16))) char smem[];
  const int bid = blockIdx.x, nblk = gridDim.x;
  if (tid_opaque() == 0) *(u32x4*)(smem + MEGA_LDS_MAIN) = (u32x4){0u, 0u, 0u, 0u};
  __syncthreads();
  (void)xcd_barrier_post(p.w.bar(), (volatile LAS unsigned*)(smem + MEGA_LDS_MAIN));

  if (threadIdx.x == 0) {
    const unsigned xcc = xb_xcc_id();
    const int rank = atomicAdd(&p.w.ctrl()[CTRL_XR + 16 * xcc], 1);
    *(int*)(smem + MEGA_LDS_MAIN + 12) = rank;
  }
  ph_mod_hid(p, smem, bid, nblk);
  cvt_job(p.in.w_in, p.w.w_in_t(), D, INCOLS, 1, bid, nblk, HYCOLS);
  cvt_job(p.in.w_in + (size_t)D * INCOLS, p.w.w_in_t() + (size_t)WIN_ROWS * D, D, INCOLS, 1, bid, nblk, HYCOLS);
  cvt8_job(p.in.w_in + HYCOLS, p.w.w_g8(), D, INCOLS, 1, bid, nblk, GLACOLS);
  cvt8_job(p.in.w_in + (size_t)D * INCOLS + HYCOLS, p.w.w_g8() + (size_t)GW_ROWS * D, D, INCOLS, 1, bid, nblk, GLACOLS);
  cvt_job(p.in.w_out, p.w.w_out_t(), D, D, DEPTH, bid, nblk);
  cvt_job(p.in.router_w, p.w.router_t(), D, NE, DEPTH, bid, nblk);
  cvt8_job(p.in.sh_w1, p.w.sh1_t(), D, DE, DEPTH, bid, nblk);
  cvt8_job(p.in.sh_w3, p.w.sh3_t(), D, DE, DEPTH, bid, nblk);
  cvt8_job(p.in.sh_w2, p.w.sh2_t(), DE, D, DEPTH, bid, nblk);
  grid_sync(p.w.bar(), smem + MEGA_LDS_MAIN);
  int vb = bid;
  {
    const int rank = *(const int*)(smem + MEGA_LDS_MAIN + 12);
    const unsigned xcc = xb_xcc_id();
    int npop = 0, xidx = 0, cnt0 = -1; bool equal = true;
    for (int j = 0; j < 16; ++j) {
      const int c = p.w.ctrl()[CTRL_XR + 16 * j];
      if (c > 0) {
        if (cnt0 < 0) cnt0 = c; else if (c != cnt0) equal = false;
        if (j < (int)xcc) ++xidx;
        ++npop;
      }
    }
    if (equal && cnt0 > 0 && npop * cnt0 == nblk && rank < cnt0) vb = xidx * cnt0 + rank;
  }
  ph_gtab(p, smem, bid, nblk);
  ph_init_norm1(p, bid, nblk);
  grid_sync(p.w.bar(), smem + MEGA_LDS_MAIN);

  const int vbu = __builtin_amdgcn_readfirstlane(vb);
#pragma unroll 1
  for (int l0 = 0; l0 < DEPTH; ++l0) {
#define LL opq(l0)
    const bool last = (l0 == DEPTH - 1);
    const int mrows = last ? NL : NT;
#define MODL (p.w.mod() + (size_t)LL * 17 * 6 * D)
    {
      G8InZT g; g.wt = p.w.w_in_t() + (size_t)LL * WIN_ROWS * D; g.A = p.w.abuf(); g.zt = p.w.zt(); g.ntok = last ? NL : NT;
      gemm8_run(g, smem, opq(vbu), nblk);
    }
    {
      G8InG g; g.wt = p.w.w_g8() + (size_t)LL * GW_ROWS * D; g.A = p.w.abuf8(); g.zg = p.w.zg();
      gemm8_run(g, smem, opq(vbu), nblk);
    }
    grid_sync(p.w.bar(), smem + MEGA_LDS_MAIN);
    ph_mixer(p, smem, LL, last, opq(bid), nblk);
    grid_sync(p.w.bar(), smem + MEGA_LDS_MAIN);
    ph_gla_out(p, smem, LL, mrows, opq(bid), nblk);
    grid_sync(p.w.bar(), smem + MEGA_LDS_MAIN);
    {
      G8Out g; g.mrows = mrows; g.ymix = p.w.ymix(); g.wt = p.w.w_out_t() + (size_t)LL * D * D; g.modl = MODL; g.xs = p.w.xs();
      gemm8_run(g, smem, opq(vbu), nblk);
    }
    grid_sync(p.w.bar(), smem + MEGA_LDS_MAIN);
    ph_norm2(p, LL, mrows, opq(bid), nblk);
    grid_sync(p.w.bar(), smem + MEGA_LDS_MAIN);
    {
      G8Router g; g.mrows = mrows; g.A = p.w.abuf(); g.rwt = p.w.router_t() + (size_t)LL * NE * D; g.logits = p.w.logits();
      gemm8_run(g, smem, opq(vbu), nblk);
    }
    {
      G8ShUp g; g.mrows = mrows; g.A8 = p.w.abuf8(); g.s1t = p.w.sh1_t() + (size_t)LL * DE * D; g.s3t = p.w.sh3_t() + (size_t)LL * DE * D; g.hs = p.w.hs();
      int rid = vbu - (mrows >> 8) % nblk; rid += rid < 0 ? nblk : 0;
      gemm8_run(g, smem, opq(rid), nblk);
    }
    grid_sync(p.w.bar(), smem + MEGA_LDS_MAIN);
    ph_route(p, smem, LL, mrows, opq(bid), nblk);
    grid_sync(p.w.bar(), smem + MEGA_LDS_MAIN);
    ph_assign(p, smem, LL, mrows, opq(bid), nblk);
    grid_sync(p.w.bar(), smem + MEGA_LDS_MAIN);
    {
      G8Up g; g.A8 = p.w.abuf8(); g.slot_tok = p.w.slot_tok(); g.pad_start = p.w.pad_start(); g.w1t = p.w.e1_t(); g.w3t = p.w.e3_t(); g.H = p.w.hbuf(); g.tile_e = (const unsigned short*)(smem + LDS_TILE_E);
      gemm8_run(g, smem, opq(vbu), nblk);
    }
    {
      G8ShDown g; g.mrows = mrows; g.hs = p.w.hs(); g.wt = p.w.sh2_t() + (size_t)LL * D * DE; g.modl = MODL; g.xs = p.w.xs();
      int rid = vbu - __builtin_amdgcn_readfirstlane(((p.w.pad_start()[NE] >> 8) * 2) % nblk); rid += rid < 0 ? nblk : 0;
      gemm8_run(g, smem, opq(rid), nblk);
    }
    grid_sync(p.w.bar(), smem + MEGA_LDS_MAIN);
    {
      G8Down g; g.H = p.w.hbuf(); g.pad_start = p.w.pad_start(); g.w2t = p.w.e2_t(); g.Y = p.w.ybuf(); g.tile_e = (const unsigned short*)(smem + LDS_TILE_E);
      gemm8_run(g, smem, opq(vbu), nblk);
    }
    grid_sync(p.w.bar(), smem + MEGA_LDS_MAIN);
    ph_combine(p, LL, mrows, last, opq(bid), nblk);
    if (!last) grid_sync(p.w.bar(), smem + MEGA_LDS_MAIN);
  }
#undef LL
#undef MODL
}

static inline size_t align_up(size_t v, size_t a) { return (v + a - 1) / a * a; }

extern "C" void kernel_launch(void* const* d_in, const int* in_sizes, int n_in, void* d_out, int out_size, void* d_ws,
                              size_t ws_size, hipStream_t stream) {
  MP p;
  memset(&p, 0, sizeof(p));
  const float** ip = (const float**)&p.in;
  for (int i = 0; i < 30; ++i) ip[i] = (const float*)d_in[i];
  p.out = (float*)d_out;

  p.w.b = (char*)d_ws;
  const size_t zero_bytes = wso::zero_end;
  (void)ws_size; (void)n_in; (void)in_sizes; (void)out_size;

  static int grid = 0;
  if (!grid) {
    hipFuncSetAttribute((const void*)k_mega, hipFuncAttributeMaxDynamicSharedMemorySize, MEGA_LDS);
    int dev = 0, cus = 0, per_cu = 0;
    hipGetDevice(&dev);
    hipDeviceGetAttribute(&cus, hipDeviceAttributeMultiprocessorCount, dev);
    hipOccupancyMaxActiveBlocksPerMultiprocessor(&per_cu, k_mega, 512, MEGA_LDS);
    if (cus <= 0) cus = 256;
    grid = per_cu >= 1 ? cus : 0;
    if (grid <= 0) grid = 256;
  }
  hipMemsetAsync(d_ws, 0, zero_bytes, stream);
  hipLaunchKernelGGL(k_mega, dim3(grid), dim3(512), MEGA_LDS, stream, p);
}
```

```cpp
#include <hip/hip_runtime.h>
#include <hip/hip_bf16.h>
#include <stdint.h>
#include <string.h>

typedef __hip_bfloat16 bf16;

constexpr int D = 1024, NB = 16, SEQ = 2048, LC = 256, DEPTH = 2;
constexpr int NL = NB * SEQ, NC = NB * LC, NT = NL + NC;
constexpr int HYW = 512, HYCOLS = 1536, GLACOLS = 1568, INCOLS = 3104;
constexpr int NE = 256, TOPK = 8, DE = 256;
constexpr int NSLOT = NT * TOPK + NE * 256;
constexpr float EPS = 1e-6f;
constexpr float HY_MIN_DECAY = 3.0701134573253945f;
constexpr float HY_MAX_DECAY = 15.350567286626973f;
constexpr int GSTR_L = 4096, GSTR_C = 512;
constexpr int WIN_ROWS = HYCOLS;
constexpr int GW_ROWS = 7 * 256;

__device__ __forceinline__ float bf2f(bf16 v) { return __bfloat162float(v); }
__device__ __forceinline__ bf16 f2bf(float v) { return __float2bfloat16(v); }
__device__ __forceinline__ float silu_f(float x) { return x / (1.f + __expf(-x)); }
__device__ __forceinline__ float sigmoid_f(float x) { return 1.f / (1.f + __expf(-x)); }
__device__ __forceinline__ float logsigmoid_f(float x) { return fminf(x, 0.f) - __logf(1.f + __expf(-fabsf(x))); }

__device__ __forceinline__ float shx_f(float v, int mask, int lane) { return __int_as_float(__builtin_amdgcn_ds_bpermute((lane ^ mask) << 2, __float_as_int(v))); }
__device__ __forceinline__ int shx_i(int v, int mask, int lane) { return __builtin_amdgcn_ds_bpermute((lane ^ mask) << 2, v); }
__device__ __forceinline__ float shl_f(float v, int src) { return __int_as_float(__builtin_amdgcn_ds_bpermute(src << 2, __float_as_int(v))); }
__device__ __forceinline__ int shl_i(int v, int src) { return __builtin_amdgcn_ds_bpermute(src << 2, v); }
__device__ __forceinline__ float wave_sum(float v, int lane) {
#pragma unroll
  for (int o = 32; o > 0; o >>= 1) v += shx_f(v, o, lane);
  return v;
}

struct Inputs {
  const float *x, *c, *ctx, *c_ctx, *ada_w, *ada_b, *norm1_g, *norm2_g, *w_in, *w_out, *hy_conv_w, *hy_conv_b,
      *hy_f_w1, *hy_f_b1, *hy_f_w2, *hy_f_b2, *hy_f_w3, *hy_skip, *gla_wa2, *gla_ba2, *gla_norm_g, *router_w,
      *router_b, *exp_w1, *exp_w3, *exp_w2, *sh_w1, *sh_w3, *sh_w2, *final_g;
};

__device__ __forceinline__ int opq(int v) { asm volatile("" : "+s"(v)); return v; }
__device__ __forceinline__ int tid_opaque() { int t = threadIdx.x; asm volatile("" : "+v"(t)); return t; }
__device__ __forceinline__ int row_batch(int row) { return row < NL ? (row >> 11) : 16; }

#define XB_TMO      128
#define XB_XCNT(j)  (256  + 64 * (j))
#define XB_XSUB(j)  (1280 + 64 * (j))
#define XB_XGEN(j)  (2304 + 64 * (j))
#define XB_TOP      3328
#define XB_TOPGEN   3392
#define XCD_BAR_WORDS 3456
#define XB_SPIN_CAP (1u << 18)
#define LAS __attribute__((address_space(3)))

__device__ __forceinline__ unsigned xb_ld(unsigned* p)              { return __hip_atomic_load(p, __ATOMIC_RELAXED, __HIP_MEMORY_SCOPE_AGENT); }
__device__ __forceinline__ unsigned xb_add(unsigned* p, unsigned v) { return __hip_atomic_fetch_add(p, v, __ATOMIC_RELAXED, __HIP_MEMORY_SCOPE_AGENT); }
__device__ __forceinline__ unsigned xb_xcc_id() { return (unsigned)__builtin_amdgcn_s_getreg((3 << 11) | 20) & 0xFu; }
#define XB_SPIN(cond, bar) do { unsigned _sp = 0; while (cond) { __builtin_amdgcn_s_sleep(1); \
    if ((++_sp & 255u) == 0u) { if (xb_ld(&(bar)[XB_TMO])) break; if (_sp > XB_SPIN_CAP) { atomicAdd(&(bar)[XB_TMO], 1u); break; } } } } while (0)

struct XcdBarrier {
    unsigned* bar; unsigned x;
    volatile LAS unsigned* st;
};

__device__ __forceinline__ XcdBarrier xcd_barrier_post(unsigned* bar, volatile LAS unsigned* st) {
    XcdBarrier b; b.bar = bar; b.x = xb_xcc_id(); b.st = st;
    if (threadIdx.x == 0) (void)xb_add(&bar[XB_XCNT(b.x)], 1u);
    return b;
}
__device__ __forceinline__ void xcd_barrier_complete(unsigned* bar, unsigned x, unsigned& nloc, unsigned& nx) {
    const unsigned G = gridDim.x * gridDim.y * gridDim.z;
    unsigned sum, cnt, mine, sp = 0u;
    for (;;) {
        sum = 0u; cnt = 0u; mine = 0u;
#pragma unroll
        for (unsigned j = 0; j < 16; ++j) { const unsigned c = xb_ld(&bar[XB_XCNT(j)]); sum += c; cnt += (c > 0u) ? 1u : 0u; mine = (j == x) ? c : mine; }
        if (sum == G) break;
        __builtin_amdgcn_s_sleep(1);
        if ((++sp & 255u) == 0u) { if (xb_ld(&bar[XB_TMO])) break; if (sp > XB_SPIN_CAP) { atomicAdd(&bar[XB_TMO], 1u); break; } }
    }
    nloc = mine > 0u ? mine : 1u; nx = cnt > 0u ? cnt : 1u;
}
__device__ __forceinline__ void xcd_barrier(const XcdBarrier& b) {
    asm volatile("s_waitcnt vmcnt(0)" ::: "memory");
    __syncthreads();
    if (threadIdx.x == 0) {
        unsigned* bar = b.bar;
        __builtin_amdgcn_s_waitcnt(0);
        unsigned nloc = b.st[0], nx = b.st[1];
        if (nloc == 0u) { xcd_barrier_complete(bar, b.x, nloc, nx); b.st[0] = nloc; b.st[1] = nx; }
        const unsigned old = xb_add(&bar[XB_XSUB(b.x)], 1u);
        const unsigned gen = old / nloc;
        if (old + 1u == (gen + 1u) * nloc) {
            __builtin_amdgcn_fence(__ATOMIC_RELEASE, "agent");
            asm volatile("s_waitcnt vmcnt(0)" ::: "memory");
            const unsigned og = xb_add(&bar[XB_TOP], 1u);
            const unsigned tg = og / nx;
            if (og + 1u == (tg + 1u) * nx) xb_add(&bar[XB_TOPGEN], 1u);
            else XB_SPIN(xb_ld(&bar[XB_TOPGEN]) == tg, bar);
            __builtin_amdgcn_fence(__ATOMIC_ACQUIRE, "agent");
            xb_add(&bar[XB_XGEN(b.x)], 1u);
            asm volatile("s_waitcnt vmcnt(0)" ::: "memory");
        } else {
            XB_SPIN(xb_ld(&bar[XB_XGEN(b.x)]) == gen, bar);
            __builtin_amdgcn_fence(__ATOMIC_ACQUIRE, "agent");
            asm volatile("s_waitcnt vmcnt(0)" ::: "memory");
        }
    }
    __syncthreads();
}

__device__ __forceinline__ void grid_sync(unsigned* bar0, char* stw) {
  unsigned* q = bar0;
  asm volatile("" : "+s"(q));
  XcdBarrier b; b.bar = q; b.x = xb_xcc_id(); b.st = (volatile LAS unsigned*)stw;
  xcd_barrier(b);
}

typedef __attribute__((ext_vector_type(8))) __bf16 bf16x8;
typedef __attribute__((ext_vector_type(16))) float f32x16;
typedef __attribute__((ext_vector_type(4))) float f32x4;
typedef __attribute__((ext_vector_type(2))) float f32x2v;
typedef __attribute__((ext_vector_type(2))) __bf16 bf16x2v;
typedef __attribute__((ext_vector_type(4))) unsigned int u32x4;
typedef __attribute__((ext_vector_type(2))) unsigned int u32x2;

__device__ __forceinline__ unsigned pack_bf16(float a, float b) {
  f32x2v v = {a, b};
  return __builtin_bit_cast(unsigned, __builtin_convertvector(v, bf16x2v));
}
__device__ __forceinline__ f32x4 xs_load4(const bf16* p) {
  const u32x2 w = *(const u32x2*)p;
  return (f32x4){__uint_as_float(w.x << 16), __uint_as_float(w.x & 0xffff0000u), __uint_as_float(w.y << 16), __uint_as_float(w.y & 0xffff0000u)};
}
__device__ __forceinline__ void xs_store4(bf16* p, const f32x4 v) {
  u32x2 w; w.x = pack_bf16(v.x, v.y); w.y = pack_bf16(v.z, v.w);
  *(u32x2*)p = w;
}
__device__ __forceinline__ int swz(int row, int chunk) { return row * 128 + ((chunk ^ ((row >> 1) & 7)) << 4); }
__device__ __forceinline__ int rowmap(int reg, int lh) { return (reg & 3) + 8 * (reg >> 2) + 4 * lh; }

__device__ __forceinline__ int find_group(const int* __restrict__ pad_start, int m0) {
  int lo = 0, hi = NE - 1;
  while (lo < hi) {
    int mid = (lo + hi + 1) >> 1;
    if (pad_start[mid] <= m0) lo = mid; else hi = mid - 1;
  }
  return lo;
}

__device__ __forceinline__ void cvt_wave_tile(const float* __restrict__ src, bf16* __restrict__ dst, int K, int N, int kt, int ntile, int lane) {
  const int k0 = kt * 64 + (lane & 7) * 8, n0 = ntile * 32 + (lane >> 3) * 4;
  const float* s = src + (size_t)k0 * N + n0;
  const f32x4 v0 = __builtin_nontemporal_load((const f32x4*)(s)), v1 = __builtin_nontemporal_load((const f32x4*)(s + (size_t)N));
  const f32x4 v2 = __builtin_nontemporal_load((const f32x4*)(s + (size_t)2 * N)), v3 = __builtin_nontemporal_load((const f32x4*)(s + (size_t)3 * N));
  const f32x4 v4 = __builtin_nontemporal_load((const f32x4*)(s + (size_t)4 * N)), v5 = __builtin_nontemporal_load((const f32x4*)(s + (size_t)5 * N));
  const f32x4 v6 = __builtin_nontemporal_load((const f32x4*)(s + (size_t)6 * N)), v7 = __builtin_nontemporal_load((const f32x4*)(s + (size_t)7 * N));
  bf16* d = dst + (size_t)n0 * K + k0;
  *(u32x4*)(d) = (u32x4){pack_bf16(v0.x, v1.x), pack_bf16(v2.x, v3.x), pack_bf16(v4.x, v5.x), pack_bf16(v6.x, v7.x)};
  *(u32x4*)(d + (size_t)K) = (u32x4){pack_bf16(v0.y, v1.y), pack_bf16(v2.y, v3.y), pack_bf16(v4.y, v5.y), pack_bf16(v6.y, v7.y)};
  *(u32x4*)(d + (size_t)2 * K) = (u32x4){pack_bf16(v0.z, v1.z), pack_bf16(v2.z, v3.z), pack_bf16(v4.z, v5.z), pack_bf16(v6.z, v7.z)};
  *(u32x4*)(d + (size_t)3 * K) = (u32x4){pack_bf16(v0.w, v1.w), pack_bf16(v2.w, v3.w), pack_bf16(v4.w, v5.w), pack_bf16(v6.w, v7.w)};
}
typedef __attribute__((ext_vector_type(8))) int i32x8;
typedef __attribute__((ext_vector_type(4))) int i32x4;
__device__ __forceinline__ float clamp_fp8(float x) { return __builtin_amdgcn_fmed3f(x, -448.0f, 448.0f); }
__device__ __forceinline__ unsigned pk4_fp8(float a, float b, float c, float d) {
  a = clamp_fp8(a); b = clamp_fp8(b); c = clamp_fp8(c); d = clamp_fp8(d);
  int w = 0;
  w = __builtin_amdgcn_cvt_pk_fp8_f32(a, b, w, false);
  w = __builtin_amdgcn_cvt_pk_fp8_f32(c, d, w, true);
  return (unsigned)w;
}
__device__ __forceinline__ void cvt8_wave_tile(const float* __restrict__ src, unsigned char* __restrict__ dst, int K, int N, int kt, int ntile, int lane) {
  const int k0 = kt * 64 + (lane & 7) * 8, n0 = ntile * 32 + (lane >> 3) * 4;
  const float* s = src + (size_t)k0 * N + n0;
  const float sc = 16.0f;
  const f32x4 v0 = __builtin_nontemporal_load((const f32x4*)(s)) * sc, v1 = __builtin_nontemporal_load((const f32x4*)(s + (size_t)N)) * sc;
  const f32x4 v2 = __builtin_nontemporal_load((const f32x4*)(s + (size_t)2 * N)) * sc, v3 = __builtin_nontemporal_load((const f32x4*)(s + (size_t)3 * N)) * sc;
  const f32x4 v4 = __builtin_nontemporal_load((const f32x4*)(s + (size_t)4 * N)) * sc, v5 = __builtin_nontemporal_load((const f32x4*)(s + (size_t)5 * N)) * sc;
  const f32x4 v6 = __builtin_nontemporal_load((const f32x4*)(s + (size_t)6 * N)) * sc, v7 = __builtin_nontemporal_load((const f32x4*)(s + (size_t)7 * N)) * sc;
  unsigned char* d = dst + (size_t)n0 * K + k0;
  *(u32x2*)(d) = (u32x2){pk4_fp8(v0.x, v1.x, v2.x, v3.x), pk4_fp8(v4.x, v5.x, v6.x, v7.x)};
  *(u32x2*)(d + (size_t)K) = (u32x2){pk4_fp8(v0.y, v1.y, v2.y, v3.y), pk4_fp8(v4.y, v5.y, v6.y, v7.y)};
  *(u32x2*)(d + (size_t)2 * K) = (u32x2){pk4_fp8(v0.z, v1.z, v2.z, v3.z), pk4_fp8(v4.z, v5.z, v6.z, v7.z)};
  *(u32x2*)(d + (size_t)3 * K) = (u32x2){pk4_fp8(v0.w, v1.w, v2.w, v3.w), pk4_fp8(v4.w, v5.w, v6.w, v7.w)};
}
__device__ __forceinline__ void cvt8_job(const float* __restrict__ src, unsigned char* __restrict__ dst, int K, int N, int nmat, int bid, int nblk, int W = 0) {
  const int tid = tid_opaque(), lane = tid & 63, wave = tid >> 6;
  if (W == 0) W = N;
  const int tk = K >> 6, tn = W >> 5, per = tk * tn;
  const int total = per * nmat;
  for (int u = bid * 8 + wave; u < total; u += nblk * 8) {
    const int mat = u / per, r = u - mat * per;
    const int ntile = r / tk, kt = r - ntile * tk;
    cvt8_wave_tile(src + (size_t)mat * K * N, dst + (size_t)mat * K * W, K, N, kt, ntile, lane);
  }
}

__device__ __forceinline__ void cvt_job(const float* __restrict__ src, bf16* __restrict__ dst, int K, int N, int nmat, int bid, int nblk, int W = 0) {
  const int tid = tid_opaque(), lane = tid & 63, wave = tid >> 6;
  if (W == 0) W = N;
  const int tk = K >> 6, tn = W >> 5, per = tk * tn;
  const int total = per * nmat;
  for (int u = bid * 8 + wave; u < total; u += nblk * 8) {
    const int mat = u / per, r = u - mat * per;
    const int ntile = r / tk, kt = r - ntile * tk;
    cvt_wave_tile(src + (size_t)mat * K * N, dst + (size_t)mat * K * W, K, N, kt, ntile, lane);
  }
}

constexpr int G8_HT = 128 * 64;
constexpr int G8_LDS = 8 * G8_HT * 2;

__device__ __forceinline__ int g8_lds_byte(int r, int c) {
  int st = (r >> 4) * 2 + (c >> 5), rr = r & 15, cc = c & 31, ob = rr * 64 + cc * 2;
  return st * 1024 + (ob ^ (((ob >> 9) & 1) << 5));
}
__device__ __forceinline__ void g8_stage_rc(int b, int& R, int& C) {
  int st = b / 1024, sb = b % 1024, sw = sb ^ (((sb >> 9) & 1) << 5);
  R = (st >> 1) * 16 + sw / 64; C = (st & 1) * 32 + (sw % 64) / 2;
}

typedef f32x4 g8acc_t[2][2][4][2];

template <class P>
__device__ __forceinline__ void gemm8_run(const P& p, char* smem, int bid, int nblk) {
  const int ntl = __builtin_amdgcn_readfirstlane(p.ntiles());
  if (bid >= ntl) return;
  bf16* shm = (bf16*)smem;
#define SA(b, h) (shm + ((b) * 2 + (h)) * G8_HT)
#define SB(b, h) (shm + (4 + (b) * 2 + (h)) * G8_HT)
#define GLDS(SRC, DST) __builtin_amdgcn_global_load_lds((const unsigned*)(SRC), (unsigned*)(DST), 16, 0, 0)
#define STAGE_A(PP, BASE, KT) do { GLDS((BASE) + (oa + (KT) * 64), (char*)(PP) + ldsd); GLDS((BASE) + 64 * P::A_PITCH + (oa + (KT) * 64), (char*)(PP) + ldsd + 8192); } while (0)
#define STAGE_B(PP, BASE, OB, KT) do { \
    if constexpr (P::B_GATHER) { GLDS((BASE) + ((((OB) & 0xffffu) * (unsigned)P::B_PITCH + cc) + (KT) * 64), (char*)(PP) + ldsd); \
                                 GLDS((BASE) + ((((OB) >> 16) * (unsigned)P::B_PITCH + cc) + (KT) * 64), (char*)(PP) + ldsd + 8192); } \
    else { GLDS((BASE) + ((OB) + (KT) * 64), (char*)(PP) + ldsd); GLDS((BASE) + 64 * P::B_PITCH + ((OB) + (KT) * 64), (char*)(PP) + ldsd + 8192); } } while (0)
#define LDA(dst, b, h) for (int m = 0; m < 4; ++m) \
    dst[m] = __builtin_shufflevector(*reinterpret_cast<const i32x4*>((char*)SA(b, h) + aoff + m * 2048), \
                                     *reinterpret_cast<const i32x4*>((char*)SA(b, h) + aoff + m * 2048 + 1024), 0, 1, 2, 3, 4, 5, 6, 7)
#define LDB(dst, b, h) for (int n = 0; n < 2; ++n) \
    dst[n] = __builtin_shufflevector(*reinterpret_cast<const i32x4*>((char*)SB(b, h) + boff + n * 2048), \
                                     *reinterpret_cast<const i32x4*>((char*)SB(b, h) + boff + n * 2048 + 1024), 0, 1, 2, 3, 4, 5, 6, 7)
#define FRAG_LO(x) __builtin_bit_cast(bf16x8, __builtin_shufflevector(x, x, 0, 1, 2, 3))
#define FRAG_HI(x) __builtin_bit_cast(bf16x8, __builtin_shufflevector(x, x, 4, 5, 6, 7))
#define MMA(ai, bj, At_, Bt_) do { __builtin_amdgcn_s_setprio(1); \
    if constexpr (P::FP8) { \
      for (int m = 0; m < 4; ++m) for (int n = 0; n < 2; ++n) \
        asm volatile("v_mfma_f32_16x16x128_f8f6f4 %0, %1, %2, %0" \
                     : "+v"(acc[ai][bj][m][n]) : "v"(At_[m]), "v"(Bt_[n])); \
    } else { \
      for (int m = 0; m < 4; ++m) for (int n = 0; n < 2; ++n) { \
        acc[ai][bj][m][n] = __builtin_amdgcn_mfma_f32_16x16x32_bf16(FRAG_LO(At_[m]), FRAG_LO(Bt_[n]), acc[ai][bj][m][n], 0, 0, 0); \
        acc[ai][bj][m][n] = __builtin_amdgcn_mfma_f32_16x16x32_bf16(FRAG_HI(At_[m]), FRAG_HI(Bt_[n]), acc[ai][bj][m][n], 0, 0, 0); } \
    } \
    __builtin_amdgcn_s_setprio(0); } while (0)
#define WAIT_V(n) asm volatile("s_waitcnt vmcnt(" #n ")" ::: "memory")
#define WAIT_L(n) asm volatile("s_waitcnt lgkmcnt(" #n ")" ::: "memory")
#define BAR __builtin_amdgcn_s_barrier()
#define SCHED __builtin_amdgcn_sched_barrier(0)

  typename P::Ctx cur, nxt;
  p.tile(bid, cur);
  int aoff, boff, ldsd;
  unsigned oa, cc, ob0, ob1;
  bool wr1;
  {
    const int tid = tid_opaque();
    const int wid = tid >> 6, lane = tid & 63, wr = wid >> 2, wc = wid & 3, fr = lane & 15, fq = lane >> 4;
    aoff = g8_lds_byte(wr * 64 + fr, fq * 8); boff = g8_lds_byte(wc * 32 + fr, fq * 8);
    ldsd = tid * 16; wr1 = (wr == 1);
    int R0, C0;
    g8_stage_rc(tid * 16, R0, C0);
    cc = C0;
    oa = (((R0 >> 2) & 3) * 16 + (R0 >> 4) * 4 + (R0 & 3)) * P::A_PITCH + C0;
    if constexpr (P::B_GATHER) {
      ob0 = p.b_row(cur, 0, R0) | (p.b_row(cur, 0, R0 + 64) << 16);
      ob1 = p.b_row(cur, 1, R0) | (p.b_row(cur, 1, R0 + 64) << 16);
    } else { ob0 = R0 * P::B_PITCH + C0; ob1 = ob0; }
  }
  const bf16* ca0 = p.a_base(cur, 0);
  const bf16* ca1 = p.a_base(cur, 1);
  const bf16* cb0 = p.b_base(cur, 0);
  const bf16* cb1 = p.b_base(cur, 1);

  g8acc_t acc;
#pragma unroll
  for (int a0 = 0; a0 < 2; ++a0)
#pragma unroll
    for (int b0 = 0; b0 < 2; ++b0)
#pragma unroll
      for (int m = 0; m < 4; ++m)
#pragma unroll
        for (int n = 0; n < 2; ++n) acc[a0][b0][m][n] = (f32x4){0.f, 0.f, 0.f, 0.f};
  i32x8 At[4], B0[2], B1[2];
  const int mxs = 0x7F7F7F7F;
  const int nt = opq(P::NKT);
  STAGE_B(SB(0, 0), cb0, ob0, 0); STAGE_A(SA(0, 0), ca0, 0);
  STAGE_B(SB(0, 1), cb1, ob1, 0); STAGE_A(SA(0, 1), ca1, 0);
  if (wr1) BAR;
  WAIT_V(4); BAR;
  STAGE_B(SB(1, 0), cb0, ob0, 1); STAGE_A(SA(1, 0), ca0, 1); STAGE_B(SB(1, 1), cb1, ob1, 1);
  WAIT_V(6); BAR;
#pragma unroll 1
  for (int idx = bid;;) {
    const int nidx = idx + nblk;
    const bool has_next = nidx < ntl;
    if (has_next) p.tile(nidx, nxt); else nxt = cur;
    const bf16* na0 = p.a_base(nxt, 0);
    const bf16* na1 = p.a_base(nxt, 1);
    const bf16* nb0 = p.b_base(nxt, 0);
    const bf16* nb1 = p.b_base(nxt, 1);
    unsigned nob0 = ob0, nob1 = ob1;
    if constexpr (P::B_GATHER) {
      const int t2 = tid_opaque();
      int R0, C0;
      g8_stage_rc(t2 * 16, R0, C0);
      nob0 = p.b_row(nxt, 0, R0) | (p.b_row(nxt, 0, R0 + 64) << 16);
      nob1 = p.b_row(nxt, 1, R0) | (p.b_row(nxt, 1, R0 + 64) << 16);
    }
#pragma unroll 1
    for (int t = 0; t < nt; t += 2) {
      const bool last = (t == nt - 2);
      const bf16* a2h0 = last ? na0 : ca0; const bf16* a2h1 = last ? na1 : ca1;
      const bf16* b2h0 = last ? nb0 : cb0; const bf16* b2h1 = last ? nb1 : cb1;
      const int k2 = last ? 0 : t + 2;
      const unsigned q0 = last ? nob0 : ob0, q1 = last ? nob1 : ob1;
      LDB(B0, 0, 0); SCHED; LDA(At, 0, 0); STAGE_A(SA(1, 1), ca1, t + 1);
      WAIT_L(8); BAR; WAIT_L(0); MMA(0, 0, At, B0); BAR; SCHED;
      LDB(B1, 0, 1); STAGE_B(SB(0, 0), b2h0, q0, k2);
      BAR; WAIT_L(0); MMA(0, 1, At, B1); BAR;
      LDA(At, 0, 1); STAGE_A(SA(0, 0), a2h0, k2);
      BAR; WAIT_L(0); MMA(1, 0, At, B0); BAR; SCHED;
      STAGE_B(SB(0, 1), b2h1, q1, k2);
      WAIT_V(6); BAR; MMA(1, 1, At, B1); BAR;
      LDB(B0, 1, 0); SCHED; LDA(At, 1, 0); STAGE_A(SA(0, 1), a2h1, k2);
      WAIT_L(8); BAR; WAIT_L(0); MMA(0, 0, At, B0); BAR; SCHED;
      LDB(B1, 1, 1); STAGE_B(SB(1, 0), b2h0, q0, k2 + 1);
      BAR; WAIT_L(0); MMA(0, 1, At, B1); BAR;
      LDA(At, 1, 1); STAGE_A(SA(1, 0), a2h0, k2 + 1);
      BAR; WAIT_L(0); MMA(1, 0, At, B0); BAR; SCHED;
      STAGE_B(SB(1, 1), b2h1, q1, k2 + 1);
      WAIT_V(6); BAR; MMA(1, 1, At, B1); BAR;
    }
    if constexpr (P::FP8) asm volatile("s_nop 15\n\ts_nop 15" ::: "memory");
    {
      const int t3 = tid_opaque();
      const int wid = t3 >> 6, lane = t3 & 63;
      p.epi(cur, acc, wid >> 2, wid & 3, lane & 15, lane >> 4);
    }
    if (!has_next) break;
#pragma unroll
    for (int a0 = 0; a0 < 2; ++a0)
#pragma unroll
      for (int b0 = 0; b0 < 2; ++b0)
#pragma unroll
        for (int m = 0; m < 4; ++m)
#pragma unroll
          for (int n = 0; n < 2; ++n) acc[a0][b0][m][n] = (f32x4){0.f, 0.f, 0.f, 0.f};
    cur = nxt; ca0 = na0; ca1 = na1; cb0 = nb0; cb1 = nb1;
    ob0 = nob0; ob1 = nob1;
    idx = nidx;
  }
  WAIT_V(0);
  if (!wr1) BAR;
  BAR;
#undef SA
#undef SB
#undef GLDS
#undef STAGE_A
#undef STAGE_B
#undef LDA
#undef LDB
#undef MMA
#undef FRAG_LO
#undef FRAG_HI
#undef WAIT_V
#undef WAIT_L
#undef BAR
#undef SCHED
}

#define G8_FOR_BLK(AI, BJ, M, N) \
  _Pragma("unroll") for (int AI = 0; AI < 2; ++AI) _Pragma("unroll") for (int BJ = 0; BJ < 2; ++BJ) \
  _Pragma("unroll") for (int M = 0; M < 4; ++M) _Pragma("unroll") for (int N = 0; N < 2; ++N)
#define G8_AIDX(AI, M) ((AI) * 128 + wr * 64 + fq * 16 + (M) * 4)
#define G8_BIDX(BJ, N) ((BJ) * 128 + wc * 32 + (N) * 16 + fr)
__device__ __forceinline__ u32x2 pack4_bf16(const f32x4 v) { return (u32x2){pack_bf16(v.x, v.y), pack_bf16(v.z, v.w)}; }
__device__ __forceinline__ unsigned pack4_fp8(const f32x4 v) { return pk4_fp8(v.x, v.y, v.z, v.w); }
__device__ __forceinline__ u32x4 pack8_bf16(const f32x4 a, const f32x4 b) { return (u32x4){pack_bf16(a.x, a.y), pack_bf16(a.z, a.w), pack_bf16(b.x, b.y), pack_bf16(b.z, b.w)}; }
#define G8_FOR_BLK2(AI, BJ, M2, N) \
  _Pragma("unroll") for (int AI = 0; AI < 2; ++AI) _Pragma("unroll") for (int BJ = 0; BJ < 2; ++BJ) \
  _Pragma("unroll") for (int M2 = 0; M2 < 4; M2 += 2) _Pragma("unroll") for (int N = 0; N < 2; ++N)

struct G8InZT {
  static constexpr int NKT = 16; static constexpr bool B_GATHER = false; static constexpr bool FP8 = false; static constexpr int B_PITCH = D; static constexpr int A_PITCH = D;
  template <class C_> __device__ unsigned b_row(const C_&, int, int) const { return 0u; }
  struct Ctx { int t0, z0; };
  const bf16* wt; const bf16* A; bf16* zt; int ntok;
  __device__ int ntiles() const { return 6 * (ntok / 256); }
  __device__ void tile(int idx, Ctx& c) const { int tt = idx / 6; c.z0 = (idx - tt * 6) * 256; c.t0 = tt * 256; }
  __device__ const bf16* a_base(const Ctx& c, int h) const { return A + (size_t)(c.t0 + h * 128) * D; }
  __device__ unsigned a_off(const Ctx&, int, int r) const { return r * D; }
  __device__ const bf16* b_base(const Ctx& c, int h) const { return wt + (size_t)(c.z0 + h * 128) * D; }
  __device__ unsigned b_off(const Ctx&, int, int r) const { return r * D; }
  __device__ void epi(const Ctx& c, g8acc_t& acc, int wr, int wc, int fr, int fq) const {
    G8_FOR_BLK2(ai, bj, m, n) {
      const int tok = c.t0 + G8_AIDX(ai, m), z = c.z0 + G8_BIDX(bj, n);
      *(u32x4*)(zt + (size_t)z * NT + tok) = pack8_bf16(acc[ai][bj][m][n], acc[ai][bj][m + 1][n]);
    }
  }
};
struct G8InG {
  static constexpr int NKT = 8; static constexpr bool B_GATHER = false; static constexpr bool FP8 = true; static constexpr int B_PITCH = D / 2; static constexpr int A_PITCH = D / 2;
  template <class C_> __device__ unsigned b_row(const C_&, int, int) const { return 0u; }
  struct Ctx { int c0, t0; };
  const unsigned char* wt; const unsigned char* A; bf16* zg;
  __device__ int ntiles() const { return 7 * (NT / 256); }
  __device__ void tile(int idx, Ctx& c) const { int tt = idx / 7; c.t0 = tt * 256; c.c0 = (idx - tt * 7) * 256; }
  __device__ const bf16* a_base(const Ctx& c, int h) const { return (const bf16*)(wt + (size_t)(c.c0 + h * 128) * D); }
  __device__ unsigned a_off(const Ctx&, int, int r) const { return r * (D / 2); }
  __device__ const bf16* b_base(const Ctx& c, int h) const { return (const bf16*)(A + (size_t)(c.t0 + h * 128) * D); }
  __device__ unsigned b_off(const Ctx&, int, int r) const { return r * (D / 2); }
  __device__ void epi(const Ctx& c, g8acc_t& acc, int wr, int wc, int fr, int fq) const {
    const float isc = 1.0f / 16.0f;
    G8_FOR_BLK2(ai, bj, m, n) {
      const int col = c.c0 + G8_AIDX(ai, m), tok = c.t0 + G8_BIDX(bj, n);
      if (col < GLACOLS) *(u32x4*)(zg + (size_t)tok * GLACOLS + col) = pack8_bf16(acc[ai][bj][m][n] * isc, acc[ai][bj][m + 1][n] * isc);
    }
  }
};
struct G8Out {
  static constexpr int NKT = 16; static constexpr bool B_GATHER = false; static constexpr bool FP8 = false; static constexpr int B_PITCH = D; static constexpr int A_PITCH = D;
  template <class C_> __device__ unsigned b_row(const C_&, int, int) const { return 0u; }
  struct Ctx { int c0, t0; };
  int mrows; const bf16* ymix; const bf16* wt; const float* modl; bf16* xs;
  __device__ int ntiles() const { return (mrows / 256) * 4; }
  __device__ void tile(int idx, Ctx& c) const { c.t0 = (idx >> 2) * 256; c.c0 = (idx & 3) * 256; }
  __device__ const bf16* a_base(const Ctx& c, int h) const { return wt + (size_t)(c.c0 + h * 128) * D; }
  __device__ unsigned a_off(const Ctx&, int, int r) const { return r * D; }
  __device__ const bf16* b_base(const Ctx& c, int h) const { return ymix + (size_t)(c.t0 + h * 128) * D; }
  __device__ unsigned b_off(const Ctx&, int, int r) const { return r * D; }
  __device__ void epi(const Ctx& c, g8acc_t& acc, int wr, int wc, int fr, int fq) const {
    const float* g1 = modl + (size_t)row_batch(c.t0) * 6 * D + 2 * D;
#pragma unroll
    for (int ai = 0; ai < 2; ++ai)
#pragma unroll
      for (int bj = 0; bj < 2; ++bj)
#pragma unroll
        for (int n = 0; n < 2; ++n) {
          const int col = c.c0 + G8_AIDX(ai, 0), tok = c.t0 + G8_BIDX(bj, n);
          bf16* xp = xs + (size_t)tok * D + col;
          const u32x4 w0 = *(const u32x4*)xp, w1 = *(const u32x4*)(xp + 8);
          const f32x4 r0 = (f32x4){__uint_as_float(w0.x << 16), __uint_as_float(w0.x & 0xffff0000u), __uint_as_float(w0.y << 16), __uint_as_float(w0.y & 0xffff0000u)} + *(const f32x4*)(g1 + col) * acc[ai][bj][0][n];
          const f32x4 r1 = (f32x4){__uint_as_float(w0.z << 16), __uint_as_float(w0.z & 0xffff0000u), __uint_as_float(w0.w << 16), __uint_as_float(w0.w & 0xffff0000u)} + *(const f32x4*)(g1 + col + 4) * acc[ai][bj][1][n];
          const f32x4 r2 = (f32x4){__uint_as_float(w1.x << 16), __uint_as_float(w1.x & 0xffff0000u), __uint_as_float(w1.y << 16), __uint_as_float(w1.y & 0xffff0000u)} + *(const f32x4*)(g1 + col + 8) * acc[ai][bj][2][n];
          const f32x4 r3 = (f32x4){__uint_as_float(w1.z << 16), __uint_as_float(w1.z & 0xffff0000u), __uint_as_float(w1.w << 16), __uint_as_float(w1.w & 0xffff0000u)} + *(const f32x4*)(g1 + col + 12) * acc[ai][bj][3][n];
          *(u32x4*)xp = (u32x4){pack_bf16(r0.x, r0.y), pack_bf16(r0.z, r0.w), pack_bf16(r1.x, r1.y), pack_bf16(r1.z, r1.w)};
          *(u32x4*)(xp + 8) = (u32x4){pack_bf16(r2.x, r2.y), pack_bf16(r2.z, r2.w), pack_bf16(r3.x, r3.y), pack_bf16(r3.z, r3.w)};
        }
  }
};
struct G8Router {
  static constexpr int NKT = 16; static constexpr bool B_GATHER = false; static constexpr bool FP8 = false; static constexpr int B_PITCH = D; static constexpr int A_PITCH = D;
  template <class C_> __device__ unsigned b_row(const C_&, int, int) const { return 0u; }
  struct Ctx { int t0; };
  int mrows; const bf16* A; const bf16* rwt; float* logits;
  __device__ int ntiles() const { return mrows / 256; }
  __device__ void tile(int idx, Ctx& c) const { c.t0 = idx * 256; }
  __device__ const bf16* a_base(const Ctx&, int h) const { return rwt + (size_t)(h * 128) * D; }
  __device__ unsigned a_off(const Ctx&, int, int r) const { return r * D; }
  __device__ const bf16* b_base(const Ctx& c, int h) const { return A + (size_t)(c.t0 + h * 128) * D; }
  __device__ unsigned b_off(const Ctx&, int, int r) const { return r * D; }
  __device__ void epi(const Ctx& c, g8acc_t& acc, int wr, int wc, int fr, int fq) const {
    G8_FOR_BLK(ai, bj, m, n) {
      const int e = G8_AIDX(ai, m), tok = c.t0 + G8_BIDX(bj, n);
      *(f32x4*)(logits + (size_t)tok * NE + e) = acc[ai][bj][m][n];
    }
  }
};
struct G8ShUp {
  static constexpr int NKT = 8; static constexpr bool B_GATHER = false; static constexpr bool FP8 = true; static constexpr int B_PITCH = D / 2; static constexpr int A_PITCH = D / 2;
  template <class C_> __device__ unsigned b_row(const C_&, int, int) const { return 0u; }
  struct Ctx { int t0, hb; };
  int mrows; const unsigned char* A8; const unsigned char* s1t; const unsigned char* s3t; unsigned char* hs;
  __device__ int ntiles() const { return (mrows / 256) * 2; }
  __device__ void tile(int idx, Ctx& c) const { c.t0 = (idx >> 1) * 256; c.hb = (idx & 1) * 128; }
  __device__ const bf16* a_base(const Ctx& c, int h) const { return (const bf16*)((h ? s3t : s1t) + (size_t)c.hb * D); }
  __device__ unsigned a_off(const Ctx&, int, int r) const { return r * (D / 2); }
  __device__ const bf16* b_base(const Ctx& c, int h) const { return (const bf16*)(A8 + (size_t)(c.t0 + h * 128) * D); }
  __device__ unsigned b_off(const Ctx&, int, int r) const { return r * (D / 2); }
  __device__ void epi(const Ctx& c, g8acc_t& acc, int wr, int wc, int fr, int fq) const {
    const float isc = 1.0f / 16.0f;
#pragma unroll
    for (int bj = 0; bj < 2; ++bj)
#pragma unroll
      for (int n = 0; n < 2; ++n) {
        const int hcol = c.hb + wr * 64 + fq * 16, tok = c.t0 + G8_BIDX(bj, n);
        u32x4 o;
#pragma unroll
        for (int m = 0; m < 4; ++m) {
          const f32x4 u = acc[0][bj][m][n] * isc, v = acc[1][bj][m][n] * isc;
          const unsigned w = pk4_fp8(silu_f(u.x) * v.x, silu_f(u.y) * v.y, silu_f(u.z) * v.z, silu_f(u.w) * v.w);
          if (m == 0) o.x = w; else if (m == 1) o.y = w; else if (m == 2) o.z = w; else o.w = w;
        }
        *(u32x4*)(hs + (size_t)tok * DE + hcol) = o;
      }
  }
};
struct G8Up {
  static constexpr int NKT = 8; static constexpr bool B_GATHER = true; static constexpr bool FP8 = true; static constexpr int B_PITCH = D / 2; static constexpr int A_PITCH = D / 2;
  struct Ctx { int s0, hb, grp; };
  const unsigned char* A8; const int* slot_tok; const int* pad_start; const unsigned char* w1t; const unsigned char* w3t; unsigned char* H; const unsigned short* tile_e;
  __device__ int ntiles() const { return (pad_start[NE] >> 8) * 2; }
  __device__ void tile(int idx, Ctx& c) const { c.s0 = (idx >> 1) * 256; c.hb = (idx & 1) * 128; c.grp = __builtin_amdgcn_readfirstlane((int)tile_e[idx >> 1]); }
  __device__ const bf16* a_base(const Ctx& c, int h) const { return (const bf16*)((h ? w3t : w1t) + ((size_t)c.grp * DE + c.hb) * D); }
  __device__ unsigned a_off(const Ctx&, int, int r) const { return r * (D / 2); }
  __device__ const bf16* b_base(const Ctx&, int) const { return (const bf16*)A8; }
  __device__ unsigned b_off(const Ctx&, int, int) const { return 0u; }
  __device__ unsigned b_row(const Ctx& c, int h, int r) const { int t = slot_tok[c.s0 + h * 128 + r]; t = (t < 0 || t >= NT) ? 0 : t; return (unsigned)t; }
  __device__ void epi(const Ctx& c, g8acc_t& acc, int wr, int wc, int fr, int fq) const {
    const float isc = 1.0f / 16.0f;
#pragma unroll
    for (int bj = 0; bj < 2; ++bj)
#pragma unroll
      for (int n = 0; n < 2; ++n) {
        const int hcol = c.hb + wr * 64 + fq * 16, slot = c.s0 + G8_BIDX(bj, n);
        u32x4 o;
#pragma unroll
        for (int m = 0; m < 4; ++m) {
          const f32x4 u = acc[0][bj][m][n] * isc, v = acc[1][bj][m][n] * isc;
          const unsigned w = pk4_fp8(silu_f(u.x) * v.x, silu_f(u.y) * v.y, silu_f(u.z) * v.z, silu_f(u.w) * v.w);
          if (m == 0) o.x = w; else if (m == 1) o.y = w; else if (m == 2) o.z = w; else o.w = w;
        }
        *(u32x4*)(H + (size_t)slot * DE + hcol) = o;
      }
  }
};
struct G8ShDown {
  static constexpr int NKT = 2; static constexpr bool B_GATHER = false; static constexpr bool FP8 = true; static constexpr int B_PITCH = DE / 2; static constexpr int A_PITCH = DE / 2;
  template <class C_> __device__ unsigned b_row(const C_&, int, int) const { return 0u; }
  struct Ctx { int c0, t0; };
  int mrows; const unsigned char* hs; const unsigned char* wt; unsigned char* ysh;
  __device__ int ntiles() const { return (mrows / 256) * 4; }
  __device__ void tile(int idx, Ctx& c) const { c.t0 = (idx >> 2) * 256; c.c0 = (idx & 3) * 256; }
  __device__ const bf16* a_base(const Ctx& c, int h) const { return (const bf16*)(wt + (size_t)(c.c0 + h * 128) * DE); }
  __device__ unsigned a_off(const Ctx&, int, int r) const { return r * (DE / 2); }
  __device__ const bf16* b_base(const Ctx& c, int h) const { return (const bf16*)(hs + (size_t)(c.t0 + h * 128) * DE); }
  __device__ unsigned b_off(const Ctx&, int, int r) const { return r * (DE / 2); }
  __device__ void epi(const Ctx& c, g8acc_t& acc, int wr, int wc, int fr, int fq) const {
    const float isc = 1.0f / 16.0f;
#pragma unroll
    for (int ai = 0; ai < 2; ++ai)
#pragma unroll
      for (int bj = 0; bj < 2; ++bj)
#pragma unroll
        for (int n = 0; n < 2; ++n) {
          const int col = c.c0 + G8_AIDX(ai, 0), tok = c.t0 + G8_BIDX(bj, n);
          u32x4 o;
          o.x = pack4_fp8(acc[ai][bj][0][n] * isc); o.y = pack4_fp8(acc[ai][bj][1][n] * isc);
          o.z = pack4_fp8(acc[ai][bj][2][n] * isc); o.w = pack4_fp8(acc[ai][bj][3][n] * isc);
          *(u32x4*)(ysh + (size_t)tok * D + col) = o;
        }
  }
};
struct G8Down {
  static constexpr int NKT = 2; static constexpr bool B_GATHER = false; static constexpr bool FP8 = true; static constexpr int B_PITCH = DE / 2; static constexpr int A_PITCH = DE / 2;
  struct Ctx { int c0, s0, grp; };
  const unsigned char* H; const int* pad_start; const unsigned char* w2t; unsigned char* Y; const unsigned short* tile_e;
  template <class C_> __device__ unsigned b_row(const C_&, int, int) const { return 0u; }
  __device__ int ntiles() const { return (pad_start[NE] >> 8) * 4; }
  __device__ void tile(int idx, Ctx& c) const { c.s0 = (idx >> 2) * 256; c.c0 = (idx & 3) * 256; c.grp = __builtin_amdgcn_readfirstlane((int)tile_e[idx >> 2]); }
  __device__ const bf16* a_base(const Ctx& c, int h) const { return (const bf16*)(w2t + ((size_t)c.grp * D + c.c0 + h * 128) * DE); }
  __device__ unsigned a_off(const Ctx&, int, int r) const { return r * (DE / 2); }
  __device__ const bf16* b_base(const Ctx& c, int h) const { return (const bf16*)(H + (size_t)(c.s0 + h * 128) * DE); }
  __device__ unsigned b_off(const Ctx&, int, int r) const { return r * (DE / 2); }
  __device__ void epi(const Ctx& c, g8acc_t& acc, int wr, int wc, int fr, int fq) const {
    const float isc = 1.0f / 16.0f;
#pragma unroll
    for (int ai = 0; ai < 2; ++ai)
#pragma unroll
      for (int bj = 0; bj < 2; ++bj)
#pragma unroll
        for (int n = 0; n < 2; ++n) {
          const int col = c.c0 + G8_AIDX(ai, 0), slot = c.s0 + G8_BIDX(bj, n);
          u32x4 o;
          o.x = pack4_fp8(acc[ai][bj][0][n] * isc); o.y = pack4_fp8(acc[ai][bj][1][n] * isc);
          o.z = pack4_fp8(acc[ai][bj][2][n] * isc); o.w = pack4_fp8(acc[ai][bj][3][n] * isc);
          *(u32x4*)(Y + (size_t)slot * D + col) = o;
        }
  }
};

constexpr int CVT_TILES = 3 * NE * 128;
struct CvtCtx { const float* w1; const float* w3; const float* w2; unsigned char* d1; unsigned char* d3; unsigned char* d2; };
struct CvtRegs { int pend; f32x4 r0, r1, r2, r3, r4, r5, r6, r7; };
__device__ __forceinline__ void cvt_locate(const CvtCtx& js, int u, int lane, const float*& s, unsigned char*& d, int& K, int& N) {
  const int job = u >> 15, r = u & 32767, mat = r >> 7, rr = r & 127;
  int kt, ntile;
  if (job < 2) { K = D; N = DE; ntile = rr >> 4; kt = rr & 15; } else { K = DE; N = D; ntile = rr >> 2; kt = rr & 3; }
  const float* s1 = js.w1; const float* s3 = js.w3; const float* s2 = js.w2;
  unsigned char* q1 = js.d1; unsigned char* q3 = js.d3; unsigned char* q2 = js.d2;
  const float* sb = job == 0 ? s1 : (job == 1 ? s3 : s2);
  unsigned char* db = job == 0 ? q1 : (job == 1 ? q3 : q2);
  const int k0 = kt * 64 + (lane & 7) * 8, n0 = ntile * 32 + (lane >> 3) * 4;
  s = sb + (size_t)mat * D * DE + (size_t)k0 * N + n0;
  d = db + (size_t)mat * D * DE + (size_t)n0 * K + k0;
}
__device__ __forceinline__ void cvt_init(CvtRegs& st) {
  st.pend = -1;
  st.r0 = st.r1 = st.r2 = st.r3 = st.r4 = st.r5 = st.r6 = st.r7 = (f32x4){0.f, 0.f, 0.f, 0.f};
}
__device__ __forceinline__ void cvt_finish(const CvtCtx& cx, CvtRegs& st, int lane) {
  if (st.pend < 0) return;
  const float* s; unsigned char* d; int K, N;
  cvt_locate(cx, st.pend, lane, s, d, K, N);
  const float sc = 16.0f;
  const f32x4 v0 = st.r0 * sc, v1 = st.r1 * sc, v2 = st.r2 * sc, v3 = st.r3 * sc, v4 = st.r4 * sc, v5 = st.r5 * sc, v6 = st.r6 * sc, v7 = st.r7 * sc;
  *(u32x2*)(d) = (u32x2){pk4_fp8(v0.x, v1.x, v2.x, v3.x), pk4_fp8(v4.x, v5.x, v6.x, v7.x)};
  *(u32x2*)(d + (size_t)K) = (u32x2){pk4_fp8(v0.y, v1.y, v2.y, v3.y), pk4_fp8(v4.y, v5.y, v6.y, v7.y)};
  *(u32x2*)(d + (size_t)2 * K) = (u32x2){pk4_fp8(v0.z, v1.z, v2.z, v3.z), pk4_fp8(v4.z, v5.z, v6.z, v7.z)};
  *(u32x2*)(d + (size_t)3 * K) = (u32x2){pk4_fp8(v0.w, v1.w, v2.w, v3.w), pk4_fp8(v4.w, v5.w, v6.w, v7.w)};
  st.pend = -1;
}
constexpr int CVT_GLA_TILES = 128 * 36 * 2 * 8;
static_assert(CVT_GLA_TILES + 512 * 2 * 3 * 8 == CVT_TILES, "tile ownership must cover every tile exactly once");
__device__ __forceinline__ void cvt_step(const CvtCtx& cx, CvtRegs& st, int lane, int u) {
  cvt_finish(cx, st, lane);
  const float* s; unsigned char* d; int K, N;
  cvt_locate(cx, u, lane, s, d, K, N);
  st.r0 = __builtin_nontemporal_load((const f32x4*)(s));
  st.r1 = __builtin_nontemporal_load((const f32x4*)(s + (size_t)N));
  st.r2 = __builtin_nontemporal_load((const f32x4*)(s + (size_t)2 * N));
  st.r3 = __builtin_nontemporal_load((const f32x4*)(s + (size_t)3 * N));
  st.r4 = __builtin_nontemporal_load((const f32x4*)(s + (size_t)4 * N));
  st.r5 = __builtin_nontemporal_load((const f32x4*)(s + (size_t)5 * N));
  st.r6 = __builtin_nontemporal_load((const f32x4*)(s + (size_t)6 * N));
  st.r7 = __builtin_nontemporal_load((const f32x4*)(s + (size_t)7 * N));
  st.pend = u;
}

constexpr int UST = 2056;
constexpr int HY_U_BYTES = 16 * UST * 2;
constexpr int TCOPY = 2064;
constexpr int HY_T_BYTES = 4 * TCOPY * 4;
constexpr int HY_LDS = HY_U_BYTES + HY_T_BYTES;
constexpr int USTC = 264;
constexpr int TCOPYC = 264;

__device__ __forceinline__ f32x4 mfma16(bf16x8 a, bf16x8 b, f32x4 c) {
  return __builtin_amdgcn_mfma_f32_16x16x32_bf16(a, b, c, 0, 0, 0);
}
__device__ __forceinline__ float bflo(unsigned v) { return __uint_as_float(v << 16); }
__device__ __forceinline__ float bfhi(unsigned v) { return __uint_as_float(v & 0xffff0000u); }
__device__ __forceinline__ float ldbf(const bf16* p) { return bf2f(*p); }

template <int GSTR, int TCP>
__device__ __forceinline__ void hy_load_tables(const bf16* __restrict__ G, int c, unsigned* T) {
  constexpr int NCH = GSTR / 8;
  for (int q = tid_opaque(); q < 2 * NCH; q += 512) {
    int o = q / NCH, ch = q - o * NCH;
    const unsigned* s32 = (const unsigned*)(G + ((size_t)(o * 512 + c)) * GSTR);
    u32x4 a = *(const u32x4*)(s32 + 4 * ch);
    unsigned nx = (ch + 1 < NCH) ? s32[4 * ch + 4] : 0u;
    unsigned* d0 = T + o * 2 * TCP;
    unsigned* d1 = d0 + TCP;
    *(u32x4*)(d0 + 4 * ch) = a;
    u32x4 b;
    b.x = (a.x >> 16) | (a.y << 16); b.y = (a.y >> 16) | (a.z << 16); b.z = (a.z >> 16) | (a.w << 16); b.w = (a.w >> 16) | (nx << 16);
    *(u32x4*)(d1 + 4 * ch) = b;
  }
}

template <int L, int USTR>
__device__ __forceinline__ void hy_load_u(const bf16* __restrict__ z, float w0, float w1, float w2, float bb, bf16* U) {
  constexpr int CPB = L / 8;
  for (int q = tid_opaque(); q < 16 * CPB; q += 512) {
    int b = q / CPB, t8 = (q - b * CPB) * 8;
    const bf16* zr = z + (size_t)b * L + t8;
    u32x4 v = *(const u32x4*)zr;
    float zm = t8 > 0 ? ldbf(zr - 1) : 0.f;
    float zp = t8 + 8 < L ? ldbf(zr + 8) : 0.f;
    float e0 = bflo(v.x), e1 = bfhi(v.x), e2 = bflo(v.y), e3 = bfhi(v.y), e4 = bflo(v.z), e5 = bfhi(v.z), e6 = bflo(v.w), e7 = bfhi(v.w);
    u32x4 o;
    o.x = pack_bf16(w0 * zm + w1 * e0 + w2 * e1 + bb, w0 * e0 + w1 * e1 + w2 * e2 + bb);
    o.y = pack_bf16(w0 * e1 + w1 * e2 + w2 * e3 + bb, w0 * e2 + w1 * e3 + w2 * e4 + bb);
    o.z = pack_bf16(w0 * e3 + w1 * e4 + w2 * e5 + bb, w0 * e4 + w1 * e5 + w2 * e6 + bb);
    o.w = pack_bf16(w0 * e5 + w1 * e6 + w2 * e7 + bb, w0 * e6 + w1 * e7 + w2 * zp + bb);
    *(u32x4*)(U + b * USTR + t8) = o;
  }
}

template <int L>
__device__ __forceinline__ void hy_gate4(const bf16* __restrict__ zr, int t0, float w0, float w1, float w2, float bb, float (&x)[4]) {
  u32x2 v = *(const u32x2*)(zr + t0);
  float zm = t0 > 0 ? ldbf(zr + t0 - 1) : 0.f;
  float zp = t0 + 4 < L ? ldbf(zr + t0 + 4) : 0.f;
  float e0 = bflo(v.x), e1 = bfhi(v.x), e2 = bflo(v.y), e3 = bfhi(v.y);
  x[0] = w0 * zm + w1 * e0 + w2 * e1 + bb;
  x[1] = w0 * e0 + w1 * e1 + w2 * e2 + bb;
  x[2] = w0 * e1 + w1 * e2 + w2 * e3 + bb;
  x[3] = w0 * e2 + w1 * e3 + w2 * zp + bb;
}

__device__ __forceinline__ bf16x8 hy_frag(const unsigned* p) {
  u32x4 v; v.x = p[0]; v.y = p[1]; v.z = p[2]; v.w = p[3];
  return __builtin_bit_cast(bf16x8, v);
}

__device__ __forceinline__ void hyena_latent(int c, const bf16* __restrict__ zt, const float* __restrict__ cw,
                                             const float* __restrict__ cb, const bf16* __restrict__ G,
                                             bf16* __restrict__ yt, char* smem, const CvtCtx& cx) {
  const int tid = tid_opaque(), lane = tid & 63, wave = tid >> 6;
  bf16* U = (bf16*)smem;
  unsigned* T = (unsigned*)(smem + HY_U_BYTES);
  __syncthreads();
  hy_load_tables<GSTR_L, TCOPY>(G, c, T);
  hy_load_u<SEQ, UST>(zt + (size_t)c * NT, cw[c], cw[HYCOLS + c], cw[2 * HYCOLS + c], cb[c], U);
  __syncthreads();
  const int r = lane & 15, kg = lane >> 4;
  const int par = (r + 1) & 1;
  const int base_dw = 1023 - (r >> 1) + 4 * kg - 128 * wave;
  const char* ub = smem + (r * UST + 8 * kg) * 2;
  const int tw = wave * 256;
#pragma unroll 1
  for (int order = 0; order < 2; ++order) {
    const unsigned* tb = T + order * 2 * TCOPY + par * TCOPY + base_dw;
    f32x4 acc[16];
#pragma unroll
    for (int i = 0; i < 16; ++i) acc[i] = (f32x4){0.f, 0.f, 0.f, 0.f};
    bf16x8 W[16];
#pragma unroll
    for (int f = -15; f <= 0; ++f) W[f & 15] = hy_frag(tb + 8 * f);
    CvtRegs cr; cvt_init(cr);
    const int wv = __builtin_amdgcn_readfirstlane(wave);
#pragma unroll 1
    for (int J = 0; J < 8; ++J) {
      const unsigned* tj = tb + 128 * J;
      const char* uj = ub + 512 * J;
#pragma unroll
      for (int jj = 0; jj < 8; ++jj) {
        if (jj == 0 && (J == 0 || J == 3 || J == 6)) cvt_step(cx, cr, lane, CVT_GLA_TILES + ((c * 2 + order) * 3 + J / 3) * 8 + wv);
        bf16x8 uf = *(const bf16x8*)(uj + 64 * jj);
        acc[15] = mfma16(W[(2 * jj - 15) & 15], uf, acc[15]);
        acc[14] = mfma16(W[(2 * jj - 14) & 15], uf, acc[14]);
        if (J * 8 + jj < 63) {
          W[(2 * jj + 1) & 15] = hy_frag(tj + 8 * (2 * jj + 1));
          W[(2 * jj + 2) & 15] = hy_frag(tj + 8 * (2 * jj + 2));
        }
#pragma unroll
        for (int i = 13; i >= 0; --i) acc[i] = mfma16(W[(2 * jj - i) & 15], uf, acc[i]);
      }
    }
    cvt_finish(cx, cr, lane);
    __syncthreads();
    {
      const int col = (order + 1) * 512 + c;
      const float w0 = cw[col], w1 = cw[HYCOLS + col], w2 = cw[2 * HYCOLS + col], bb = cb[col];
      const bf16* zr = zt + (size_t)col * NT + (size_t)r * SEQ;
      u32x2 gv[16]; unsigned gm[16], gp[16];
#pragma unroll
      for (int i = 0; i < 16; ++i) {
        const int t0 = tw + 16 * i + 4 * kg;
        gv[i] = *(const u32x2*)(zr + t0);
        gm[i] = t0 > 0 ? (unsigned)*(const unsigned short*)(zr + t0 - 1) : 0u;
        gp[i] = t0 + 4 < SEQ ? (unsigned)*(const unsigned short*)(zr + t0 + 4) : 0u;
      }
#pragma unroll
      for (int i = 0; i < 16; ++i) {
        const int t0 = tw + 16 * i + 4 * kg;
        const float zm = __uint_as_float(gm[i] << 16), zp = __uint_as_float(gp[i] << 16);
        const float e0 = bflo(gv[i].x), e1 = bfhi(gv[i].x), e2 = bflo(gv[i].y), e3 = bfhi(gv[i].y);
        const float x0 = w0 * zm + w1 * e0 + w2 * e1 + bb, x1 = w0 * e0 + w1 * e1 + w2 * e2 + bb;
        const float x2 = w0 * e1 + w1 * e2 + w2 * e3 + bb, x3 = w0 * e2 + w1 * e3 + w2 * zp + bb;
        u32x2 o;
        o.x = pack_bf16(x0 * acc[i][0], x1 * acc[i][1]);
        o.y = pack_bf16(x2 * acc[i][2], x3 * acc[i][3]);
        *(u32x2*)(U + r * UST + t0) = o;
      }
    }
    __syncthreads();
  }
  for (int q = tid; q < 16 * 256; q += 512) {
    int b = q >> 8, t8 = (q & 255) * 8;
    *(u32x4*)(yt + (size_t)c * NT + (size_t)b * SEQ + t8) = *(const u32x4*)(U + b * UST + t8);
  }
}

__device__ __forceinline__ void hyena_ctx(int c, const bf16* __restrict__ zt, const float* __restrict__ cw,
                                          const float* __restrict__ cb, const bf16* __restrict__ G,
                                          bf16* __restrict__ yt, char* smem) {
  const int tid = tid_opaque(), lane = tid & 63, wave = tid >> 6;
  bf16* U = (bf16*)smem;
  unsigned* T = (unsigned*)(smem + HY_U_BYTES);
  __syncthreads();
  hy_load_tables<GSTR_C, TCOPYC>(G, c, T);
  hy_load_u<LC, USTC>(zt + (size_t)c * NT, cw[c], cw[HYCOLS + c], cw[2 * HYCOLS + c], cb[c], U);
  __syncthreads();
  const int r = lane & 15, kg = lane >> 4;
  const int par = (r + 1) & 1;
  const int base_dw = (8 * kg - r + 255 - par) >> 1;
  const char* ub = smem + (r * USTC + 8 * kg) * 2;
#pragma unroll 1
  for (int order = 0; order < 2; ++order) {
    const unsigned* tb = T + order * 2 * TCOPYC + par * TCOPYC + base_dw;
    f32x4 acc[2];
    acc[0] = (f32x4){0.f, 0.f, 0.f, 0.f};
    acc[1] = acc[0];
#pragma unroll
    for (int j = 0; j < 8; ++j) {
      bf16x8 uf = *(const bf16x8*)(ub + 64 * j);
#pragma unroll
      for (int ii = 0; ii < 2; ++ii) {
        const int i = wave * 2 + ii;
        acc[ii] = mfma16(hy_frag(tb + 16 * j - 8 * i), uf, acc[ii]);
      }
    }
    __syncthreads();
    {
      const int col = (order + 1) * 512 + c;
      const float w0 = cw[col], w1 = cw[HYCOLS + col], w2 = cw[2 * HYCOLS + col], bb = cb[col];
      const bf16* zr = zt + (size_t)col * NT + (size_t)r * LC;
#pragma unroll
      for (int ii = 0; ii < 2; ++ii) {
        const int t0 = (wave * 2 + ii) * 16 + 4 * kg;
        float x[4];
        hy_gate4<LC>(zr, t0, w0, w1, w2, bb, x);
        u32x2 o;
        o.x = pack_bf16(x[0] * acc[ii][0], x[1] * acc[ii][1]);
        o.y = pack_bf16(x[2] * acc[ii][2], x[3] * acc[ii][3]);
        *(u32x2*)(U + r * USTC + t0) = o;
      }
    }
    __syncthreads();
  }
  {
    int b = tid >> 5, t8 = (tid & 31) * 8;
    *(u32x4*)(yt + (size_t)c * NT + (size_t)b * LC + t8) = *(const u32x4*)(U + b * USTC + t8);
  }
}

constexpr int GL_QE = 0, GL_KE = 8192, GL_KST = 16384, GL_ATT = 24576, GL_ST = 32768, GL_VT = 49152  ;
constexpr int GL_RAW = 81920  , GL_RAWSZ = 18432, GL_SEG = 118784, GL_DEC = 120832;
constexpr int GLA_LDS = 121088;

__device__ __forceinline__ f32x16 mfma32(bf16x8 a, bf16x8 b, f32x16 c) {
  return __builtin_amdgcn_mfma_f32_32x32x16_bf16(a, b, c, 0, 0, 0);
}
__device__ __forceinline__ unsigned short bf16bits(float v) { bf16 h = f2bf(v); return *(unsigned short*)&h; }

struct GlaArgs {
  const bf16* zg; const float* wa2; const float* ba2; bf16* of; bf16* ob; int emit_ctx; int pad_;
};

__device__ __forceinline__ void gla_unit(int unit, const GlaArgs& a, char* smem, const CvtCtx& cx) {
  const int tid = tid_opaque(), lane = tid & 63, wave = tid >> 6;
  const int dir = unit & 1, h = (unit >> 1) & 3, b = unit >> 3;
  const int lr = lane & 31, lh = lane >> 5;
  const int swl = (lr >> 1) & 7;
  bf16* outp = dir ? a.ob : a.of;
  __syncthreads();
  const int d = tid & 63, sg = tid >> 6;
  float wa[16];
#pragma unroll
  for (int r = 0; r < 16; ++r) wa[r] = a.wa2[(dir * 16 + r) * 256 + h * 64 + d];
  const float ba = a.ba2[dir * 256 + h * 64 + d];
  { unsigned zz = 0u; asm volatile("" : "+v"(zz));
    for (int q = tid; q < 16384 / 16; q += 512) *(u32x4*)(smem + GL_ST + q * 16) = (u32x4){zz, zz, zz, zz}; }
  f32x16 S;
#pragma unroll
  for (int r = 0; r < 16; ++r) S[r] = 0.f;

  const int qi = tid >> 3, qc = tid & 7;
  const int ai = (tid >> 1) & 63, ac = tid & 1;
  const int vsg = (tid >> 5) & 7, vdq = tid & 31;
  u32x4 pq, pk, pa;
  u32x2 pw0, pw1, pw2, pw3, pw4, pw5, pw6, pw7;

#define GLA_ROW(N_, I_, ROW_)                                                        \
  {                                                                                  \
    const int n_ = (N_);                                                             \
    const int Ls_ = n_ < 4 ? LC : SEQ;                                               \
    const int cn_ = n_ < 4 ? n_ : n_ - 4;                                            \
    const int rb_ = n_ < 4 ? (NL + b * LC) : (b * SEQ);                              \
    const int pos_ = cn_ * 64 + (I_);                                                \
    ROW_ = rb_ + (dir ? (Ls_ - 1 - pos_) : pos_);                                    \
  }
#define GLA_LOAD_RAW(N_)                                                             \
  {                                                                                  \
    int row_;                                                                        \
    GLA_ROW(N_, qi, row_);                                                           \
    const bf16* zr_ = a.zg + (size_t)row_ * GLACOLS;                                 \
    pq = *(const u32x4*)(zr_ + h * 64 + qc * 8);                                     \
    pk = *(const u32x4*)(zr_ + 256 + h * 64 + qc * 8);                               \
    int ra_;                                                                         \
    GLA_ROW(N_, ai, ra_);                                                            \
    pa = *(const u32x4*)(a.zg + (size_t)ra_ * GLACOLS + 1536 + dir * 16 + ac * 8);   \
  }
#define GLA_LOAD_V(N_)                                                               \
  {                                                                                  \
    int rv_;                                                                         \
    GLA_ROW(N_, vsg * 8 + 0, rv_); pw0 = *(const u32x2*)(a.zg + (size_t)rv_ * GLACOLS + 512 + h * 128 + vdq * 4); \
    GLA_ROW(N_, vsg * 8 + 1, rv_); pw1 = *(const u32x2*)(a.zg + (size_t)rv_ * GLACOLS + 512 + h * 128 + vdq * 4); \
    GLA_ROW(N_, vsg * 8 + 2, rv_); pw2 = *(const u32x2*)(a.zg + (size_t)rv_ * GLACOLS + 512 + h * 128 + vdq * 4); \
    GLA_ROW(N_, vsg * 8 + 3, rv_); pw3 = *(const u32x2*)(a.zg + (size_t)rv_ * GLACOLS + 512 + h * 128 + vdq * 4); \
    GLA_ROW(N_, vsg * 8 + 4, rv_); pw4 = *(const u32x2*)(a.zg + (size_t)rv_ * GLACOLS + 512 + h * 128 + vdq * 4); \
    GLA_ROW(N_, vsg * 8 + 5, rv_); pw5 = *(const u32x2*)(a.zg + (size_t)rv_ * GLACOLS + 512 + h * 128 + vdq * 4); \
    GLA_ROW(N_, vsg * 8 + 6, rv_); pw6 = *(const u32x2*)(a.zg + (size_t)rv_ * GLACOLS + 512 + h * 128 + vdq * 4); \
    GLA_ROW(N_, vsg * 8 + 7, rv_); pw7 = *(const u32x2*)(a.zg + (size_t)rv_ * GLACOLS + 512 + h * 128 + vdq * 4); \
  }
#define GLA_STORE_RAW(RB_)                                                           \
  {                                                                                  \
    char* rw_ = smem + GL_RAW + (RB_) * GL_RAWSZ;                                    \
    *(u32x4*)(rw_ + qi * 128 + qc * 16) = pq;                                        \
    *(u32x4*)(rw_ + 8192 + qi * 128 + qc * 16) = pk;                                 \
    if (tid < 128) *(u32x4*)(rw_ + 16384 + ai * 32 + ac * 16) = pa;                  \
  }
#define GLA_STORE_V(VB_)                                                             \
  if (tid < 256) {                                                                   \
    char* vt_ = smem + GL_VT + (VB_) * 16384;                                        \
    u32x4 o;                                                                         \
    o.x = (pw0.x & 0xffffu) | (pw1.x << 16); o.y = (pw2.x & 0xffffu) | (pw3.x << 16); o.z = (pw4.x & 0xffffu) | (pw5.x << 16); o.w = (pw6.x & 0xffffu) | (pw7.x << 16); \
    *(u32x4*)(vt_ + swz(vdq * 4 + 0, vsg)) = o;                                      \
    o.x = (pw0.x >> 16) | (pw1.x & 0xffff0000u); o.y = (pw2.x >> 16) | (pw3.x & 0xffff0000u); o.z = (pw4.x >> 16) | (pw5.x & 0xffff0000u); o.w = (pw6.x >> 16) | (pw7.x & 0xffff0000u); \
    *(u32x4*)(vt_ + swz(vdq * 4 + 1, vsg)) = o;                                      \
    o.x = (pw0.y & 0xffffu) | (pw1.y << 16); o.y = (pw2.y & 0xffffu) | (pw3.y << 16); o.z = (pw4.y & 0xffffu) | (pw5.y << 16); o.w = (pw6.y & 0xffffu) | (pw7.y << 16); \
    *(u32x4*)(vt_ + swz(vdq * 4 + 2, vsg)) = o;                                      \
    o.x = (pw0.y >> 16) | (pw1.y & 0xffff0000u); o.y = (pw2.y >> 16) | (pw3.y & 0xffff0000u); o.z = (pw4.y >> 16) | (pw5.y & 0xffff0000u); o.w = (pw6.y >> 16) | (pw7.y & 0xffff0000u); \
    *(u32x4*)(vt_ + swz(vdq * 4 + 3, vsg)) = o;                                      \
  }
#define GLA_STEP3(RB_)                                                               \
  {                                                                                  \
    const char* ra_ = smem + GL_RAW + (RB_) * GL_RAWSZ + 16384;                      \
    float run = 0.f;                                                                 \
    _Pragma("unroll") for (int ii = 0; ii < 8; ++ii) {                               \
      const int i = sg * 8 + ii;                                                     \
      const u32x4 a0 = *(const u32x4*)(ra_ + i * 32);                                \
      const u32x4 a1 = *(const u32x4*)(ra_ + i * 32 + 16);                           \
      float g = ba;                                                                  \
      g += bflo(a0.x) * wa[0] + bfhi(a0.x) * wa[1] + bflo(a0.y) * wa[2] + bfhi(a0.y) * wa[3]; \
      g += bflo(a0.z) * wa[4] + bfhi(a0.z) * wa[5] + bflo(a0.w) * wa[6] + bfhi(a0.w) * wa[7]; \
      g += bflo(a1.x) * wa[8] + bfhi(a1.x) * wa[9] + bflo(a1.y) * wa[10] + bfhi(a1.y) * wa[11]; \
      g += bflo(a1.z) * wa[12] + bfhi(a1.z) * wa[13] + bflo(a1.w) * wa[14] + bfhi(a1.w) * wa[15]; \
      run += logsigmoid_f(g) * (1.0f / 16.0f);                                       \
      bl[ii] = run;                                                                  \
    }                                                                                \
    *(float*)(smem + GL_SEG + (sg * 64 + d) * 4) = run;                              \
  }
#define GLA_STEP5(RB_)                                                               \
  {                                                                                  \
    const char* rq_ = smem + GL_RAW + (RB_) * GL_RAWSZ;                              \
    float off = 0.f, tot = 0.f;                                                      \
    _Pragma("unroll") for (int s = 0; s < 8; ++s) {                                  \
      float v = *(const float*)(smem + GL_SEG + (s * 64 + d) * 4);                  \
      off += (s < sg) ? v : 0.f;                                                     \
      tot += v;                                                                      \
    }                                                                                \
    float ks[8];                                                                     \
    _Pragma("unroll") for (int ii = 0; ii < 8; ++ii) {                               \
      const int i = sg * 8 + ii;                                                     \
      const float bb = off + bl[ii];                                                 \
      const float qv = bf2f(*(const bf16*)(rq_ + i * 128 + d * 2));                 \
      const float kv = bf2f(*(const bf16*)(rq_ + 8192 + i * 128 + d * 2));          \
      const int eo = swz(i, d >> 3) + (d & 7) * 2;                                   \
      *(unsigned short*)(smem + GL_QE + eo) = bf16bits(qv * 0.125f * __expf(bb));    \
      *(unsigned short*)(smem + GL_KE + eo) = bf16bits(kv * __expf(-bb));            \
      ks[ii] = kv * __expf(tot - bb);                                                \
    }                                                                                \
    u32x4 o;                                                                         \
    o.x = pack_bf16(ks[0], ks[1]); o.y = pack_bf16(ks[2], ks[3]); o.z = pack_bf16(ks[4], ks[5]); o.w = pack_bf16(ks[6], ks[7]); \
    *(u32x4*)(smem + GL_KST + swz(d, sg)) = o;                                       \
    if (sg == 0) *(float*)(smem + GL_DEC + d * 4) = __expf(tot);                     \
  }

  const int tm = wave >> 2, tn = wave & 3;
  float bl[8];
  f32x16 oprev;
#pragma unroll
  for (int r = 0; r < 16; ++r) oprev[r] = 0.f;

#define GLA_STORE_OUT(N_)                                                                  \
  {                                                                                        \
    _Pragma("unroll") for (int r = 0; r < 16; ++r) {                                       \
      int row;                                                                             \
      GLA_ROW(N_, tm * 32 + rowmap(r, lh), row);                                           \
      *(unsigned short*)(outp + (size_t)row * 512 + h * 128 + tn * 32 + lr) = bf16bits(oprev[r]); \
    }                                                                                      \
  }
  GLA_LOAD_RAW(0); GLA_LOAD_V(0);
  GLA_STORE_RAW(0); GLA_STORE_V(0);
  GLA_LOAD_RAW(1);
  GLA_STORE_RAW(1);
  __syncthreads();
  GLA_STEP3(0);
  __syncthreads();
  GLA_STEP5(0);
  GLA_LOAD_RAW(2); GLA_LOAD_V(1);
  __syncthreads();
  CvtRegs cr; cvt_init(cr);
  const int cvt_u0 = __builtin_amdgcn_readfirstlane(unit * 36 * 16 + wave);
#pragma unroll 1
  for (int n = 0; n < 36; ++n) {
    const int vb = n & 1;
    const bool has1 = n + 1 < 36;
    cvt_step(cx, cr, lane, cvt_u0 + n * 16);
    f32x16 oacc;
#pragma unroll
    for (int r = 0; r < 16; ++r) oacc[r] = 0.f;
#pragma unroll
    for (int r = 0; r < 16; ++r) S[r] *= *(const float*)(smem + GL_DEC + (tm * 32 + rowmap(r, lh)) * 4);
#pragma unroll
    for (int ks4 = 0; ks4 < 4; ++ks4) {
      const int c = ((2 * ks4 + lh) ^ swl) << 4;
      const bf16x8 fq = *(const bf16x8*)(smem + GL_QE + (tm * 32 + lr) * 128 + c);
      const bf16x8 fs = *(const bf16x8*)(smem + GL_ST + (tn * 32 + lr) * 128 + c);
      oacc = mfma32(fq, fs, oacc);
      const bf16x8 fk = *(const bf16x8*)(smem + GL_KST + (tm * 32 + lr) * 128 + c);
      const bf16x8 fv = *(const bf16x8*)(smem + GL_VT + vb * 16384 + (tn * 32 + lr) * 128 + c);
      S = mfma32(fk, fv, S);
    }
    if (wave < 4) {
      const int am = wave >> 1, an = wave & 1;
      f32x16 att;
#pragma unroll
      for (int r = 0; r < 16; ++r) att[r] = 0.f;
#pragma unroll
      for (int ks4 = 0; ks4 < 4; ++ks4) {
        const int c = ((2 * ks4 + lh) ^ swl) << 4;
        const bf16x8 fq = *(const bf16x8*)(smem + GL_QE + (am * 32 + lr) * 128 + c);
        const bf16x8 fk = *(const bf16x8*)(smem + GL_KE + (an * 32 + lr) * 128 + c);
        att = mfma32(fq, fk, att);
      }
      const int s = an * 32 + lr;
#pragma unroll
      for (int r = 0; r < 16; ++r) {
        const int t = am * 32 + rowmap(r, lh);
        const float v = (s <= t) ? att[r] : 0.f;
        *(unsigned short*)(smem + GL_ATT + swz(t, s >> 3) + (s & 7) * 2) = bf16bits(v);
      }
    }
    if (has1) GLA_STEP3((n + 1) & 1);
    __syncthreads();
    cvt_step(cx, cr, lane, cvt_u0 + n * 16 + 8);
#pragma unroll
    for (int ks4 = 0; ks4 < 4; ++ks4) {
      const int c = ((2 * ks4 + lh) ^ swl) << 4;
      const bf16x8 fa = *(const bf16x8*)(smem + GL_ATT + (tm * 32 + lr) * 128 + c);
      const bf16x8 fv = *(const bf16x8*)(smem + GL_VT + vb * 16384 + (tn * 32 + lr) * 128 + c);
      oacc = mfma32(fa, fv, oacc);
    }
#pragma unroll
    for (int g = 0; g < 4; ++g) {
      u32x2 o;
      o.x = pack_bf16(S[4 * g + 0], S[4 * g + 1]);
      o.y = pack_bf16(S[4 * g + 2], S[4 * g + 3]);
      *(u32x2*)(smem + GL_ST + swz(tn * 32 + lr, tm * 4 + g) + 8 * lh) = o;
    }
    if (has1) {
      GLA_STEP5((n + 1) & 1);
      GLA_STORE_V((n + 1) & 1);
      if (n + 2 < 36) GLA_STORE_RAW(n & 1);
    }
    if (n > 0 && (n - 1 >= 4 || a.emit_ctx)) { GLA_STORE_OUT(n - 1); }
    { const int nr = n + 3 < 36 ? n + 3 : 35; GLA_LOAD_RAW(nr); const int nv = n + 2 < 36 ? n + 2 : 35; GLA_LOAD_V(nv); }
    oprev = oacc;
    __syncthreads();
  }
  cvt_finish(cx, cr, lane);
  { GLA_STORE_OUT(35); }
#undef GLA_STORE_OUT
#undef GLA_ROW
#undef GLA_LOAD_RAW
#undef GLA_LOAD_V
#undef GLA_STORE_RAW
#undef GLA_STORE_V
#undef GLA_STEP3
#undef GLA_STEP5
}


constexpr int CTRL_Q = 0;
constexpr int CTRL_CNT = 128;
constexpr int CTRL_CUR = 640;
constexpr int CTRL_XR = 1152;
constexpr int CTRL_WORDS = 1152 + 256;
constexpr size_t al256(size_t v) { return (v + 255) / 256 * 256; }
namespace wso {
constexpr size_t bar = 0;
constexpr size_t ctrl = al256(bar + (size_t)XCD_BAR_WORDS * 4);
constexpr size_t zero_end = al256(ctrl + (size_t)CTRL_WORDS * 4);
constexpr size_t xs = al256(ctrl + (size_t)CTRL_WORDS * 4);
constexpr size_t mod = al256(xs + (size_t)NT * D * 4);
constexpr size_t abuf = al256(mod + (size_t)DEPTH * 17 * 6 * D * 4);
constexpr size_t zt = al256(abuf + (size_t)NT * D * 2);
constexpr size_t zg = al256(zt + (size_t)HYCOLS * NT * 2);
constexpr size_t yt = al256(zg + (size_t)NT * GLACOLS * 2);
constexpr size_t of = al256(yt + (size_t)HYW * NT * 2);
constexpr size_t ob = al256(of + (size_t)NT * 512 * 4);
constexpr size_t ymix = al256(ob + (size_t)NT * 512 * 4);
constexpr size_t region_end_raw = al256(ymix + (size_t)NT * D * 2);
constexpr size_t region_end = (region_end_raw > zt + al256((size_t)NSLOT * D * 2)) ? region_end_raw : zt + al256((size_t)NSLOT * D * 2);
constexpr size_t hid = region_end;
constexpr size_t gl = al256(hid + (size_t)DEPTH * 2 * SEQ * 64 * 4);
constexpr size_t gc = al256(gl + (size_t)DEPTH * 2 * HYW * GSTR_L * 2);
constexpr size_t logits = al256(gc + (size_t)2 * HYW * GSTR_C * 2);
constexpr size_t tok_e = al256(logits + (size_t)NT * NE * 4);
constexpr size_t tok_gate = al256(tok_e + (size_t)NT * TOPK * 4);
constexpr size_t tok_slot = al256(tok_gate + (size_t)NT * TOPK * 4);
constexpr size_t pad_start = al256(tok_slot + (size_t)NT * TOPK * 4);
constexpr size_t slot_tok = al256(pad_start + (size_t)(NE + 2) * 4);
constexpr size_t blkcnt = al256(slot_tok + (size_t)NSLOT * 4);
constexpr size_t hbuf = al256(blkcnt + (size_t)512 * NE * 4);
constexpr size_t hs = al256(hbuf + (size_t)NSLOT * DE);
constexpr size_t w_in_t = al256(hs + (size_t)NT * DE);
constexpr size_t w_out_t = al256(w_in_t + (size_t)DEPTH * WIN_ROWS * D * 2);
constexpr size_t router_t = al256(w_out_t + (size_t)DEPTH * D * D * 2);
constexpr size_t sh1_t = al256(router_t + (size_t)DEPTH * NE * D * 2);
constexpr size_t sh3_t = al256(sh1_t + (size_t)DEPTH * DE * D);
constexpr size_t sh2_t = al256(sh3_t + (size_t)DEPTH * DE * D);
constexpr size_t e1_t = al256(sh2_t + (size_t)DEPTH * D * DE);
constexpr size_t e3_t = al256(e1_t + (size_t)NE * DE * D);
constexpr size_t e2_t = al256(e3_t + (size_t)NE * DE * D);
constexpr size_t abuf8 = al256(e2_t + (size_t)NE * D * DE);
constexpr size_t w_g8 = al256(abuf8 + (size_t)NT * D);
constexpr size_t ysh = al256(w_g8 + (size_t)DEPTH * GW_ROWS * D);
constexpr size_t total = al256(ysh + (size_t)NT * D);
constexpr size_t ybuf = zt;
}
struct WS {
  char* b;
  __device__ __forceinline__ unsigned* bar() const { char* q = b; asm volatile("" : "+s"(q)); return (unsigned*)(q + wso::bar); }
  __device__ __forceinline__ int* ctrl() const { char* q = b; asm volatile("" : "+s"(q)); return (int*)(q + wso::ctrl); }
  __device__ __forceinline__ bf16* xs() const { char* q = b; asm volatile("" : "+s"(q)); return (bf16*)(q + wso::xs); }
  __device__ __forceinline__ float* mod() const { char* q = b; asm volatile("" : "+s"(q)); return (float*)(q + wso::mod); }
  __device__ __forceinline__ bf16* abuf() const { char* q = b; asm volatile("" : "+s"(q)); return (bf16*)(q + wso::abuf); }
  __device__ __forceinline__ bf16* zt() const { char* q = b; asm volatile("" : "+s"(q)); return (bf16*)(q + wso::zt); }
  __device__ __forceinline__ bf16* zg() const { char* q = b; asm volatile("" : "+s"(q)); return (bf16*)(q + wso::zg); }
  __device__ __forceinline__ bf16* yt() const { char* q = b; asm volatile("" : "+s"(q)); return (bf16*)(q + wso::yt); }
  __device__ __forceinline__ bf16* of() const { char* q = b; asm volatile("" : "+s"(q)); return (bf16*)(q + wso::of); }
  __device__ __forceinline__ bf16* ob() const { char* q = b; asm volatile("" : "+s"(q)); return (bf16*)(q + wso::ob); }
  __device__ __forceinline__ bf16* ymix() const { char* q = b; asm volatile("" : "+s"(q)); return (bf16*)(q + wso::ymix); }
  __device__ __forceinline__ float* hid() const { char* q = b; asm volatile("" : "+s"(q)); return (float*)(q + wso::hid); }
  __device__ __forceinline__ bf16* gl() const { char* q = b; asm volatile("" : "+s"(q)); return (bf16*)(q + wso::gl); }
  __device__ __forceinline__ bf16* gc() const { char* q = b; asm volatile("" : "+s"(q)); return (bf16*)(q + wso::gc); }
  __device__ __forceinline__ float* logits() const { char* q = b; asm volatile("" : "+s"(q)); return (float*)(q + wso::logits); }
  __device__ __forceinline__ int* tok_e() const { char* q = b; asm volatile("" : "+s"(q)); return (int*)(q + wso::tok_e); }
  __device__ __forceinline__ float* tok_gate() const { char* q = b; asm volatile("" : "+s"(q)); return (float*)(q + wso::tok_gate); }
  __device__ __forceinline__ int* tok_slot() const { char* q = b; asm volatile("" : "+s"(q)); return (int*)(q + wso::tok_slot); }
  __device__ __forceinline__ int* pad_start() const { char* q = b; asm volatile("" : "+s"(q)); return (int*)(q + wso::pad_start); }
  __device__ __forceinline__ int* slot_tok() const { char* q = b; asm volatile("" : "+s"(q)); return (int*)(q + wso::slot_tok); }
  __device__ __forceinline__ int* blkcnt() const { char* q = b; asm volatile("" : "+s"(q)); return (int*)(q + wso::blkcnt); }
  __device__ __forceinline__ unsigned char* hbuf() const { char* q = b; asm volatile("" : "+s"(q)); return (unsigned char*)(q + wso::hbuf); }
  __device__ __forceinline__ unsigned char* hs() const { char* q = b; asm volatile("" : "+s"(q)); return (unsigned char*)(q + wso::hs); }
  __device__ __forceinline__ bf16* w_in_t() const { char* q = b; asm volatile("" : "+s"(q)); return (bf16*)(q + wso::w_in_t); }
  __device__ __forceinline__ bf16* w_out_t() const { char* q = b; asm volatile("" : "+s"(q)); return (bf16*)(q + wso::w_out_t); }
  __device__ __forceinline__ bf16* router_t() const { char* q = b; asm volatile("" : "+s"(q)); return (bf16*)(q + wso::router_t); }
  __device__ __forceinline__ unsigned char* sh1_t() const { char* q = b; asm volatile("" : "+s"(q)); return (unsigned char*)(q + wso::sh1_t); }
  __device__ __forceinline__ unsigned char* sh3_t() const { char* q = b; asm volatile("" : "+s"(q)); return (unsigned char*)(q + wso::sh3_t); }
  __device__ __forceinline__ unsigned char* sh2_t() const { char* q = b; asm volatile("" : "+s"(q)); return (unsigned char*)(q + wso::sh2_t); }
  __device__ __forceinline__ unsigned char* e1_t() const { char* q = b; asm volatile("" : "+s"(q)); return (unsigned char*)(q + wso::e1_t); }
  __device__ __forceinline__ unsigned char* e3_t() const { char* q = b; asm volatile("" : "+s"(q)); return (unsigned char*)(q + wso::e3_t); }
  __device__ __forceinline__ unsigned char* e2_t() const { char* q = b; asm volatile("" : "+s"(q)); return (unsigned char*)(q + wso::e2_t); }
  __device__ __forceinline__ unsigned char* ybuf() const { char* q = b; asm volatile("" : "+s"(q)); return (unsigned char*)(q + wso::ybuf); }
  __device__ __forceinline__ unsigned char* abuf8() const { char* q = b; asm volatile("" : "+s"(q)); return (unsigned char*)(q + wso::abuf8); }
  __device__ __forceinline__ unsigned char* w_g8() const { char* q = b; asm volatile("" : "+s"(q)); return (unsigned char*)(q + wso::w_g8); }
  __device__ __forceinline__ unsigned char* ysh() const { char* q = b; asm volatile("" : "+s"(q)); return (unsigned char*)(q + wso::ysh); }
};

constexpr int MEGA_LDS_MAIN = G8_LDS;
constexpr int LDS_TILE_E = MEGA_LDS_MAIN + 16;
constexpr int MEGA_LDS = MEGA_LDS_MAIN + 16 + 4096;

struct MP { Inputs in; WS w; float* out; };

__device__ __forceinline__ void row_load(const float* __restrict__ p, int lane, f32x4 (&v)[4]) {
#pragma unroll
  for (int j = 0; j < 4; ++j) v[j] = *(const f32x4*)(p + j * 256 + lane * 4);
}
__device__ __forceinline__ void row_load_xs(const bf16* __restrict__ p, int lane, f32x4 (&v)[4]) {
#pragma unroll
  for (int j = 0; j < 4; ++j) v[j] = xs_load4(p + j * 256 + lane * 4);
}
__device__ __forceinline__ float row_rinv(const f32x4 (&v)[4], int lane) {
  float ss = 0.f;
#pragma unroll
  for (int j = 0; j < 4; ++j) ss += v[j].x * v[j].x + v[j].y * v[j].y + v[j].z * v[j].z + v[j].w * v[j].w;
  ss = wave_sum(ss, lane);
  return rsqrtf(ss * (1.0f / D) + EPS);
}
__device__ __forceinline__ void row_norm_mod_store(const f32x4 (&v)[4], float rinv, const float* __restrict__ g,
                                                   const float* __restrict__ sh, const float* __restrict__ sc, int lane,
                                                   bf16* __restrict__ dst, unsigned char* __restrict__ dst8 = nullptr) {
#pragma unroll
  for (int j = 0; j < 4; ++j) {
    const int d = j * 256 + lane * 4;
    const f32x4 gv = *(const f32x4*)(g + d), shv = *(const f32x4*)(sh + d), scv = *(const f32x4*)(sc + d);
    const float y0 = v[j].x * rinv * gv.x * (1.f + scv.x) + shv.x, y1 = v[j].y * rinv * gv.y * (1.f + scv.y) + shv.y;
    const float y2 = v[j].z * rinv * gv.z * (1.f + scv.z) + shv.z, y3 = v[j].w * rinv * gv.w * (1.f + scv.w) + shv.w;
    u32x2 o;
    o.x = pack_bf16(y0, y1);
    o.y = pack_bf16(y2, y3);
    *(u32x2*)(dst + d) = o;
    if (dst8) *(unsigned*)(dst8 + d) = pk4_fp8(y0, y1, y2, y3);
  }
}

__device__ __forceinline__ void ph_mod_hid(const MP& p, char* smem, int bid, int nblk) {
  const int tid = tid_opaque(), lane = tid & 63, wave = tid >> 6;
  float* sc = (float*)smem;
  for (int u = bid; u < 192; u += nblk) {
    const int l = u / 96, col0 = (u - l * 96) * 64;
    __syncthreads();
    for (int i = tid; i < 17 * 1024; i += 512) {
      const int r = i >> 10, k = i & 1023;
      const float v = (r < 16) ? p.in.c[r * D + k] : p.in.c_ctx[k];
      sc[i] = silu_f(v);
    }
    __syncthreads();
    const int col = tid & 63, ks = tid >> 6;
    float acc[17];
#pragma unroll
    for (int r = 0; r < 17; ++r) acc[r] = 0.f;
    const float* wp = p.in.ada_w + ((size_t)l * D + ks * 128) * (6 * D) + col0 + col;
#pragma unroll 16
    for (int kk = 0; kk < 128; ++kk) {
      const float wv = wp[(size_t)kk * (6 * D)];
#pragma unroll
      for (int r = 0; r < 17; ++r) acc[r] += sc[r * 1024 + ks * 128 + kk] * wv;
    }
    __syncthreads();
#pragma unroll
    for (int r = 0; r < 17; ++r) sc[(ks * 17 + r) * 64 + col] = acc[r];
    __syncthreads();
    for (int i = tid; i < 17 * 64; i += 512) {
      const int r = i >> 6, cc = i & 63;
      float s = 0.f;
#pragma unroll
      for (int k8 = 0; k8 < 8; ++k8) s += sc[(k8 * 17 + r) * 64 + cc];
      p.w.mod()[((size_t)l * 17 + r) * (6 * D) + col0 + cc] = s + p.in.ada_b[l * 6 * D + col0 + cc];
    }
  }
  for (int it = bid; it * 8 < 4352; it += nblk) {
    const int rid = it * 8 + wave;
    int l, ty, t;
    if (rid < 2048) { l = 0; ty = 0; t = rid; }
    else if (rid < 2304) { l = 0; ty = 1; t = rid - 2048; }
    else { l = 1; ty = 0; t = rid - 2304; }
    const int L = ty ? LC : SEQ;
    const float* w1 = p.in.hy_f_w1 + l * 33 * 64; const float* b1 = p.in.hy_f_b1 + l * 64;
    const float* w2 = p.in.hy_f_w2 + l * 64 * 64; const float* b2 = p.in.hy_f_b2 + l * 64;
    float pv = 0.f;
    if (lane == 0) pv = (float)t / (float)(L - 1);
    else if (lane < 33) {
      const int bi = (lane - 1) & 15;
      const float wph = 2.0f * 3.14159265358979323846f * (float)t / (float)L;
      const float f = 1e-4f + (float)bi * ((15.0f - 1e-4f) / 15.0f);
      pv = (lane <= 16) ? cosf(f * wph) : -sinf(f * wph);
    }
    float a1 = b1[lane];
#pragma unroll
    for (int i = 0; i < 33; ++i) a1 += shl_f(pv, i) * w1[i * 64 + lane];
    const float h1 = sinf(a1);
    float a2 = b2[lane];
#pragma unroll 16
    for (int i = 0; i < 64; ++i) a2 += shl_f(h1, i) * w2[i * 64 + lane];
    p.w.hid()[((size_t)(l * 2 + ty) * SEQ + t) * 64 + lane] = sinf(a2);
  }
}

__device__ __forceinline__ void ph_gtab(const MP& p, char* smem, int bid, int nblk) {
  const int tid = tid_opaque();
  float* wl = (float*)smem;
  for (int u = bid; u < 544; u += nblk) {
    int l, ty, ib, cg;
    if (u < 512) { l = u >> 8; ty = 0; ib = (u >> 5) & 7; cg = u & 31; }
    else { l = 0; ty = 1; ib = 0; cg = u - 512; }
    const int L = ty ? LC : SEQ, gstr = ty ? GSTR_C : GSTR_L;
    const float* hid = p.w.hid() + (size_t)(l * 2 + ty) * SEQ * 64;
    const float* w3 = p.in.hy_f_w3 + (size_t)l * 64 * 2048;
    const float* skip = p.in.hy_skip + l * 2 * 512;
    bf16* G = ty ? p.w.gc() : (p.w.gl() + (size_t)l * 2 * HYW * GSTR_L);
    __syncthreads();
    for (int i = tid; i < 2 * 32 * 64; i += 512) {
      const int dir = i >> 11, cc = (i >> 6) & 31, j = i & 63;
      const int oc = cg * 32 + cc, o = oc >> 9, c = oc & 511;
      wl[i] = w3[(size_t)j * 2048 + o * 1024 + dir * 512 + c];
    }
    __syncthreads();
    const int i = ib * 512 + tid;
    const int dd = i - (L - 1);
    const int t = dd < 0 ? -dd : dd;
    const bool inr = i < 2 * L - 1;
    const int dir = dd > 0 ? 1 : 0;
    float hr[64];
    {
      const float* hp = hid + (size_t)(inr ? t : 0) * 64;
#pragma unroll
      for (int j = 0; j < 16; ++j) { const f32x4 v = *(const f32x4*)(hp + 4 * j); hr[4 * j] = v.x; hr[4 * j + 1] = v.y; hr[4 * j + 2] = v.z; hr[4 * j + 3] = v.w; }
    }
    const float tn = (float)t / (float)(L - 1);
#pragma unroll 1
    for (int cc = 0; cc < 32; ++cc) {
      const int oc = cg * 32 + cc, o = oc >> 9, c = oc & 511;
      const float* wc = wl + (dir * 32 + cc) * 64;
      float s = 0.f;
#pragma unroll
      for (int j = 0; j < 16; ++j) { const f32x4 wv = *(const f32x4*)(wc + 4 * j); s += hr[4 * j] * wv.x + hr[4 * j + 1] * wv.y + hr[4 * j + 2] * wv.z + hr[4 * j + 3] * wv.w; }
      if (dd == 0) {
        const float* wc1 = wl + (32 + cc) * 64;
        float s1 = 0.f;
#pragma unroll
        for (int j = 0; j < 16; ++j) { const f32x4 wv = *(const f32x4*)(wc1 + 4 * j); s1 += hr[4 * j] * wv.x + hr[4 * j + 1] * wv.y + hr[4 * j + 2] * wv.z + hr[4 * j + 3] * wv.w; }
        s += s1;
      }
      const float delta = HY_MIN_DECAY + (float)c * ((HY_MAX_DECAY - HY_MIN_DECAY) / 511.0f);
      float val = s * __expf(-tn * delta);
      if (dd == 0) val += skip[o * 512 + c];
      if (!inr) val = 0.f;
      G[(size_t)oc * gstr + i] = f2bf(val);
    }
  }
}

__device__ __forceinline__ void ph_init_norm1(const MP& p, int bid, int nblk) {
  const int lane = tid_opaque() & 63, wave = tid_opaque() >> 6;
  const float* g = p.in.norm1_g;
  for (int it = bid; it * 8 < SEQ; it += nblk) {
    const int t = it * 8 + wave;
    const float rr = (float)(t >> 6), colp = (float)(t & 63);
    f32x4 e[4];
#pragma unroll
    for (int j = 0; j < 4; ++j) {
      float ev[4];
#pragma unroll
      for (int q = 0; q < 4; ++q) {
        const int i = lane * 4 + q;
        const float omega = 1.0f / powf(10000.0f, (float)i / 256.0f);
        const float a = ((j < 2) ? rr : colp) * omega;
        ev[q] = (j & 1) ? cosf(a) : sinf(a);
      }
      e[j] = (f32x4){ev[0], ev[1], ev[2], ev[3]};
    }
    for (int b = 0; b < NB; ++b) {
      const int row = b * SEQ + t;
      f32x4 v[4];
      row_load(p.in.x + (size_t)row * D, lane, v);
#pragma unroll
      for (int j = 0; j < 4; ++j) { v[j] += e[j]; xs_store4(p.w.xs() + (size_t)row * D + j * 256 + lane * 4, v[j]); }
      const float rinv = row_rinv(v, lane);
      const float* mb = p.w.mod() + (size_t)b * 6 * D;
      row_norm_mod_store(v, rinv, g, mb, mb + D, lane, p.w.abuf() + (size_t)row * D, p.w.abuf8() + (size_t)row * D);
    }
  }
  for (int it = bid; it * 8 < NC; it += nblk) {
    const int rc = it * 8 + wave, row = NL + rc;
    f32x4 v[4];
    row_load(p.in.ctx + (size_t)rc * D, lane, v);
#pragma unroll
    for (int j = 0; j < 4; ++j) xs_store4(p.w.xs() + (size_t)row * D + j * 256 + lane * 4, v[j]);
    const float rinv = row_rinv(v, lane);
    const float* mb = p.w.mod() + (size_t)16 * 6 * D;
    row_norm_mod_store(v, rinv, g, mb, mb + D, lane, p.w.abuf() + (size_t)row * D, p.w.abuf8() + (size_t)row * D);
  }
}

__device__ __forceinline__ void ph_mixer(const MP& p, char* smem, int l, bool last, int bid, int nblk) {
  int* qctr = p.w.ctrl() + CTRL_Q + 64 * l;
  int* slot = (int*)(smem + MEGA_LDS_MAIN + 8);
  GlaArgs ga;
  ga.zg = p.w.zg(); ga.wa2 = p.in.gla_wa2 + (size_t)l * 2 * 16 * 256; ga.ba2 = p.in.gla_ba2 + (size_t)l * 2 * 256;
  ga.of = p.w.of(); ga.ob = p.w.ob(); ga.emit_ctx = last ? 0 : 1; ga.pad_ = 0;
  const float* cw = p.in.hy_conv_w + (size_t)l * 3 * HYCOLS;
  const float* cb = p.in.hy_conv_b + (size_t)l * HYCOLS;
  const bf16* gl = p.w.gl() + (size_t)l * 2 * HYW * GSTR_L;
  CvtCtx cx;
  cx.w1 = p.in.exp_w1 + (size_t)l * NE * D * DE; cx.w3 = p.in.exp_w3 + (size_t)l * NE * D * DE; cx.w2 = p.in.exp_w2 + (size_t)l * NE * DE * D;
  cx.d1 = p.w.e1_t(); cx.d3 = p.w.e3_t(); cx.d2 = p.w.e2_t();
  for (;;) {
    __syncthreads();
    if (tid_opaque() == 0) *slot = atomicAdd(qctr, 1);
    __syncthreads();
    const int u = *slot;
    const int nunits = last ? 640 : 1152;
    if (u >= nunits) break;
    if (u < 128) gla_unit(u, ga, smem, cx);
    else if (u < 640) hyena_latent(u - 128, p.w.zt(), cw, cb, gl, p.w.yt(), smem, cx);
    else hyena_ctx(u - 640, p.w.zt() + NL, cw, cb, p.w.gc(), p.w.yt() + NL, smem);
  }
}

__device__ __forceinline__ void ph_gla_out(const MP& p, char* smem, int l, int mrows, int bid, int nblk) {
  const int tid = tid_opaque();
  const int lane = tid & 63, wave = tid >> 6;
  {
    const float* gn = p.in.gla_norm_g + l * 128 + (lane & 15) * 8;
    const f32x4 ga = *(const f32x4*)gn, gb = *(const f32x4*)(gn + 4);
    const bf16* of = p.w.of(); const bf16* ob = p.w.ob(); const bf16* zg = p.w.zg(); bf16* ymix = p.w.ymix();
#pragma unroll 2
    for (int it = bid; it * 8 < mrows; it += nblk) {
      const int row = it * 8 + wave;
      const size_t base = (size_t)row * 512 + lane * 8;
      const u32x4 av = *(const u32x4*)(of + base), bv = *(const u32x4*)(ob + base);
      const f32x4 a0 = {bflo(av.x), bfhi(av.x), bflo(av.y), bfhi(av.y)}, a1 = {bflo(av.z), bfhi(av.z), bflo(av.w), bfhi(av.w)};
      const f32x4 b0 = {bflo(bv.x), bfhi(bv.x), bflo(bv.y), bfhi(bv.y)}, b1 = {bflo(bv.z), bfhi(bv.z), bflo(bv.w), bfhi(bv.w)};
      const u32x4 rv = *(const u32x4*)(zg + (size_t)row * GLACOLS + 1024 + lane * 8);
      const f32x4 o0 = a0 + b0, o1 = a1 + b1;
      float ss = o0.x * o0.x + o0.y * o0.y + o0.z * o0.z + o0.w * o0.w + o1.x * o1.x + o1.y * o1.y + o1.z * o1.z + o1.w * o1.w;
      ss += shx_f(ss, 1, lane); ss += shx_f(ss, 2, lane); ss += shx_f(ss, 4, lane); ss += shx_f(ss, 8, lane);
      const float rinv = rsqrtf(ss * (1.0f / 128.0f) + EPS);
      u32x4 o;
      o.x = pack_bf16(o0.x * rinv * ga.x * silu_f(bflo(rv.x)), o0.y * rinv * ga.y * silu_f(bfhi(rv.x)));
      o.y = pack_bf16(o0.z * rinv * ga.z * silu_f(bflo(rv.y)), o0.w * rinv * ga.w * silu_f(bfhi(rv.y)));
      o.z = pack_bf16(o1.x * rinv * gb.x * silu_f(bflo(rv.z)), o1.y * rinv * gb.y * silu_f(bfhi(rv.z)));
      o.w = pack_bf16(o1.z * rinv * gb.z * silu_f(bflo(rv.w)), o1.w * rinv * gb.w * silu_f(bfhi(rv.w)));
      *(u32x4*)(ymix + (size_t)row * D + 512 + lane * 8) = o;
    }
  }
  {
    const bf16* yt = p.w.yt(); bf16* ymix = p.w.ymix();
    for (int tt = bid; tt * 64 < mrows; tt += nblk) {
      const int tok0 = tt * 64;
      __syncthreads();
#pragma unroll
      for (int i = 0; i < 8; ++i) {
        const int q = tid + i * 512, c = q >> 3, ch = q & 7;
        const u32x4 v = *(const u32x4*)(yt + (size_t)c * NT + tok0 + ch * 8);
        unsigned* d = (unsigned*)(smem + c * 132 + ch * 16);
        d[0] = v.x; d[1] = v.y; d[2] = v.z; d[3] = v.w;
      }
      __syncthreads();
#pragma unroll
      for (int i = 0; i < 8; ++i) {
        const int c8 = wave * 8 + (lane & 7), t = i * 8 + (lane >> 3);
        const unsigned short* s = (const unsigned short*)(smem + (c8 * 8) * 132 + t * 2);
        const unsigned e0 = s[0], e1 = s[66], e2 = s[132], e3 = s[198], e4 = s[264], e5 = s[330], e6 = s[396], e7 = s[462];
        *(u32x4*)(ymix + (size_t)(tok0 + t) * D + c8 * 8) = (u32x4){e0 | (e1 << 16), e2 | (e3 << 16), e4 | (e5 << 16), e6 | (e7 << 16)};
      }
    }
  }
}

__device__ __forceinline__ void ph_norm2(const MP& p, int l, int mrows, int bid, int nblk) {
  const int lane = tid_opaque() & 63, wave = tid_opaque() >> 6;
  const float* g = p.in.norm2_g + l * D;
  const float* modl = p.w.mod() + (size_t)l * 17 * 6 * D;
  for (int it = bid; it * 8 < mrows; it += nblk) {
    const int row = it * 8 + wave;
    f32x4 v[4];
    row_load_xs(p.w.xs() + (size_t)row * D, lane, v);
    const float rinv = row_rinv(v, lane);
    const float* mb = modl + (size_t)row_batch(row) * 6 * D;
    row_norm_mod_store(v, rinv, g, mb + 3 * D, mb + 4 * D, lane, p.w.abuf() + (size_t)row * D, p.w.abuf8() + (size_t)row * D);
  }
}

__device__ __forceinline__ void ph_route(const MP& p, char* smem, int l, int ntok, int bid, int nblk) {
  const int tid = tid_opaque();
  const int lane = tid & 63, wave = tid >> 6;
  const float* rb = p.in.router_b + l * NE;
  int* lcnt = (int*)smem;
  __syncthreads();
  if (tid < NE) lcnt[tid] = 0;
  __syncthreads();
  const f32x4 bb = *(const f32x4*)(rb + lane * 4);
  const int tpb = (ntok + nblk - 1) / nblk;
  for (int it = wave; it < tpb; it += 8) {
    const int tok = bid * tpb + it;
    if (tok >= ntok) break;
    const f32x4 lg = *(const f32x4*)(p.w.logits() + (size_t)tok * NE + lane * 4);
    const float s0 = sigmoid_f(lg.x), s1 = sigmoid_f(lg.y), s2 = sigmoid_f(lg.z), s3 = sigmoid_f(lg.w);
    const float v0 = s0 + bb.x, v1 = s1 + bb.y, v2 = s2 + bb.z, v3 = s3 + bb.w;
    float m1 = fmaxf(v0, v1), m2 = fminf(v0, v1);
    { float n1 = fmaxf(m1, v2); float n2 = fmaxf(fminf(m1, v2), m2); m1 = n1; m2 = n2; }
    { float n1 = fmaxf(m1, v3); float n2 = fmaxf(fminf(m1, v3), m2); m1 = n1; m2 = n2; }
#pragma unroll
    for (int o = 1; o <= 4; o <<= 1) {
      float a1 = shx_f(m1, o, lane), a2 = shx_f(m2, o, lane);
      float n1 = fmaxf(m1, a1);
      float n2 = fmaxf(fminf(m1, a1), fmaxf(m2, a2));
      m1 = n1; m2 = n2;
    }
    const float gs = m1 + m2;
    const int g = lane >> 3;
    int rank = 0;
#pragma unroll
    for (int gg = 0; gg < 8; ++gg) {
      const float og = __int_as_float(__builtin_amdgcn_readlane(__float_as_int(gs), gg * 8));
      rank += (og > gs || (og == gs && gg < g)) ? 1 : 0;
    }
    unsigned k0, k1, k2, k3;
    {
      const bool sel = rank < 4;
      unsigned u;
      u = __float_as_uint(v0); u = (u & 0x80000000u) ? ~u : (u | 0x80000000u); k0 = sel ? ((u & 0xffffff00u) | (unsigned)(255 - (lane * 4 + 0))) : 0u;
      u = __float_as_uint(v1); u = (u & 0x80000000u) ? ~u : (u | 0x80000000u); k1 = sel ? ((u & 0xffffff00u) | (unsigned)(255 - (lane * 4 + 1))) : 0u;
      u = __float_as_uint(v2); u = (u & 0x80000000u) ? ~u : (u | 0x80000000u); k2 = sel ? ((u & 0xffffff00u) | (unsigned)(255 - (lane * 4 + 2))) : 0u;
      u = __float_as_uint(v3); u = (u & 0x80000000u) ? ~u : (u | 0x80000000u); k3 = sel ? ((u & 0xffffff00u) | (unsigned)(255 - (lane * 4 + 3))) : 0u;
    }
    float gsum = 0.f, myg = 0.f; int mye = 0;
#pragma unroll
    for (int k = 0; k < TOPK; ++k) {
      unsigned m = max(max(k0, k1), max(k2, k3));
      m = max(m, (unsigned)__builtin_amdgcn_update_dpp(0, (int)m, 0x111, 0xf, 0xf, false));
      m = max(m, (unsigned)__builtin_amdgcn_update_dpp(0, (int)m, 0x112, 0xf, 0xf, false));
      m = max(m, (unsigned)__builtin_amdgcn_update_dpp(0, (int)m, 0x114, 0xf, 0xf, false));
      m = max(m, (unsigned)__builtin_amdgcn_update_dpp(0, (int)m, 0x118, 0xf, 0xf, false));
      m = max(m, (unsigned)__builtin_amdgcn_update_dpp(0, (int)m, 0x142, 0xa, 0xf, false));
      m = max(m, (unsigned)__builtin_amdgcn_update_dpp(0, (int)m, 0x143, 0xc, 0xf, false));
      const unsigned wk = (unsigned)__builtin_amdgcn_readlane((int)m, 63);
      const int we = 255 - (int)(wk & 255u);
      const int wl = we >> 2, wi = we & 3;
      const float sv = __int_as_float(__builtin_amdgcn_readlane(__float_as_int(wi == 0 ? s0 : wi == 1 ? s1 : wi == 2 ? s2 : s3), wl));
      if (lane == wl) { if (wi == 0) k0 = 0u; else if (wi == 1) k1 = 0u; else if (wi == 2) k2 = 0u; else k3 = 0u; }
      gsum += sv;
      if (lane == k) { myg = sv; mye = we; }
    }
    if (lane < TOPK) {
      p.w.tok_e()[tok * TOPK + lane] = mye;
      p.w.tok_gate()[tok * TOPK + lane] = myg / gsum * 2.5f;
      atomicAdd(&lcnt[mye], 1);
    }
  }
  __syncthreads();
  if (tid < NE) p.w.blkcnt()[bid * NE + tid] = lcnt[tid];
}

__device__ __forceinline__ void ph_assign(const MP& p, char* smem, int l, int ntok, int bid, int nblk) {
  const int tid = tid_opaque();
  int* ps = (int*)smem;
  int* cur = (int*)smem + 512;
  __syncthreads();
  int* part = (int*)smem + 1024;
  {
    const int eg = tid & 63, bg = tid >> 6;
    const int per = (nblk + 7) >> 3;
    int t0 = 0, t1 = 0, t2 = 0, t3 = 0, b0 = 0, b1 = 0, b2 = 0, b3 = 0;
    const int* src = p.w.blkcnt() + eg * 4;
#pragma unroll 8
    for (int i = 0; i < per; ++i) {
      const int b = bg * per + i;
      if (b < nblk) {
        const u32x4 v = *(const u32x4*)(src + (size_t)b * NE);
        t0 += (int)v.x; t1 += (int)v.y; t2 += (int)v.z; t3 += (int)v.w;
        if (b < bid) { b0 += (int)v.x; b1 += (int)v.y; b2 += (int)v.z; b3 += (int)v.w; }
      }
    }
    int* pt = part + bg * 512 + eg * 4;
    pt[0] = t0; pt[1] = t1; pt[2] = t2; pt[3] = t3;
    pt[256] = b0; pt[257] = b1; pt[258] = b2; pt[259] = b3;
  }
  __syncthreads();
  int before = 0;
  if (tid < NE) {
    int tot = 0;
#pragma unroll
    for (int g = 0; g < 8; ++g) { tot += part[g * 512 + tid]; before += part[g * 512 + 256 + tid]; }
    const int pc = (tot + 255) & ~255;
    const int lane = tid & 63;
    int inc = pc;
#pragma unroll
    for (int o = 1; o < 64; o <<= 1) { const int n = shl_i(inc, lane - o); if (lane >= o) inc += n; }
    ps[tid + 1] = inc;
    if (lane == 63) cur[tid >> 6] = inc;
  }
  __syncthreads();
  if (tid < NE) {
    const int w = tid >> 6;
    int offs = 0;
#pragma unroll
    for (int k = 0; k < 3; ++k) offs += (k < w) ? cur[k] : 0;
    ps[tid + 1] += offs;
    if (tid == 0) ps[0] = 0;
  }
  __syncthreads();
  if (tid < NE) {
    unsigned short* te = (unsigned short*)(smem + LDS_TILE_E);
    for (int t = ps[tid] >> 8; t < (ps[tid + 1] >> 8); ++t) te[t] = (unsigned short)tid;
  }
  if (tid < NE) cur[tid] = ps[tid] + before;
  if (bid == 0 && tid <= NE) p.w.pad_start()[tid] = ps[tid];
  __syncthreads();
  const int tpb = (ntok + nblk - 1) / nblk;
  for (int i = tid; i < tpb * TOPK; i += 512) {
    const int gi = bid * tpb * TOPK + i;
    if (gi >= ntok * TOPK) break;
    const int e = p.w.tok_e()[gi];
    const int slot = atomicAdd(&cur[e], 1);
    p.w.slot_tok()[slot] = gi >> 3;
    p.w.tok_slot()[gi] = slot;
  }
}

__device__ __forceinline__ void ph_combine(const MP& p, int l, int mrows, bool last, int bid, int nblk) {
  const int lane = tid_opaque() & 63, wave = tid_opaque() >> 6;
  const float* modl = p.w.mod() + (size_t)l * 17 * 6 * D;
  for (int it = bid; it * 8 < mrows; it += nblk) {
    const int row = it * 8 + wave;
    const int b = row_batch(row);
    f32x4 v[4], acc[4];
    row_load_xs(p.w.xs() + (size_t)row * D, lane, v);
#pragma unroll
    for (int j = 0; j < 4; ++j) acc[j] = (f32x4){0.f, 0.f, 0.f, 0.f};
    int sl = 0; float gt = 0.f;
    if (lane < TOPK) { sl = p.w.tok_slot()[row * TOPK + lane]; gt = p.w.tok_gate()[row * TOPK + lane]; }
#pragma unroll
    for (int k = 0; k < TOPK; ++k) {
      const int s = shl_i(sl, k);
      const float gk = shl_f(gt, k);
      const unsigned char* yr = p.w.ybuf() + (size_t)s * D + lane * 4;
#pragma unroll
      for (int j = 0; j < 4; ++j) {
        const int y = *(const int*)(yr + j * 256);
        const f32x2v lo = __builtin_amdgcn_cvt_pk_f32_fp8(y, false), hi = __builtin_amdgcn_cvt_pk_f32_fp8(y, true);
        acc[j].x += gk * lo.x; acc[j].y += gk * lo.y; acc[j].z += gk * hi.x; acc[j].w += gk * hi.y;
      }
    }
    {
      const unsigned char* yr = p.w.ysh() + (size_t)row * D + lane * 4;
#pragma unroll
      for (int j = 0; j < 4; ++j) {
        const int y = *(const int*)(yr + j * 256);
        const f32x2v lo = __builtin_amdgcn_cvt_pk_f32_fp8(y, false), hi = __builtin_amdgcn_cvt_pk_f32_fp8(y, true);
        acc[j].x += lo.x; acc[j].y += lo.y; acc[j].z += hi.x; acc[j].w += hi.y;
      }
    }
    const float* g2 = modl + (size_t)b * 6 * D + 5 * D;
#pragma unroll
    for (int j = 0; j < 4; ++j) {
      const f32x4 gv = *(const f32x4*)(g2 + j * 256 + lane * 4);
      v[j] += gv * acc[j];
    }
    const float rinv = row_rinv(v, lane);
    if (last) {
#pragma unroll
      for (int j = 0; j < 4; ++j) {
        const f32x4 fg = *(const f32x4*)(p.in.final_g + j * 256 + lane * 4);
        *(f32x4*)(p.out + (size_t)row * D + j * 256 + lane * 4) = v[j] * rinv * fg;
      }
    } else {
#pragma unroll
      for (int j = 0; j < 4; ++j) xs_store4(p.w.xs() + (size_t)row * D + j * 256 + lane * 4, v[j]);
      const float* mb = p.w.mod() + ((size_t)(l + 1) * 17 + b) * 6 * D;
      row_norm_mod_store(v, rinv, p.in.norm1_g + (l + 1) * D, mb, mb + D, lane, p.w.abuf() + (size_t)row * D, p.w.abuf8() + (size_t)row * D);
    }
  }
}

__global__ void __launch_bounds__(512, 2) k_mega(MP p) {
  extern __shared__ __attribute__((aligned(16))) char smem[];
  const int bid = blockIdx.x, nblk = gridDim.x;
  if (tid_opaque() == 0) *(u32x4*)(smem + MEGA_LDS_MAIN) = (u32x4){0u, 0u, 0u, 0u};
  __syncthreads();
  (void)xcd_barrier_post(p.w.bar(), (volatile LAS unsigned*)(smem + MEGA_LDS_MAIN));

  if (threadIdx.x == 0) {
    const unsigned xcc = xb_xcc_id();
    const int rank = atomicAdd(&p.w.ctrl()[CTRL_XR + 16 * xcc], 1);
    *(int*)(smem + MEGA_LDS_MAIN + 12) = rank;
  }
  ph_mod_hid(p, smem, bid, nblk);
  cvt_job(p.in.w_in, p.w.w_in_t(), D, INCOLS, 1, bid, nblk, HYCOLS);
  cvt_job(p.in.w_in + (size_t)D * INCOLS, p.w.w_in_t() + (size_t)WIN_ROWS * D, D, INCOLS, 1, bid, nblk, HYCOLS);
  cvt8_job(p.in.w_in + HYCOLS, p.w.w_g8(), D, INCOLS, 1, bid, nblk, GLACOLS);
  cvt8_job(p.in.w_in + (size_t)D * INCOLS + HYCOLS, p.w.w_g8() + (size_t)GW_ROWS * D, D, INCOLS, 1, bid, nblk, GLACOLS);
  cvt_job(p.in.w_out, p.w.w_out_t(), D, D, DEPTH, bid, nblk);
  cvt_job(p.in.router_w, p.w.router_t(), D, NE, DEPTH, bid, nblk);
  cvt8_job(p.in.sh_w1, p.w.sh1_t(), D, DE, DEPTH, bid, nblk);
  cvt8_job(p.in.sh_w3, p.w.sh3_t(), D, DE, DEPTH, bid, nblk);
  cvt8_job(p.in.sh_w2, p.w.sh2_t(), DE, D, DEPTH, bid, nblk);
  grid_sync(p.w.bar(), smem + MEGA_LDS_MAIN);
  int vb = bid;
  {
    const int rank = *(const int*)(smem + MEGA_LDS_MAIN + 12);
    const unsigned xcc = xb_xcc_id();
    int npop = 0, xidx = 0, cnt0 = -1; bool equal = true;
    for (int j = 0; j < 16; ++j) {
      const int c = p.w.ctrl()[CTRL_XR + 16 * j];
      if (c > 0) {
        if (cnt0 < 0) cnt0 = c; else if (c != cnt0) equal = false;
        if (j < (int)xcc) ++xidx;
        ++npop;
      }
    }
    if (equal && cnt0 > 0 && npop * cnt0 == nblk && rank < cnt0) vb = xidx * cnt0 + rank;
  }
  ph_gtab(p, smem, bid, nblk);
  ph_init_norm1(p, bid, nblk);
  grid_sync(p.w.bar(), smem + MEGA_LDS_MAIN);

  const int vbu = __builtin_amdgcn_readfirstlane(vb);
#pragma unroll 1
  for (int l0 = 0; l0 < DEPTH; ++l0) {
#define LL opq(l0)
    const bool last = (l0 == DEPTH - 1);
    const int mrows = last ? NL : NT;
#define MODL (p.w.mod() + (size_t)LL * 17 * 6 * D)
    {
      G8InZT g; g.wt = p.w.w_in_t() + (size_t)LL * WIN_ROWS * D; g.A = p.w.abuf(); g.zt = p.w.zt(); g.ntok = last ? NL : NT;
      gemm8_run(g, smem, opq(vbu), nblk);
    }
    {
      G8InG g; g.wt = p.w.w_g8() + (size_t)LL * GW_ROWS * D; g.A = p.w.abuf8(); g.zg = p.w.zg();
      gemm8_run(g, smem, opq(vbu), nblk);
    }
    grid_sync(p.w.bar(), smem + MEGA_LDS_MAIN);
    ph_mixer(p, smem, LL, last, opq(bid), nblk);
    grid_sync(p.w.bar(), smem + MEGA_LDS_MAIN);
    ph_gla_out(p, smem, LL, mrows, opq(bid), nblk);
    grid_sync(p.w.bar(), smem + MEGA_LDS_MAIN);
    {
      G8Out g; g.mrows = mrows; g.ymix = p.w.ymix(); g.wt = p.w.w_out_t() + (size_t)LL * D * D; g.modl = MODL; g.xs = p.w.xs();
      gemm8_run(g, smem, opq(vbu), nblk);
    }
    grid_sync(p.w.bar(), smem + MEGA_LDS_MAIN);
    ph_norm2(p, LL, mrows, opq(bid), nblk);
    grid_sync(p.w.bar(), smem + MEGA_LDS_MAIN);
    {
      G8Router g; g.mrows = mrows; g.A = p.w.abuf(); g.rwt = p.w.router_t() + (size_t)LL * NE * D; g.logits = p.w.logits();
      gemm8_run(g, smem, opq(vbu), nblk);
    }
    {
      G8ShUp g; g.mrows = mrows; g.A8 = p.w.abuf8(); g.s1t = p.w.sh1_t() + (size_t)LL * DE * D; g.s3t = p.w.sh3_t() + (size_t)LL * DE * D; g.hs = p.w.hs();
      int rid = vbu - (mrows >> 8) % nblk; rid += rid < 0 ? nblk : 0;
      gemm8_run(g, smem, opq(rid), nblk);
    }
    grid_sync(p.w.bar(), smem + MEGA_LDS_MAIN);
    ph_route(p, smem, LL, mrows, opq(bid), nblk);
    grid_sync(p.w.bar(), smem + MEGA_LDS_MAIN);
    ph_assign(p, smem, LL, mrows, opq(bid), nblk);
    grid_sync(p.w.bar(), smem + MEGA_LDS_MAIN);
    {
      G8Up g; g.A8 = p.w.abuf8(); g.slot_tok = p.w.slot_tok(); g.pad_start = p.w.pad_start(); g.w1t = p.w.e1_t(); g.w3t = p.w.e3_t(); g.H = p.w.hbuf(); g.tile_e = (const unsigned short*)(smem + LDS_TILE_E);
      gemm8_run(g, smem, opq(vbu), nblk);
    }
    {
      G8ShDown g; g.mrows = mrows; g.hs = p.w.hs(); g.wt = p.w.sh2_t() + (size_t)LL * D * DE; g.ysh = p.w.ysh();
      int rid = vbu - __builtin_amdgcn_readfirstlane(((p.w.pad_start()[NE] >> 8) * 2) % nblk); rid += rid < 0 ? nblk : 0;
      gemm8_run(g, smem, opq(rid), nblk);
    }
    grid_sync(p.w.bar(), smem + MEGA_LDS_MAIN);
    {
      G8Down g; g.H = p.w.hbuf(); g.pad_start = p.w.pad_start(); g.w2t = p.w.e2_t(); g.Y = p.w.ybuf(); g.tile_e = (const unsigned short*)(smem + LDS_TILE_E);
      gemm8_run(g, smem, opq(vbu), nblk);
    }
    grid_sync(p.w.bar(), smem + MEGA_LDS_MAIN);
    ph_combine(p, LL, mrows, last, opq(bid), nblk);
    if (!last) grid_sync(p.w.bar(), smem + MEGA_LDS_MAIN);
  }
#undef LL
#undef MODL
}

static inline size_t align_up(size_t v, size_t a) { return (v + a - 1) / a * a; }

extern "C" void kernel_launch(void* const* d_in, const int* in_sizes, int n_in, void* d_out, int out_size, void* d_ws,
                              size_t ws_size, hipStream_t stream) {
  MP p;
  memset(&p, 0, sizeof(p));
  const float** ip = (const float**)&p.in;
  for (int i = 0; i < 30; ++i) ip[i] = (const float*)d_in[i];
  p.out = (float*)d_out;

  p.w.b = (char*)d_ws;
  const size_t zero_bytes = wso::zero_end;
  (void)ws_size; (void)n_in; (void)in_sizes; (void)out_size;

  static int grid = 0;
  if (!grid) {
    hipFuncSetAttribute((const void*)k_mega, hipFuncAttributeMaxDynamicSharedMemorySize, MEGA_LDS);
    int dev = 0, cus = 0, per_cu = 0;
    hipGetDevice(&dev);
    hipDeviceGetAttribute(&cus, hipDeviceAttributeMultiprocessorCount, dev);
    hipOccupancyMaxActiveBlocksPerMultiprocessor(&per_cu, k_mega, 512, MEGA_LDS);
    if (cus <= 0) cus = 256;
    grid = per_cu >= 1 ? cus : 0;
    if (grid <= 0) grid = 256;
  }
  hipMemsetAsync(d_ws, 0, zero_bytes, stream);
  hipLaunchKernelGGL(k_mega, dim3(grid), dim3(512), MEGA_LDS, stream, p);
}
```

```cpp
#include <hip/hip_runtime.h>
#include <hip/hip_bf16.h>
#include <stdint.h>
#include <string.h>

typedef __hip_bfloat16 bf16;

constexpr int D = 1024, NB = 16, SEQ = 2048, LC = 256, DEPTH = 2;
constexpr int NL = NB * SEQ, NC = NB * LC, NT = NL + NC;
constexpr int HYW = 512, HYCOLS = 1536, GLACOLS = 1568, INCOLS = 3104;
constexpr int NE = 256, TOPK = 8, DE = 256;
constexpr int NSLOT = NT * TOPK + NE * 256;
constexpr float EPS = 1e-6f;
constexpr float HY_MIN_DECAY = 3.0701134573253945f;
constexpr float HY_MAX_DECAY = 15.350567286626973f;
constexpr int GSTR_L = 4096, GSTR_C = 512;
constexpr int WIN_ROWS = HYCOLS;
constexpr int GW_ROWS = 7 * 256;

__device__ __forceinline__ float bf2f(bf16 v) { return __bfloat162float(v); }
__device__ __forceinline__ bf16 f2bf(float v) { return __float2bfloat16(v); }
__device__ __forceinline__ float silu_f(float x) { return x / (1.f + __expf(-x)); }
__device__ __forceinline__ float sigmoid_f(float x) { return 1.f / (1.f + __expf(-x)); }
__device__ __forceinline__ float logsigmoid_f(float x) { return fminf(x, 0.f) - __logf(1.f + __expf(-fabsf(x))); }

__device__ __forceinline__ float shx_f(float v, int mask, int lane) { return __int_as_float(__builtin_amdgcn_ds_bpermute((lane ^ mask) << 2, __float_as_int(v))); }
__device__ __forceinline__ int shx_i(int v, int mask, int lane) { return __builtin_amdgcn_ds_bpermute((lane ^ mask) << 2, v); }
__device__ __forceinline__ float shl_f(float v, int src) { return __int_as_float(__builtin_amdgcn_ds_bpermute(src << 2, __float_as_int(v))); }
__device__ __forceinline__ int shl_i(int v, int src) { return __builtin_amdgcn_ds_bpermute(src << 2, v); }
__device__ __forceinline__ float wave_sum(float v, int lane) {
#pragma unroll
  for (int o = 32; o > 0; o >>= 1) v += shx_f(v, o, lane);
  return v;
}

struct Inputs {
  const float *x, *c, *ctx, *c_ctx, *ada_w, *ada_b, *norm1_g, *norm2_g, *w_in, *w_out, *hy_conv_w, *hy_conv_b,
      *hy_f_w1, *hy_f_b1, *hy_f_w2, *hy_f_b2, *hy_f_w3, *hy_skip, *gla_wa2, *gla_ba2, *gla_norm_g, *router_w,
      *router_b, *exp_w1, *exp_w3, *exp_w2, *sh_w1, *sh_w3, *sh_w2, *final_g;
};

__device__ __forceinline__ int opq(int v) { asm volatile("" : "+s"(v)); return v; }
__device__ __forceinline__ int tid_opaque() { int t = threadIdx.x; asm volatile("" : "+v"(t)); return t; }
__device__ __forceinline__ int row_batch(int row) { return row < NL ? (row >> 11) : 16; }

#define XB_TMO      128
#define XB_XCNT(j)  (256  + 64 * (j))
#define XB_XSUB(j)  (1280 + 64 * (j))
#define XB_XGEN(j)  (2304 + 64 * (j))
#define XB_TOP      3328
#define XB_TOPGEN   3392
#define XCD_BAR_WORDS 3456
#define XB_SPIN_CAP (1u << 18)
#define LAS __attribute__((address_space(3)))

__device__ __forceinline__ unsigned xb_ld(unsigned* p)              { return __hip_atomic_load(p, __ATOMIC_RELAXED, __HIP_MEMORY_SCOPE_AGENT); }
__device__ __forceinline__ unsigned xb_add(unsigned* p, unsigned v) { return __hip_atomic_fetch_add(p, v, __ATOMIC_RELAXED, __HIP_MEMORY_SCOPE_AGENT); }
__device__ __forceinline__ unsigned xb_xcc_id() { return (unsigned)__builtin_amdgcn_s_getreg((3 << 11) | 20) & 0xFu; }
#define XB_SPIN(cond, bar) do { unsigned _sp = 0; while (cond) { __builtin_amdgcn_s_sleep(1); \
    if ((++_sp & 255u) == 0u) { if (xb_ld(&(bar)[XB_TMO])) break; if (_sp > XB_SPIN_CAP) { atomicAdd(&(bar)[XB_TMO], 1u); break; } } } } while (0)

struct XcdBarrier {
    unsigned* bar; unsigned x;
    volatile LAS unsigned* st;
};

__device__ __forceinline__ XcdBarrier xcd_barrier_post(unsigned* bar, volatile LAS unsigned* st) {
    XcdBarrier b; b.bar = bar; b.x = xb_xcc_id(); b.st = st;
    if (threadIdx.x == 0) (void)xb_add(&bar[XB_XCNT(b.x)], 1u);
    return b;
}
__device__ __forceinline__ void xcd_barrier_complete(unsigned* bar, unsigned x, unsigned& nloc, unsigned& nx) {
    const unsigned G = gridDim.x * gridDim.y * gridDim.z;
    unsigned sum, cnt, mine, sp = 0u;
    for (;;) {
        sum = 0u; cnt = 0u; mine = 0u;
#pragma unroll
        for (unsigned j = 0; j < 16; ++j) { const unsigned c = xb_ld(&bar[XB_XCNT(j)]); sum += c; cnt += (c > 0u) ? 1u : 0u; mine = (j == x) ? c : mine; }
        if (sum == G) break;
        __builtin_amdgcn_s_sleep(1);
        if ((++sp & 255u) == 0u) { if (xb_ld(&bar[XB_TMO])) break; if (sp > XB_SPIN_CAP) { atomicAdd(&bar[XB_TMO], 1u); break; } }
    }
    nloc = mine > 0u ? mine : 1u; nx = cnt > 0u ? cnt : 1u;
}
__device__ __forceinline__ void xcd_barrier(const XcdBarrier& b) {
    asm volatile("s_waitcnt vmcnt(0)" ::: "memory");
    __syncthreads();
    if (threadIdx.x == 0) {
        unsigned* bar = b.bar;
        __builtin_amdgcn_s_waitcnt(0);
        unsigned nloc = b.st[0], nx = b.st[1];
        if (nloc == 0u) { xcd_barrier_complete(bar, b.x, nloc, nx); b.st[0] = nloc; b.st[1] = nx; }
        const unsigned old = xb_add(&bar[XB_XSUB(b.x)], 1u);
        const unsigned gen = old / nloc;
        if (old + 1u == (gen + 1u) * nloc) {
            __builtin_amdgcn_fence(__ATOMIC_RELEASE, "agent");
            asm volatile("s_waitcnt vmcnt(0)" ::: "memory");
            const unsigned og = xb_add(&bar[XB_TOP], 1u);
            const unsigned tg = og / nx;
            if (og + 1u == (tg + 1u) * nx) xb_add(&bar[XB_TOPGEN], 1u);
            else XB_SPIN(xb_ld(&bar[XB_TOPGEN]) == tg, bar);
            __builtin_amdgcn_fence(__ATOMIC_ACQUIRE, "agent");
            xb_add(&bar[XB_XGEN(b.x)], 1u);
            asm volatile("s_waitcnt vmcnt(0)" ::: "memory");
        } else {
            XB_SPIN(xb_ld(&bar[XB_XGEN(b.x)]) == gen, bar);
            __builtin_amdgcn_fence(__ATOMIC_ACQUIRE, "agent");
            asm volatile("s_waitcnt vmcnt(0)" ::: "memory");
        }
    }
    __syncthreads();
}

__device__ __forceinline__ void grid_sync(unsigned* bar0, char* stw) {
  unsigned* q = bar0;
  asm volatile("" : "+s"(q));
  XcdBarrier b; b.bar = q; b.x = xb_xcc_id(); b.st = (volatile LAS unsigned*)stw;
  xcd_barrier(b);
}

typedef __attribute__((ext_vector_type(8))) __bf16 bf16x8;
typedef __attribute__((ext_vector_type(16))) float f32x16;
typedef __attribute__((ext_vector_type(4))) float f32x4;
typedef __attribute__((ext_vector_type(2))) float f32x2v;
typedef __attribute__((ext_vector_type(2))) __bf16 bf16x2v;
typedef __attribute__((ext_vector_type(4))) unsigned int u32x4;
typedef __attribute__((ext_vector_type(2))) unsigned int u32x2;

__device__ __forceinline__ unsigned pack_bf16(float a, float b) {
  f32x2v v = {a, b};
  return __builtin_bit_cast(unsigned, __builtin_convertvector(v, bf16x2v));
}
__device__ __forceinline__ f32x4 xs_load4(const bf16* p) {
  const u32x2 w = *(const u32x2*)p;
  return (f32x4){__uint_as_float(w.x << 16), __uint_as_float(w.x & 0xffff0000u), __uint_as_float(w.y << 16), __uint_as_float(w.y & 0xffff0000u)};
}
__device__ __forceinline__ void xs_store4(bf16* p, const f32x4 v) {
  u32x2 w; w.x = pack_bf16(v.x, v.y); w.y = pack_bf16(v.z, v.w);
  *(u32x2*)p = w;
}
__device__ __forceinline__ int swz(int row, int chunk) { return row * 128 + ((chunk ^ ((row >> 1) & 7)) << 4); }
__device__ __forceinline__ int rowmap(int reg, int lh) { return (reg & 3) + 8 * (reg >> 2) + 4 * lh; }

__device__ __forceinline__ int find_group(const int* __restrict__ pad_start, int m0) {
  int lo = 0, hi = NE - 1;
  while (lo < hi) {
    int mid = (lo + hi + 1) >> 1;
    if (pad_start[mid] <= m0) lo = mid; else hi = mid - 1;
  }
  return lo;
}

__device__ __forceinline__ void cvt_wave_tile(const float* __restrict__ src, bf16* __restrict__ dst, int K, int N, int kt, int ntile, int lane) {
  const int k0 = kt * 64 + (lane & 7) * 8, n0 = ntile * 32 + (lane >> 3) * 4;
  const float* s = src + (size_t)k0 * N + n0;
  const f32x4 v0 = __builtin_nontemporal_load((const f32x4*)(s)), v1 = __builtin_nontemporal_load((const f32x4*)(s + (size_t)N));
  const f32x4 v2 = __builtin_nontemporal_load((const f32x4*)(s + (size_t)2 * N)), v3 = __builtin_nontemporal_load((const f32x4*)(s + (size_t)3 * N));
  const f32x4 v4 = __builtin_nontemporal_load((const f32x4*)(s + (size_t)4 * N)), v5 = __builtin_nontemporal_load((const f32x4*)(s + (size_t)5 * N));
  const f32x4 v6 = __builtin_nontemporal_load((const f32x4*)(s + (size_t)6 * N)), v7 = __builtin_nontemporal_load((const f32x4*)(s + (size_t)7 * N));
  bf16* d = dst + (size_t)n0 * K + k0;
  *(u32x4*)(d) = (u32x4){pack_bf16(v0.x, v1.x), pack_bf16(v2.x, v3.x), pack_bf16(v4.x, v5.x), pack_bf16(v6.x, v7.x)};
  *(u32x4*)(d + (size_t)K) = (u32x4){pack_bf16(v0.y, v1.y), pack_bf16(v2.y, v3.y), pack_bf16(v4.y, v5.y), pack_bf16(v6.y, v7.y)};
  *(u32x4*)(d + (size_t)2 * K) = (u32x4){pack_bf16(v0.z, v1.z), pack_bf16(v2.z, v3.z), pack_bf16(v4.z, v5.z), pack_bf16(v6.z, v7.z)};
  *(u32x4*)(d + (size_t)3 * K) = (u32x4){pack_bf16(v0.w, v1.w), pack_bf16(v2.w, v3.w), pack_bf16(v4.w, v5.w), pack_bf16(v6.w, v7.w)};
}
typedef __attribute__((ext_vector_type(8))) int i32x8;
typedef __attribute__((ext_vector_type(4))) int i32x4;
__device__ __forceinline__ float clamp_fp8(float x) { return __builtin_amdgcn_fmed3f(x, -448.0f, 448.0f); }
__device__ __forceinline__ unsigned pk4_fp8(float a, float b, float c, float d) {
  a = clamp_fp8(a); b = clamp_fp8(b); c = clamp_fp8(c); d = clamp_fp8(d);
  int w = 0;
  w = __builtin_amdgcn_cvt_pk_fp8_f32(a, b, w, false);
  w = __builtin_amdgcn_cvt_pk_fp8_f32(c, d, w, true);
  return (unsigned)w;
}
__device__ __forceinline__ void cvt8_wave_tile(const float* __restrict__ src, unsigned char* __restrict__ dst, int K, int N, int kt, int ntile, int lane) {
  const int k0 = kt * 64 + (lane & 7) * 8, n0 = ntile * 32 + (lane >> 3) * 4;
  const float* s = src + (size_t)k0 * N + n0;
  const float sc = 16.0f;
  const f32x4 v0 = __builtin_nontemporal_load((const f32x4*)(s)) * sc, v1 = __builtin_nontemporal_load((const f32x4*)(s + (size_t)N)) * sc;
  const f32x4 v2 = __builtin_nontemporal_load((const f32x4*)(s + (size_t)2 * N)) * sc, v3 = __builtin_nontemporal_load((const f32x4*)(s + (size_t)3 * N)) * sc;
  const f32x4 v4 = __builtin_nontemporal_load((const f32x4*)(s + (size_t)4 * N)) * sc, v5 = __builtin_nontemporal_load((const f32x4*)(s + (size_t)5 * N)) * sc;
  const f32x4 v6 = __builtin_nontemporal_load((const f32x4*)(s + (size_t)6 * N)) * sc, v7 = __builtin_nontemporal_load((const f32x4*)(s + (size_t)7 * N)) * sc;
  unsigned char* d = dst + (size_t)n0 * K + k0;
  *(u32x2*)(d) = (u32x2){pk4_fp8(v0.x, v1.x, v2.x, v3.x), pk4_fp8(v4.x, v5.x, v6.x, v7.x)};
  *(u32x2*)(d + (size_t)K) = (u32x2){pk4_fp8(v0.y, v1.y, v2.y, v3.y), pk4_fp8(v4.y, v5.y, v6.y, v7.y)};
  *(u32x2*)(d + (size_t)2 * K) = (u32x2){pk4_fp8(v0.z, v1.z, v2.z, v3.z), pk4_fp8(v4.z, v5.z, v6.z, v7.z)};
  *(u32x2*)(d + (size_t)3 * K) = (u32x2){pk4_fp8(v0.w, v1.w, v2.w, v3.w), pk4_fp8(v4.w, v5.w, v6.w, v7.w)};
}
__device__ __forceinline__ void cvt8_job(const float* __restrict__ src, unsigned char* __restrict__ dst, int K, int N, int nmat, int bid, int nblk, int W = 0) {
  const int tid = tid_opaque(), lane = tid & 63, wave = tid >> 6;
  if (W == 0) W = N;
  const int tk = K >> 6, tn = W >> 5, per = tk * tn;
  const int total = per * nmat;
  for (int u = bid * 8 + wave; u < total; u += nblk * 8) {
    const int mat = u / per, r = u - mat * per;
    const int ntile = r / tk, kt = r - ntile * tk;
    cvt8_wave_tile(src + (size_t)mat * K * N, dst + (size_t)mat * K * W, K, N, kt, ntile, lane);
  }
}

__device__ __forceinline__ void cvt_job(const float* __restrict__ src, bf16* __restrict__ dst, int K, int N, int nmat, int bid, int nblk, int W = 0) {
  const int tid = tid_opaque(), lane = tid & 63, wave = tid >> 6;
  if (W == 0) W = N;
  const int tk = K >> 6, tn = W >> 5, per = tk * tn;
  const int total = per * nmat;
  for (int u = bid * 8 + wave; u < total; u += nblk * 8) {
    const int mat = u / per, r = u - mat * per;
    const int ntile = r / tk, kt = r - ntile * tk;
    cvt_wave_tile(src + (size_t)mat * K * N, dst + (size_t)mat * K * W, K, N, kt, ntile, lane);
  }
}

constexpr int G8_HT = 128 * 64;
constexpr int G8_LDS = 8 * G8_HT * 2;

__device__ __forceinline__ int g8_lds_byte(int r, int c) {
  int st = (r >> 4) * 2 + (c >> 5), rr = r & 15, cc = c & 31, ob = rr * 64 + cc * 2;
  return st * 1024 + (ob ^ (((ob >> 9) & 1) << 5));
}
__device__ __forceinline__ void g8_stage_rc(int b, int& R, int& C) {
  int st = b / 1024, sb = b % 1024, sw = sb ^ (((sb >> 9) & 1) << 5);
  R = (st >> 1) * 16 + sw / 64; C = (st & 1) * 32 + (sw % 64) / 2;
}

typedef f32x4 g8acc_t[2][2][4][2];

template <class P>
__device__ __forceinline__ void gemm8_run(const P& p, char* smem, int bid, int nblk) {
  const int ntl = __builtin_amdgcn_readfirstlane(p.ntiles());
  if (bid >= ntl) return;
  bf16* shm = (bf16*)smem;
#define SA(b, h) (shm + ((b) * 2 + (h)) * G8_HT)
#define SB(b, h) (shm + (4 + (b) * 2 + (h)) * G8_HT)
#define GLDS(SRC, DST) __builtin_amdgcn_global_load_lds((const unsigned*)(SRC), (unsigned*)(DST), 16, 0, 0)
#define STAGE_A(PP, BASE, KT) do { GLDS((BASE) + (oa + (KT) * 64), (char*)(PP) + ldsd); GLDS((BASE) + 64 * P::A_PITCH + (oa + (KT) * 64), (char*)(PP) + ldsd + 8192); } while (0)
#define STAGE_B(PP, BASE, OB, KT) do { \
    if constexpr (P::B_GATHER) { GLDS((BASE) + ((((OB) & 0xffffu) * (unsigned)P::B_PITCH + cc) + (KT) * 64), (char*)(PP) + ldsd); \
                                 GLDS((BASE) + ((((OB) >> 16) * (unsigned)P::B_PITCH + cc) + (KT) * 64), (char*)(PP) + ldsd + 8192); } \
    else { GLDS((BASE) + ((OB) + (KT) * 64), (char*)(PP) + ldsd); GLDS((BASE) + 64 * P::B_PITCH + ((OB) + (KT) * 64), (char*)(PP) + ldsd + 8192); } } while (0)
#define LDA(dst, b, h) for (int m = 0; m < 4; ++m) \
    dst[m] = __builtin_shufflevector(*reinterpret_cast<const i32x4*>((char*)SA(b, h) + aoff + m * 2048), \
                                     *reinterpret_cast<const i32x4*>((char*)SA(b, h) + aoff + m * 2048 + 1024), 0, 1, 2, 3, 4, 5, 6, 7)
#define LDB(dst, b, h) for (int n = 0; n < 2; ++n) \
    dst[n] = __builtin_shufflevector(*reinterpret_cast<const i32x4*>((char*)SB(b, h) + boff + n * 2048), \
                                     *reinterpret_cast<const i32x4*>((char*)SB(b, h) + boff + n * 2048 + 1024), 0, 1, 2, 3, 4, 5, 6, 7)
#define FRAG_LO(x) __builtin_bit_cast(bf16x8, __builtin_shufflevector(x, x, 0, 1, 2, 3))
#define FRAG_HI(x) __builtin_bit_cast(bf16x8, __builtin_shufflevector(x, x, 4, 5, 6, 7))
#define MMA(ai, bj, At_, Bt_) do { __builtin_amdgcn_s_setprio(1); \
    if constexpr (P::FP8) { \
      for (int m = 0; m < 4; ++m) for (int n = 0; n < 2; ++n) \
        asm volatile("v_mfma_f32_16x16x128_f8f6f4 %0, %1, %2, %0" \
                     : "+v"(acc[ai][bj][m][n]) : "v"(At_[m]), "v"(Bt_[n])); \
    } else { \
      for (int m = 0; m < 4; ++m) for (int n = 0; n < 2; ++n) { \
        acc[ai][bj][m][n] = __builtin_amdgcn_mfma_f32_16x16x32_bf16(FRAG_LO(At_[m]), FRAG_LO(Bt_[n]), acc[ai][bj][m][n], 0, 0, 0); \
        acc[ai][bj][m][n] = __builtin_amdgcn_mfma_f32_16x16x32_bf16(FRAG_HI(At_[m]), FRAG_HI(Bt_[n]), acc[ai][bj][m][n], 0, 0, 0); } \
    } \
    __builtin_amdgcn_s_setprio(0); } while (0)
#define WAIT_V(n) asm volatile("s_waitcnt vmcnt(" #n ")" ::: "memory")
#define WAIT_L(n) asm volatile("s_waitcnt lgkmcnt(" #n ")" ::: "memory")
#define BAR __builtin_amdgcn_s_barrier()
#define SCHED __builtin_amdgcn_sched_barrier(0)

  typename P::Ctx cur, nxt;
  p.tile(bid, cur);
  int aoff, boff, ldsd;
  unsigned oa, cc, ob0, ob1;
  bool wr1;
  {
    const int tid = tid_opaque();
    const int wid = tid >> 6, lane = tid & 63, wr = wid >> 2, wc = wid & 3, fr = lane & 15, fq = lane >> 4;
    aoff = g8_lds_byte(wr * 64 + fr, fq * 8); boff = g8_lds_byte(wc * 32 + fr, fq * 8);
    ldsd = tid * 16; wr1 = (wr == 1);
    int R0, C0;
    g8_stage_rc(tid * 16, R0, C0);
    cc = C0;
    oa = (((R0 >> 2) & 3) * 16 + (R0 >> 4) * 4 + (R0 & 3)) * P::A_PITCH + C0;
    if constexpr (P::B_GATHER) {
      ob0 = p.b_row(cur, 0, R0) | (p.b_row(cur, 0, R0 + 64) << 16);
      ob1 = p.b_row(cur, 1, R0) | (p.b_row(cur, 1, R0 + 64) << 16);
    } else { ob0 = R0 * P::B_PITCH + C0; ob1 = ob0; }
  }
  const bf16* ca0 = p.a_base(cur, 0);
  const bf16* ca1 = p.a_base(cur, 1);
  const bf16* cb0 = p.b_base(cur, 0);
  const bf16* cb1 = p.b_base(cur, 1);

  g8acc_t acc;
#pragma unroll
  for (int a0 = 0; a0 < 2; ++a0)
#pragma unroll
    for (int b0 = 0; b0 < 2; ++b0)
#pragma unroll
      for (int m = 0; m < 4; ++m)
#pragma unroll
        for (int n = 0; n < 2; ++n) acc[a0][b0][m][n] = (f32x4){0.f, 0.f, 0.f, 0.f};
  i32x8 At[4], B0[2], B1[2];
  const int mxs = 0x7F7F7F7F;
  const int nt = opq(P::NKT);
  STAGE_B(SB(0, 0), cb0, ob0, 0); STAGE_A(SA(0, 0), ca0, 0);
  STAGE_B(SB(0, 1), cb1, ob1, 0); STAGE_A(SA(0, 1), ca1, 0);
  if (wr1) BAR;
  WAIT_V(4); BAR;
  STAGE_B(SB(1, 0), cb0, ob0, 1); STAGE_A(SA(1, 0), ca0, 1); STAGE_B(SB(1, 1), cb1, ob1, 1);
  WAIT_V(6); BAR;
#pragma unroll 1
  for (int idx = bid;;) {
    const int nidx = idx + nblk;
    const bool has_next = nidx < ntl;
    if (has_next) p.tile(nidx, nxt); else nxt = cur;
    const bf16* na0 = p.a_base(nxt, 0);
    const bf16* na1 = p.a_base(nxt, 1);
    const bf16* nb0 = p.b_base(nxt, 0);
    const bf16* nb1 = p.b_base(nxt, 1);
    unsigned nob0 = ob0, nob1 = ob1;
    if constexpr (P::B_GATHER) {
      const int t2 = tid_opaque();
      int R0, C0;
      g8_stage_rc(t2 * 16, R0, C0);
      nob0 = p.b_row(nxt, 0, R0) | (p.b_row(nxt, 0, R0 + 64) << 16);
      nob1 = p.b_row(nxt, 1, R0) | (p.b_row(nxt, 1, R0 + 64) << 16);
    }
#pragma unroll 1
    for (int t = 0; t < nt; t += 2) {
      const bool last = (t == nt - 2);
      const bf16* a2h0 = last ? na0 : ca0; const bf16* a2h1 = last ? na1 : ca1;
      const bf16* b2h0 = last ? nb0 : cb0; const bf16* b2h1 = last ? nb1 : cb1;
      const int k2 = last ? 0 : t + 2;
      const unsigned q0 = last ? nob0 : ob0, q1 = last ? nob1 : ob1;
      LDB(B0, 0, 0); SCHED; LDA(At, 0, 0); STAGE_A(SA(1, 1), ca1, t + 1);
      WAIT_L(8); BAR; WAIT_L(0); MMA(0, 0, At, B0); BAR; SCHED;
      LDB(B1, 0, 1); STAGE_B(SB(0, 0), b2h0, q0, k2);
      BAR; WAIT_L(0); MMA(0, 1, At, B1); BAR;
      LDA(At, 0, 1); STAGE_A(SA(0, 0), a2h0, k2);
      BAR; WAIT_L(0); MMA(1, 0, At, B0); BAR; SCHED;
      STAGE_B(SB(0, 1), b2h1, q1, k2);
      WAIT_V(6); BAR; MMA(1, 1, At, B1); BAR;
      LDB(B0, 1, 0); SCHED; LDA(At, 1, 0); STAGE_A(SA(0, 1), a2h1, k2);
      WAIT_L(8); BAR; WAIT_L(0); MMA(0, 0, At, B0); BAR; SCHED;
      LDB(B1, 1, 1); STAGE_B(SB(1, 0), b2h0, q0, k2 + 1);
      BAR; WAIT_L(0); MMA(0, 1, At, B1); BAR;
      LDA(At, 1, 1); STAGE_A(SA(1, 0), a2h0, k2 + 1);
      BAR; WAIT_L(0); MMA(1, 0, At, B0); BAR; SCHED;
      STAGE_B(SB(1, 1), b2h1, q1, k2 + 1);
      WAIT_V(6); BAR; MMA(1, 1, At, B1); BAR;
    }
    if constexpr (P::FP8) asm volatile("s_nop 15\n\ts_nop 15" ::: "memory");
    {
      const int t3 = tid_opaque();
      const int wid = t3 >> 6, lane = t3 & 63;
      p.epi(cur, acc, wid >> 2, wid & 3, lane & 15, lane >> 4);
    }
    if (!has_next) break;
#pragma unroll
    for (int a0 = 0; a0 < 2; ++a0)
#pragma unroll
      for (int b0 = 0; b0 < 2; ++b0)
#pragma unroll
        for (int m = 0; m < 4; ++m)
#pragma unroll
          for (int n = 0; n < 2; ++n) acc[a0][b0][m][n] = (f32x4){0.f, 0.f, 0.f, 0.f};
    cur = nxt; ca0 = na0; ca1 = na1; cb0 = nb0; cb1 = nb1;
    ob0 = nob0; ob1 = nob1;
    idx = nidx;
  }
  WAIT_V(0);
  if (!wr1) BAR;
  BAR;
#undef SA
#undef SB
#undef GLDS
#undef STAGE_A
#undef STAGE_B
#undef LDA
#undef LDB
#undef MMA
#undef FRAG_LO
#undef FRAG_HI
#undef WAIT_V
#undef WAIT_L
#undef BAR
#undef SCHED
}

#define G8_FOR_BLK(AI, BJ, M, N) \
  _Pragma("unroll") for (int AI = 0; AI < 2; ++AI) _Pragma("unroll") for (int BJ = 0; BJ < 2; ++BJ) \
  _Pragma("unroll") for (int M = 0; M < 4; ++M) _Pragma("unroll") for (int N = 0; N < 2; ++N)
#define G8_AIDX(AI, M) ((AI) * 128 + wr * 64 + fq * 16 + (M) * 4)
#define G8_BIDX(BJ, N) ((BJ) * 128 + wc * 32 + (N) * 16 + fr)
__device__ __forceinline__ u32x2 pack4_bf16(const f32x4 v) { return (u32x2){pack_bf16(v.x, v.y), pack_bf16(v.z, v.w)}; }
__device__ __forceinline__ unsigned pack4_fp8(const f32x4 v) { return pk4_fp8(v.x, v.y, v.z, v.w); }
__device__ __forceinline__ u32x4 pack8_bf16(const f32x4 a, const f32x4 b) { return (u32x4){pack_bf16(a.x, a.y), pack_bf16(a.z, a.w), pack_bf16(b.x, b.y), pack_bf16(b.z, b.w)}; }
#define G8_FOR_BLK2(AI, BJ, M2, N) \
  _Pragma("unroll") for (int AI = 0; AI < 2; ++AI) _Pragma("unroll") for (int BJ = 0; BJ < 2; ++BJ) \
  _Pragma("unroll") for (int M2 = 0; M2 < 4; M2 += 2) _Pragma("unroll") for (int N = 0; N < 2; ++N)

struct G8InZT {
  static constexpr int NKT = 16; static constexpr bool B_GATHER = false; static constexpr bool FP8 = false; static constexpr int B_PITCH = D; static constexpr int A_PITCH = D;
  template <class C_> __device__ unsigned b_row(const C_&, int, int) const { return 0u; }
  struct Ctx { int t0, z0; };
  const bf16* wt; const bf16* A; bf16* zt; int ntok;
  __device__ int ntiles() const { return 6 * (ntok / 256); }
  __device__ void tile(int idx, Ctx& c) const { int tt = idx / 6; c.z0 = (idx - tt * 6) * 256; c.t0 = tt * 256; }
  __device__ const bf16* a_base(const Ctx& c, int h) const { return A + (size_t)(c.t0 + h * 128) * D; }
  __device__ unsigned a_off(const Ctx&, int, int r) const { return r * D; }
  __device__ const bf16* b_base(const Ctx& c, int h) const { return wt + (size_t)(c.z0 + h * 128) * D; }
  __device__ unsigned b_off(const Ctx&, int, int r) const { return r * D; }
  __device__ void epi(const Ctx& c, g8acc_t& acc, int wr, int wc, int fr, int fq) const {
    G8_FOR_BLK2(ai, bj, m, n) {
      const int tok = c.t0 + G8_AIDX(ai, m), z = c.z0 + G8_BIDX(bj, n);
      *(u32x4*)(zt + (size_t)z * NT + tok) = pack8_bf16(acc[ai][bj][m][n], acc[ai][bj][m + 1][n]);
    }
  }
};
struct G8InG {
  static constexpr int NKT = 8; static constexpr bool B_GATHER = false; static constexpr bool FP8 = true; static constexpr int B_PITCH = D / 2; static constexpr int A_PITCH = D / 2;
  template <class C_> __device__ unsigned b_row(const C_&, int, int) const { return 0u; }
  struct Ctx { int c0, t0; };
  const unsigned char* wt; const unsigned char* A; bf16* zg;
  __device__ int ntiles() const { return 7 * (NT / 256); }
  __device__ void tile(int idx, Ctx& c) const { int tt = idx / 7; c.t0 = tt * 256; c.c0 = (idx - tt * 7) * 256; }
  __device__ const bf16* a_base(const Ctx& c, int h) const { return (const bf16*)(wt + (size_t)(c.c0 + h * 128) * D); }
  __device__ unsigned a_off(const Ctx&, int, int r) const { return r * (D / 2); }
  __device__ const bf16* b_base(const Ctx& c, int h) const { return (const bf16*)(A + (size_t)(c.t0 + h * 128) * D); }
  __device__ unsigned b_off(const Ctx&, int, int r) const { return r * (D / 2); }
  __device__ void epi(const Ctx& c, g8acc_t& acc, int wr, int wc, int fr, int fq) const {
    const float isc = 1.0f / 16.0f;
    G8_FOR_BLK2(ai, bj, m, n) {
      const int col = c.c0 + G8_AIDX(ai, m), tok = c.t0 + G8_BIDX(bj, n);
      if (col < GLACOLS) *(u32x4*)(zg + (size_t)tok * GLACOLS + col) = pack8_bf16(acc[ai][bj][m][n] * isc, acc[ai][bj][m + 1][n] * isc);
    }
  }
};
struct G8Out {
  static constexpr int NKT = 16; static constexpr bool B_GATHER = false; static constexpr bool FP8 = false; static constexpr int B_PITCH = D; static constexpr int A_PITCH = D;
  template <class C_> __device__ unsigned b_row(const C_&, int, int) const { return 0u; }
  struct Ctx { int c0, t0; };
  int mrows; const bf16* ymix; const bf16* wt; const float* modl; bf16* xs;
  __device__ int ntiles() const { return (mrows / 256) * 4; }
  __device__ void tile(int idx, Ctx& c) const { c.t0 = (idx >> 2) * 256; c.c0 = (idx & 3) * 256; }
  __device__ const bf16* a_base(const Ctx& c, int h) const { return wt + (size_t)(c.c0 + h * 128) * D; }
  __device__ unsigned a_off(const Ctx&, int, int r) const { return r * D; }
  __device__ const bf16* b_base(const Ctx& c, int h) const { return ymix + (size_t)(c.t0 + h * 128) * D; }
  __device__ unsigned b_off(const Ctx&, int, int r) const { return r * D; }
  __device__ void epi(const Ctx& c, g8acc_t& acc, int wr, int wc, int fr, int fq) const {
    const float* g1 = modl + (size_t)row_batch(c.t0) * 6 * D + 2 * D;
#pragma unroll
    for (int ai = 0; ai < 2; ++ai)
#pragma unroll
      for (int bj = 0; bj < 2; ++bj)
#pragma unroll
        for (int n = 0; n < 2; ++n) {
          const int col = c.c0 + G8_AIDX(ai, 0), tok = c.t0 + G8_BIDX(bj, n);
          bf16* xp = xs + (size_t)tok * D + col;
          const u32x4 w0 = *(const u32x4*)xp, w1 = *(const u32x4*)(xp + 8);
          const f32x4 r0 = (f32x4){__uint_as_float(w0.x << 16), __uint_as_float(w0.x & 0xffff0000u), __uint_as_float(w0.y << 16), __uint_as_float(w0.y & 0xffff0000u)} + *(const f32x4*)(g1 + col) * acc[ai][bj][0][n];
          const f32x4 r1 = (f32x4){__uint_as_float(w0.z << 16), __uint_as_float(w0.z & 0xffff0000u), __uint_as_float(w0.w << 16), __uint_as_float(w0.w & 0xffff0000u)} + *(const f32x4*)(g1 + col + 4) * acc[ai][bj][1][n];
          const f32x4 r2 = (f32x4){__uint_as_float(w1.x << 16), __uint_as_float(w1.x & 0xffff0000u), __uint_as_float(w1.y << 16), __uint_as_float(w1.y & 0xffff0000u)} + *(const f32x4*)(g1 + col + 8) * acc[ai][bj][2][n];
          const f32x4 r3 = (f32x4){__uint_as_float(w1.z << 16), __uint_as_float(w1.z & 0xffff0000u), __uint_as_float(w1.w << 16), __uint_as_float(w1.w & 0xffff0000u)} + *(const f32x4*)(g1 + col + 12) * acc[ai][bj][3][n];
          *(u32x4*)xp = (u32x4){pack_bf16(r0.x, r0.y), pack_bf16(r0.z, r0.w), pack_bf16(r1.x, r1.y), pack_bf16(r1.z, r1.w)};
          *(u32x4*)(xp + 8) = (u32x4){pack_bf16(r2.x, r2.y), pack_bf16(r2.z, r2.w), pack_bf16(r3.x, r3.y), pack_bf16(r3.z, r3.w)};
        }
  }
};
struct G8Router {
  static constexpr int NKT = 16; static constexpr bool B_GATHER = false; static constexpr bool FP8 = false; static constexpr int B_PITCH = D; static constexpr int A_PITCH = D;
  template <class C_> __device__ unsigned b_row(const C_&, int, int) const { return 0u; }
  struct Ctx { int t0; };
  int mrows; const bf16* A; const bf16* rwt; float* logits;
  __device__ int ntiles() const { return mrows / 256; }
  __device__ void tile(int idx, Ctx& c) const { c.t0 = idx * 256; }
  __device__ const bf16* a_base(const Ctx&, int h) const { return rwt + (size_t)(h * 128) * D; }
  __device__ unsigned a_off(const Ctx&, int, int r) const { return r * D; }
  __device__ const bf16* b_base(const Ctx& c, int h) const { return A + (size_t)(c.t0 + h * 128) * D; }
  __device__ unsigned b_off(const Ctx&, int, int r) const { return r * D; }
  __device__ void epi(const Ctx& c, g8acc_t& acc, int wr, int wc, int fr, int fq) const {
    G8_FOR_BLK(ai, bj, m, n) {
      const int e = G8_AIDX(ai, m), tok = c.t0 + G8_BIDX(bj, n);
      *(f32x4*)(logits + (size_t)tok * NE + e) = acc[ai][bj][m][n];
    }
  }
};
struct G8ShUp {
  static constexpr int NKT = 8; static constexpr bool B_GATHER = false; static constexpr bool FP8 = true; static constexpr int B_PITCH = D / 2; static constexpr int A_PITCH = D / 2;
  template <class C_> __device__ unsigned b_row(const C_&, int, int) const { return 0u; }
  struct Ctx { int t0, hb; };
  int mrows; const unsigned char* A8; const unsigned char* s1t; const unsigned char* s3t; unsigned char* hs;
  __device__ int ntiles() const { return (mrows / 256) * 2; }
  __device__ void tile(int idx, Ctx& c) const { c.t0 = (idx >> 1) * 256; c.hb = (idx & 1) * 128; }
  __device__ const bf16* a_base(const Ctx& c, int h) const { return (const bf16*)((h ? s3t : s1t) + (size_t)c.hb * D); }
  __device__ unsigned a_off(const Ctx&, int, int r) const { return r * (D / 2); }
  __device__ const bf16* b_base(const Ctx& c, int h) const { return (const bf16*)(A8 + (size_t)(c.t0 + h * 128) * D); }
  __device__ unsigned b_off(const Ctx&, int, int r) const { return r * (D / 2); }
  __device__ void epi(const Ctx& c, g8acc_t& acc, int wr, int wc, int fr, int fq) const {
    const float isc = 1.0f / 16.0f;
#pragma unroll
    for (int bj = 0; bj < 2; ++bj)
#pragma unroll
      for (int n = 0; n < 2; ++n) {
        const int hcol = c.hb + wr * 64 + fq * 16, tok = c.t0 + G8_BIDX(bj, n);
        u32x4 o;
#pragma unroll
        for (int m = 0; m < 4; ++m) {
          const f32x4 u = acc[0][bj][m][n] * isc, v = acc[1][bj][m][n] * isc;
          const unsigned w = pk4_fp8(silu_f(u.x) * v.x, silu_f(u.y) * v.y, silu_f(u.z) * v.z, silu_f(u.w) * v.w);
          if (m == 0) o.x = w; else if (m == 1) o.y = w; else if (m == 2) o.z = w; else o.w = w;
        }
        *(u32x4*)(hs + (size_t)tok * DE + hcol) = o;
      }
  }
};
struct G8Up {
  static constexpr int NKT = 8; static constexpr bool B_GATHER = true; static constexpr bool FP8 = true; static constexpr int B_PITCH = D / 2; static constexpr int A_PITCH = D / 2;
  struct Ctx { int s0, hb, grp; };
  const unsigned char* A8; const int* slot_tok; const int* pad_start; const unsigned char* w1t; const unsigned char* w3t; unsigned char* H; const unsigned short* tile_e;
  __device__ int ntiles() const { return (pad_start[NE] >> 8) * 2; }
  __device__ void tile(int idx, Ctx& c) const { c.s0 = (idx >> 1) * 256; c.hb = (idx & 1) * 128; c.grp = __builtin_amdgcn_readfirstlane((int)tile_e[idx >> 1]); }
  __device__ const bf16* a_base(const Ctx& c, int h) const { return (const bf16*)((h ? w3t : w1t) + ((size_t)c.grp * DE + c.hb) * D); }
  __device__ unsigned a_off(const Ctx&, int, int r) const { return r * (D / 2); }
  __device__ const bf16* b_base(const Ctx&, int) const { return (const bf16*)A8; }
  __device__ unsigned b_off(const Ctx&, int, int) const { return 0u; }
  __device__ unsigned b_row(const Ctx& c, int h, int r) const { int t = slot_tok[c.s0 + h * 128 + r]; t = (t < 0 || t >= NT) ? 0 : t; return (unsigned)t; }
  __device__ void epi(const Ctx& c, g8acc_t& acc, int wr, int wc, int fr, int fq) const {
    const float isc = 1.0f / 16.0f;
#pragma unroll
    for (int bj = 0; bj < 2; ++bj)
#pragma unroll
      for (int n = 0; n < 2; ++n) {
        const int hcol = c.hb + wr * 64 + fq * 16, slot = c.s0 + G8_BIDX(bj, n);
        u32x4 o;
#pragma unroll
        for (int m = 0; m < 4; ++m) {
          const f32x4 u = acc[0][bj][m][n] * isc, v = acc[1][bj][m][n] * isc;
          const unsigned w = pk4_fp8(silu_f(u.x) * v.x, silu_f(u.y) * v.y, silu_f(u.z) * v.z, silu_f(u.w) * v.w);
          if (m == 0) o.x = w; else if (m == 1) o.y = w; else if (m == 2) o.z = w; else o.w = w;
        }
        *(u32x4*)(H + (size_t)slot * DE + hcol) = o;
      }
  }
};
struct G8ShDown {
  static constexpr int NKT = 2; static constexpr bool B_GATHER = false; static constexpr bool FP8 = true; static constexpr int B_PITCH = DE / 2; static constexpr int A_PITCH = DE / 2;
  template <class C_> __device__ unsigned b_row(const C_&, int, int) const { return 0u; }
  struct Ctx { int c0, t0; };
  int mrows; const unsigned char* hs; const unsigned char* wt; unsigned char* ysh;
  __device__ int ntiles() const { return (mrows / 256) * 4; }
  __device__ void tile(int idx, Ctx& c) const { c.t0 = (idx >> 2) * 256; c.c0 = (idx & 3) * 256; }
  __device__ const bf16* a_base(const Ctx& c, int h) const { return (const bf16*)(wt + (size_t)(c.c0 + h * 128) * DE); }
  __device__ unsigned a_off(const Ctx&, int, int r) const { return r * (DE / 2); }
  __device__ const bf16* b_base(const Ctx& c, int h) const { return (const bf16*)(hs + (size_t)(c.t0 + h * 128) * DE); }
  __device__ unsigned b_off(const Ctx&, int, int r) const { return r * (DE / 2); }
  __device__ void epi(const Ctx& c, g8acc_t& acc, int wr, int wc, int fr, int fq) const {
    const float isc = 1.0f / 16.0f;
#pragma unroll
    for (int ai = 0; ai < 2; ++ai)
#pragma unroll
      for (int bj = 0; bj < 2; ++bj)
#pragma unroll
        for (int n = 0; n < 2; ++n) {
          const int col = c.c0 + G8_AIDX(ai, 0), tok = c.t0 + G8_BIDX(bj, n);
          u32x4 o;
          o.x = pack4_fp8(acc[ai][bj][0][n] * isc); o.y = pack4_fp8(acc[ai][bj][1][n] * isc);
          o.z = pack4_fp8(acc[ai][bj][2][n] * isc); o.w = pack4_fp8(acc[ai][bj][3][n] * isc);
          *(u32x4*)(ysh + (size_t)tok * D + col) = o;
        }
  }
};
struct G8Down {
  static constexpr int NKT = 2; static constexpr bool B_GATHER = false; static constexpr bool FP8 = true; static constexpr int B_PITCH = DE / 2; static constexpr int A_PITCH = DE / 2;
  struct Ctx { int c0, s0, grp; };
  const unsigned char* H; const int* pad_start; const unsigned char* w2t; unsigned char* Y; const unsigned short* tile_e;
  template <class C_> __device__ unsigned b_row(const C_&, int, int) const { return 0u; }
  __device__ int ntiles() const { return (pad_start[NE] >> 8) * 4; }
  __device__ void tile(int idx, Ctx& c) const { c.s0 = (idx >> 2) * 256; c.c0 = (idx & 3) * 256; c.grp = __builtin_amdgcn_readfirstlane((int)tile_e[idx >> 2]); }
  __device__ const bf16* a_base(const Ctx& c, int h) const { return (const bf16*)(w2t + ((size_t)c.grp * D + c.c0 + h * 128) * DE); }
  __device__ unsigned a_off(const Ctx&, int, int r) const { return r * (DE / 2); }
  __device__ const bf16* b_base(const Ctx& c, int h) const { return (const bf16*)(H + (size_t)(c.s0 + h * 128) * DE); }
  __device__ unsigned b_off(const Ctx&, int, int r) const { return r * (DE / 2); }
  __device__ void epi(const Ctx& c, g8acc_t& acc, int wr, int wc, int fr, int fq) const {
    const float isc = 1.0f / 16.0f;
#pragma unroll
    for (int ai = 0; ai < 2; ++ai)
#pragma unroll
      for (int bj = 0; bj < 2; ++bj)
#pragma unroll
        for (int n = 0; n < 2; ++n) {
          const int col = c.c0 + G8_AIDX(ai, 0), slot = c.s0 + G8_BIDX(bj, n);
          u32x4 o;
          o.x = pack4_fp8(acc[ai][bj][0][n] * isc); o.y = pack4_fp8(acc[ai][bj][1][n] * isc);
          o.z = pack4_fp8(acc[ai][bj][2][n] * isc); o.w = pack4_fp8(acc[ai][bj][3][n] * isc);
          *(u32x4*)(Y + (size_t)slot * D + col) = o;
        }
  }
};

constexpr int CVT_TILES = 3 * NE * 128;
struct CvtCtx { const float* w1; const float* w3; const float* w2; unsigned char* d1; unsigned char* d3; unsigned char* d2; };
struct CvtRegs { int pend; f32x4 r0, r1, r2, r3, r4, r5, r6, r7; };
__device__ __forceinline__ void cvt_locate(const CvtCtx& js, int u, int lane, const float*& s, unsigned char*& d, int& K, int& N) {
  const int job = u >> 15, r = u & 32767, mat = r >> 7, rr = r & 127;
  int kt, ntile;
  if (job < 2) { K = D; N = DE; ntile = rr >> 4; kt = rr & 15; } else { K = DE; N = D; ntile = rr >> 2; kt = rr & 3; }
  const float* s1 = js.w1; const float* s3 = js.w3; const float* s2 = js.w2;
  unsigned char* q1 = js.d1; unsigned char* q3 = js.d3; unsigned char* q2 = js.d2;
  const float* sb = job == 0 ? s1 : (job == 1 ? s3 : s2);
  unsigned char* db = job == 0 ? q1 : (job == 1 ? q3 : q2);
  const int k0 = kt * 64 + (lane & 7) * 8, n0 = ntile * 32 + (lane >> 3) * 4;
  s = sb + (size_t)mat * D * DE + (size_t)k0 * N + n0;
  d = db + (size_t)mat * D * DE + (size_t)n0 * K + k0;
}
__device__ __forceinline__ void cvt_init(CvtRegs& st) {
  st.pend = -1;
  st.r0 = st.r1 = st.r2 = st.r3 = st.r4 = st.r5 = st.r6 = st.r7 = (f32x4){0.f, 0.f, 0.f, 0.f};
}
__device__ __forceinline__ void cvt_finish(const CvtCtx& cx, CvtRegs& st, int lane) {
  if (st.pend < 0) return;
  const float* s; unsigned char* d; int K, N;
  cvt_locate(cx, st.pend, lane, s, d, K, N);
  const float sc = 16.0f;
  const f32x4 v0 = st.r0 * sc, v1 = st.r1 * sc, v2 = st.r2 * sc, v3 = st.r3 * sc, v4 = st.r4 * sc, v5 = st.r5 * sc, v6 = st.r6 * sc, v7 = st.r7 * sc;
  *(u32x2*)(d) = (u32x2){pk4_fp8(v0.x, v1.x, v2.x, v3.x), pk4_fp8(v4.x, v5.x, v6.x, v7.x)};
  *(u32x2*)(d + (size_t)K) = (u32x2){pk4_fp8(v0.y, v1.y, v2.y, v3.y), pk4_fp8(v4.y, v5.y, v6.y, v7.y)};
  *(u32x2*)(d + (size_t)2 * K) = (u32x2){pk4_fp8(v0.z, v1.z, v2.z, v3.z), pk4_fp8(v4.z, v5.z, v6.z, v7.z)};
  *(u32x2*)(d + (size_t)3 * K) = (u32x2){pk4_fp8(v0.w, v1.w, v2.w, v3.w), pk4_fp8(v4.w, v5.w, v6.w, v7.w)};
  st.pend = -1;
}
constexpr int CVT_GLA_TILES = 128 * 36 * 2 * 8;
static_assert(CVT_GLA_TILES + 512 * 2 * 3 * 8 == CVT_TILES, "tile ownership must cover every tile exactly once");
__device__ __forceinline__ void cvt_step(const CvtCtx& cx, CvtRegs& st, int lane, int u) {
  cvt_finish(cx, st, lane);
  const float* s; unsigned char* d; int K, N;
  cvt_locate(cx, u, lane, s, d, K, N);
  st.r0 = __builtin_nontemporal_load((const f32x4*)(s));
  st.r1 = __builtin_nontemporal_load((const f32x4*)(s + (size_t)N));
  st.r2 = __builtin_nontemporal_load((const f32x4*)(s + (size_t)2 * N));
  st.r3 = __builtin_nontemporal_load((const f32x4*)(s + (size_t)3 * N));
  st.r4 = __builtin_nontemporal_load((const f32x4*)(s + (size_t)4 * N));
  st.r5 = __builtin_nontemporal_load((const f32x4*)(s + (size_t)5 * N));
  st.r6 = __builtin_nontemporal_load((const f32x4*)(s + (size_t)6 * N));
  st.r7 = __builtin_nontemporal_load((const f32x4*)(s + (size_t)7 * N));
  st.pend = u;
}

constexpr int UST = 2056;
constexpr int HY_U_BYTES = 16 * UST * 2;
constexpr int TCOPY = 2064;
constexpr int HY_T_BYTES = 4 * TCOPY * 4;
constexpr int HY_LDS = HY_U_BYTES + HY_T_BYTES;
constexpr int HY_SROW = 176;
constexpr int HY_SLAB = 16 * HY_SROW;
constexpr int USTC = 264;
constexpr int TCOPYC = 264;

__device__ __forceinline__ f32x4 mfma16(bf16x8 a, bf16x8 b, f32x4 c) {
  return __builtin_amdgcn_mfma_f32_16x16x32_bf16(a, b, c, 0, 0, 0);
}
__device__ __forceinline__ float bflo(unsigned v) { return __uint_as_float(v << 16); }
__device__ __forceinline__ float bfhi(unsigned v) { return __uint_as_float(v & 0xffff0000u); }
__device__ __forceinline__ float ldbf(const bf16* p) { return bf2f(*p); }

template <int GSTR, int TCP>
__device__ __forceinline__ void hy_load_tables(const bf16* __restrict__ G, int c, unsigned* T) {
  constexpr int NCH = GSTR / 8;
  for (int q = tid_opaque(); q < 2 * NCH; q += 512) {
    int o = q / NCH, ch = q - o * NCH;
    const unsigned* s32 = (const unsigned*)(G + ((size_t)(o * 512 + c)) * GSTR);
    u32x4 a = *(const u32x4*)(s32 + 4 * ch);
    unsigned nx = (ch + 1 < NCH) ? s32[4 * ch + 4] : 0u;
    unsigned* d0 = T + o * 2 * TCP;
    unsigned* d1 = d0 + TCP;
    *(u32x4*)(d0 + 4 * ch) = a;
    u32x4 b;
    b.x = (a.x >> 16) | (a.y << 16); b.y = (a.y >> 16) | (a.z << 16); b.z = (a.z >> 16) | (a.w << 16); b.w = (a.w >> 16) | (nx << 16);
    *(u32x4*)(d1 + 4 * ch) = b;
  }
}

template <int L, int USTR>
__device__ __forceinline__ void hy_load_u(const bf16* __restrict__ z, float w0, float w1, float w2, float bb, bf16* U) {
  constexpr int CPB = L / 8;
  for (int q = tid_opaque(); q < 16 * CPB; q += 512) {
    int b = q / CPB, t8 = (q - b * CPB) * 8;
    const bf16* zr = z + (size_t)b * L + t8;
    u32x4 v = *(const u32x4*)zr;
    float zm = t8 > 0 ? ldbf(zr - 1) : 0.f;
    float zp = t8 + 8 < L ? ldbf(zr + 8) : 0.f;
    float e0 = bflo(v.x), e1 = bfhi(v.x), e2 = bflo(v.y), e3 = bfhi(v.y), e4 = bflo(v.z), e5 = bfhi(v.z), e6 = bflo(v.w), e7 = bfhi(v.w);
    u32x4 o;
    o.x = pack_bf16(w0 * zm + w1 * e0 + w2 * e1 + bb, w0 * e0 + w1 * e1 + w2 * e2 + bb);
    o.y = pack_bf16(w0 * e1 + w1 * e2 + w2 * e3 + bb, w0 * e2 + w1 * e3 + w2 * e4 + bb);
    o.z = pack_bf16(w0 * e3 + w1 * e4 + w2 * e5 + bb, w0 * e4 + w1 * e5 + w2 * e6 + bb);
    o.w = pack_bf16(w0 * e5 + w1 * e6 + w2 * e7 + bb, w0 * e6 + w1 * e7 + w2 * zp + bb);
    *(u32x4*)(U + b * USTR + t8) = o;
  }
}

template <int L>
__device__ __forceinline__ void hy_gate4(const bf16* __restrict__ zr, int t0, float w0, float w1, float w2, float bb, float (&x)[4]) {
  u32x2 v = *(const u32x2*)(zr + t0);
  float zm = t0 > 0 ? ldbf(zr + t0 - 1) : 0.f;
  float zp = t0 + 4 < L ? ldbf(zr + t0 + 4) : 0.f;
  float e0 = bflo(v.x), e1 = bfhi(v.x), e2 = bflo(v.y), e3 = bfhi(v.y);
  x[0] = w0 * zm + w1 * e0 + w2 * e1 + bb;
  x[1] = w0 * e0 + w1 * e1 + w2 * e2 + bb;
  x[2] = w0 * e1 + w1 * e2 + w2 * e3 + bb;
  x[3] = w0 * e2 + w1 * e3 + w2 * zp + bb;
}

__device__ __forceinline__ bf16x8 hy_frag(const unsigned* p) {
  u32x4 v; v.x = p[0]; v.y = p[1]; v.z = p[2]; v.w = p[3];
  return __builtin_bit_cast(bf16x8, v);
}

__device__ __forceinline__ void hyena_latent(int c, const bf16* __restrict__ zt, const float* __restrict__ cw,
                                             const float* __restrict__ cb, const bf16* __restrict__ G,
                                             bf16* __restrict__ yt, char* smem, const CvtCtx& cx) {
  const int tid = tid_opaque(), lane = tid & 63, wave = tid >> 6;
  bf16* U = (bf16*)smem;
  unsigned* T = (unsigned*)(smem + HY_U_BYTES);
  __syncthreads();
  hy_load_tables<GSTR_L, TCOPY>(G, c, T);
  hy_load_u<SEQ, UST>(zt + (size_t)c * NT, cw[c], cw[HYCOLS + c], cw[2 * HYCOLS + c], cb[c], U);
  __syncthreads();
  const int r = lane & 15, kg = lane >> 4;
  const int par = (r + 1) & 1;
  const int base_dw = 1023 - (r >> 1) + 4 * kg - 128 * wave;
  const char* ub = smem + (r * UST + 8 * kg) * 2;
  const int tw = wave * 256;
#pragma unroll 1
  for (int order = 0; order < 2; ++order) {
    const unsigned* tb = T + order * 2 * TCOPY + par * TCOPY + base_dw;
    f32x4 acc[16];
#pragma unroll
    for (int i = 0; i < 16; ++i) acc[i] = (f32x4){0.f, 0.f, 0.f, 0.f};
    bf16x8 W[16];
#pragma unroll
    for (int f = -15; f <= 0; ++f) W[f & 15] = hy_frag(tb + 8 * f);
    CvtRegs cr; cvt_init(cr);
    const int wv = __builtin_amdgcn_readfirstlane(wave);
#pragma unroll 1
    for (int J = 0; J < 8; ++J) {
      const unsigned* tj = tb + 128 * J;
      const char* uj = ub + 512 * J;
#pragma unroll
      for (int jj = 0; jj < 8; ++jj) {
        if (jj == 0 && (J == 0 || J == 3 || J == 6)) cvt_step(cx, cr, lane, CVT_GLA_TILES + ((c * 2 + order) * 3 + J / 3) * 8 + wv);
        bf16x8 uf = *(const bf16x8*)(uj + 64 * jj);
        acc[15] = mfma16(W[(2 * jj - 15) & 15], uf, acc[15]);
        acc[14] = mfma16(W[(2 * jj - 14) & 15], uf, acc[14]);
        if (J * 8 + jj < 63) {
          W[(2 * jj + 1) & 15] = hy_frag(tj + 8 * (2 * jj + 1));
          W[(2 * jj + 2) & 15] = hy_frag(tj + 8 * (2 * jj + 2));
        }
#pragma unroll
        for (int i = 13; i >= 0; --i) acc[i] = mfma16(W[(2 * jj - i) & 15], uf, acc[i]);
      }
    }
    cvt_finish(cx, cr, lane);
    __syncthreads();
    {
      const int col = (order + 1) * 512 + c;
      const float w0 = cw[col], w1 = cw[HYCOLS + col], w2 = cw[2 * HYCOLS + col], bb = cb[col];
      const bf16* zc = zt + (size_t)col * NT;
      char* slab = smem + HY_LDS + wave * HY_SLAB;
      u32x4 gq[4][3];
#pragma unroll
      for (int q = 0; q < 4; ++q)
#pragma unroll
        for (int k = 0; k < 3; ++k) {
          const int idx = k * 64 + lane, row = idx / 10, ch = idx - row * 10;
          const int pos = tw + 64 * q - 8 + 8 * ch;
          const bool inb = idx < 160 && pos >= 0 && pos < SEQ;
          gq[q][k] = (u32x4){0u, 0u, 0u, 0u};
          if (inb) gq[q][k] = *(const u32x4*)(zc + (size_t)row * SEQ + pos);
        }
#pragma unroll
      for (int q = 0; q < 4; ++q) {
#pragma unroll
        for (int k = 0; k < 3; ++k) {
          const int idx = k * 64 + lane, row = idx / 10, ch = idx - row * 10;
          if (idx < 160) *(u32x4*)(slab + row * HY_SROW + ch * 16) = gq[q][k];
        }
#pragma unroll
        for (int i4 = 0; i4 < 4; ++i4) {
          const int i = 4 * q + i4;
          const int t0 = tw + 16 * i + 4 * kg;
          const char* sp = slab + r * HY_SROW + (16 * i4 + 4 * kg + 8) * 2;
          const u32x2 gv = *(const u32x2*)sp;
          const unsigned gm = *(const unsigned short*)(sp - 2), gp = *(const unsigned short*)(sp + 8);
          const float zm = __uint_as_float(gm << 16), zp = __uint_as_float(gp << 16);
          const float e0 = bflo(gv.x), e1 = bfhi(gv.x), e2 = bflo(gv.y), e3 = bfhi(gv.y);
          const float x0 = w0 * zm + w1 * e0 + w2 * e1 + bb, x1 = w0 * e0 + w1 * e1 + w2 * e2 + bb;
          const float x2 = w0 * e1 + w1 * e2 + w2 * e3 + bb, x3 = w0 * e2 + w1 * e3 + w2 * zp + bb;
          u32x2 o;
          o.x = pack_bf16(x0 * acc[i][0], x1 * acc[i][1]);
          o.y = pack_bf16(x2 * acc[i][2], x3 * acc[i][3]);
          *(u32x2*)(U + r * UST + t0) = o;
        }
      }
    }
    __syncthreads();
  }
  for (int q = tid; q < 16 * 256; q += 512) {
    int b = q >> 8, t8 = (q & 255) * 8;
    *(u32x4*)(yt + (size_t)c * NT + (size_t)b * SEQ + t8) = *(const u32x4*)(U + b * UST + t8);
  }
}

__device__ __forceinline__ void hyena_ctx(int c, const bf16* __restrict__ zt, const float* __restrict__ cw,
                                          const float* __restrict__ cb, const bf16* __restrict__ G,
                                          bf16* __restrict__ yt, char* smem) {
  const int tid = tid_opaque(), lane = tid & 63, wave = tid >> 6;
  bf16* U = (bf16*)smem;
  unsigned* T = (unsigned*)(smem + HY_U_BYTES);
  __syncthreads();
  hy_load_tables<GSTR_C, TCOPYC>(G, c, T);
  hy_load_u<LC, USTC>(zt + (size_t)c * NT, cw[c], cw[HYCOLS + c], cw[2 * HYCOLS + c], cb[c], U);
  __syncthreads();
  const int r = lane & 15, kg = lane >> 4;
  const int par = (r + 1) & 1;
  const int base_dw = (8 * kg - r + 255 - par) >> 1;
  const char* ub = smem + (r * USTC + 8 * kg) * 2;
#pragma unroll 1
  for (int order = 0; order < 2; ++order) {
    const unsigned* tb = T + order * 2 * TCOPYC + par * TCOPYC + base_dw;
    f32x4 acc[2];
    acc[0] = (f32x4){0.f, 0.f, 0.f, 0.f};
    acc[1] = acc[0];
#pragma unroll
    for (int j = 0; j < 8; ++j) {
      bf16x8 uf = *(const bf16x8*)(ub + 64 * j);
#pragma unroll
      for (int ii = 0; ii < 2; ++ii) {
        const int i = wave * 2 + ii;
        acc[ii] = mfma16(hy_frag(tb + 16 * j - 8 * i), uf, acc[ii]);
      }
    }
    __syncthreads();
    {
      const int col = (order + 1) * 512 + c;
      const float w0 = cw[col], w1 = cw[HYCOLS + col], w2 = cw[2 * HYCOLS + col], bb = cb[col];
      const bf16* zr = zt + (size_t)col * NT + (size_t)r * LC;
#pragma unroll
      for (int ii = 0; ii < 2; ++ii) {
        const int t0 = (wave * 2 + ii) * 16 + 4 * kg;
        float x[4];
        hy_gate4<LC>(zr, t0, w0, w1, w2, bb, x);
        u32x2 o;
        o.x = pack_bf16(x[0] * acc[ii][0], x[1] * acc[ii][1]);
        o.y = pack_bf16(x[2] * acc[ii][2], x[3] * acc[ii][3]);
        *(u32x2*)(U + r * USTC + t0) = o;
      }
    }
    __syncthreads();
  }
  {
    int b = tid >> 5, t8 = (tid & 31) * 8;
    *(u32x4*)(yt + (size_t)c * NT + (size_t)b * LC + t8) = *(const u32x4*)(U + b * USTC + t8);
  }
}

constexpr int GL_QE = 0, GL_KE = 8192, GL_KST = 16384, GL_ATT = 24576, GL_ST = 32768, GL_VT = 49152  ;
constexpr int GL_RAW = 81920  , GL_RAWSZ = 18432, GL_SEG = 118784, GL_DEC = 120832;
constexpr int GLA_LDS = 121088;

__device__ __forceinline__ f32x16 mfma32(bf16x8 a, bf16x8 b, f32x16 c) {
  return __builtin_amdgcn_mfma_f32_32x32x16_bf16(a, b, c, 0, 0, 0);
}
__device__ __forceinline__ unsigned short bf16bits(float v) { bf16 h = f2bf(v); return *(unsigned short*)&h; }

struct GlaArgs {
  const bf16* zg; const float* wa2; const float* ba2; bf16* of; bf16* ob; int emit_ctx; int pad_;
};

__device__ __forceinline__ void gla_unit(int unit, const GlaArgs& a, char* smem, const CvtCtx& cx) {
  const int tid = tid_opaque(), lane = tid & 63, wave = tid >> 6;
  const int dir = unit & 1, h = (unit >> 1) & 3, b = unit >> 3;
  const int lr = lane & 31, lh = lane >> 5;
  const int swl = (lr >> 1) & 7;
  bf16* outp = dir ? a.ob : a.of;
  __syncthreads();
  const int d = tid & 63, sg = tid >> 6;
  float wa[16];
#pragma unroll
  for (int r = 0; r < 16; ++r) wa[r] = a.wa2[(dir * 16 + r) * 256 + h * 64 + d];
  const float ba = a.ba2[dir * 256 + h * 64 + d];
  { unsigned zz = 0u; asm volatile("" : "+v"(zz));
    for (int q = tid; q < 16384 / 16; q += 512) *(u32x4*)(smem + GL_ST + q * 16) = (u32x4){zz, zz, zz, zz}; }
  f32x16 S;
#pragma unroll
  for (int r = 0; r < 16; ++r) S[r] = 0.f;

  const int qi = tid >> 3, qc = tid & 7;
  const int ai = (tid >> 1) & 63, ac = tid & 1;
  const int vsg = (tid >> 5) & 7, vdq = tid & 31;
  u32x4 pq, pk, pa;
  u32x2 pw0, pw1, pw2, pw3, pw4, pw5, pw6, pw7;

#define GLA_ROW(N_, I_, ROW_)                                                        \
  {                                                                                  \
    const int n_ = (N_);                                                             \
    const int Ls_ = n_ < 4 ? LC : SEQ;                                               \
    const int cn_ = n_ < 4 ? n_ : n_ - 4;                                            \
    const int rb_ = n_ < 4 ? (NL + b * LC) : (b * SEQ);                              \
    const int pos_ = cn_ * 64 + (I_);                                                \
    ROW_ = rb_ + (dir ? (Ls_ - 1 - pos_) : pos_);                                    \
  }
#define GLA_LOAD_RAW(N_)                                                             \
  {                                                                                  \
    int row_;                                                                        \
    GLA_ROW(N_, qi, row_);                                                           \
    const bf16* zr_ = a.zg + (size_t)row_ * GLACOLS;                                 \
    pq = *(const u32x4*)(zr_ + h * 64 + qc * 8);                                     \
    pk = *(const u32x4*)(zr_ + 256 + h * 64 + qc * 8);                               \
    int ra_;                                                                         \
    GLA_ROW(N_, ai, ra_);                                                            \
    pa = *(const u32x4*)(a.zg + (size_t)ra_ * GLACOLS + 1536 + dir * 16 + ac * 8);   \
  }
#define GLA_LOAD_V(N_)                                                               \
  {                                                                                  \
    int rv_;                                                                         \
    GLA_ROW(N_, vsg * 8 + 0, rv_); pw0 = *(const u32x2*)(a.zg + (size_t)rv_ * GLACOLS + 512 + h * 128 + vdq * 4); \
    GLA_ROW(N_, vsg * 8 + 1, rv_); pw1 = *(const u32x2*)(a.zg + (size_t)rv_ * GLACOLS + 512 + h * 128 + vdq * 4); \
    GLA_ROW(N_, vsg * 8 + 2, rv_); pw2 = *(const u32x2*)(a.zg + (size_t)rv_ * GLACOLS + 512 + h * 128 + vdq * 4); \
    GLA_ROW(N_, vsg * 8 + 3, rv_); pw3 = *(const u32x2*)(a.zg + (size_t)rv_ * GLACOLS + 512 + h * 128 + vdq * 4); \
    GLA_ROW(N_, vsg * 8 + 4, rv_); pw4 = *(const u32x2*)(a.zg + (size_t)rv_ * GLACOLS + 512 + h * 128 + vdq * 4); \
    GLA_ROW(N_, vsg * 8 + 5, rv_); pw5 = *(const u32x2*)(a.zg + (size_t)rv_ * GLACOLS + 512 + h * 128 + vdq * 4); \
    GLA_ROW(N_, vsg * 8 + 6, rv_); pw6 = *(const u32x2*)(a.zg + (size_t)rv_ * GLACOLS + 512 + h * 128 + vdq * 4); \
    GLA_ROW(N_, vsg * 8 + 7, rv_); pw7 = *(const u32x2*)(a.zg + (size_t)rv_ * GLACOLS + 512 + h * 128 + vdq * 4); \
  }
#define GLA_STORE_RAW(RB_)                                                           \
  {                                                                                  \
    char* rw_ = smem + GL_RAW + (RB_) * GL_RAWSZ;                                    \
    *(u32x4*)(rw_ + qi * 128 + qc * 16) = pq;                                        \
    *(u32x4*)(rw_ + 8192 + qi * 128 + qc * 16) = pk;                                 \
    if (tid < 128) *(u32x4*)(rw_ + 16384 + ai * 32 + ac * 16) = pa;                  \
  }
#define GLA_STORE_V(VB_)                                                             \
  if (tid < 256) {                                                                   \
    char* vt_ = smem + GL_VT + (VB_) * 16384;                                        \
    u32x4 o;                                                                         \
    o.x = (pw0.x & 0xffffu) | (pw1.x << 16); o.y = (pw2.x & 0xffffu) | (pw3.x << 16); o.z = (pw4.x & 0xffffu) | (pw5.x << 16); o.w = (pw6.x & 0xffffu) | (pw7.x << 16); \
    *(u32x4*)(vt_ + swz(vdq * 4 + 0, vsg)) = o;                                      \
    o.x = (pw0.x >> 16) | (pw1.x & 0xffff0000u); o.y = (pw2.x >> 16) | (pw3.x & 0xffff0000u); o.z = (pw4.x >> 16) | (pw5.x & 0xffff0000u); o.w = (pw6.x >> 16) | (pw7.x & 0xffff0000u); \
    *(u32x4*)(vt_ + swz(vdq * 4 + 1, vsg)) = o;                                      \
    o.x = (pw0.y & 0xffffu) | (pw1.y << 16); o.y = (pw2.y & 0xffffu) | (pw3.y << 16); o.z = (pw4.y & 0xffffu) | (pw5.y << 16); o.w = (pw6.y & 0xffffu) | (pw7.y << 16); \
    *(u32x4*)(vt_ + swz(vdq * 4 + 2, vsg)) = o;                                      \
    o.x = (pw0.y >> 16) | (pw1.y & 0xffff0000u); o.y = (pw2.y >> 16) | (pw3.y & 0xffff0000u); o.z = (pw4.y >> 16) | (pw5.y & 0xffff0000u); o.w = (pw6.y >> 16) | (pw7.y & 0xffff0000u); \
    *(u32x4*)(vt_ + swz(vdq * 4 + 3, vsg)) = o;                                      \
  }
#define GLA_STEP3(RB_)                                                               \
  {                                                                                  \
    const char* ra_ = smem + GL_RAW + (RB_) * GL_RAWSZ + 16384;                      \
    float run = 0.f;                                                                 \
    _Pragma("unroll") for (int ii = 0; ii < 8; ++ii) {                               \
      const int i = sg * 8 + ii;                                                     \
      const u32x4 a0 = *(const u32x4*)(ra_ + i * 32);                                \
      const u32x4 a1 = *(const u32x4*)(ra_ + i * 32 + 16);                           \
      float g = ba;                                                                  \
      g += bflo(a0.x) * wa[0] + bfhi(a0.x) * wa[1] + bflo(a0.y) * wa[2] + bfhi(a0.y) * wa[3]; \
      g += bflo(a0.z) * wa[4] + bfhi(a0.z) * wa[5] + bflo(a0.w) * wa[6] + bfhi(a0.w) * wa[7]; \
      g += bflo(a1.x) * wa[8] + bfhi(a1.x) * wa[9] + bflo(a1.y) * wa[10] + bfhi(a1.y) * wa[11]; \
      g += bflo(a1.z) * wa[12] + bfhi(a1.z) * wa[13] + bflo(a1.w) * wa[14] + bfhi(a1.w) * wa[15]; \
      run += logsigmoid_f(g) * (1.0f / 16.0f);                                       \
      bl[ii] = run;                                                                  \
    }                                                                                \
    *(float*)(smem + GL_SEG + (sg * 64 + d) * 4) = run;                              \
  }
#define GLA_STEP5(RB_)                                                               \
  {                                                                                  \
    const char* rq_ = smem + GL_RAW + (RB_) * GL_RAWSZ;                              \
    float off = 0.f, tot = 0.f;                                                      \
    _Pragma("unroll") for (int s = 0; s < 8; ++s) {                                  \
      float v = *(const float*)(smem + GL_SEG + (s * 64 + d) * 4);                  \
      off += (s < sg) ? v : 0.f;                                                     \
      tot += v;                                                                      \
    }                                                                                \
    float ks[8];                                                                     \
    _Pragma("unroll") for (int ii = 0; ii < 8; ++ii) {                               \
      const int i = sg * 8 + ii;                                                     \
      const float bb = off + bl[ii];                                                 \
      const float qv = bf2f(*(const bf16*)(rq_ + i * 128 + d * 2));                 \
      const float kv = bf2f(*(const bf16*)(rq_ + 8192 + i * 128 + d * 2));          \
      const int eo = swz(i, d >> 3) + (d & 7) * 2;                                   \
      *(unsigned short*)(smem + GL_QE + eo) = bf16bits(qv * 0.125f * __expf(bb));    \
      *(unsigned short*)(smem + GL_KE + eo) = bf16bits(kv * __expf(-bb));            \
      ks[ii] = kv * __expf(tot - bb);                                                \
    }                                                                                \
    u32x4 o;                                                                         \
    o.x = pack_bf16(ks[0], ks[1]); o.y = pack_bf16(ks[2], ks[3]); o.z = pack_bf16(ks[4], ks[5]); o.w = pack_bf16(ks[6], ks[7]); \
    *(u32x4*)(smem + GL_KST + swz(d, sg)) = o;                                       \
    if (sg == 0) *(float*)(smem + GL_DEC + d * 4) = __expf(tot);                     \
  }

  const int tm = wave >> 2, tn = wave & 3;
  float bl[8];
  f32x16 oprev;
#pragma unroll
  for (int r = 0; r < 16; ++r) oprev[r] = 0.f;

#define GLA_STORE_OUT(N_)                                                                  \
  {                                                                                        \
    _Pragma("unroll") for (int r = 0; r < 16; ++r) {                                       \
      int row;                                                                             \
      GLA_ROW(N_, tm * 32 + rowmap(r, lh), row);                                           \
      *(unsigned short*)(outp + (size_t)row * 512 + h * 128 + tn * 32 + lr) = bf16bits(oprev[r]); \
    }                                                                                      \
  }
  GLA_LOAD_RAW(0); GLA_LOAD_V(0);
  GLA_STORE_RAW(0); GLA_STORE_V(0);
  GLA_LOAD_RAW(1);
  GLA_STORE_RAW(1);
  __syncthreads();
  GLA_STEP3(0);
  __syncthreads();
  GLA_STEP5(0);
  GLA_LOAD_RAW(2); GLA_LOAD_V(1);
  __syncthreads();
  CvtRegs cr; cvt_init(cr);
  const int cvt_u0 = __builtin_amdgcn_readfirstlane(unit * 36 * 16 + wave);
#pragma unroll 1
  for (int n = 0; n < 36; ++n) {
    const int vb = n & 1;
    const bool has1 = n + 1 < 36;
    cvt_step(cx, cr, lane, cvt_u0 + n * 16);
    f32x16 oacc;
#pragma unroll
    for (int r = 0; r < 16; ++r) oacc[r] = 0.f;
#pragma unroll
    for (int r = 0; r < 16; ++r) S[r] *= *(const float*)(smem + GL_DEC + (tm * 32 + rowmap(r, lh)) * 4);
#pragma unroll
    for (int ks4 = 0; ks4 < 4; ++ks4) {
      const int c = ((2 * ks4 + lh) ^ swl) << 4;
      const bf16x8 fq = *(const bf16x8*)(smem + GL_QE + (tm * 32 + lr) * 128 + c);
      const bf16x8 fs = *(const bf16x8*)(smem + GL_ST + (tn * 32 + lr) * 128 + c);
      oacc = mfma32(fq, fs, oacc);
      const bf16x8 fk = *(const bf16x8*)(smem + GL_KST + (tm * 32 + lr) * 128 + c);
      const bf16x8 fv = *(const bf16x8*)(smem + GL_VT + vb * 16384 + (tn * 32 + lr) * 128 + c);
      S = mfma32(fk, fv, S);
    }
    if (wave < 4) {
      const int am = wave >> 1, an = wave & 1;
      f32x16 att;
#pragma unroll
      for (int r = 0; r < 16; ++r) att[r] = 0.f;
#pragma unroll
      for (int ks4 = 0; ks4 < 4; ++ks4) {
        const int c = ((2 * ks4 + lh) ^ swl) << 4;
        const bf16x8 fq = *(const bf16x8*)(smem + GL_QE + (am * 32 + lr) * 128 + c);
        const bf16x8 fk = *(const bf16x8*)(smem + GL_KE + (an * 32 + lr) * 128 + c);
        att = mfma32(fq, fk, att);
      }
      const int s = an * 32 + lr;
#pragma unroll
      for (int r = 0; r < 16; ++r) {
        const int t = am * 32 + rowmap(r, lh);
        const float v = (s <= t) ? att[r] : 0.f;
        *(unsigned short*)(smem + GL_ATT + swz(t, s >> 3) + (s & 7) * 2) = bf16bits(v);
      }
    }
    if (has1) GLA_STEP3((n + 1) & 1);
    __syncthreads();
    cvt_step(cx, cr, lane, cvt_u0 + n * 16 + 8);
#pragma unroll
    for (int ks4 = 0; ks4 < 4; ++ks4) {
      const int c = ((2 * ks4 + lh) ^ swl) << 4;
      const bf16x8 fa = *(const bf16x8*)(smem + GL_ATT + (tm * 32 + lr) * 128 + c);
      const bf16x8 fv = *(const bf16x8*)(smem + GL_VT + vb * 16384 + (tn * 32 + lr) * 128 + c);
      oacc = mfma32(fa, fv, oacc);
    }
#pragma unroll
    for (int g = 0; g < 4; ++g) {
      u32x2 o;
      o.x = pack_bf16(S[4 * g + 0], S[4 * g + 1]);
      o.y = pack_bf16(S[4 * g + 2], S[4 * g + 3]);
      *(u32x2*)(smem + GL_ST + swz(tn * 32 + lr, tm * 4 + g) + 8 * lh) = o;
    }
    if (has1) {
      GLA_STEP5((n + 1) & 1);
      GLA_STORE_V((n + 1) & 1);
      if (n + 2 < 36) GLA_STORE_RAW(n & 1);
    }
    if (n > 0 && (n - 1 >= 4 || a.emit_ctx)) { GLA_STORE_OUT(n - 1); }
    { const int nr = n + 3 < 36 ? n + 3 : 35; GLA_LOAD_RAW(nr); const int nv = n + 2 < 36 ? n + 2 : 35; GLA_LOAD_V(nv); }
    oprev = oacc;
    __syncthreads();
  }
  cvt_finish(cx, cr, lane);
  { GLA_STORE_OUT(35); }
#undef GLA_STORE_OUT
#undef GLA_ROW
#undef GLA_LOAD_RAW
#undef GLA_LOAD_V
#undef GLA_STORE_RAW
#undef GLA_STORE_V
#undef GLA_STEP3
#undef GLA_STEP5
}


constexpr int CTRL_Q = 0;
constexpr int CTRL_CNT = 128;
constexpr int CTRL_CUR = 640;
constexpr int CTRL_XR = 1152;
constexpr int CTRL_WORDS = 1152 + 256;
constexpr size_t al256(size_t v) { return (v + 255) / 256 * 256; }
namespace wso {
constexpr size_t bar = 0;
constexpr size_t ctrl = al256(bar + (size_t)XCD_BAR_WORDS * 4);
constexpr size_t zero_end = al256(ctrl + (size_t)CTRL_WORDS * 4);
constexpr size_t xs = al256(ctrl + (size_t)CTRL_WORDS * 4);
constexpr size_t mod = al256(xs + (size_t)NT * D * 4);
constexpr size_t abuf = al256(mod + (size_t)DEPTH * 17 * 6 * D * 4);
constexpr size_t zt = al256(abuf + (size_t)NT * D * 2);
constexpr size_t zg = al256(zt + (size_t)HYCOLS * NT * 2);
constexpr size_t yt = al256(zg + (size_t)NT * GLACOLS * 2);
constexpr size_t of = al256(yt + (size_t)HYW * NT * 2);
constexpr size_t ob = al256(of + (size_t)NT * 512 * 4);
constexpr size_t ymix = al256(ob + (size_t)NT * 512 * 4);
constexpr size_t region_end_raw = al256(ymix + (size_t)NT * D * 2);
constexpr size_t region_end = (region_end_raw > zt + al256((size_t)NSLOT * D * 2)) ? region_end_raw : zt + al256((size_t)NSLOT * D * 2);
constexpr size_t hid = region_end;
constexpr size_t gl = al256(hid + (size_t)DEPTH * 2 * SEQ * 64 * 4);
constexpr size_t gc = al256(gl + (size_t)DEPTH * 2 * HYW * GSTR_L * 2);
constexpr size_t logits = al256(gc + (size_t)2 * HYW * GSTR_C * 2);
constexpr size_t tok_e = al256(logits + (size_t)NT * NE * 4);
constexpr size_t tok_gate = al256(tok_e + (size_t)NT * TOPK * 4);
constexpr size_t tok_slot = al256(tok_gate + (size_t)NT * TOPK * 4);
constexpr size_t pad_start = al256(tok_slot + (size_t)NT * TOPK * 4);
constexpr size_t slot_tok = al256(pad_start + (size_t)(NE + 2) * 4);
constexpr size_t blkcnt = al256(slot_tok + (size_t)NSLOT * 4);
constexpr size_t hbuf = al256(blkcnt + (size_t)512 * NE * 4);
constexpr size_t hs = al256(hbuf + (size_t)NSLOT * DE);
constexpr size_t w_in_t = al256(hs + (size_t)NT * DE);
constexpr size_t w_out_t = al256(w_in_t + (size_t)DEPTH * WIN_ROWS * D * 2);
constexpr size_t router_t = al256(w_out_t + (size_t)DEPTH * D * D * 2);
constexpr size_t sh1_t = al256(router_t + (size_t)DEPTH * NE * D * 2);
constexpr size_t sh3_t = al256(sh1_t + (size_t)DEPTH * DE * D);
constexpr size_t sh2_t = al256(sh3_t + (size_t)DEPTH * DE * D);
constexpr size_t e1_t = al256(sh2_t + (size_t)DEPTH * D * DE);
constexpr size_t e3_t = al256(e1_t + (size_t)NE * DE * D);
constexpr size_t e2_t = al256(e3_t + (size_t)NE * DE * D);
constexpr size_t abuf8 = al256(e2_t + (size_t)NE * D * DE);
constexpr size_t w_g8 = al256(abuf8 + (size_t)NT * D);
constexpr size_t ysh = al256(w_g8 + (size_t)DEPTH * GW_ROWS * D);
constexpr size_t total = al256(ysh + (size_t)NT * D);
constexpr size_t ybuf = zt;
}
struct WS {
  char* b;
  __device__ __forceinline__ unsigned* bar() const { char* q = b; asm volatile("" : "+s"(q)); return (unsigned*)(q + wso::bar); }
  __device__ __forceinline__ int* ctrl() const { char* q = b; asm volatile("" : "+s"(q)); return (int*)(q + wso::ctrl); }
  __device__ __forceinline__ bf16* xs() const { char* q = b; asm volatile("" : "+s"(q)); return (bf16*)(q + wso::xs); }
  __device__ __forceinline__ float* mod() const { char* q = b; asm volatile("" : "+s"(q)); return (float*)(q + wso::mod); }
  __device__ __forceinline__ bf16* abuf() const { char* q = b; asm volatile("" : "+s"(q)); return (bf16*)(q + wso::abuf); }
  __device__ __forceinline__ bf16* zt() const { char* q = b; asm volatile("" : "+s"(q)); return (bf16*)(q + wso::zt); }
  __device__ __forceinline__ bf16* zg() const { char* q = b; asm volatile("" : "+s"(q)); return (bf16*)(q + wso::zg); }
  __device__ __forceinline__ bf16* yt() const { char* q = b; asm volatile("" : "+s"(q)); return (bf16*)(q + wso::yt); }
  __device__ __forceinline__ bf16* of() const { char* q = b; asm volatile("" : "+s"(q)); return (bf16*)(q + wso::of); }
  __device__ __forceinline__ bf16* ob() const { char* q = b; asm volatile("" : "+s"(q)); return (bf16*)(q + wso::ob); }
  __device__ __forceinline__ bf16* ymix() const { char* q = b; asm volatile("" : "+s"(q)); return (bf16*)(q + wso::ymix); }
  __device__ __forceinline__ float* hid() const { char* q = b; asm volatile("" : "+s"(q)); return (float*)(q + wso::hid); }
  __device__ __forceinline__ bf16* gl() const { char* q = b; asm volatile("" : "+s"(q)); return (bf16*)(q + wso::gl); }
  __device__ __forceinline__ bf16* gc() const { char* q = b; asm volatile("" : "+s"(q)); return (bf16*)(q + wso::gc); }
  __device__ __forceinline__ float* logits() const { char* q = b; asm volatile("" : "+s"(q)); return (float*)(q + wso::logits); }
  __device__ __forceinline__ int* tok_e() const { char* q = b; asm volatile("" : "+s"(q)); return (int*)(q + wso::tok_e); }
  __device__ __forceinline__ float* tok_gate() const { char* q = b; asm volatile("" : "+s"(q)); return (float*)(q + wso::tok_gate); }
  __device__ __forceinline__ int* tok_slot() const { char* q = b; asm volatile("" : "+s"(q)); return (int*)(q + wso::tok_slot); }
  __device__ __forceinline__ int* pad_start() const { char* q = b; asm volatile("" : "+s"(q)); return (int*)(q + wso::pad_start); }
  __device__ __forceinline__ int* slot_tok() const { char* q = b; asm volatile("" : "+s"(q)); return (int*)(q + wso::slot_tok); }
  __device__ __forceinline__ int* blkcnt() const { char* q = b; asm volatile("" : "+s"(q)); return (int*)(q + wso::blkcnt); }
  __device__ __forceinline__ unsigned char* hbuf() const { char* q = b; asm volatile("" : "+s"(q)); return (unsigned char*)(q + wso::hbuf); }
  __device__ __forceinline__ unsigned char* hs() const { char* q = b; asm volatile("" : "+s"(q)); return (unsigned char*)(q + wso::hs); }
  __device__ __forceinline__ bf16* w_in_t() const { char* q = b; asm volatile("" : "+s"(q)); return (bf16*)(q + wso::w_in_t); }
  __device__ __forceinline__ bf16* w_out_t() const { char* q = b; asm volatile("" : "+s"(q)); return (bf16*)(q + wso::w_out_t); }
  __device__ __forceinline__ bf16* router_t() const { char* q = b; asm volatile("" : "+s"(q)); return (bf16*)(q + wso::router_t); }
  __device__ __forceinline__ unsigned char* sh1_t() const { char* q = b; asm volatile("" : "+s"(q)); return (unsigned char*)(q + wso::sh1_t); }
  __device__ __forceinline__ unsigned char* sh3_t() const { char* q = b; asm volatile("" : "+s"(q)); return (unsigned char*)(q + wso::sh3_t); }
  __device__ __forceinline__ unsigned char* sh2_t() const { char* q = b; asm volatile("" : "+s"(q)); return (unsigned char*)(q + wso::sh2_t); }
  __device__ __forceinline__ unsigned char* e1_t() const { char* q = b; asm volatile("" : "+s"(q)); return (unsigned char*)(q + wso::e1_t); }
  __device__ __forceinline__ unsigned char* e3_t() const { char* q = b; asm volatile("" : "+s"(q)); return (unsigned char*)(q + wso::e3_t); }
  __device__ __forceinline__ unsigned char* e2_t() const { char* q = b; asm volatile("" : "+s"(q)); return (unsigned char*)(q + wso::e2_t); }
  __device__ __forceinline__ unsigned char* ybuf() const { char* q = b; asm volatile("" : "+s"(q)); return (unsigned char*)(q + wso::ybuf); }
  __device__ __forceinline__ unsigned char* abuf8() const { char* q = b; asm volatile("" : "+s"(q)); return (unsigned char*)(q + wso::abuf8); }
  __device__ __forceinline__ unsigned char* w_g8() const { char* q = b; asm volatile("" : "+s"(q)); return (unsigned char*)(q + wso::w_g8); }
  __device__ __forceinline__ unsigned char* ysh() const { char* q = b; asm volatile("" : "+s"(q)); return (unsigned char*)(q + wso::ysh); }
};

constexpr int MEGA_LDS_MAIN = G8_LDS;
constexpr int LDS_TILE_E = MEGA_LDS_MAIN + 16;
constexpr int MEGA_LDS = MEGA_LDS_MAIN + 16 + 4096;

struct MP { Inputs in; WS w; float* out; };

__device__ __forceinline__ void row_load(const float* __restrict__ p, int lane, f32x4 (&v)[4]) {
#pragma unroll
  for (int j = 0; j < 4; ++j) v[j] = *(const f32x4*)(p + j * 256 + lane * 4);
}
__device__ __forceinline__ void row_load_xs(const bf16* __restrict__ p, int lane, f32x4 (&v)[4]) {
#pragma unroll
  for (int j = 0; j < 4; ++j) v[j] = xs_load4(p + j * 256 + lane * 4);
}
__device__ __forceinline__ float row_rinv(const f32x4 (&v)[4], int lane) {
  float ss = 0.f;
#pragma unroll
  for (int j = 0; j < 4; ++j) ss += v[j].x * v[j].x + v[j].y * v[j].y + v[j].z * v[j].z + v[j].w * v[j].w;
  ss = wave_sum(ss, lane);
  return rsqrtf(ss * (1.0f / D) + EPS);
}
__device__ __forceinline__ void row_norm_mod_store(const f32x4 (&v)[4], float rinv, const float* __restrict__ g,
                                                   const float* __restrict__ sh, const float* __restrict__ sc, int lane,
                                                   bf16* __restrict__ dst, unsigned char* __restrict__ dst8 = nullptr) {
#pragma unroll
  for (int j = 0; j < 4; ++j) {
    const int d = j * 256 + lane * 4;
    const f32x4 gv = *(const f32x4*)(g + d), shv = *(const f32x4*)(sh + d), scv = *(const f32x4*)(sc + d);
    const float y0 = v[j].x * rinv * gv.x * (1.f + scv.x) + shv.x, y1 = v[j].y * rinv * gv.y * (1.f + scv.y) + shv.y;
    const float y2 = v[j].z * rinv * gv.z * (1.f + scv.z) + shv.z, y3 = v[j].w * rinv * gv.w * (1.f + scv.w) + shv.w;
    u32x2 o;
    o.x = pack_bf16(y0, y1);
    o.y = pack_bf16(y2, y3);
    *(u32x2*)(dst + d) = o;
    if (dst8) *(unsigned*)(dst8 + d) = pk4_fp8(y0, y1, y2, y3);
  }
}

__device__ __forceinline__ void ph_mod_hid(const MP& p, char* smem, int bid, int nblk) {
  const int tid = tid_opaque(), lane = tid & 63, wave = tid >> 6;
  float* sc = (float*)smem;
  for (int u = bid; u < 192; u += nblk) {
    const int l = u / 96, col0 = (u - l * 96) * 64;
    __syncthreads();
    for (int i = tid; i < 17 * 1024; i += 512) {
      const int r = i >> 10, k = i & 1023;
      const float v = (r < 16) ? p.in.c[r * D + k] : p.in.c_ctx[k];
      sc[i] = silu_f(v);
    }
    __syncthreads();
    const int col = tid & 63, ks = tid >> 6;
    float acc[17];
#pragma unroll
    for (int r = 0; r < 17; ++r) acc[r] = 0.f;
    const float* wp = p.in.ada_w + ((size_t)l * D + ks * 128) * (6 * D) + col0 + col;
#pragma unroll 16
    for (int kk = 0; kk < 128; ++kk) {
      const float wv = wp[(size_t)kk * (6 * D)];
#pragma unroll
      for (int r = 0; r < 17; ++r) acc[r] += sc[r * 1024 + ks * 128 + kk] * wv;
    }
    __syncthreads();
#pragma unroll
    for (int r = 0; r < 17; ++r) sc[(ks * 17 + r) * 64 + col] = acc[r];
    __syncthreads();
    for (int i = tid; i < 17 * 64; i += 512) {
      const int r = i >> 6, cc = i & 63;
      float s = 0.f;
#pragma unroll
      for (int k8 = 0; k8 < 8; ++k8) s += sc[(k8 * 17 + r) * 64 + cc];
      p.w.mod()[((size_t)l * 17 + r) * (6 * D) + col0 + cc] = s + p.in.ada_b[l * 6 * D + col0 + cc];
    }
  }
  for (int it = bid; it * 8 < 4352; it += nblk) {
    const int rid = it * 8 + wave;
    int l, ty, t;
    if (rid < 2048) { l = 0; ty = 0; t = rid; }
    else if (rid < 2304) { l = 0; ty = 1; t = rid - 2048; }
    else { l = 1; ty = 0; t = rid - 2304; }
    const int L = ty ? LC : SEQ;
    const float* w1 = p.in.hy_f_w1 + l * 33 * 64; const float* b1 = p.in.hy_f_b1 + l * 64;
    const float* w2 = p.in.hy_f_w2 + l * 64 * 64; const float* b2 = p.in.hy_f_b2 + l * 64;
    float pv = 0.f;
    if (lane == 0) pv = (float)t / (float)(L - 1);
    else if (lane < 33) {
      const int bi = (lane - 1) & 15;
      const float wph = 2.0f * 3.14159265358979323846f * (float)t / (float)L;
      const float f = 1e-4f + (float)bi * ((15.0f - 1e-4f) / 15.0f);
      pv = (lane <= 16) ? cosf(f * wph) : -sinf(f * wph);
    }
    float a1 = b1[lane];
#pragma unroll
    for (int i = 0; i < 33; ++i) a1 += shl_f(pv, i) * w1[i * 64 + lane];
    const float h1 = sinf(a1);
    float a2 = b2[lane];
#pragma unroll 16
    for (int i = 0; i < 64; ++i) a2 += shl_f(h1, i) * w2[i * 64 + lane];
    p.w.hid()[((size_t)(l * 2 + ty) * SEQ + t) * 64 + lane] = sinf(a2);
  }
}

__device__ __forceinline__ void ph_gtab(const MP& p, char* smem, int bid, int nblk) {
  const int tid = tid_opaque();
  float* wl = (float*)smem;
  for (int u = bid; u < 544; u += nblk) {
    int l, ty, ib, cg;
    if (u < 512) { l = u >> 8; ty = 0; ib = (u >> 5) & 7; cg = u & 31; }
    else { l = 0; ty = 1; ib = 0; cg = u - 512; }
    const int L = ty ? LC : SEQ, gstr = ty ? GSTR_C : GSTR_L;
    const float* hid = p.w.hid() + (size_t)(l * 2 + ty) * SEQ * 64;
    const float* w3 = p.in.hy_f_w3 + (size_t)l * 64 * 2048;
    const float* skip = p.in.hy_skip + l * 2 * 512;
    bf16* G = ty ? p.w.gc() : (p.w.gl() + (size_t)l * 2 * HYW * GSTR_L);
    __syncthreads();
    for (int i = tid; i < 2 * 32 * 64; i += 512) {
      const int dir = i >> 11, cc = (i >> 6) & 31, j = i & 63;
      const int oc = cg * 32 + cc, o = oc >> 9, c = oc & 511;
      wl[i] = w3[(size_t)j * 2048 + o * 1024 + dir * 512 + c];
    }
    __syncthreads();
    const int i = ib * 512 + tid;
    const int dd = i - (L - 1);
    const int t = dd < 0 ? -dd : dd;
    const bool inr = i < 2 * L - 1;
    const int dir = dd > 0 ? 1 : 0;
    float hr[64];
    {
      const float* hp = hid + (size_t)(inr ? t : 0) * 64;
#pragma unroll
      for (int j = 0; j < 16; ++j) { const f32x4 v = *(const f32x4*)(hp + 4 * j); hr[4 * j] = v.x; hr[4 * j + 1] = v.y; hr[4 * j + 2] = v.z; hr[4 * j + 3] = v.w; }
    }
    const float tn = (float)t / (float)(L - 1);
#pragma unroll 1
    for (int cc = 0; cc < 32; ++cc) {
      const int oc = cg * 32 + cc, o = oc >> 9, c = oc & 511;
      const float* wc = wl + (dir * 32 + cc) * 64;
      float s = 0.f;
#pragma unroll
      for (int j = 0; j < 16; ++j) { const f32x4 wv = *(const f32x4*)(wc + 4 * j); s += hr[4 * j] * wv.x + hr[4 * j + 1] * wv.y + hr[4 * j + 2] * wv.z + hr[4 * j + 3] * wv.w; }
      if (dd == 0) {
        const float* wc1 = wl + (32 + cc) * 64;
        float s1 = 0.f;
#pragma unroll
        for (int j = 0; j < 16; ++j) { const f32x4 wv = *(const f32x4*)(wc1 + 4 * j); s1 += hr[4 * j] * wv.x + hr[4 * j + 1] * wv.y + hr[4 * j + 2] * wv.z + hr[4 * j + 3] * wv.w; }
        s += s1;
      }
      const float delta = HY_MIN_DECAY + (float)c * ((HY_MAX_DECAY - HY_MIN_DECAY) / 511.0f);
      float val = s * __expf(-tn * delta);
      if (dd == 0) val += skip[o * 512 + c];
      if (!inr) val = 0.f;
      G[(size_t)oc * gstr + i] = f2bf(val);
    }
  }
}

__device__ __forceinline__ void ph_init_norm1(const MP& p, int bid, int nblk) {
  const int lane = tid_opaque() & 63, wave = tid_opaque() >> 6;
  const float* g = p.in.norm1_g;
  for (int it = bid; it * 8 < SEQ; it += nblk) {
    const int t = it * 8 + wave;
    const float rr = (float)(t >> 6), colp = (float)(t & 63);
    f32x4 e[4];
#pragma unroll
    for (int j = 0; j < 4; ++j) {
      float ev[4];
#pragma unroll
      for (int q = 0; q < 4; ++q) {
        const int i = lane * 4 + q;
        const float omega = 1.0f / powf(10000.0f, (float)i / 256.0f);
        const float a = ((j < 2) ? rr : colp) * omega;
        ev[q] = (j & 1) ? cosf(a) : sinf(a);
      }
      e[j] = (f32x4){ev[0], ev[1], ev[2], ev[3]};
    }
    for (int b = 0; b < NB; ++b) {
      const int row = b * SEQ + t;
      f32x4 v[4];
      row_load(p.in.x + (size_t)row * D, lane, v);
#pragma unroll
      for (int j = 0; j < 4; ++j) { v[j] += e[j]; xs_store4(p.w.xs() + (size_t)row * D + j * 256 + lane * 4, v[j]); }
      const float rinv = row_rinv(v, lane);
      const float* mb = p.w.mod() + (size_t)b * 6 * D;
      row_norm_mod_store(v, rinv, g, mb, mb + D, lane, p.w.abuf() + (size_t)row * D, p.w.abuf8() + (size_t)row * D);
    }
  }
  for (int it = bid; it * 8 < NC; it += nblk) {
    const int rc = it * 8 + wave, row = NL + rc;
    f32x4 v[4];
    row_load(p.in.ctx + (size_t)rc * D, lane, v);
#pragma unroll
    for (int j = 0; j < 4; ++j) xs_store4(p.w.xs() + (size_t)row * D + j * 256 + lane * 4, v[j]);
    const float rinv = row_rinv(v, lane);
    const float* mb = p.w.mod() + (size_t)16 * 6 * D;
    row_norm_mod_store(v, rinv, g, mb, mb + D, lane, p.w.abuf() + (size_t)row * D, p.w.abuf8() + (size_t)row * D);
  }
}

__device__ __forceinline__ void ph_mixer(const MP& p, char* smem, int l, bool last, int bid, int nblk) {
  int* qctr = p.w.ctrl() + CTRL_Q + 64 * l;
  int* slot = (int*)(smem + MEGA_LDS_MAIN + 8);
  GlaArgs ga;
  ga.zg = p.w.zg(); ga.wa2 = p.in.gla_wa2 + (size_t)l * 2 * 16 * 256; ga.ba2 = p.in.gla_ba2 + (size_t)l * 2 * 256;
  ga.of = p.w.of(); ga.ob = p.w.ob(); ga.emit_ctx = last ? 0 : 1; ga.pad_ = 0;
  const float* cw = p.in.hy_conv_w + (size_t)l * 3 * HYCOLS;
  const float* cb = p.in.hy_conv_b + (size_t)l * HYCOLS;
  const bf16* gl = p.w.gl() + (size_t)l * 2 * HYW * GSTR_L;
  CvtCtx cx;
  cx.w1 = p.in.exp_w1 + (size_t)l * NE * D * DE; cx.w3 = p.in.exp_w3 + (size_t)l * NE * D * DE; cx.w2 = p.in.exp_w2 + (size_t)l * NE * DE * D;
  cx.d1 = p.w.e1_t(); cx.d3 = p.w.e3_t(); cx.d2 = p.w.e2_t();
  for (;;) {
    __syncthreads();
    if (tid_opaque() == 0) *slot = atomicAdd(qctr, 1);
    __syncthreads();
    const int u = *slot;
    const int nunits = last ? 640 : 1152;
    if (u >= nunits) break;
    if (u < 128) gla_unit(u, ga, smem, cx);
    else if (u < 640) hyena_latent(u - 128, p.w.zt(), cw, cb, gl, p.w.yt(), smem, cx);
    else hyena_ctx(u - 640, p.w.zt() + NL, cw, cb, p.w.gc(), p.w.yt() + NL, smem);
  }
}

__device__ __forceinline__ void ph_gla_out(const MP& p, char* smem, int l, int mrows, int bid, int nblk) {
  const int tid = tid_opaque();
  const int lane = tid & 63, wave = tid >> 6;
  {
    const float* gn = p.in.gla_norm_g + l * 128 + (lane & 15) * 8;
    const f32x4 ga = *(const f32x4*)gn, gb = *(const f32x4*)(gn + 4);
    const bf16* of = p.w.of(); const bf16* ob = p.w.ob(); const bf16* zg = p.w.zg(); bf16* ymix = p.w.ymix();
#pragma unroll 2
    for (int it = bid; it * 8 < mrows; it += nblk) {
      const int row = it * 8 + wave;
      const size_t base = (size_t)row * 512 + lane * 8;
      const u32x4 av = *(const u32x4*)(of + base), bv = *(const u32x4*)(ob + base);
      const f32x4 a0 = {bflo(av.x), bfhi(av.x), bflo(av.y), bfhi(av.y)}, a1 = {bflo(av.z), bfhi(av.z), bflo(av.w), bfhi(av.w)};
      const f32x4 b0 = {bflo(bv.x), bfhi(bv.x), bflo(bv.y), bfhi(bv.y)}, b1 = {bflo(bv.z), bfhi(bv.z), bflo(bv.w), bfhi(bv.w)};
      const u32x4 rv = *(const u32x4*)(zg + (size_t)row * GLACOLS + 1024 + lane * 8);
      const f32x4 o0 = a0 + b0, o1 = a1 + b1;
      float ss = o0.x * o0.x + o0.y * o0.y + o0.z * o0.z + o0.w * o0.w + o1.x * o1.x + o1.y * o1.y + o1.z * o1.z + o1.w * o1.w;
      ss += shx_f(ss, 1, lane); ss += shx_f(ss, 2, lane); ss += shx_f(ss, 4, lane); ss += shx_f(ss, 8, lane);
      const float rinv = rsqrtf(ss * (1.0f / 128.0f) + EPS);
      u32x4 o;
      o.x = pack_bf16(o0.x * rinv * ga.x * silu_f(bflo(rv.x)), o0.y * rinv * ga.y * silu_f(bfhi(rv.x)));
      o.y = pack_bf16(o0.z * rinv * ga.z * silu_f(bflo(rv.y)), o0.w * rinv * ga.w * silu_f(bfhi(rv.y)));
      o.z = pack_bf16(o1.x * rinv * gb.x * silu_f(bflo(rv.z)), o1.y * rinv * gb.y * silu_f(bfhi(rv.z)));
      o.w = pack_bf16(o1.z * rinv * gb.z * silu_f(bflo(rv.w)), o1.w * rinv * gb.w * silu_f(bfhi(rv.w)));
      *(u32x4*)(ymix + (size_t)row * D + 512 + lane * 8) = o;
    }
  }
  {
    const bf16* yt = p.w.yt(); bf16* ymix = p.w.ymix();
    for (int tt = bid; tt * 64 < mrows; tt += nblk) {
      const int tok0 = tt * 64;
      __syncthreads();
#pragma unroll
      for (int i = 0; i < 8; ++i) {
        const int q = tid + i * 512, c = q >> 3, ch = q & 7;
        const u32x4 v = *(const u32x4*)(yt + (size_t)c * NT + tok0 + ch * 8);
        unsigned* d = (unsigned*)(smem + c * 132 + ch * 16);
        d[0] = v.x; d[1] = v.y; d[2] = v.z; d[3] = v.w;
      }
      __syncthreads();
#pragma unroll
      for (int i = 0; i < 8; ++i) {
        const int c8 = wave * 8 + (lane & 7), t = i * 8 + (lane >> 3);
        const unsigned short* s = (const unsigned short*)(smem + (c8 * 8) * 132 + t * 2);
        const unsigned e0 = s[0], e1 = s[66], e2 = s[132], e3 = s[198], e4 = s[264], e5 = s[330], e6 = s[396], e7 = s[462];
        *(u32x4*)(ymix + (size_t)(tok0 + t) * D + c8 * 8) = (u32x4){e0 | (e1 << 16), e2 | (e3 << 16), e4 | (e5 << 16), e6 | (e7 << 16)};
      }
    }
  }
}

__device__ __forceinline__ void ph_norm2(const MP& p, int l, int mrows, int bid, int nblk) {
  const int lane = tid_opaque() & 63, wave = tid_opaque() >> 6;
  const float* g = p.in.norm2_g + l * D;
  const float* modl = p.w.mod() + (size_t)l * 17 * 6 * D;
  for (int it = bid; it * 8 < mrows; it += nblk) {
    const int row = it * 8 + wave;
    f32x4 v[4];
    row_load_xs(p.w.xs() + (size_t)row * D, lane, v);
    const float rinv = row_rinv(v, lane);
    const float* mb = modl + (size_t)row_batch(row) * 6 * D;
    row_norm_mod_store(v, rinv, g, mb + 3 * D, mb + 4 * D, lane, p.w.abuf() + (size_t)row * D, p.w.abuf8() + (size_t)row * D);
  }
}

__device__ __forceinline__ void ph_route(const MP& p, char* smem, int l, int ntok, int bid, int nblk) {
  const int tid = tid_opaque();
  const int lane = tid & 63, wave = tid >> 6;
  const float* rb = p.in.router_b + l * NE;
  int* lcnt = (int*)smem;
  __syncthreads();
  if (tid < NE) lcnt[tid] = 0;
  __syncthreads();
  const f32x4 bb = *(const f32x4*)(rb + lane * 4);
  const int tpb = (ntok + nblk - 1) / nblk;
  for (int it = wave; it < tpb; it += 8) {
    const int tok = bid * tpb + it;
    if (tok >= ntok) break;
    const f32x4 lg = *(const f32x4*)(p.w.logits() + (size_t)tok * NE + lane * 4);
    const float s0 = sigmoid_f(lg.x), s1 = sigmoid_f(lg.y), s2 = sigmoid_f(lg.z), s3 = sigmoid_f(lg.w);
    const float v0 = s0 + bb.x, v1 = s1 + bb.y, v2 = s2 + bb.z, v3 = s3 + bb.w;
    float m1 = fmaxf(v0, v1), m2 = fminf(v0, v1);
    { float n1 = fmaxf(m1, v2); float n2 = fmaxf(fminf(m1, v2), m2); m1 = n1; m2 = n2; }
    { float n1 = fmaxf(m1, v3); float n2 = fmaxf(fminf(m1, v3), m2); m1 = n1; m2 = n2; }
#pragma unroll
    for (int o = 1; o <= 4; o <<= 1) {
      float a1 = shx_f(m1, o, lane), a2 = shx_f(m2, o, lane);
      float n1 = fmaxf(m1, a1);
      float n2 = fmaxf(fminf(m1, a1), fmaxf(m2, a2));
      m1 = n1; m2 = n2;
    }
    const float gs = m1 + m2;
    const int g = lane >> 3;
    int rank = 0;
#pragma unroll
    for (int gg = 0; gg < 8; ++gg) {
      const float og = __int_as_float(__builtin_amdgcn_readlane(__float_as_int(gs), gg * 8));
      rank += (og > gs || (og == gs && gg < g)) ? 1 : 0;
    }
    unsigned k0, k1, k2, k3;
    {
      const bool sel = rank < 4;
      unsigned u;
      u = __float_as_uint(v0); u = (u & 0x80000000u) ? ~u : (u | 0x80000000u); k0 = sel ? ((u & 0xffffff00u) | (unsigned)(255 - (lane * 4 + 0))) : 0u;
      u = __float_as_uint(v1); u = (u & 0x80000000u) ? ~u : (u | 0x80000000u); k1 = sel ? ((u & 0xffffff00u) | (unsigned)(255 - (lane * 4 + 1))) : 0u;
      u = __float_as_uint(v2); u = (u & 0x80000000u) ? ~u : (u | 0x80000000u); k2 = sel ? ((u & 0xffffff00u) | (unsigned)(255 - (lane * 4 + 2))) : 0u;
      u = __float_as_uint(v3); u = (u & 0x80000000u) ? ~u : (u | 0x80000000u); k3 = sel ? ((u & 0xffffff00u) | (unsigned)(255 - (lane * 4 + 3))) : 0u;
    }
    float gsum = 0.f, myg = 0.f; int mye = 0;
#pragma unroll
    for (int k = 0; k < TOPK; ++k) {
      unsigned m = max(max(k0, k1), max(k2, k3));
      m = max(m, (unsigned)__builtin_amdgcn_update_dpp(0, (int)m, 0x111, 0xf, 0xf, false));
      m = max(m, (unsigned)__builtin_amdgcn_update_dpp(0, (int)m, 0x112, 0xf, 0xf, false));
      m = max(m, (unsigned)__builtin_amdgcn_update_dpp(0, (int)m, 0x114, 0xf, 0xf, false));
      m = max(m, (unsigned)__builtin_amdgcn_update_dpp(0, (int)m, 0x118, 0xf, 0xf, false));
      m = max(m, (unsigned)__builtin_amdgcn_update_dpp(0, (int)m, 0x142, 0xa, 0xf, false));
      m = max(m, (unsigned)__builtin_amdgcn_update_dpp(0, (int)m, 0x143, 0xc, 0xf, false));
      const unsigned wk = (unsigned)__builtin_amdgcn_readlane((int)m, 63);
      const int we = 255 - (int)(wk & 255u);
      const int wl = we >> 2, wi = we & 3;
      const float sv = __int_as_float(__builtin_amdgcn_readlane(__float_as_int(wi == 0 ? s0 : wi == 1 ? s1 : wi == 2 ? s2 : s3), wl));
      if (lane == wl) { if (wi == 0) k0 = 0u; else if (wi == 1) k1 = 0u; else if (wi == 2) k2 = 0u; else k3 = 0u; }
      gsum += sv;
      if (lane == k) { myg = sv; mye = we; }
    }
    if (lane < TOPK) {
      p.w.tok_e()[tok * TOPK + lane] = mye;
      p.w.tok_gate()[tok * TOPK + lane] = myg / gsum * 2.5f;
      atomicAdd(&lcnt[mye], 1);
    }
  }
  __syncthreads();
  if (tid < NE) p.w.blkcnt()[bid * NE + tid] = lcnt[tid];
}

__device__ __forceinline__ void ph_assign(const MP& p, char* smem, int l, int ntok, int bid, int nblk) {
  const int tid = tid_opaque();
  int* ps = (int*)smem;
  int* cur = (int*)smem + 512;
  __syncthreads();
  int* part = (int*)smem + 1024;
  {
    const int eg = tid & 63, bg = tid >> 6;
    const int per = (nblk + 7) >> 3;
    int t0 = 0, t1 = 0, t2 = 0, t3 = 0, b0 = 0, b1 = 0, b2 = 0, b3 = 0;
    const int* src = p.w.blkcnt() + eg * 4;
#pragma unroll 8
    for (int i = 0; i < per; ++i) {
      const int b = bg * per + i;
      if (b < nblk) {
        const u32x4 v = *(const u32x4*)(src + (size_t)b * NE);
        t0 += (int)v.x; t1 += (int)v.y; t2 += (int)v.z; t3 += (int)v.w;
        if (b < bid) { b0 += (int)v.x; b1 += (int)v.y; b2 += (int)v.z; b3 += (int)v.w; }
      }
    }
    int* pt = part + bg * 512 + eg * 4;
    pt[0] = t0; pt[1] = t1; pt[2] = t2; pt[3] = t3;
    pt[256] = b0; pt[257] = b1; pt[258] = b2; pt[259] = b3;
  }
  __syncthreads();
  int before = 0;
  if (tid < NE) {
    int tot = 0;
#pragma unroll
    for (int g = 0; g < 8; ++g) { tot += part[g * 512 + tid]; before += part[g * 512 + 256 + tid]; }
    const int pc = (tot + 255) & ~255;
    const int lane = tid & 63;
    int inc = pc;
#pragma unroll
    for (int o = 1; o < 64; o <<= 1) { const int n = shl_i(inc, lane - o); if (lane >= o) inc += n; }
    ps[tid + 1] = inc;
    if (lane == 63) cur[tid >> 6] = inc;
  }
  __syncthreads();
  if (tid < NE) {
    const int w = tid >> 6;
    int offs = 0;
#pragma unroll
    for (int k = 0; k < 3; ++k) offs += (k < w) ? cur[k] : 0;
    ps[tid + 1] += offs;
    if (tid == 0) ps[0] = 0;
  }
  __syncthreads();
  if (tid < NE) {
    unsigned short* te = (unsigned short*)(smem + LDS_TILE_E);
    for (int t = ps[tid] >> 8; t < (ps[tid + 1] >> 8); ++t) te[t] = (unsigned short)tid;
  }
  if (tid < NE) cur[tid] = ps[tid] + before;
  if (bid == 0 && tid <= NE) p.w.pad_start()[tid] = ps[tid];
  __syncthreads();
  const int tpb = (ntok + nblk - 1) / nblk;
  for (int i = tid; i < tpb * TOPK; i += 512) {
    const int gi = bid * tpb * TOPK + i;
    if (gi >= ntok * TOPK) break;
    const int e = p.w.tok_e()[gi];
    const int slot = atomicAdd(&cur[e], 1);
    p.w.slot_tok()[slot] = gi >> 3;
    p.w.tok_slot()[gi] = slot;
  }
}

__device__ __forceinline__ void ph_combine(const MP& p, int l, int mrows, bool last, int bid, int nblk) {
  const int lane = tid_opaque() & 63, wave = tid_opaque() >> 6;
  const float* modl = p.w.mod() + (size_t)l * 17 * 6 * D;
  for (int it = bid; it * 8 < mrows; it += nblk) {
    const int row = it * 8 + wave;
    const int b = row_batch(row);
    f32x4 v[4], acc[4];
    row_load_xs(p.w.xs() + (size_t)row * D, lane, v);
#pragma unroll
    for (int j = 0; j < 4; ++j) acc[j] = (f32x4){0.f, 0.f, 0.f, 0.f};
    int sl = 0; float gt = 0.f;
    if (lane < TOPK) { sl = p.w.tok_slot()[row * TOPK + lane]; gt = p.w.tok_gate()[row * TOPK + lane]; }
#pragma unroll
    for (int k = 0; k < TOPK; ++k) {
      const int s = shl_i(sl, k);
      const float gk = shl_f(gt, k);
      const unsigned char* yr = p.w.ybuf() + (size_t)s * D + lane * 4;
#pragma unroll
      for (int j = 0; j < 4; ++j) {
        const int y = *(const int*)(yr + j * 256);
        const f32x2v lo = __builtin_amdgcn_cvt_pk_f32_fp8(y, false), hi = __builtin_amdgcn_cvt_pk_f32_fp8(y, true);
        acc[j].x += gk * lo.x; acc[j].y += gk * lo.y; acc[j].z += gk * hi.x; acc[j].w += gk * hi.y;
      }
    }
    {
      const unsigned char* yr = p.w.ysh() + (size_t)row * D + lane * 4;
#pragma unroll
      for (int j = 0; j < 4; ++j) {
        const int y = *(const int*)(yr + j * 256);
        const f32x2v lo = __builtin_amdgcn_cvt_pk_f32_fp8(y, false), hi = __builtin_amdgcn_cvt_pk_f32_fp8(y, true);
        acc[j].x += lo.x; acc[j].y += lo.y; acc[j].z += hi.x; acc[j].w += hi.y;
      }
    }
    const float* g2 = modl + (size_t)b * 6 * D + 5 * D;
#pragma unroll
    for (int j = 0; j < 4; ++j) {
      const f32x4 gv = *(const f32x4*)(g2 + j * 256 + lane * 4);
      v[j] += gv * acc[j];
    }
    const float rinv = row_rinv(v, lane);
    if (last) {
#pragma unroll
      for (int j = 0; j < 4; ++j) {
        const f32x4 fg = *(const f32x4*)(p.in.final_g + j * 256 + lane * 4);
        *(f32x4*)(p.out + (size_t)row * D + j * 256 + lane * 4) = v[j] * rinv * fg;
      }
    } else {
#pragma unroll
      for (int j = 0; j < 4; ++j) xs_store4(p.w.xs() + (size_t)row * D + j * 256 + lane * 4, v[j]);
      const float* mb = p.w.mod() + ((size_t)(l + 1) * 17 + b) * 6 * D;
      row_norm_mod_store(v, rinv, p.in.norm1_g + (l + 1) * D, mb, mb + D, lane, p.w.abuf() + (size_t)row * D, p.w.abuf8() + (size_t)row * D);
    }
  }
}

__global__ void __launch_bounds__(512, 2) k_mega(MP p) {
  extern __shared__ __attribute__((aligned(16))) char smem[];
  const int bid = blockIdx.x, nblk = gridDim.x;
  if (tid_opaque() == 0) *(u32x4*)(smem + MEGA_LDS_MAIN) = (u32x4){0u, 0u, 0u, 0u};
  __syncthreads();
  (void)xcd_barrier_post(p.w.bar(), (volatile LAS unsigned*)(smem + MEGA_LDS_MAIN));

  if (threadIdx.x == 0) {
    const unsigned xcc = xb_xcc_id();
    const int rank = atomicAdd(&p.w.ctrl()[CTRL_XR + 16 * xcc], 1);
    *(int*)(smem + MEGA_LDS_MAIN + 12) = rank;
  }
  ph_mod_hid(p, smem, bid, nblk);
  cvt_job(p.in.w_in, p.w.w_in_t(), D, INCOLS, 1, bid, nblk, HYCOLS);
  cvt_job(p.in.w_in + (size_t)D * INCOLS, p.w.w_in_t() + (size_t)WIN_ROWS * D, D, INCOLS, 1, bid, nblk, HYCOLS);
  cvt8_job(p.in.w_in + HYCOLS, p.w.w_g8(), D, INCOLS, 1, bid, nblk, GLACOLS);
  cvt8_job(p.in.w_in + (size_t)D * INCOLS + HYCOLS, p.w.w_g8() + (size_t)GW_ROWS * D, D, INCOLS, 1, bid, nblk, GLACOLS);
  cvt_job(p.in.w_out, p.w.w_out_t(), D, D, DEPTH, bid, nblk);
  cvt_job(p.in.router_w, p.w.router_t(), D, NE, DEPTH, bid, nblk);
  cvt8_job(p.in.sh_w1, p.w.sh1_t(), D, DE, DEPTH, bid, nblk);
  cvt8_job(p.in.sh_w3, p.w.sh3_t(), D, DE, DEPTH, bid, nblk);
  cvt8_job(p.in.sh_w2, p.w.sh2_t(), DE, D, DEPTH, bid, nblk);
  grid_sync(p.w.bar(), smem + MEGA_LDS_MAIN);
  int vb = bid;
  {
    const int rank = *(const int*)(smem + MEGA_LDS_MAIN + 12);
    const unsigned xcc = xb_xcc_id();
    int npop = 0, xidx = 0, cnt0 = -1; bool equal = true;
    for (int j = 0; j < 16; ++j) {
      const int c = p.w.ctrl()[CTRL_XR + 16 * j];
      if (c > 0) {
        if (cnt0 < 0) cnt0 = c; else if (c != cnt0) equal = false;
        if (j < (int)xcc) ++xidx;
        ++npop;
      }
    }
    if (equal && cnt0 > 0 && npop * cnt0 == nblk && rank < cnt0) vb = xidx * cnt0 + rank;
  }
  ph_gtab(p, smem, bid, nblk);
  ph_init_norm1(p, bid, nblk);
  grid_sync(p.w.bar(), smem + MEGA_LDS_MAIN);

  const int vbu = __builtin_amdgcn_readfirstlane(vb);
#pragma unroll 1
  for (int l0 = 0; l0 < DEPTH; ++l0) {
#define LL opq(l0)
    const bool last = (l0 == DEPTH - 1);
    const int mrows = last ? NL : NT;
#define MODL (p.w.mod() + (size_t)LL * 17 * 6 * D)
    {
      G8InZT g; g.wt = p.w.w_in_t() + (size_t)LL * WIN_ROWS * D; g.A = p.w.abuf(); g.zt = p.w.zt(); g.ntok = last ? NL : NT;
      gemm8_run(g, smem, opq(vbu), nblk);
    }
    {
      G8InG g; g.wt = p.w.w_g8() + (size_t)LL * GW_ROWS * D; g.A = p.w.abuf8(); g.zg = p.w.zg();
      gemm8_run(g, smem, opq(vbu), nblk);
    }
    grid_sync(p.w.bar(), smem + MEGA_LDS_MAIN);
    ph_mixer(p, smem, LL, last, opq(bid), nblk);
    grid_sync(p.w.bar(), smem + MEGA_LDS_MAIN);
    ph_gla_out(p, smem, LL, mrows, opq(bid), nblk);
    grid_sync(p.w.bar(), smem + MEGA_LDS_MAIN);
    {
      G8Out g; g.mrows = mrows; g.ymix = p.w.ymix(); g.wt = p.w.w_out_t() + (size_t)LL * D * D; g.modl = MODL; g.xs = p.w.xs();
      gemm8_run(g, smem, opq(vbu), nblk);
    }
    grid_sync(p.w.bar(), smem + MEGA_LDS_MAIN);
    ph_norm2(p, LL, mrows, opq(bid), nblk);
    grid_sync(p.w.bar(), smem + MEGA_LDS_MAIN);
    {
      G8Router g; g.mrows = mrows; g.A = p.w.abuf(); g.rwt = p.w.router_t() + (size_t)LL * NE * D; g.logits = p.w.logits();
      gemm8_run(g, smem, opq(vbu), nblk);
    }
    {
      G8ShUp g; g.mrows = mrows; g.A8 = p.w.abuf8(); g.s1t = p.w.sh1_t() + (size_t)LL * DE * D; g.s3t = p.w.sh3_t() + (size_t)LL * DE * D; g.hs = p.w.hs();
      int rid = vbu - (mrows >> 8) % nblk; rid += rid < 0 ? nblk : 0;
      gemm8_run(g, smem, opq(rid), nblk);
    }
    grid_sync(p.w.bar(), smem + MEGA_LDS_MAIN);
    ph_route(p, smem, LL, mrows, opq(bid), nblk);
    grid_sync(p.w.bar(), smem + MEGA_LDS_MAIN);
    ph_assign(p, smem, LL, mrows, opq(bid), nblk);
    grid_sync(p.w.bar(), smem + MEGA_LDS_MAIN);
    {
      G8Up g; g.A8 = p.w.abuf8(); g.slot_tok = p.w.slot_tok(); g.pad_start = p.w.pad_start(); g.w1t = p.w.e1_t(); g.w3t = p.w.e3_t(); g.H = p.w.hbuf(); g.tile_e = (const unsigned short*)(smem + LDS_TILE_E);
      gemm8_run(g, smem, opq(vbu), nblk);
    }
    {
      G8ShDown g; g.mrows = mrows; g.hs = p.w.hs(); g.wt = p.w.sh2_t() + (size_t)LL * D * DE; g.ysh = p.w.ysh();
      int rid = vbu - __builtin_amdgcn_readfirstlane(((p.w.pad_start()[NE] >> 8) * 2) % nblk); rid += rid < 0 ? nblk : 0;
      gemm8_run(g, smem, opq(rid), nblk);
    }
    grid_sync(p.w.bar(), smem + MEGA_LDS_MAIN);
    {
      G8Down g; g.H = p.w.hbuf(); g.pad_start = p.w.pad_start(); g.w2t = p.w.e2_t(); g.Y = p.w.ybuf(); g.tile_e = (const unsigned short*)(smem + LDS_TILE_E);
      gemm8_run(g, smem, opq(vbu), nblk);
    }
    grid_sync(p.w.bar(), smem + MEGA_LDS_MAIN);
    ph_combine(p, LL, mrows, last, opq(bid), nblk);
    if (!last) grid_sync(p.w.bar(), smem + MEGA_LDS_MAIN);
  }
#undef LL
#undef MODL
}

static inline size_t align_up(size_t v, size_t a) { return (v + a - 1) / a * a; }

extern "C" void kernel_launch(void* const* d_in, const int* in_sizes, int n_in, void* d_out, int out_size, void* d_ws,
                              size_t ws_size, hipStream_t stream) {
  MP p;
  memset(&p, 0, sizeof(p));
  const float** ip = (const float**)&p.in;
  for (int i = 0; i < 30; ++i) ip[i] = (const float*)d_in[i];
  p.out = (float*)d_out;

  p.w.b = (char*)d_ws;
  const size_t zero_bytes = wso::zero_end;
  (void)ws_size; (void)n_in; (void)in_sizes; (void)out_size;

  static int grid = 0;
  if (!grid) {
    hipFuncSetAttribute((const void*)k_mega, hipFuncAttributeMaxDynamicSharedMemorySize, MEGA_LDS);
    int dev = 0, cus = 0, per_cu = 0;
    hipGetDevice(&dev);
    hipDeviceGetAttribute(&cus, hipDeviceAttributeMultiprocessorCount, dev);
    hipOccupancyMaxActiveBlocksPerMultiprocessor(&per_cu, k_mega, 512, MEGA_LDS);
    if (cus <= 0) cus = 256;
    grid = per_cu >= 1 ? cus : 0;
    if (grid <= 0) grid = 256;
  }
  hipMemsetAsync(d_ws, 0, zero_bytes, stream);
  hipLaunchKernelGGL(k_mega, dim3(grid), dim3(512), MEGA_LDS, stream, p);
}
```
